# Optimizing an MI355X kernel written in HIP

```python
import jax, jax.numpy as jnp
from jax import lax
import numpy as np

D_MODEL = 1024
BATCH = 2
SEQ = 8192
DEPTH = 2

N_A_LAYERS = DEPTH // 2
N_B_LAYERS = DEPTH - N_A_LAYERS

SSM_EXPAND = 2
D_INNER = SSM_EXPAND * D_MODEL
SSM_HEAD_DIM = 64
SSM_HEADS = D_INNER // SSM_HEAD_DIM
SSM_GROUPS = 4
SSM_STATE = 128
CONV_WIDTH = 4
CHUNK = 256
CONV_DIM = D_INNER + 2 * SSM_GROUPS * SSM_STATE
SSM_IN_DIM = D_INNER + CONV_DIM + SSM_HEADS

MLA_HEADS = 16
QK_NOPE = 64
QK_ROPE = 32
V_HEAD = 64
Q_LORA = 384
KV_LORA = 256
ROPE_BASE = 10000.0
Q_BLOCK = 128
MLA_IN_DIM = Q_LORA + MLA_HEADS * V_HEAD

EPS = 1e-6

kernel_name = "yoco_mamba2_mla_hybrid"


def rms_norm(x, g):
    xf = x.astype(jnp.float32)
    y = xf * lax.rsqrt(jnp.mean(xf * xf, axis=-1, keepdims=True) + EPS)
    return (y * g.astype(jnp.float32)).astype(x.dtype)


def rope_tables(positions):
    inv = ROPE_BASE ** (-jnp.arange(0, QK_ROPE, 2, dtype=jnp.float32) / QK_ROPE)
    ang = positions.astype(jnp.float32)[..., None] * inv
    return jnp.cos(ang), jnp.sin(ang)


def apply_rope(x, cos, sin):
    x1, x2 = jnp.split(x.astype(jnp.float32), 2, axis=-1)
    out = jnp.concatenate([x1 * cos - x2 * sin, x1 * sin + x2 * cos], axis=-1)
    return out.astype(x.dtype)


def causal_depthwise_conv(u, w, b):
    K = w.shape[0]
    S = u.shape[1]
    up = jnp.pad(u, ((0, 0), (K - 1, 0), (0, 0)))
    out = b
    for k in range(K):
        out = out + up[:, k:k + S, :] * w[k]
    return out


def ssd_chunked_scan(xh, dt, A, Bm, Cm):
    Bsz, S, H, P = xh.shape
    G, N = Bm.shape[2], Bm.shape[3]
    Hg = H // G
    nc = -(-S // CHUNK)
    pad = nc * CHUNK - S

    def chunkify(t):
        t = jnp.pad(t, [(0, 0), (0, pad)] + [(0, 0)] * (t.ndim - 2))
        t = t.reshape((Bsz, nc, CHUNK) + t.shape[2:])
        return jnp.moveaxis(t, 1, 0)

    xc = chunkify(xh.reshape(Bsz, S, G, Hg, P))
    dtc = chunkify(dt.reshape(Bsz, S, G, Hg))
    Bc = chunkify(Bm)
    Cc = chunkify(Cm)
    A_g = A.reshape(G, Hg)
    causal = jnp.tril(jnp.ones((CHUNK, CHUNK), dtype=bool))[None, :, :, None, None]

    def step(state, inp):
        x_c, dt_c, B_c, C_c = inp
        cum = jnp.cumsum(dt_c * A_g, axis=1)
        seg = cum[:, :, None] - cum[:, None, :]
        L = jnp.exp(jnp.where(causal, seg, -jnp.inf))
        CB = jnp.einsum('btgn,bsgn->btsg', C_c, B_c)
        y_intra = jnp.einsum('btsg,btsgh,bsgh,bsghp->btghp', CB, L, dt_c, x_c)
        y_inter = jnp.einsum('btgn,bghpn,btgh->btghp', C_c, state, jnp.exp(cum))
        w_end = jnp.exp(cum[:, -1:] - cum) * dt_c
        new_state = state * jnp.exp(cum[:, -1])[..., None, None] + \
            jnp.einsum('bsgn,bsgh,bsghp->bghpn', B_c, w_end, x_c)
        return new_state, y_intra + y_inter

    state0 = jnp.zeros((Bsz, G, Hg, P, N), jnp.float32)
    _, yc = lax.scan(step, state0, (xc, dtc, Bc, Cc))
    return jnp.moveaxis(yc, 0, 1).reshape(Bsz, nc * CHUNK, H, P)[:, :S]


def mamba2_mixer(h, w_in, conv_w, conv_b, dt_bias, A_log, D_skip, g_out, w_out):
    Bsz, S, _ = h.shape
    proj = h @ w_in
    z, xBC, dt_raw = jnp.split(proj, [D_INNER, D_INNER + CONV_DIM], axis=-1)
    xBC = jax.nn.silu(causal_depthwise_conv(xBC, conv_w, conv_b))
    xs, Bm, Cm = jnp.split(xBC, [D_INNER, D_INNER + SSM_GROUPS * SSM_STATE], axis=-1)
    dt = jax.nn.softplus((dt_raw + dt_bias).astype(jnp.float32))
    A = -jnp.exp(A_log.astype(jnp.float32))
    xh = xs.reshape(Bsz, S, SSM_HEADS, SSM_HEAD_DIM).astype(jnp.float32)
    y = ssd_chunked_scan(
        xh, dt, A,
        Bm.reshape(Bsz, S, SSM_GROUPS, SSM_STATE).astype(jnp.float32),
        Cm.reshape(Bsz, S, SSM_GROUPS, SSM_STATE).astype(jnp.float32))
    y = y + D_skip.astype(jnp.float32)[:, None] * xh
    y = y.reshape(Bsz, S, D_INNER) * jax.nn.silu(z.astype(jnp.float32))
    y = y.reshape(Bsz, S, SSM_GROUPS, D_INNER // SSM_GROUPS)
    y = y * lax.rsqrt(jnp.mean(y * y, axis=-1, keepdims=True) + EPS)
    y = y.reshape(Bsz, S, D_INNER) * g_out.astype(jnp.float32)
    return y.astype(h.dtype) @ w_out


def mla_shared_kv(h, g_kv_in, w_dkv, g_ckv, w_ukv, cos, sin):
    Bsz, S, _ = h.shape
    hn = rms_norm(h, g_kv_in)
    ckv, k_rope = jnp.split(hn @ w_dkv, [KV_LORA], axis=-1)
    ckv = rms_norm(ckv, g_ckv)
    kv = (ckv @ w_ukv).reshape(Bsz, S, MLA_HEADS, QK_NOPE + V_HEAD)
    k_nope, v = jnp.split(kv, [QK_NOPE], axis=-1)
    k_rope = apply_rope(k_rope, cos, sin)
    return k_nope, k_rope, v


def causal_block_attention(q_nope, q_rope, k_nope, k_rope, v):
    S = q_nope.shape[1]
    scale = (QK_NOPE + QK_ROPE) ** -0.5
    local = jnp.arange(Q_BLOCK)
    outs = []
    for i in range(S // Q_BLOCK):
        q0 = i * Q_BLOCK
        kv_len = q0 + Q_BLOCK
        s = jnp.einsum('bqhd,bkhd->bhqk', q_nope[:, q0:kv_len], k_nope[:, :kv_len]) + \
            jnp.einsum('bqhr,bkr->bhqk', q_rope[:, q0:kv_len], k_rope[:, :kv_len])
        s = s.astype(jnp.float32) * scale
        mask = (q0 + local)[:, None] >= jnp.arange(kv_len)[None, :]
        p = jax.nn.softmax(jnp.where(mask, s, -jnp.inf), axis=-1).astype(v.dtype)
        outs.append(jnp.einsum('bhqk,bkhd->bqhd', p, v[:, :kv_len]))
    return jnp.concatenate(outs, axis=1)


def mla_mixer(h, k_nope, k_rope, v, cos, sin, w_in, g_q, w_uq, w_out):
    Bsz, S, _ = h.shape
    cq, gate = jnp.split(h @ w_in, [Q_LORA], axis=-1)
    q = (rms_norm(cq, g_q) @ w_uq).reshape(Bsz, S, MLA_HEADS, QK_NOPE + QK_ROPE)
    q_nope, q_rope = jnp.split(q, [QK_NOPE], axis=-1)
    q_rope = apply_rope(q_rope, cos[:, :, None, :], sin[:, :, None, :])
    o = causal_block_attention(q_nope, q_rope, k_nope, k_rope, v)
    o = o.reshape(Bsz, S, MLA_HEADS * V_HEAD) * jax.nn.silu(gate)
    return o @ w_out


def setup_inputs(seed: int = 0) -> dict:
    key = jax.random.key(seed)
    ks = jax.random.split(key, 24)
    f32 = jnp.float32

    def nrm(k, shape, fan_in):
        return jax.random.normal(k, shape, f32) * (fan_in ** -0.5)

    def gain(k, shape):
        return 1.0 + 0.01 * jax.random.normal(k, shape, f32)

    x = jax.random.normal(ks[0], (BATCH, SEQ, D_MODEL), f32)
    offset = jax.random.randint(ks[1], (BATCH, 1), 0, 4096, dtype=jnp.int32)
    positions = offset + jnp.arange(SEQ, dtype=jnp.int32)[None, :]

    g_pre = gain(ks[2], (DEPTH, D_MODEL))
    ssm_w_in = nrm(ks[3], (N_A_LAYERS, D_MODEL, SSM_IN_DIM), D_MODEL)
    ssm_conv_w = nrm(ks[4], (N_A_LAYERS, CONV_WIDTH, CONV_DIM), CONV_WIDTH)
    ssm_conv_b = 0.01 * jax.random.normal(ks[5], (N_A_LAYERS, CONV_DIM), f32)
    dt0 = jnp.exp(jax.random.uniform(ks[6], (N_A_LAYERS, SSM_HEADS), f32,
                                     np.log(1e-3), np.log(1e-1)))
    ssm_dt_bias = dt0 + jnp.log(-jnp.expm1(-dt0))
    ssm_A_log = jnp.log(jax.random.uniform(ks[7], (N_A_LAYERS, SSM_HEADS), f32, 1.0, 16.0))
    ssm_D = 1.0 + 0.1 * jax.random.normal(ks[8], (N_A_LAYERS, SSM_HEADS), f32)
    ssm_g_out = gain(ks[9], (N_A_LAYERS, D_INNER))
    ssm_w_out = nrm(ks[10], (N_A_LAYERS, D_INNER, D_MODEL), D_INNER)
    kv_g_in = gain(ks[11], (D_MODEL,))
    kv_w_down = nrm(ks[12], (D_MODEL, KV_LORA + QK_ROPE), D_MODEL)
    kv_g_latent = gain(ks[13], (KV_LORA,))
    kv_w_up = nrm(ks[14], (KV_LORA, MLA_HEADS * (QK_NOPE + V_HEAD)), KV_LORA)
    mla_w_in = nrm(ks[15], (N_B_LAYERS, D_MODEL, MLA_IN_DIM), D_MODEL)
    mla_g_q = gain(ks[16], (N_B_LAYERS, Q_LORA))
    mla_w_uq = nrm(ks[17], (N_B_LAYERS, Q_LORA, MLA_HEADS * (QK_NOPE + QK_ROPE)), Q_LORA)
    mla_w_out = nrm(ks[18], (N_B_LAYERS, MLA_HEADS * V_HEAD, D_MODEL), MLA_HEADS * V_HEAD)
    g_final = gain(ks[19], (D_MODEL,))
    return {
        'x': x, 'positions': positions, 'g_pre': g_pre,
        'ssm_w_in': ssm_w_in, 'ssm_conv_w': ssm_conv_w, 'ssm_conv_b': ssm_conv_b,
        'ssm_dt_bias': ssm_dt_bias, 'ssm_A_log': ssm_A_log, 'ssm_D': ssm_D,
        'ssm_g_out': ssm_g_out, 'ssm_w_out': ssm_w_out,
        'kv_g_in': kv_g_in, 'kv_w_down': kv_w_down, 'kv_g_latent': kv_g_latent, 'kv_w_up': kv_w_up,
        'mla_w_in': mla_w_in, 'mla_g_q': mla_g_q, 'mla_w_uq': mla_w_uq, 'mla_w_out': mla_w_out,
        'g_final': g_final,
    }


def reference(x, positions, g_pre, ssm_w_in, ssm_conv_w, ssm_conv_b, ssm_dt_bias, ssm_A_log,
              ssm_D, ssm_g_out, ssm_w_out, kv_g_in, kv_w_down, kv_g_latent, kv_w_up,
              mla_w_in, mla_g_q, mla_w_uq, mla_w_out, g_final):
    cos, sin = rope_tables(positions)
    h = x
    shared_kv = None
    for l in range(DEPTH):
        hn = rms_norm(h, g_pre[l])
        if l < N_A_LAYERS:
            h = h + mamba2_mixer(hn, ssm_w_in[l], ssm_conv_w[l], ssm_conv_b[l], ssm_dt_bias[l],
                                 ssm_A_log[l], ssm_D[l], ssm_g_out[l], ssm_w_out[l])
        else:
            if shared_kv is None:
                shared_kv = mla_shared_kv(h, kv_g_in, kv_w_down, kv_g_latent, kv_w_up, cos, sin)
            k_nope, k_rope, v = shared_kv
            j = l - N_A_LAYERS
            h = h + mla_mixer(hn, k_nope, k_rope, v, cos, sin,
                              mla_w_in[j], mla_g_q[j], mla_w_uq[j], mla_w_out[j])
    return rms_norm(h, g_final)
```

```cpp
#include <hip/hip_runtime.h>
#include <hip/hip_cooperative_groups.h>
#include <cstdio>
#include <cstdint>
namespace cg = cooperative_groups;

typedef unsigned short bf16_t;
typedef short bf16x8 __attribute__((ext_vector_type(8)));
typedef float f32x16 __attribute__((ext_vector_type(16)));
#define DI __device__ __forceinline__
#define MFMA32(a, b, c) __builtin_amdgcn_mfma_f32_32x32x16_bf16((a), (b), (c), 0, 0, 0)

constexpr int T = 16384, SEQ = 8192, DM = 1024;
constexpr int NTHREADS = 512;
constexpr size_t MiB = 1024 * 1024;
constexpr size_t OFF_W1 = 0;
constexpr size_t OFF_W2 = OFF_W1 + (size_t)5376 * 1024 * 2;
constexpr size_t OFF_W3 = OFF_W2 + (size_t)1024 * 2048 * 2;
constexpr size_t OFF_W4 = OFF_W3 + (size_t)1792 * 1024 * 2;
constexpr size_t OFF_W5 = OFF_W4 + (size_t)2048 * 256 * 2;
constexpr size_t OFF_W6 = OFF_W5 + (size_t)1536 * 384 * 2;
constexpr size_t OFF_XN = 24 * MiB;
constexpr size_t OFF_XT = 56 * MiB;
constexpr size_t OFF_BT = 120 * MiB;
constexpr size_t OFF_BR = 136 * MiB;
constexpr size_t OFF_CR = 152 * MiB;
constexpr size_t OFF_DT = 168 * MiB;
constexpr size_t OFF_ST = 170 * MiB;
constexpr size_t OFF_DEC = 234 * MiB;
constexpr size_t OFF_BAR = 236 * MiB;
constexpr size_t OFF_COS = 238 * MiB;
constexpr size_t OFF_SIN = 239 * MiB;
constexpr size_t OFF_SSQ = 240 * MiB;
constexpr size_t WS_NEED = 241 * MiB;

struct Params {
  const float* x; const int* pos; const float* g_pre; const float* ssm_w_in; const float* conv_w; const float* conv_b;
  const float* dt_bias; const float* A_log; const float* Dskip; const float* g_out; const float* ssm_w_out;
  const float* kv_g_in; const float* kv_w_down; const float* kv_g_lat; const float* kv_w_up;
  const float* mla_w_in; const float* mla_g_q; const float* mla_w_uq; const float* mla_w_out; const float* g_final;
  float* out; unsigned char* ws;
};

DI bf16_t f2bf(float x) { unsigned u = __float_as_uint(x); u += 0x7fffu + ((u >> 16) & 1u); return (bf16_t)(u >> 16); }
DI float bf2f(bf16_t b) { return __uint_as_float(((unsigned)b) << 16); }
DI float lo16(unsigned u) { return __uint_as_float(u << 16); }
DI float hi16(unsigned u) { return __uint_as_float(u & 0xffff0000u); }
typedef float f32x2 __attribute__((ext_vector_type(2)));
typedef __bf16 bf16x2_t __attribute__((ext_vector_type(2)));
DI unsigned pk2(float a, float b) { f32x2 v = {a, b}; bf16x2_t r = __builtin_convertvector(v, bf16x2_t); return __builtin_bit_cast(unsigned, r); }
DI float wave_sum(float v) {
#pragma unroll
  for (int o = 32; o >= 1; o >>= 1) v += __shfl_xor(v, o);
  return v;
}
DI int otid() { int t = threadIdx.x; asm volatile("" : "+v"(t)); return t; }
template <int K> DI float swz_xor(float v) {
  return __int_as_float(__builtin_amdgcn_ds_swizzle(__float_as_int(v), (K << 10) | 0x1f));
}
DI float silu_f(float v) { return v * __builtin_amdgcn_rcpf(1.f + __expf(-v)); }


#define XB_TMO      128
#define XB_XCNT(j)  (256  + 64 * (j))
#define XB_XSUB(j)  (1280 + 64 * (j))
#define XB_XGEN(j)  (2304 + 64 * (j))
#define XB_TOP      3328
#define XB_TOPGEN   3392
#define XCD_BAR_WORDS 3456
#define XB_SPIN_CAP (1u << 18)
DI unsigned xb_ld(unsigned* p)              { return __hip_atomic_load(p, __ATOMIC_RELAXED, __HIP_MEMORY_SCOPE_AGENT); }
DI unsigned xb_add(unsigned* p, unsigned v) { return __hip_atomic_fetch_add(p, v, __ATOMIC_RELAXED, __HIP_MEMORY_SCOPE_AGENT); }
DI unsigned xb_xcc_id() { return (unsigned)__builtin_amdgcn_s_getreg((3 << 11) | 20) & 0xFu; }
#define XB_SPIN(cond, bar) do { unsigned _sp = 0; while (cond) { __builtin_amdgcn_s_sleep(1); \
    if ((++_sp & 255u) == 0u) { if (xb_ld(&(bar)[XB_TMO])) break; if (_sp > XB_SPIN_CAP) { atomicAdd(&(bar)[XB_TMO], 1u); break; } } } } while (0)
struct XcdBarrier { unsigned* bar; unsigned x; volatile unsigned* st; };
DI XcdBarrier xcd_barrier_post(unsigned* bar, volatile unsigned* st) {
  XcdBarrier b; b.bar = bar; b.x = xb_xcc_id(); b.st = st;
  if (threadIdx.x == 0) (void)xb_add(&bar[XB_XCNT(b.x)], 1u);
  return b;
}
DI void xcd_barrier_complete(unsigned* bar, unsigned x, unsigned& nloc, unsigned& nx) {
  const unsigned G = gridDim.x * gridDim.y * gridDim.z;
  unsigned sum, cnt, mine, sp = 0u;
  for (;;) {
    sum = 0u; cnt = 0u; mine = 0u;
#pragma unroll
    for (unsigned j = 0; j < 16; ++j) { const unsigned c = xb_ld(&bar[XB_XCNT(j)]); sum += c; cnt += (c > 0u) ? 1u : 0u; mine = (j == x) ? c : mine; }
    if (sum == G) break;
    __builtin_amdgcn_s_sleep(1);
    if ((++sp & 255u) == 0u) { if (xb_ld(&bar[XB_TMO])) break; if (sp > XB_SPIN_CAP) { atomicAdd(&bar[XB_TMO], 1u); break; } }
  }
  nloc = mine > 0u ? mine : 1u; nx = cnt > 0u ? cnt : 1u;
}
DI void xcd_barrier(const XcdBarrier& b) {
  asm volatile("s_waitcnt vmcnt(0)" ::: "memory");
  __syncthreads();
  if (threadIdx.x == 0) {
    unsigned* bar = b.bar;
    __builtin_amdgcn_s_waitcnt(0);
    unsigned nloc = b.st[0], nx = b.st[1];
    if (nloc == 0u) { xcd_barrier_complete(bar, b.x, nloc, nx); b.st[0] = nloc; b.st[1] = nx; }
    const unsigned old = xb_add(&bar[XB_XSUB(b.x)], 1u);
    const unsigned gen = old / nloc;
    if (old + 1u == (gen + 1u) * nloc) {
      __builtin_amdgcn_fence(__ATOMIC_RELEASE, "agent");
      asm volatile("s_waitcnt vmcnt(0)" ::: "memory");
      const unsigned og = xb_add(&bar[XB_TOP], 1u);
      const unsigned tg = og / nx;
      if (og + 1u == (tg + 1u) * nx) xb_add(&bar[XB_TOPGEN], 1u);
      else XB_SPIN(xb_ld(&bar[XB_TOPGEN]) == tg, bar);
      __builtin_amdgcn_fence(__ATOMIC_ACQUIRE, "agent");
      xb_add(&bar[XB_XGEN(b.x)], 1u);
      asm volatile("s_waitcnt vmcnt(0)" ::: "memory");
    } else {
      XB_SPIN(xb_ld(&bar[XB_XGEN(b.x)]) == gen, bar);
      __builtin_amdgcn_fence(__ATOMIC_ACQUIRE, "agent");
      asm volatile("s_waitcnt vmcnt(0)" ::: "memory");
    }
  }
  __syncthreads();
}

struct WJob { const float* src; const float* gain; bf16_t* dst; int ld, col0, ncols, K, tile; };
DI WJob wprep_job(const Params& p, int u) {
  bf16_t* W1 = (bf16_t*)(p.ws + OFF_W1); bf16_t* W2 = (bf16_t*)(p.ws + OFF_W2); bf16_t* W3 = (bf16_t*)(p.ws + OFF_W3);
  bf16_t* W4 = (bf16_t*)(p.ws + OFF_W4); bf16_t* W5 = (bf16_t*)(p.ws + OFF_W5); bf16_t* W6 = (bf16_t*)(p.ws + OFF_W6);
  int t = u; WJob j;
  if (t < 1344) { j = {p.ssm_w_in, p.g_pre, W1, 5152, 0, 5152, 1024, t}; return j; } t -= 1344;
  if (t < 512) { j = {p.ssm_w_out, p.g_out, W2, 1024, 0, 1024, 2048, t}; return j; } t -= 512;
  if (t < 64) { j = {p.kv_w_down, p.kv_g_in, W3, 288, 0, 256, 1024, t}; return j; } t -= 64;
  if (t < 96) { j = {p.mla_w_in, p.g_pre + 1024, W3 + (size_t)256 * 1024, 1408, 0, 384, 1024, t}; return j; } t -= 96;
  if (t < 256) { j = {p.mla_w_in, p.g_pre + 1024, W3 + (size_t)640 * 1024, 1408, 384, 1024, 1024, t}; return j; } t -= 256;
  if (t < 32) { j = {p.kv_w_down, p.kv_g_in, W3 + (size_t)1664 * 1024, 288, 256, 32, 1024, t}; return j; } t -= 32;
  if (t < 128) { j = {p.kv_w_up, p.kv_g_lat, W4, 2048, 0, 2048, 256, t}; return j; } t -= 128;
  if (t < 144) { j = {p.mla_w_uq, p.mla_g_q, W5, 1536, 0, 1536, 384, t}; return j; } t -= 144;
  j = {p.mla_w_out, nullptr, W6, 1024, 0, 1024, 1024, t}; return j;
}
DI void wprep_load(const WJob& j, int tid0, float4 (&v)[2], float (&gk)[2]) {
  const int nkt = j.K >> 6; const int tn = j.tile / nkt, tk = j.tile % nkt; const int n0 = tn * 64, k0 = tk * 64;
#pragma unroll
  for (int i = 0; i < 2; ++i) {
    const int e = tid0 + NTHREADS * i; const int kk = e >> 4, n4 = (e & 15) * 4;
    v[i] = make_float4(0.f, 0.f, 0.f, 0.f);
    if (n0 + n4 < j.ncols) v[i] = *(const float4*)(j.src + (size_t)(k0 + kk) * j.ld + j.col0 + n0 + n4);
    gk[i] = j.gain ? j.gain[k0 + kk] : 1.f;
  }
}
DI void phase_prep(const Params& p, unsigned char* smem, int ustart, int uend, int ustride) {
  float* sm = (float*)smem;
  const int tid0 = otid();
  int u = ustart;
  if (u >= uend) return;
  WJob j = wprep_job(p, u);
  float4 v[2]; float gk[2];
  wprep_load(j, tid0, v, gk);
  for (;;) {
#pragma unroll
    for (int i = 0; i < 2; ++i) {
      const int e = tid0 + NTHREADS * i; const int kk = e >> 4, n4 = (e & 15) * 4;
      float* d = sm + kk * 65 + n4;
      d[0] = v[i].x * gk[i]; d[1] = v[i].y * gk[i]; d[2] = v[i].z * gk[i]; d[3] = v[i].w * gk[i];
    }
    __syncthreads();
    const WJob jc = j;
    const int un = u + ustride; const bool more = (un < uend);
    if (more) { j = wprep_job(p, un); wprep_load(j, tid0, v, gk); }
    {
      const int nkt = jc.K >> 6; const int tn = jc.tile / nkt, tk = jc.tile % nkt; const int n0 = tn * 64, k0 = tk * 64;
      const int nn = tid0 >> 3, kc = (tid0 & 7) * 8;
      uint4 o;
      o.x = pk2(sm[(kc + 0) * 65 + nn], sm[(kc + 1) * 65 + nn]); o.y = pk2(sm[(kc + 2) * 65 + nn], sm[(kc + 3) * 65 + nn]);
      o.z = pk2(sm[(kc + 4) * 65 + nn], sm[(kc + 5) * 65 + nn]); o.w = pk2(sm[(kc + 6) * 65 + nn], sm[(kc + 7) * 65 + nn]);
      *(uint4*)(jc.dst + (size_t)(n0 + nn) * jc.K + k0 + kc) = o;
    }
    __syncthreads();
    if (!more) break;
    u = un;
  }
}

DI void phase_rope_tables(const Params& p) {
  float* COS = (float*)(p.ws + OFF_COS); float* SIN = (float*)(p.ws + OFF_SIN);
  for (int e = blockIdx.x * NTHREADS + otid(); e < T * 16; e += gridDim.x * NTHREADS) {
    const int t = e >> 4, i = e & 15;
    const float ang = (float)p.pos[t] * powf(10000.f, -(float)(2 * i) / 32.f);
    COS[e] = cosf(ang); SIN[e] = sinf(ang);
  }
  float* SSQ = (float*)(p.ws + OFF_SSQ);
  for (int e = blockIdx.x * NTHREADS + otid(); e < 3 * T; e += gridDim.x * NTHREADS) SSQ[e] = 0.f;
}

DI void phase_rmsnorm_rows(const float* __restrict__ src, bf16_t* __restrict__ dst) {
  const int tid = otid(); const int lane = tid & 63, w = tid >> 6;
  for (int row = (blockIdx.x * 8 + w) * 2; row < T; row += gridDim.x * 16) {
    float4 v[2][4]; float ss[2] = {0.f, 0.f};
#pragma unroll
    for (int u = 0; u < 2; ++u)
#pragma unroll
      for (int i = 0; i < 4; ++i) v[u][i] = ((const float4*)(src + (size_t)(row + u) * DM))[lane + 64 * i];
#pragma unroll
    for (int u = 0; u < 2; ++u) {
#pragma unroll
      for (int i = 0; i < 4; ++i) ss[u] += v[u][i].x * v[u][i].x + v[u][i].y * v[u][i].y + v[u][i].z * v[u][i].z + v[u][i].w * v[u][i].w;
      ss[u] = wave_sum(ss[u]);
      const float r = rsqrtf(ss[u] * (1.f / 1024.f) + 1e-6f);
#pragma unroll
      for (int i = 0; i < 4; ++i) {
        uint2 o; o.x = pk2(v[u][i].x * r, v[u][i].y * r); o.y = pk2(v[u][i].z * r, v[u][i].w * r);
        *(uint2*)(dst + (size_t)(row + u) * DM + (lane + 64 * i) * 4) = o;
      }
    }
  }
}

enum { EPI_SSM_IN = 0, EPI_OUT1 = 1, EPI_MLA_IN = 2, EPI_KVUP = 3, EPI_QUP = 4, EPI_OUT2 = 5 };


typedef float f32x4 __attribute__((ext_vector_type(4)));
constexpr int EPI_WAVE_BYTES = 8704;
constexpr int TM_ROW = 72;
constexpr int CM_ROW = 40;
constexpr int F32_ROW = 68;

template <bool SILU>
DI void stage_tm(const f32x4 (&a)[4][2], bf16_t* wl, int fr, int fq) {
#pragma unroll
  for (int m = 0; m < 4; ++m)
#pragma unroll
    for (int n = 0; n < 2; ++n) {
      float v0 = a[m][n][0], v1 = a[m][n][1], v2 = a[m][n][2], v3 = a[m][n][3];
      if (SILU) { v0 = silu_f(v0); v1 = silu_f(v1); v2 = silu_f(v2); v3 = silu_f(v3); }
      uint2 o; o.x = pk2(v0, v1); o.y = pk2(v2, v3);
      *(uint2*)(wl + (n * 16 + fr) * TM_ROW + m * 16 + fq * 4) = o;
    }
}
DI void readout_tm(const bf16_t* wl, bf16_t* gdst, size_t ld, int lane) {
#pragma unroll
  for (int it = 0; it < 4; ++it) {
    const int idx = lane + 64 * it; const int row = idx >> 3, ch = idx & 7;
    *(uint4*)(gdst + (size_t)row * ld + ch * 8) = *(const uint4*)(wl + row * TM_ROW + ch * 8);
  }
}
DI void stage_cm(const f32x4 (&a)[4][2], bf16_t* wl, int fr, int fq) {
#pragma unroll
  for (int m = 0; m < 4; ++m)
#pragma unroll
    for (int n = 0; n < 2; ++n)
#pragma unroll
      for (int j = 0; j < 4; ++j) wl[(m * 16 + fq * 4 + j) * CM_ROW + n * 16 + fr] = f2bf(a[m][n][j]);
}
DI void readout_cm(const bf16_t* wl, bf16_t* gdst, int lane) {
#pragma unroll
  for (int it = 0; it < 4; ++it) {
    const int idx = lane + 64 * it; const int row = idx >> 2, ch = idx & 3;
    *(uint4*)(gdst + (size_t)row * SEQ + ch * 8) = *(const uint4*)(wl + row * CM_ROW + ch * 8);
  }
}
constexpr int CMP_ROW = 72;
DI void stage_cm_pair(const f32x4 (&a)[4][2], bf16_t* wlp, int par, int fr, int fq) {
#pragma unroll
  for (int m = 0; m < 4; ++m)
#pragma unroll
    for (int n = 0; n < 2; ++n)
#pragma unroll
      for (int j = 0; j < 4; ++j) wlp[(m * 16 + fq * 4 + j) * CMP_ROW + par * 32 + n * 16 + fr] = f2bf(a[m][n][j]);
}
DI void readout_cm_pair(const bf16_t* wlp, bf16_t* gdst, int par, int lane) {
#pragma unroll
  for (int it = 0; it < 4; ++it) {
    const int idx = lane + 64 * it; const int row = par * 32 + (idx >> 3), ch = idx & 7;
    *(uint4*)(gdst + (size_t)row * SEQ + ch * 8) = *(const uint4*)(wlp + row * CMP_ROW + ch * 8);
  }
}
DI void stage_f32(const f32x4 (&a)[4][2], float* wl, int fr, int fq) {
#pragma unroll
  for (int m = 0; m < 4; ++m)
#pragma unroll
    for (int n = 0; n < 2; ++n) *(f32x4*)(wl + (n * 16 + fr) * F32_ROW + m * 16 + fq * 4) = a[m][n];
}
DI void readout_f32_resid(const float* wl, const float* __restrict__ resid, float* __restrict__ gdst, int lane) {
#pragma unroll 4
  for (int it = 0; it < 8; ++it) {
    const int idx = lane + 64 * it; const int row = idx >> 4, ch = idx & 15;
    const float4 v = *(const float4*)(wl + row * F32_ROW + ch * 4);
    const float4 r = *(const float4*)(resid + (size_t)row * DM + ch * 4);
    *(float4*)(gdst + (size_t)row * DM + ch * 4) = make_float4(v.x + r.x, v.y + r.y, v.z + r.z, v.w + r.w);
  }
}

DI void readout_f32_resid_ssq(const float* wl, const float* __restrict__ resid, float* __restrict__ gdst, bf16_t* __restrict__ hs, float* __restrict__ ssq, int lane) {
#pragma unroll 4
  for (int it = 0; it < 8; ++it) {
    const int idx = lane + 64 * it; const int row = idx >> 4, ch = idx & 15;
    const float4 v = *(const float4*)(wl + row * F32_ROW + ch * 4);
    const float4 r = *(const float4*)(resid + (size_t)row * DM + ch * 4);
    const float4 h = make_float4(v.x + r.x, v.y + r.y, v.z + r.z, v.w + r.w);
    *(float4*)(gdst + (size_t)row * DM + ch * 4) = h;
    uint2 o; o.x = pk2(h.x, h.y); o.y = pk2(h.z, h.w);
    *(uint2*)(hs + (size_t)row * DM + ch * 4) = o;
    float q = h.x * h.x + h.y * h.y + h.z * h.z + h.w * h.w;
    q += swz_xor<1>(q); q += swz_xor<2>(q); q += swz_xor<4>(q); q += swz_xor<8>(q);
    if (ch == 0) atomicAdd(ssq + row, q);
  }
}

template <int EPI>
DI void epilogue_block(const Params& p, const f32x4 (&a)[4][2], int c0, int mt, bf16_t* wl, bf16_t* wlp, int par, int lane, int fr, int fq) {
  unsigned char* ws = p.ws;
  const int b = mt >> 13, tok0 = mt & 8191;
  const int tok0p = tok0 - par * 32;
  if (EPI == EPI_SSM_IN) {
    if (c0 < 2048 || (c0 >= 4096 && c0 < 5120)) stage_tm<false>(a, wl, fr, fq);
    else if (c0 < 4096) stage_cm_pair(a, wlp, par, fr, fq);
    __syncthreads();
    if (c0 < 2048) readout_tm(wl, (bf16_t*)p.out + (size_t)mt * 2048 + c0, 2048, lane);
    else if (c0 < 4096) readout_cm_pair(wlp, (bf16_t*)(ws + OFF_XT) + ((size_t)(b * 2048 + (c0 - 2048))) * SEQ + tok0p, par, lane);
    else if (c0 < 4608) readout_tm(wl, (bf16_t*)(ws + OFF_BR) + (size_t)mt * 512 + (c0 - 4096), 512, lane);
    else if (c0 < 5120) readout_tm(wl, (bf16_t*)(ws + OFF_CR) + (size_t)mt * 512 + (c0 - 4608), 512, lane);
    else if (c0 == 5120) {
#pragma unroll
      for (int m = 0; m < 2; ++m)
#pragma unroll
        for (int n = 0; n < 2; ++n) {
          const int h = m * 16 + fq * 4;
          float4 o; float* op = (float*)&o;
#pragma unroll
          for (int j = 0; j < 4; ++j) { const float t = a[m][n][j] + p.dt_bias[h + j]; op[j] = (t > 20.f) ? t : log1pf(__expf(t)); }
          *(float4*)((float*)(ws + OFF_DT) + (size_t)(mt + n * 16 + fr) * 32 + h) = o;
        }
    }
    __syncthreads();
    if (c0 >= 4096 && c0 < 4608) stage_cm_pair(a, wlp, par, fr, fq);
    __syncthreads();
    if (c0 >= 4096 && c0 < 4608) readout_cm_pair(wlp, (bf16_t*)(ws + OFF_BT) + ((size_t)(b * 512 + (c0 - 4096))) * SEQ + tok0p, par, lane);
    __syncthreads();
  } else if (EPI == EPI_OUT1 || EPI == EPI_OUT2) {
    const float* resid = (EPI == EPI_OUT1) ? p.x : (const float*)(ws + OFF_XT);
    float* dst = (EPI == EPI_OUT1) ? (float*)(ws + OFF_XT) : p.out;
    stage_f32(a, (float*)wl, fr, fq); __syncthreads();
    if (EPI == EPI_OUT1) readout_f32_resid_ssq((const float*)wl, resid + (size_t)mt * DM + c0, dst + (size_t)mt * DM + c0, (bf16_t*)(ws + OFF_XN) + (size_t)mt * DM + c0, (float*)(ws + OFF_SSQ) + mt, lane);
    else readout_f32_resid((const float*)wl, resid + (size_t)mt * DM + c0, dst + (size_t)mt * DM + c0, lane);
    __syncthreads();
  } else if (EPI == EPI_MLA_IN) {
    const float* SSQ = (const float*)(ws + OFF_SSQ);
    f32x4 a2[4][2];
    float rs[2];
#pragma unroll
    for (int n = 0; n < 2; ++n) rs[n] = rsqrtf(SSQ[mt + n * 16 + fr] * (1.f / 1024.f) + 1e-6f);
#pragma unroll
    for (int m = 0; m < 4; ++m)
#pragma unroll
      for (int n = 0; n < 2; ++n) a2[m][n] = a[m][n] * rs[n];
    if (c0 < 640) {
      float* dstq = (float*)(ws + OFF_SSQ) + (c0 < 256 ? T : 2 * T);
#pragma unroll
      for (int n = 0; n < 2; ++n) {
        float q = 0.f;
#pragma unroll
        for (int m = 0; m < 4; ++m) q += a2[m][n][0] * a2[m][n][0] + a2[m][n][1] * a2[m][n][1] + a2[m][n][2] * a2[m][n][2] + a2[m][n][3] * a2[m][n][3];
        q += swz_xor<16>(q); q += __shfl_xor(q, 32);
        if (fq == 0) atomicAdd(dstq + mt + n * 16 + fr, q);
      }
    }
    const f32x4 (&a)[4][2] = a2;
    if (c0 < 640) stage_tm<false>(a, wl, fr, fq);
    else if (c0 < 1664) stage_tm<true>(a, wl, fr, fq);
    __syncthreads();
    if (c0 < 256) readout_tm(wl, (bf16_t*)(ws + OFF_ST + 32 * MiB) + (size_t)mt * 256 + c0, 256, lane);
    else if (c0 < 640) readout_tm(wl, (bf16_t*)(ws + OFF_ST + 40 * MiB) + (size_t)mt * 384 + (c0 - 256), 384, lane);
    else if (c0 < 1664) readout_tm(wl, (bf16_t*)(ws + OFF_ST) + (size_t)mt * 1024 + (c0 - 640), 1024, lane);
    else if (c0 == 1664) {
      const float* COS = (const float*)(ws + OFF_COS); const float* SIN = (const float*)(ws + OFF_SIN);
      bf16_t* KROPE = (bf16_t*)(ws + OFF_DEC);
#pragma unroll
      for (int n = 0; n < 2; ++n) {
        const int t = mt + n * 16 + fr;
        const f32x4 cs = *(const f32x4*)(COS + (size_t)t * 16 + fq * 4), sn = *(const f32x4*)(SIN + (size_t)t * 16 + fq * 4);
        const f32x4 x1 = a[0][n], x2 = a[1][n];
        const f32x4 r1 = x1 * cs - x2 * sn, r2 = x1 * sn + x2 * cs;
        uint2 o1, o2; o1.x = pk2(r1[0], r1[1]); o1.y = pk2(r1[2], r1[3]); o2.x = pk2(r2[0], r2[1]); o2.y = pk2(r2[2], r2[3]);
        *(uint2*)(KROPE + (size_t)t * 32 + fq * 4) = o1; *(uint2*)(KROPE + (size_t)t * 32 + 16 + fq * 4) = o2;
      }
    }
    __syncthreads();
  } else if (EPI == EPI_KVUP) {
    const int head = c0 >> 7; const bool isv = (c0 & 64) != 0;
    const float* SSQ = (const float*)(ws + OFF_SSQ) + T;
    f32x4 a2[4][2];
#pragma unroll
    for (int n = 0; n < 2; ++n) {
      const float rsn = rsqrtf(SSQ[mt + n * 16 + fr] * (1.f / 256.f) + 1e-6f);
#pragma unroll
      for (int m = 0; m < 4; ++m) a2[m][n] = a[m][n] * rsn;
    }
    const f32x4 (&a)[4][2] = a2;
    if (!isv) stage_tm<false>(a, wl, fr, fq); else stage_cm_pair(a, wlp, par, fr, fq);
    __syncthreads();
    if (!isv) readout_tm(wl, (bf16_t*)(ws + OFF_XN) + (size_t)mt * 1024 + head * 64, 1024, lane);
    else readout_cm_pair(wlp, (bf16_t*)(ws + OFF_BT) + ((size_t)((b * 16 + head) * 64)) * SEQ + tok0p, par, lane);
    __syncthreads();
  } else if (EPI == EPI_QUP) {
    const float SC = 0.10206207261596575f * 1.4426950408889634f;
    const float* SSQ = (const float*)(ws + OFF_SSQ) + 2 * T;
    f32x4 v[4][2];
#pragma unroll
    for (int n = 0; n < 2; ++n) {
      const float rsn = rsqrtf(SSQ[mt + n * 16 + fr] * (1.f / 384.f) + 1e-6f) * SC;
#pragma unroll
      for (int m = 0; m < 4; ++m) v[m][n] = a[m][n] * rsn;
    }
    const int ph = c0 % 96;
    if (ph != 0) {
      const float* COS = (const float*)(ws + OFF_COS); const float* SIN = (const float*)(ws + OFF_SIN);
#pragma unroll
      for (int n = 0; n < 2; ++n) {
        const int t = mt + n * 16 + fr;
        const f32x4 cs = *(const f32x4*)(COS + (size_t)t * 16 + fq * 4), sn = *(const f32x4*)(SIN + (size_t)t * 16 + fq * 4);
        if (ph == 64) { const f32x4 x1 = v[0][n], x2 = v[1][n]; v[0][n] = x1 * cs - x2 * sn; v[1][n] = x1 * sn + x2 * cs; }
        else          { const f32x4 x1 = v[2][n], x2 = v[3][n]; v[2][n] = x1 * cs - x2 * sn; v[3][n] = x1 * sn + x2 * cs; }
      }
    }
    stage_tm<false>(v, wl, fr, fq); __syncthreads();
    readout_tm(wl, (bf16_t*)p.out + (size_t)mt * 1536 + c0, 1536, lane);
    __syncthreads();
  }
}

constexpr int G8_BK = 64, G8_HALF = 128, G8_HT = G8_HALF * G8_BK;
constexpr int LDS_BYTES = 143360;
DI int g8_lds_byte(int r, int c) { const int st = (r >> 4) * 2 + (c >> 5), rr = r & 15, cc = c & 31, ob = rr * 64 + cc * 2; return st * 1024 + (ob ^ (((ob >> 9) & 1) << 5)); }
DI void g8_stage_rc(int b, int& R, int& C) { const int st = b / 1024, sb = b % 1024, swz = sb ^ (((sb >> 9) & 1) << 5); R = (st >> 1) * 16 + swz / 64; C = (st & 1) * 32 + (swz % 64) / 2; }

template <int EPI, int K>
DI void gemm_tile(const Params& p, const bf16_t* __restrict__ A, const bf16_t* __restrict__ Bt, int brow, int bcol, unsigned char* smem) {
  bf16_t* shm = (bf16_t*)smem;
#define SA(b, h) (shm + ((b) * 2 + (h)) * G8_HT)
#define SB(b, h) (shm + (4 + (b) * 2 + (h)) * G8_HT)
#define STAGE(P, BASE, br, kt) do { const long _g = (long)(br) * K + (long)(kt) * G8_BK; \
    _Pragma("unroll") for (int _i = 0; _i < 2; ++_i) { const int _b = tid * 16 + _i * 8192; int _r, _c; g8_stage_rc(_b, _r, _c); \
      __builtin_amdgcn_global_load_lds((const unsigned*)(BASE + _g + (long)_r * K + _c), (unsigned*)((char*)(P) + _b), 16, 0, 0); } } while (0)
#define LDA(dst, b, h) _Pragma("unroll") for (int m = 0; m < 4; ++m) _Pragma("unroll") for (int k = 0; k < 2; ++k) \
    dst[m][k] = *reinterpret_cast<const bf16x8*>((const char*)SA(b, h) + g8_lds_byte(wr * 64 + m * 16 + fr, k * 32 + fq * 8))
#define LDB(dst, b, h) _Pragma("unroll") for (int n = 0; n < 2; ++n) _Pragma("unroll") for (int k = 0; k < 2; ++k) \
    dst[n][k] = *reinterpret_cast<const bf16x8*>((const char*)SB(b, h) + g8_lds_byte(wc * 32 + n * 16 + fr, k * 32 + fq * 8))
#define MMA(ai, bj, At_, Bt_) do { __builtin_amdgcn_s_setprio(1); \
    _Pragma("unroll") for (int m = 0; m < 4; ++m) _Pragma("unroll") for (int n = 0; n < 2; ++n) _Pragma("unroll") for (int k = 0; k < 2; ++k) \
      acc[ai][bj][m][n] = __builtin_amdgcn_mfma_f32_16x16x32_bf16(At_[m][k], Bt_[n][k], acc[ai][bj][m][n], 0, 0, 0); \
    __builtin_amdgcn_s_setprio(0); } while (0)
#define WAIT_V(n) asm volatile("s_waitcnt vmcnt(" #n ")" ::: "memory")
#define WAIT_L(n) asm volatile("s_waitcnt lgkmcnt(" #n ")" ::: "memory")
#define BAR __builtin_amdgcn_s_barrier()
#define SCHED __builtin_amdgcn_sched_barrier(0)
  const int tid = otid();
  const int wid = tid >> 6, lane = tid & 63, wr = wid >> 2, wc = wid & 3, fr = lane & 15, fq = lane >> 4;
  f32x4 acc[2][2][4][2];
#pragma unroll
  for (int a_ = 0; a_ < 2; ++a_)
#pragma unroll
    for (int b_ = 0; b_ < 2; ++b_)
#pragma unroll
      for (int m = 0; m < 4; ++m)
#pragma unroll
        for (int n = 0; n < 2; ++n) acc[a_][b_][m][n] = (f32x4){0.f, 0.f, 0.f, 0.f};
  bf16x8 At[4][2], B0[2][2], B1[2][2];
  constexpr int nt = K / G8_BK;
  STAGE(SB(0, 0), Bt, bcol, 0); STAGE(SA(0, 0), A, brow, 0);
  STAGE(SB(0, 1), Bt, bcol + G8_HALF, 0); STAGE(SA(0, 1), A, brow + G8_HALF, 0);
  if (wr == 1) BAR;
  WAIT_V(4); BAR;
  STAGE(SB(1, 0), Bt, bcol, 1); STAGE(SA(1, 0), A, brow, 1); STAGE(SB(1, 1), Bt, bcol + G8_HALF, 1);
  WAIT_V(6); BAR;
  for (int t = 0; t < nt - 2; t += 2) {
    LDB(B0, 0, 0); SCHED; LDA(At, 0, 0); STAGE(SA(1, 1), A, brow + G8_HALF, t + 1);
    WAIT_L(8); BAR; WAIT_L(0); MMA(0, 0, At, B0); BAR; SCHED;
    LDB(B1, 0, 1); STAGE(SB(0, 0), Bt, bcol, t + 2);
    BAR; WAIT_L(0); MMA(0, 1, At, B1); BAR;
    LDA(At, 0, 1); STAGE(SA(0, 0), A, brow, t + 2);
    BAR; WAIT_L(0); MMA(1, 0, At, B0); BAR; SCHED;
    STAGE(SB(0, 1), Bt, bcol + G8_HALF, t + 2);
    WAIT_V(6); BAR; MMA(1, 1, At, B1); BAR;
    LDB(B0, 1, 0); SCHED; LDA(At, 1, 0); STAGE(SA(0, 1), A, brow + G8_HALF, t + 2);
    WAIT_L(8); BAR; WAIT_L(0); MMA(0, 0, At, B0); BAR; SCHED;
    LDB(B1, 1, 1); STAGE(SB(1, 0), Bt, bcol, t + 3);
    BAR; WAIT_L(0); MMA(0, 1, At, B1); BAR;
    LDA(At, 1, 1); STAGE(SA(1, 0), A, brow, t + 3);
    BAR; WAIT_L(0); MMA(1, 0, At, B0); BAR; SCHED;
    STAGE(SB(1, 1), Bt, bcol + G8_HALF, t + 3);
    WAIT_V(6); BAR; MMA(1, 1, At, B1); BAR;
  }
  { LDB(B0, 0, 0); LDA(At, 0, 0); STAGE(SA(1, 1), A, brow + G8_HALF, nt - 1);
    BAR; WAIT_L(0); MMA(0, 0, At, B0); BAR;
    LDB(B1, 0, 1); BAR; WAIT_L(0); MMA(0, 1, At, B1); BAR;
    LDA(At, 0, 1); WAIT_V(4); BAR; WAIT_L(0); MMA(1, 0, At, B0); MMA(1, 1, At, B1); BAR; }
  { LDB(B0, 1, 0); LDA(At, 1, 0); WAIT_V(2); BAR; WAIT_L(0); MMA(0, 0, At, B0); BAR;
    LDB(B1, 1, 1); WAIT_V(0); BAR; WAIT_L(0); MMA(0, 1, At, B1); BAR;
    LDA(At, 1, 1); BAR; WAIT_L(0); MMA(1, 0, At, B0); MMA(1, 1, At, B1); BAR; }
  if (wr == 0) BAR;
  __syncthreads();
  int t2 = tid; asm volatile("" : "+v"(t2));
  const int wid2 = t2 >> 6, lane2 = t2 & 63, wr2 = wid2 >> 2, wc2 = wid2 & 3, fr2 = lane2 & 15, fq2 = lane2 >> 4;
  bf16_t* wl = (bf16_t*)(smem + wid2 * EPI_WAVE_BYTES);
  bf16_t* wlp = (bf16_t*)(smem + (wid2 & ~1) * EPI_WAVE_BYTES);
#pragma unroll
  for (int ai = 0; ai < 2; ++ai)
#pragma unroll
    for (int bj = 0; bj < 2; ++bj)
      epilogue_block<EPI>(p, acc[ai][bj], brow + ai * 128 + wr2 * 64, bcol + bj * 128 + wc2 * 32, wl, wlp, wc2 & 1, lane2, fr2, fq2);
#undef SA
#undef SB
#undef STAGE
#undef LDA
#undef LDB
#undef MMA
#undef WAIT_V
#undef WAIT_L
#undef BAR
#undef SCHED
}

template <int EPI, int K>
DI void gemm_phase(const Params& p, const bf16_t* Wt, const bf16_t* X, int ntn, unsigned char* smem) {
  const bool xa = (gridDim.x == 256);
  const int xcd = blockIdx.x & 7, li = blockIdx.x >> 3;
  const int per_half = 4 * ntn;
  const int start = xa ? li : (int)blockIdx.x, step = xa ? 32 : (int)gridDim.x, total = ntn * (xa ? 8 : 64);
  for (int t = start; t < total; t += step) {
    int tm, tn;
    if (xa) { const int h = t / per_half, tp = t - h * per_half; tn = tp >> 2; tm = xcd * 8 + h * 4 + (tp & 3); }
    else { tm = t / ntn; tn = t % ntn; }
    gemm_tile<EPI, K>(p, Wt, X, tn * 256, tm * 256, smem);
  }
}

DI void conv8_load(const bf16_t* rp, bool has_prev, uint4& cur, uint2& prv) {
  cur = *(const uint4*)rp; prv = make_uint2(0u, 0u);
  if (has_prev) prv = *(const uint2*)(rp - 4);
}
DI float fast_silu(float v) { return v * __builtin_amdgcn_rcpf(1.f + __expf(-v)); }
DI void conv8_compute(const uint4 cur, const uint2 prv, float w0, float w1, float w2, float w3, float bias, float (&out)[8]) {
  float r[11];
  r[0] = hi16(prv.x); r[1] = lo16(prv.y); r[2] = hi16(prv.y);
  r[3] = lo16(cur.x); r[4] = hi16(cur.x); r[5] = lo16(cur.y); r[6] = hi16(cur.y); r[7] = lo16(cur.z); r[8] = hi16(cur.z); r[9] = lo16(cur.w); r[10] = hi16(cur.w);
#pragma unroll
  for (int j = 0; j < 8; ++j) out[j] = fast_silu(bias + w0 * r[j] + w1 * r[j + 1] + w2 * r[j + 2] + w3 * r[j + 3]);
}
DI void conv8(const bf16_t* rp, bool has_prev, float w0, float w1, float w2, float w3, float bias, float (&out)[8]) {
  uint4 cur; uint2 prv; conv8_load(rp, has_prev, cur, prv); conv8_compute(cur, prv, w0, w1, w2, w3, bias, out);
}
DI bf16x8 pack8(const float (&v)[8]) {
  uint4 u; u.x = pk2(v[0], v[1]); u.y = pk2(v[2], v[3]); u.z = pk2(v[4], v[5]); u.w = pk2(v[6], v[7]);
  return __builtin_bit_cast(bf16x8, u);
}
DI void chunk_cumsum(const float* __restrict__ DTp, size_t tk0, int hd, float A, int lane, float (&d4)[4], float (&c4)[4], float& last) {
#pragma unroll
  for (int i = 0; i < 4; ++i) d4[i] = DTp[(tk0 + 4 * lane + i) * 32 + hd];
  c4[0] = d4[0] * A; c4[1] = c4[0] + d4[1] * A; c4[2] = c4[1] + d4[2] * A; c4[3] = c4[2] + d4[3] * A;
  const float tot = c4[3];
  float sum = tot, ex = 0.f, t;
  t = swz_xor<1>(sum);  if (lane & 1) ex += t;  sum += t;
  t = swz_xor<2>(sum);  if (lane & 2) ex += t;  sum += t;
  t = swz_xor<4>(sum);  if (lane & 4) ex += t;  sum += t;
  t = swz_xor<8>(sum);  if (lane & 8) ex += t;  sum += t;
  t = swz_xor<16>(sum); if (lane & 16) ex += t; sum += t;
  t = __shfl_xor(sum, 32); if (lane & 32) ex += t; sum += t;
#pragma unroll
  for (int i = 0; i < 4; ++i) c4[i] += ex;
  last = sum;
}

constexpr int BT_ROW = 264;
constexpr int CN_ROW = 136;

DI void phase_ssd_state(const Params& p, unsigned char* smem) {
  const bf16_t* XT = (const bf16_t*)(p.ws + OFF_XT); const bf16_t* BT = (const bf16_t*)(p.ws + OFF_BT); const float* DTp = (const float*)(p.ws + OFF_DT);
  float* ST = (float*)(p.ws + OFF_ST); float* DEC = (float*)(p.ws + OFF_DEC);
  bf16_t* BTs = (bf16_t*)smem; float* wgt = (float*)(smem + 128 * BT_ROW * 2);
  const int tid = otid(), lane = tid & 63, w = tid >> 6, l31 = lane & 31, lh = lane >> 5;
  for (int u = blockIdx.x; u < 256; u += gridDim.x) {
    const int b = u >> 7, c = (u >> 2) & 31, g = u & 3; const int hd = 8 * g + w;
    bf16_t* XTC = (bf16_t*)(p.ws + (b ? OFF_ST + 32 * MiB : OFF_XN));
    {
      float d4[4], c4[4], last; chunk_cumsum(DTp, (size_t)b * SEQ + c * 256, hd, -__expf(p.A_log[hd]), lane, d4, c4, last);
      float4 o = {__expf(last - c4[0]) * d4[0], __expf(last - c4[1]) * d4[1], __expf(last - c4[2]) * d4[2], __expf(last - c4[3]) * d4[3]};
      *(float4*)(wgt + w * 256 + 4 * lane) = o;
      if (lane == 0) DEC[(b * 32 + c) * 32 + hd] = __expf(last);
    }
#pragma unroll 2
    for (int i = 0; i < 8; ++i) {
      const int chunk = tid + 512 * i; const int s8 = (chunk & 31) * 8, n = chunk >> 5; const int ch = 2048 + g * 128 + n;
      float v[8];
      conv8(BT + ((size_t)(b * 512 + g * 128 + n)) * SEQ + c * 256 + s8, !(c == 0 && s8 == 0),
            p.conv_w[ch], p.conv_w[3072 + ch], p.conv_w[2 * 3072 + ch], p.conv_w[3 * 3072 + ch], p.conv_b[ch], v);
      *(bf16x8*)(BTs + n * BT_ROW + s8) = pack8(v);
    }
    __syncthreads();
    f32x16 acc[2][4];
#pragma unroll
    for (int a = 0; a < 2; ++a)
#pragma unroll
      for (int q = 0; q < 4; ++q)
#pragma unroll
        for (int i = 0; i < 16; ++i) acc[a][q][i] = 0.f;
    float xw[2][4], xb[2];
#pragma unroll
    for (int pt = 0; pt < 2; ++pt) {
      const int ch = hd * 64 + pt * 32 + l31;
#pragma unroll
      for (int k = 0; k < 4; ++k) xw[pt][k] = p.conv_w[k * 3072 + ch];
      xb[pt] = p.conv_b[ch];
    }
    for (int kb = 0; kb < 16; kb += 2) {
      uint4 rc[2][2]; uint2 rp[2][2];
#pragma unroll
      for (int i = 0; i < 2; ++i)
#pragma unroll
        for (int pt = 0; pt < 2; ++pt) {
          const int s0 = (kb + i) * 16 + 8 * lh;
          conv8_load(XT + ((size_t)(b * 2048 + hd * 64 + pt * 32 + l31)) * SEQ + c * 256 + s0, !(c == 0 && s0 == 0), rc[i][pt], rp[i][pt]);
        }
#pragma unroll
      for (int i = 0; i < 2; ++i) {
        const int ks = kb + i; const int s0 = ks * 16 + 8 * lh;
        const float4 g0 = *(const float4*)(wgt + w * 256 + s0), g1 = *(const float4*)(wgt + w * 256 + s0 + 4);
        const float wg[8] = {g0.x, g0.y, g0.z, g0.w, g1.x, g1.y, g1.z, g1.w};
        bf16x8 afr[2];
#pragma unroll
        for (int pt = 0; pt < 2; ++pt) {
          float v[8];
          conv8_compute(rc[i][pt], rp[i][pt], xw[pt][0], xw[pt][1], xw[pt][2], xw[pt][3], xb[pt], v);
          *(bf16x8*)(XTC + ((size_t)(hd * 64 + pt * 32 + l31)) * SEQ + c * 256 + s0) = pack8(v);
#pragma unroll
          for (int j = 0; j < 8; ++j) v[j] *= wg[j];
          afr[pt] = pack8(v);
        }
#pragma unroll
        for (int nt = 0; nt < 4; ++nt) {
          const bf16x8 bfr = *(const bf16x8*)(BTs + (nt * 32 + l31) * BT_ROW + ks * 16 + 8 * lh);
#pragma unroll
          for (int pt = 0; pt < 2; ++pt) acc[pt][nt] = MFMA32(afr[pt], bfr, acc[pt][nt]);
        }
      }
    }
    bf16_t* Sp = (bf16_t*)ST + (((size_t)(b * 32 + c) * 32 + hd) * 64) * 128;
#pragma unroll
    for (int pt = 0; pt < 2; ++pt)
#pragma unroll
      for (int nt = 0; nt < 4; ++nt)
#pragma unroll
        for (int r = 0; r < 16; ++r) Sp[(pt * 32 + (r & 3) + 8 * (r >> 2) + 4 * lh) * 128 + nt * 32 + l31] = f2bf(acc[pt][nt][r]);
    __syncthreads();
  }
}

DI void phase_ssd_scan(const Params& p) {
  bf16_t* ST = (bf16_t*)(p.ws + OFF_ST); const float* DEC = (const float*)(p.ws + OFF_DEC);
  for (int idx = blockIdx.x * NTHREADS + otid(); idx < 131072; idx += gridDim.x * NTHREADS) {
    const int n4 = idx & 31, pp = (idx >> 5) & 63, h = (idx >> 11) & 31, b = idx >> 16;
    float run[4] = {0.f, 0.f, 0.f, 0.f};
    bf16_t* base = ST + (((size_t)(b * 32) * 32 + h) * 64 + pp) * 128 + n4 * 4;
    const float* dbase = DEC + (b * 32) * 32 + h;
    for (int c0 = 0; c0 < 32; c0 += 16) {
      uint2 loc[16]; float d[16];
#pragma unroll
      for (int i = 0; i < 16; ++i) { loc[i] = *(const uint2*)(base + (size_t)(c0 + i) * (32 * 64 * 128)); d[i] = dbase[(c0 + i) * 32]; }
#pragma unroll
      for (int i = 0; i < 16; ++i) {
        uint2 o; o.x = pk2(run[0], run[1]); o.y = pk2(run[2], run[3]);
        *(uint2*)(base + (size_t)(c0 + i) * (32 * 64 * 128)) = o;
        run[0] = run[0] * d[i] + lo16(loc[i].x); run[1] = run[1] * d[i] + hi16(loc[i].x);
        run[2] = run[2] * d[i] + lo16(loc[i].y); run[3] = run[3] * d[i] + hi16(loc[i].y);
      }
    }
  }
}

DI void stage_tokmajor(const Params& p, const bf16_t* __restrict__ RAW, int b, int tok0, int nrows, int g, int cbase, bf16_t* dst, int tid_) {
  const int tid = otid(); (void)tid_;
  const int n8 = (tid & 15) * 8; const int ch = cbase + g * 128 + n8;
  float cw[4][8], cb[8];
#pragma unroll
  for (int k = 0; k < 4; ++k) {
    const float4 a = *(const float4*)(p.conv_w + k * 3072 + ch), bq = *(const float4*)(p.conv_w + k * 3072 + ch + 4);
    cw[k][0] = a.x; cw[k][1] = a.y; cw[k][2] = a.z; cw[k][3] = a.w; cw[k][4] = bq.x; cw[k][5] = bq.y; cw[k][6] = bq.z; cw[k][7] = bq.w;
  }
  { const float4 a = *(const float4*)(p.conv_b + ch), bq = *(const float4*)(p.conv_b + ch + 4);
    cb[0] = a.x; cb[1] = a.y; cb[2] = a.z; cb[3] = a.w; cb[4] = bq.x; cb[5] = bq.y; cb[6] = bq.z; cb[7] = bq.w; }
  for (int t = tid >> 4; t < nrows; t += 64) {
    uint4 r[2][4];
#pragma unroll
    for (int u = 0; u < 2; ++u)
#pragma unroll
      for (int k = 0; k < 4; ++k) {
        const int tk = tok0 + t + 32 * u - 3 + k;
        r[u][k] = make_uint4(0u, 0u, 0u, 0u);
        if (tk >= 0) r[u][k] = *(const uint4*)(RAW + ((size_t)b * SEQ + tk) * 512 + g * 128 + n8);
      }
#pragma unroll
    for (int u = 0; u < 2; ++u) {
      float acc[8];
#pragma unroll
      for (int j = 0; j < 8; ++j) acc[j] = cb[j];
#pragma unroll
      for (int k = 0; k < 4; ++k) {
        const uint4 q = r[u][k];
        acc[0] += cw[k][0] * lo16(q.x); acc[1] += cw[k][1] * hi16(q.x); acc[2] += cw[k][2] * lo16(q.y); acc[3] += cw[k][3] * hi16(q.y);
        acc[4] += cw[k][4] * lo16(q.z); acc[5] += cw[k][5] * hi16(q.z); acc[6] += cw[k][6] * lo16(q.w); acc[7] += cw[k][7] * hi16(q.w);
      }
#pragma unroll
      for (int j = 0; j < 8; ++j) acc[j] = fast_silu(acc[j]);
      *(bf16x8*)(dst + (t + 32 * u) * CN_ROW + n8) = pack8(acc);
    }
  }
}

constexpr int S3_CS = 0, S3_BS = 64 * CN_ROW * 2, S3_CB = S3_BS + 256 * CN_ROW * 2, S3_CUM = S3_CB + 64 * BT_ROW * 2, S3_DTS = S3_CUM + 8192,
              S3_PART = S3_DTS + 8192, S3_RSTD = S3_PART + 2048, S3_END = S3_RSTD + 256;

DI void phase_ssd_out(const Params& p, unsigned char* smem) {
  const bf16_t* XT = (const bf16_t*)(p.ws + OFF_XT); const bf16_t* BR = (const bf16_t*)(p.ws + OFF_BR); const bf16_t* CR = (const bf16_t*)(p.ws + OFF_CR);
  const float* DTp = (const float*)(p.ws + OFF_DT); const float* ST = (const float*)(p.ws + OFF_ST); bf16_t* Z = (bf16_t*)p.out;
  bf16_t* Cs = (bf16_t*)(smem + S3_CS); bf16_t* Bs = (bf16_t*)(smem + S3_BS); bf16_t* CBs = (bf16_t*)(smem + S3_CB);
  float* cumA = (float*)(smem + S3_CUM); float* dts = (float*)(smem + S3_DTS); float* part = (float*)(smem + S3_PART); float* rstd = (float*)(smem + S3_RSTD);
  const int tid = otid(), lane = tid & 63, w = tid >> 6, l31 = lane & 31, lh = lane >> 5;
  const bool persist = (gridDim.x == 256);
  for (int u = blockIdx.x; u < 1024; u += gridDim.x) {
    const int tq = u >> 8, rest = u & 255; const int b = rest >> 7, c = (rest >> 2) & 31, g = rest & 3; const int hd = 8 * g + w;
    const int ns = (tq + 1) * 64;
    if (!persist || tq == 0) {
      float d4[4], c4[4], last; chunk_cumsum(DTp, (size_t)b * SEQ + c * 256, hd, -__expf(p.A_log[hd]), lane, d4, c4, last);
      *(float4*)(cumA + w * 256 + 4 * lane) = make_float4(c4[0], c4[1], c4[2], c4[3]);
      *(float4*)(dts + w * 256 + 4 * lane) = make_float4(d4[0], d4[1], d4[2], d4[3]);
    }
    stage_tokmajor(p, CR, b, c * 256 + tq * 64, 64, g, 2560, Cs, tid);
    { const int r0 = persist ? tq * 64 : 0; stage_tokmajor(p, BR, b, c * 256 + r0, ns - r0, g, 2048, Bs + r0 * CN_ROW, tid); }
    __syncthreads();
    if (32 * w < ns) {
      f32x16 a2[2];
#pragma unroll
      for (int a = 0; a < 2; ++a)
#pragma unroll
        for (int i = 0; i < 16; ++i) a2[a][i] = 0.f;
#pragma unroll
      for (int ks = 0; ks < 8; ++ks) {
        const bf16x8 af = *(const bf16x8*)(Bs + (32 * w + l31) * CN_ROW + ks * 16 + 8 * lh);
#pragma unroll
        for (int tt = 0; tt < 2; ++tt) {
          const bf16x8 bq = *(const bf16x8*)(Cs + (tt * 32 + l31) * CN_ROW + ks * 16 + 8 * lh);
          a2[tt] = MFMA32(af, bq, a2[tt]);
        }
      }
#pragma unroll
      for (int tt = 0; tt < 2; ++tt)
#pragma unroll
        for (int rg = 0; rg < 4; ++rg) {
          uint2 o; o.x = pk2(a2[tt][4 * rg], a2[tt][4 * rg + 1]); o.y = pk2(a2[tt][4 * rg + 2], a2[tt][4 * rg + 3]);
          *(uint2*)(CBs + (tt * 32 + l31) * BT_ROW + 32 * w + 8 * rg + 4 * lh) = o;
        }
    }
    __syncthreads();
    f32x16 acc[2][2];
#pragma unroll
    for (int a = 0; a < 2; ++a)
#pragma unroll
      for (int q = 0; q < 2; ++q)
#pragma unroll
        for (int i = 0; i < 16; ++i) acc[a][q][i] = 0.f;
    {
      const bf16_t* Sp = (const bf16_t*)ST + (((size_t)(b * 32 + c) * 32 + hd) * 64) * 128;
      for (int kb = 0; kb < 8; kb += 4) {
        bf16x8 bfr[4][2];
#pragma unroll
        for (int i = 0; i < 4; ++i)
#pragma unroll
          for (int pt = 0; pt < 2; ++pt) bfr[i][pt] = *(const bf16x8*)(Sp + (pt * 32 + l31) * 128 + (kb + i) * 16 + 8 * lh);
#pragma unroll
        for (int i = 0; i < 4; ++i) {
          const int ks = kb + i;
#pragma unroll
          for (int tt = 0; tt < 2; ++tt) {
            const bf16x8 af = *(const bf16x8*)(Cs + (tt * 32 + l31) * CN_ROW + ks * 16 + 8 * lh);
#pragma unroll
            for (int pt = 0; pt < 2; ++pt) acc[tt][pt] = MFMA32(af, bfr[i][pt], acc[tt][pt]);
          }
        }
      }
#pragma unroll
      for (int tt = 0; tt < 2; ++tt)
#pragma unroll
        for (int r = 0; r < 16; ++r) {
          const float e = __expf(cumA[w * 256 + tq * 64 + tt * 32 + (r & 3) + 8 * (r >> 2) + 4 * lh]);
          acc[tt][0][r] *= e; acc[tt][1][r] *= e;
        }
    }
    {
      const float Dh = p.Dskip[hd];
      const int tl0 = tq * 64 + l31, tl1 = tq * 64 + 32 + l31;
      const float ct0 = cumA[w * 256 + tl0], ct1 = cumA[w * 256 + tl1];
      const bf16_t* XTC = (const bf16_t*)(p.ws + (b ? OFF_ST + 32 * MiB : OFF_XN)) + ((size_t)(hd * 64 + l31)) * SEQ + c * 256 + 8 * lh;
      const int nks = ns >> 4;
      for (int kb = 0; kb < nks; kb += 4) {
        bf16x8 xq[4][2];
#pragma unroll
        for (int i = 0; i < 4; ++i)
#pragma unroll
          for (int pt = 0; pt < 2; ++pt) xq[i][pt] = *(const bf16x8*)(XTC + (size_t)pt * 32 * SEQ + (kb + i) * 16);
#pragma unroll
        for (int i = 0; i < 4; ++i) {
          const int ks = kb + i; const int s0 = ks * 16 + 8 * lh;
          const float4 c0 = *(const float4*)(cumA + w * 256 + s0), c1 = *(const float4*)(cumA + w * 256 + s0 + 4);
          const float4 d0 = *(const float4*)(dts + w * 256 + s0), d1 = *(const float4*)(dts + w * 256 + s0 + 4);
          const float cs[8] = {c0.x, c0.y, c0.z, c0.w, c1.x, c1.y, c1.z, c1.w};
          const float ds[8] = {d0.x, d0.y, d0.z, d0.w, d1.x, d1.y, d1.z, d1.w};
          const float cref = cumA[w * 256 + ks * 16];
          const bool steep = (cref - cumA[w * 256 + ks * 16 + 15]) > 60.f;
          float Fs[8];
#pragma unroll
          for (int j = 0; j < 8; ++j) Fs[j] = __expf(fminf(cref - cs[j], 64.f)) * ds[j];
#pragma unroll
          for (int tt = 0; tt < 2; ++tt) {
            if (ks * 16 <= tq * 64 + tt * 32 + 31) {
              const int tl = tt ? tl1 : tl0; const float ct = tt ? ct1 : ct0;
              const float Et = __expf(fminf(ct - cref, 0.f));
              const uint4 cbv = *(const uint4*)(CBs + (tt * 32 + l31) * BT_ROW + s0);
              const float cb[8] = {lo16(cbv.x), hi16(cbv.x), lo16(cbv.y), hi16(cbv.y), lo16(cbv.z), hi16(cbv.z), lo16(cbv.w), hi16(cbv.w)};
              float mv[8];
              if (steep) {
#pragma unroll
                for (int j = 0; j < 8; ++j) {
                  const int sidx = s0 + j;
                  float v = cb[j] * __expf(fminf(ct - cs[j], 0.f)) * ds[j];
                  v = (sidx <= tl) ? v : 0.f;
                  if (sidx == tl) v += Dh;
                  mv[j] = v;
                }
              } else if (ks * 16 + 15 > tq * 64 + tt * 32) {
#pragma unroll
                for (int j = 0; j < 8; ++j) {
                  const int sidx = s0 + j;
                  float v = cb[j] * (Et * Fs[j]);
                  v = (sidx <= tl) ? v : 0.f;
                  if (sidx == tl) v += Dh;
                  mv[j] = v;
                }
              } else {
#pragma unroll
                for (int j = 0; j < 8; ++j) mv[j] = cb[j] * (Et * Fs[j]);
              }
              const bf16x8 af = pack8(mv);
#pragma unroll
              for (int pt = 0; pt < 2; ++pt) acc[tt][pt] = MFMA32(af, xq[i][pt], acc[tt][pt]);
            }
          }
        }
      }
    }
    const size_t tokb = (size_t)b * SEQ + c * 256 + tq * 64;
#pragma unroll
    for (int tt = 0; tt < 2; ++tt)
#pragma unroll
      for (int r = 0; r < 16; ++r) {
        const int tloc = tt * 32 + (r & 3) + 8 * (r >> 2) + 4 * lh;
        const bf16_t* zp = Z + (tokb + tloc) * 2048 + hd * 64 + l31;
        const float y0 = acc[tt][0][r] * silu_f(bf2f(zp[0])), y1 = acc[tt][1][r] * silu_f(bf2f(zp[32]));
        acc[tt][0][r] = y0; acc[tt][1][r] = y1;
        float v = y0 * y0 + y1 * y1;
        v += swz_xor<1>(v); v += swz_xor<2>(v); v += swz_xor<4>(v); v += swz_xor<8>(v); v += swz_xor<16>(v);
        if (l31 == 0) part[w * 64 + tloc] = v;
      }
    __syncthreads();
    if (tid < 64) {
      float sres = 0.f;
#pragma unroll
      for (int ww = 0; ww < 8; ++ww) sres += part[ww * 64 + tid];
      rstd[tid] = rsqrtf(sres * (1.f / 512.f) + 1e-6f);
    }
    __syncthreads();
#pragma unroll
    for (int tt = 0; tt < 2; ++tt)
#pragma unroll
      for (int r = 0; r < 16; ++r) {
        const int tloc = tt * 32 + (r & 3) + 8 * (r >> 2) + 4 * lh;
        const float rs = rstd[tloc];
        bf16_t* zp = Z + (tokb + tloc) * 2048 + hd * 64 + l31;
        zp[0] = f2bf(acc[tt][0][r] * rs); zp[32] = f2bf(acc[tt][1][r] * rs);
      }
    __syncthreads();
  }
}

constexpr int KROW = 104;
constexpr int VROW = 68;
constexpr int ATT_K_BYTES = 64 * KROW * 2;
constexpr int ATT_V_BYTES = 64 * VROW * 2;
constexpr int ATT_STAGE = ATT_K_BYTES + ATT_V_BYTES;

DI void attn_kload(const bf16_t* sK, bf16x8 (&kf)[2][6], int l31, int lh) {
#pragma unroll
  for (int sub = 0; sub < 2; ++sub)
#pragma unroll
    for (int ks = 0; ks < 6; ++ks) kf[sub][ks] = *(const bf16x8*)(sK + (sub * 32 + l31) * KROW + ks * 16 + lh * 8);
}
DI void attn_qkmma(const bf16x8 (&kf)[2][6], const bf16x8 (&qf)[6], f32x16 (&sc)[2]) {
#pragma unroll
  for (int sub = 0; sub < 2; ++sub)
#pragma unroll
    for (int i = 0; i < 16; ++i) sc[sub][i] = 0.f;
#pragma unroll
  for (int ks = 0; ks < 6; ++ks)
#pragma unroll
    for (int sub = 0; sub < 2; ++sub) sc[sub] = MFMA32(kf[sub][ks], qf[ks], sc[sub]);
}
DI void attn_qk(const bf16_t* sK, const bf16x8 (&qf)[6], f32x16 (&sc)[2], int l31, int lh, float init = 0.f) {
  bf16x8 kf[2][6]; attn_kload(sK, kf, l31, lh);
#pragma unroll
  for (int sub = 0; sub < 2; ++sub)
#pragma unroll
    for (int i = 0; i < 16; ++i) sc[sub][i] = init;
#pragma unroll
  for (int ks = 0; ks < 6; ++ks)
#pragma unroll
    for (int sub = 0; sub < 2; ++sub) sc[sub] = MFMA32(kf[sub][ks], qf[ks], sc[sub]);
}

template <bool MASK>
DI void attn_softmax(f32x16 (&sc)[2], f32x16 (&o)[2], float& m, float& l, float mu, int kt, int myq, int lh) {
  float tmax = -1e30f;
#pragma unroll
  for (int sub = 0; sub < 2; ++sub)
#pragma unroll
    for (int r = 0; r < 16; ++r) {
      if (MASK) { const int key = kt * 64 + sub * 32 + (r & 3) + 8 * (r >> 2) + 4 * lh; if (key > myq) sc[sub][r] = -1e30f; }
      tmax = fmaxf(tmax, sc[sub][r]);
    }
  {
    const auto r = __builtin_amdgcn_permlane32_swap(__float_as_uint(tmax), __float_as_uint(tmax), false, false);
    tmax = fmaxf(__uint_as_float(r[0]), __uint_as_float(r[1]));
  }
  const float tmt = tmax + mu;
  if (__builtin_amdgcn_ballot_w64(tmt - m > 8.f) != 0) {
    const float mn = fmaxf(m, tmt); const float al = __builtin_amdgcn_exp2f(m - mn); m = mn;
    l *= al;
#pragma unroll
    for (int a = 0; a < 2; ++a)
#pragma unroll
      for (int i = 0; i < 16; ++i) o[a][i] *= al;
  }
  const float delta = m - mu;
  float ps = 0.f;
  if (__builtin_amdgcn_ballot_w64(delta != 0.f) == 0) {
#pragma unroll
    for (int sub = 0; sub < 2; ++sub)
#pragma unroll
      for (int r = 0; r < 16; ++r) { const float pe = __builtin_amdgcn_exp2f(sc[sub][r]); sc[sub][r] = pe; ps += pe; }
  } else {
#pragma unroll
    for (int sub = 0; sub < 2; ++sub)
#pragma unroll
      for (int r = 0; r < 16; ++r) { const float pe = __builtin_amdgcn_exp2f(sc[sub][r] - delta); sc[sub][r] = pe; ps += pe; }
  }
  l += ps;
}
DI void attn_pv(const f32x16 (&sc)[2], f32x16 (&o)[2], const bf16_t* sV, int l31, int lh) {
#pragma unroll
  for (int sub = 0; sub < 2; ++sub)
#pragma unroll
    for (int s2 = 0; s2 < 2; ++s2) {
      uint4 pu; pu.x = pk2(sc[sub][8 * s2], sc[sub][8 * s2 + 1]); pu.y = pk2(sc[sub][8 * s2 + 2], sc[sub][8 * s2 + 3]);
      pu.z = pk2(sc[sub][8 * s2 + 4], sc[sub][8 * s2 + 5]); pu.w = pk2(sc[sub][8 * s2 + 6], sc[sub][8 * s2 + 7]);
      const bf16x8 pb = __builtin_bit_cast(bf16x8, pu);
#pragma unroll
      for (int dvt = 0; dvt < 2; ++dvt) {
        const bf16_t* vp = sV + (dvt * 32 + l31) * VROW + sub * 32 + 16 * s2 + 4 * lh;
        const uint2 lo = *(const uint2*)vp, hi = *(const uint2*)(vp + 8);
        uint4 vu = {lo.x, lo.y, hi.x, hi.y};
        o[dvt] = MFMA32(__builtin_bit_cast(bf16x8, vu), pb, o[dvt]);
      }
    }
}

DI void attn_unit(const Params& p, int b, int h, int qb, unsigned char* smem) {
  const bf16_t* Q = (const bf16_t*)p.out; const bf16_t* KN = (const bf16_t*)(p.ws + OFF_XN); const bf16_t* VT = (const bf16_t*)(p.ws + OFF_BT);
  const bf16_t* KROPE = (const bf16_t*)(p.ws + OFF_DEC); const bf16_t* GATE = (const bf16_t*)(p.ws + OFF_ST); bf16_t* O = (bf16_t*)(p.ws + OFF_ST + 32 * MiB);
  const int tid = otid(), lane = tid & 63, w = tid >> 6, l31 = lane & 31, lh = lane >> 5;
  const int q0 = qb * 256, qw0 = q0 + 32 * w, myq = qw0 + l31;
  const size_t tq = (size_t)b * SEQ + myq;
  bf16x8 qf[6];
#pragma unroll
  for (int ks = 0; ks < 6; ++ks) qf[ks] = *(const bf16x8*)(Q + tq * 1536 + h * 96 + ks * 16 + lh * 8);
  f32x16 o[2];
#pragma unroll
  for (int a = 0; a < 2; ++a)
#pragma unroll
    for (int i = 0; i < 16; ++i) o[a][i] = 0.f;
  float m = -1e30f, l = 0.f;
  const int ntiles = 4 * qb + 4;
  const int nact = (qw0 + 31) / 64 + 1;
  const int kr = tid >> 3, kc = (tid & 7) * 8;
  const int rr = (tid & 255) >> 2, rc = (tid & 3) * 8;
  const bf16_t* gK = KN + ((size_t)b * SEQ + kr) * 1024 + h * 64 + kc;
  const bf16_t* gR = KROPE + ((size_t)b * SEQ + rr) * 32 + rc;
  const bf16_t* gV = VT + ((size_t)((b * 16 + h) * 64 + kr)) * SEQ + kc;
  uint4 rk, rr4, rv;
#define ATT_LOAD(T) do { rk = *(const uint4*)(gK + (size_t)(T) * 64 * 1024); rr4 = *(const uint4*)(gR + (size_t)(T) * 64 * 32); rv = *(const uint4*)(gV + (T) * 64); } while (0)
#define ATT_STORE(ST_) do { bf16_t* dK_ = (bf16_t*)(smem + (ST_) * ATT_STAGE); bf16_t* dV_ = (bf16_t*)(smem + (ST_) * ATT_STAGE + ATT_K_BYTES); \
    *(uint4*)(dK_ + kr * KROW + kc) = rk; *(uint4*)(dK_ + rr * KROW + 64 + rc) = rr4; \
    *(uint2*)(dV_ + kr * VROW + kc) = make_uint2(rv.x, rv.y); *(uint2*)(dV_ + kr * VROW + kc + 4) = make_uint2(rv.z, rv.w); } while (0)
  ATT_LOAD(0); ATT_STORE(0);
  ATT_LOAD(1); ATT_STORE(1);
  __syncthreads();
  f32x16 sc[2], sn[2];
  float mu_c = 0.f, mu_n = 0.f;
  attn_qk((const bf16_t*)smem, qf, sc, l31, lh);
  int st = 0;
  int kt = 0;
  for (; kt < nact - 1; ++kt) {
    const int st1 = (st == 2) ? 0 : st + 1, st2 = (st1 == 2) ? 0 : st1 + 1;
    const int tl = (kt + 2 < ntiles) ? kt + 2 : ntiles - 1;
    ATT_LOAD(tl);
    mu_n = (m > -1e29f) ? m : 0.f;
    attn_qk((const bf16_t*)(smem + st1 * ATT_STAGE), qf, sn, l31, lh, -mu_n);
    attn_softmax<false>(sc, o, m, l, mu_c, kt, myq, lh);
    attn_pv(sc, o, (const bf16_t*)(smem + st * ATT_STAGE + ATT_K_BYTES), l31, lh);
    ATT_STORE(st2);
    __syncthreads();
#pragma unroll
    for (int sub = 0; sub < 2; ++sub) sc[sub] = sn[sub];
    mu_c = mu_n;
    st = st1;
  }
  {
    const int st1 = (st == 2) ? 0 : st + 1, st2 = (st1 == 2) ? 0 : st1 + 1;
    const int tl = (kt + 2 < ntiles) ? kt + 2 : ntiles - 1;
    ATT_LOAD(tl);
    attn_softmax<true>(sc, o, m, l, mu_c, kt, myq, lh);
    attn_pv(sc, o, (const bf16_t*)(smem + st * ATT_STAGE + ATT_K_BYTES), l31, lh);
    ATT_STORE(st2);
    __syncthreads();
    st = st1; ++kt;
  }
  for (; kt < ntiles; ++kt) {
    const int st1 = (st == 2) ? 0 : st + 1, st2 = (st1 == 2) ? 0 : st1 + 1;
    const int tl = (kt + 2 < ntiles) ? kt + 2 : ntiles - 1;
    ATT_LOAD(tl);
    ATT_STORE(st2);
    __syncthreads();
    st = st1;
  }
#undef ATT_LOAD
#undef ATT_STORE
  l += __shfl_xor(l, 32);
  const float il = 1.f / l;
#pragma unroll
  for (int dvt = 0; dvt < 2; ++dvt)
#pragma unroll
    for (int rg = 0; rg < 4; ++rg) {
      const int dv = dvt * 32 + 8 * rg + 4 * lh;
      const uint2 gv = *(const uint2*)(GATE + tq * 1024 + h * 64 + dv);
      const float g0 = __uint_as_float(gv.x << 16), g1 = __uint_as_float(gv.x & 0xffff0000u), g2 = __uint_as_float(gv.y << 16), g3 = __uint_as_float(gv.y & 0xffff0000u);
      uint2 ov; ov.x = pk2(o[dvt][4 * rg] * il * g0, o[dvt][4 * rg + 1] * il * g1); ov.y = pk2(o[dvt][4 * rg + 2] * il * g2, o[dvt][4 * rg + 3] * il * g3);
      *(uint2*)(O + tq * 1024 + h * 64 + dv) = ov;
    }
}

DI void phase_attn(const Params& p, unsigned char* smem) {
  for (int u = blockIdx.x; u < 512; u += gridDim.x) {
    int pu = u;
    if (gridDim.x == 256) {
      const int xcd = blockIdx.x & 7, li = blockIdx.x >> 3, r = u >> 8;
      pu = (r * 16 + xcd * 2 + (li >> 4)) * 16 + (li & 15);
    }
    const int bh = pu >> 4, x = pu & 15;
    for (int half = 0; half < 2; ++half) attn_unit(p, bh >> 4, bh & 15, half ? x : 31 - x, smem);
  }
}

DI void phase_final_norm(const Params& p) {
  const int tid = otid(); const int lane = tid & 63, w = tid >> 6;
  float4 g[4];
#pragma unroll
  for (int i = 0; i < 4; ++i) g[i] = ((const float4*)p.g_final)[lane + 64 * i];
  for (int row = (blockIdx.x * 8 + w) * 2; row < T; row += gridDim.x * 16) {
    float4 v[2][4]; float ss[2] = {0.f, 0.f};
#pragma unroll
    for (int u = 0; u < 2; ++u)
#pragma unroll
      for (int i = 0; i < 4; ++i) v[u][i] = ((const float4*)(p.out + (size_t)(row + u) * DM))[lane + 64 * i];
#pragma unroll
    for (int u = 0; u < 2; ++u) {
#pragma unroll
      for (int i = 0; i < 4; ++i) ss[u] += v[u][i].x * v[u][i].x + v[u][i].y * v[u][i].y + v[u][i].z * v[u][i].z + v[u][i].w * v[u][i].w;
      ss[u] = wave_sum(ss[u]);
      const float r = rsqrtf(ss[u] * (1.f / 1024.f) + 1e-6f);
#pragma unroll
      for (int i = 0; i < 4; ++i)
        ((float4*)(p.out + (size_t)(row + u) * DM))[lane + 64 * i] = make_float4(v[u][i].x * r * g[i].x, v[u][i].y * r * g[i].y, v[u][i].z * r * g[i].z, v[u][i].w * r * g[i].w);
    }
  }
}

__global__ void __launch_bounds__(NTHREADS) mega(Params p) {
  cg::grid_group grid = cg::this_grid();
  extern __shared__ __attribute__((aligned(16))) unsigned char smem[];
  unsigned char* ws = p.ws;
  __shared__ unsigned bar_st[4];
  if (threadIdx.x < 4) bar_st[threadIdx.x] = 0u;
  __syncthreads();
  const XcdBarrier xb = xcd_barrier_post((unsigned*)(ws + OFF_BAR), bar_st);
  const bool tailfill = (gridDim.x == 256);
  phase_prep(p, smem, blockIdx.x, tailfill ? 1344 : 2832, gridDim.x);
  phase_rope_tables(p);
  phase_rmsnorm_rows(p.x, (bf16_t*)(ws + OFF_XN));
  if (p.out == nullptr) grid.sync();
  xcd_barrier(xb);
  gemm_phase<EPI_SSM_IN, 1024>(p, (const bf16_t*)(ws + OFF_W1), (const bf16_t*)(ws + OFF_XN), 21, smem);
  if (tailfill && (blockIdx.x >> 3) >= 8) phase_prep(p, smem, 1344 + (blockIdx.x & 7) * 24 + ((blockIdx.x >> 3) - 8), 2832, 192);
  xcd_barrier(xb);
  phase_ssd_state(p, smem);
  xcd_barrier(xb);
  phase_ssd_scan(p);
  xcd_barrier(xb);
  phase_ssd_out(p, smem);
  xcd_barrier(xb);
  gemm_phase<EPI_OUT1, 2048>(p, (const bf16_t*)(ws + OFF_W2), (const bf16_t*)p.out, 4, smem);
  xcd_barrier(xb);
  gemm_phase<EPI_MLA_IN, 1024>(p, (const bf16_t*)(ws + OFF_W3), (const bf16_t*)(ws + OFF_XN), 7, smem);
  xcd_barrier(xb);
  gemm_phase<EPI_KVUP, 256>(p, (const bf16_t*)(ws + OFF_W4), (const bf16_t*)(ws + OFF_ST + 32 * MiB), 8, smem);
  gemm_phase<EPI_QUP, 384>(p, (const bf16_t*)(ws + OFF_W5), (const bf16_t*)(ws + OFF_ST + 40 * MiB), 6, smem);
  xcd_barrier(xb);
  phase_attn(p, smem);
  xcd_barrier(xb);
  gemm_phase<EPI_OUT2, 1024>(p, (const bf16_t*)(ws + OFF_W6), (const bf16_t*)(ws + OFF_ST + 32 * MiB), 4, smem);
  xcd_barrier(xb);
  phase_final_norm(p);
}

extern "C" void kernel_launch(void* const* d_in, const int* in_sizes, int n_in, void* d_out, int out_size, void* d_ws, size_t ws_size, hipStream_t stream) {
  static int grid = 0;
  if (grid == 0) {
    if (n_in != 20 || ws_size < WS_NEED) { fprintf(stderr, "kernel_launch: unexpected n_in %d / ws_size %zu\n", n_in, ws_size); grid = -1; return; }
    int dev = 0, cus = 0, per_cu = 0;
    hipGetDevice(&dev);
    hipDeviceGetAttribute(&cus, hipDeviceAttributeMultiprocessorCount, dev);
    if (hipFuncSetAttribute((const void*)mega, hipFuncAttributeMaxDynamicSharedMemorySize, LDS_BYTES) != hipSuccess) { fprintf(stderr, "hipFuncSetAttribute failed\n"); grid = -1; return; }
    hipOccupancyMaxActiveBlocksPerMultiprocessor(&per_cu, (const void*)mega, NTHREADS, LDS_BYTES);
    if (per_cu < 1) per_cu = 1;
    (void)hipGetLastError();
    grid = cus;
  }
  if (grid < 0) return;
  Params p{};
  p.x = (const float*)d_in[0]; p.pos = (const int*)d_in[1]; p.g_pre = (const float*)d_in[2]; p.ssm_w_in = (const float*)d_in[3];
  p.conv_w = (const float*)d_in[4]; p.conv_b = (const float*)d_in[5]; p.dt_bias = (const float*)d_in[6]; p.A_log = (const float*)d_in[7];
  p.Dskip = (const float*)d_in[8]; p.g_out = (const float*)d_in[9]; p.ssm_w_out = (const float*)d_in[10]; p.kv_g_in = (const float*)d_in[11];
  p.kv_w_down = (const float*)d_in[12]; p.kv_g_lat = (const float*)d_in[13]; p.kv_w_up = (const float*)d_in[14]; p.mla_w_in = (const float*)d_in[15];
  p.mla_g_q = (const float*)d_in[16]; p.mla_w_uq = (const float*)d_in[17]; p.mla_w_out = (const float*)d_in[18]; p.g_final = (const float*)d_in[19];
  p.out = (float*)d_out; p.ws = (unsigned char*)d_ws;
  if (hipMemsetAsync((char*)d_ws + OFF_BAR, 0, XCD_BAR_WORDS * sizeof(unsigned), stream) != hipSuccess) { fprintf(stderr, "memset of barrier words failed\n"); return; }
  void* args[] = {&p};
  hipError_t e = hipLaunchCooperativeKernel((const void*)mega, dim3(grid), dim3(NTHREADS), args, LDS_BYTES, stream);
  if (e != hipSuccess) fprintf(stderr, "cooperative launch failed: %s (grid %d)\n", hipGetErrorString(e), grid);
}
```

```cpp
#include <hip/hip_runtime.h>
#include <hip/hip_cooperative_groups.h>
#include <cstdio>
#include <cstdint>
namespace cg = cooperative_groups;

typedef unsigned short bf16_t;
typedef short bf16x8 __attribute__((ext_vector_type(8)));
typedef float f32x16 __attribute__((ext_vector_type(16)));
#define DI __device__ __forceinline__
#define MFMA32(a, b, c) __builtin_amdgcn_mfma_f32_32x32x16_bf16((a), (b), (c), 0, 0, 0)

constexpr int T = 16384, SEQ = 8192, DM = 1024;
constexpr int NTHREADS = 512;
constexpr size_t MiB = 1024 * 1024;
constexpr size_t OFF_W1 = 0;
constexpr size_t OFF_W2 = OFF_W1 + (size_t)5376 * 1024 * 2;
constexpr size_t OFF_W3 = OFF_W2 + (size_t)1024 * 2048 * 2;
constexpr size_t OFF_W4 = OFF_W3 + (size_t)1792 * 1024 * 2;
constexpr size_t OFF_W5 = OFF_W4 + (size_t)2048 * 256 * 2;
constexpr size_t OFF_W6 = OFF_W5 + (size_t)1536 * 384 * 2;
constexpr size_t OFF_XN = 24 * MiB;
constexpr size_t OFF_XT = 56 * MiB;
constexpr size_t OFF_BT = 120 * MiB;
constexpr size_t OFF_BR = 136 * MiB;
constexpr size_t OFF_CR = 152 * MiB;
constexpr size_t OFF_DT = 168 * MiB;
constexpr size_t OFF_ST = 170 * MiB;
constexpr size_t OFF_DEC = 234 * MiB;
constexpr size_t OFF_BAR = 236 * MiB;
constexpr size_t OFF_COS = 238 * MiB;
constexpr size_t OFF_SIN = 239 * MiB;
constexpr size_t OFF_SSQ = 240 * MiB;
constexpr size_t WS_NEED = 241 * MiB;

struct Params {
  const float* x; const int* pos; const float* g_pre; const float* ssm_w_in; const float* conv_w; const float* conv_b;
  const float* dt_bias; const float* A_log; const float* Dskip; const float* g_out; const float* ssm_w_out;
  const float* kv_g_in; const float* kv_w_down; const float* kv_g_lat; const float* kv_w_up;
  const float* mla_w_in; const float* mla_g_q; const float* mla_w_uq; const float* mla_w_out; const float* g_final;
  float* out; unsigned char* ws;
};

DI bf16_t f2bf(float x) { unsigned u = __float_as_uint(x); u += 0x7fffu + ((u >> 16) & 1u); return (bf16_t)(u >> 16); }
DI float bf2f(bf16_t b) { return __uint_as_float(((unsigned)b) << 16); }
DI float lo16(unsigned u) { return __uint_as_float(u << 16); }
DI float hi16(unsigned u) { return __uint_as_float(u & 0xffff0000u); }
typedef float f32x2 __attribute__((ext_vector_type(2)));
typedef __bf16 bf16x2_t __attribute__((ext_vector_type(2)));
DI unsigned pk2(float a, float b) { f32x2 v = {a, b}; bf16x2_t r = __builtin_convertvector(v, bf16x2_t); return __builtin_bit_cast(unsigned, r); }
DI float wave_sum(float v) {
#pragma unroll
  for (int o = 32; o >= 1; o >>= 1) v += __shfl_xor(v, o);
  return v;
}
DI int otid() { int t = threadIdx.x; asm volatile("" : "+v"(t)); return t; }
template <int K> DI float swz_xor(float v) {
  return __int_as_float(__builtin_amdgcn_ds_swizzle(__float_as_int(v), (K << 10) | 0x1f));
}
DI float silu_f(float v) { return v * __builtin_amdgcn_rcpf(1.f + __expf(-v)); }


#define XB_TMO      128
#define XB_XCNT(j)  (256  + 64 * (j))
#define XB_XSUB(j)  (1280 + 64 * (j))
#define XB_XGEN(j)  (2304 + 64 * (j))
#define XB_TOP      3328
#define XB_TOPGEN   3392
#define XCD_BAR_WORDS 3456
#define XB_SPIN_CAP (1u << 18)
DI unsigned xb_ld(unsigned* p)              { return __hip_atomic_load(p, __ATOMIC_RELAXED, __HIP_MEMORY_SCOPE_AGENT); }
DI unsigned xb_add(unsigned* p, unsigned v) { return __hip_atomic_fetch_add(p, v, __ATOMIC_RELAXED, __HIP_MEMORY_SCOPE_AGENT); }
DI unsigned xb_xcc_id() { return (unsigned)__builtin_amdgcn_s_getreg((3 << 11) | 20) & 0xFu; }
#define XB_SPIN(cond, bar) do { unsigned _sp = 0; while (cond) { __builtin_amdgcn_s_sleep(1); \
    if ((++_sp & 255u) == 0u) { if (xb_ld(&(bar)[XB_TMO])) break; if (_sp > XB_SPIN_CAP) { atomicAdd(&(bar)[XB_TMO], 1u); break; } } } } while (0)
struct XcdBarrier { unsigned* bar; unsigned x; volatile unsigned* st; };
DI XcdBarrier xcd_barrier_post(unsigned* bar, volatile unsigned* st) {
  XcdBarrier b; b.bar = bar; b.x = xb_xcc_id(); b.st = st;
  if (threadIdx.x == 0) (void)xb_add(&bar[XB_XCNT(b.x)], 1u);
  return b;
}
DI void xcd_barrier_complete(unsigned* bar, unsigned x, unsigned& nloc, unsigned& nx) {
  const unsigned G = gridDim.x * gridDim.y * gridDim.z;
  unsigned sum, cnt, mine, sp = 0u;
  for (;;) {
    sum = 0u; cnt = 0u; mine = 0u;
#pragma unroll
    for (unsigned j = 0; j < 16; ++j) { const unsigned c = xb_ld(&bar[XB_XCNT(j)]); sum += c; cnt += (c > 0u) ? 1u : 0u; mine = (j == x) ? c : mine; }
    if (sum == G) break;
    __builtin_amdgcn_s_sleep(1);
    if ((++sp & 255u) == 0u) { if (xb_ld(&bar[XB_TMO])) break; if (sp > XB_SPIN_CAP) { atomicAdd(&bar[XB_TMO], 1u); break; } }
  }
  nloc = mine > 0u ? mine : 1u; nx = cnt > 0u ? cnt : 1u;
}
DI void xcd_barrier(const XcdBarrier& b) {
  asm volatile("s_waitcnt vmcnt(0)" ::: "memory");
  __syncthreads();
  if (threadIdx.x == 0) {
    unsigned* bar = b.bar;
    __builtin_amdgcn_s_waitcnt(0);
    unsigned nloc = b.st[0], nx = b.st[1];
    if (nloc == 0u) { xcd_barrier_complete(bar, b.x, nloc, nx); b.st[0] = nloc; b.st[1] = nx; }
    const unsigned old = xb_add(&bar[XB_XSUB(b.x)], 1u);
    const unsigned gen = old / nloc;
    if (old + 1u == (gen + 1u) * nloc) {
      __builtin_amdgcn_fence(__ATOMIC_RELEASE, "agent");
      asm volatile("s_waitcnt vmcnt(0)" ::: "memory");
      const unsigned og = xb_add(&bar[XB_TOP], 1u);
      const unsigned tg = og / nx;
      if (og + 1u == (tg + 1u) * nx) xb_add(&bar[XB_TOPGEN], 1u);
      else XB_SPIN(xb_ld(&bar[XB_TOPGEN]) == tg, bar);
      __builtin_amdgcn_fence(__ATOMIC_ACQUIRE, "agent");
      xb_add(&bar[XB_XGEN(b.x)], 1u);
      asm volatile("s_waitcnt vmcnt(0)" ::: "memory");
    } else {
      XB_SPIN(xb_ld(&bar[XB_XGEN(b.x)]) == gen, bar);
      __builtin_amdgcn_fence(__ATOMIC_ACQUIRE, "agent");
      asm volatile("s_waitcnt vmcnt(0)" ::: "memory");
    }
  }
  __syncthreads();
}

struct WJob { const float* src; const float* gain; bf16_t* dst; int ld, col0, ncols, K, tile; };
DI WJob wprep_job(const Params& p, int u) {
  bf16_t* W1 = (bf16_t*)(p.ws + OFF_W1); bf16_t* W2 = (bf16_t*)(p.ws + OFF_W2); bf16_t* W3 = (bf16_t*)(p.ws + OFF_W3);
  bf16_t* W4 = (bf16_t*)(p.ws + OFF_W4); bf16_t* W5 = (bf16_t*)(p.ws + OFF_W5); bf16_t* W6 = (bf16_t*)(p.ws + OFF_W6);
  int t = u; WJob j;
  if (t < 1344) { j = {p.ssm_w_in, p.g_pre, W1, 5152, 0, 5152, 1024, t}; return j; } t -= 1344;
  if (t < 512) { j = {p.ssm_w_out, p.g_out, W2, 1024, 0, 1024, 2048, t}; return j; } t -= 512;
  if (t < 64) { j = {p.kv_w_down, p.kv_g_in, W3, 288, 0, 256, 1024, t}; return j; } t -= 64;
  if (t < 96) { j = {p.mla_w_in, p.g_pre + 1024, W3 + (size_t)256 * 1024, 1408, 0, 384, 1024, t}; return j; } t -= 96;
  if (t < 256) { j = {p.mla_w_in, p.g_pre + 1024, W3 + (size_t)640 * 1024, 1408, 384, 1024, 1024, t}; return j; } t -= 256;
  if (t < 32) { j = {p.kv_w_down, p.kv_g_in, W3 + (size_t)1664 * 1024, 288, 256, 32, 1024, t}; return j; } t -= 32;
  if (t < 128) { j = {p.kv_w_up, p.kv_g_lat, W4, 2048, 0, 2048, 256, t}; return j; } t -= 128;
  if (t < 144) { j = {p.mla_w_uq, p.mla_g_q, W5, 1536, 0, 1536, 384, t}; return j; } t -= 144;
  j = {p.mla_w_out, nullptr, W6, 1024, 0, 1024, 1024, t}; return j;
}
DI void wprep_load(const WJob& j, int tid0, float4 (&v)[2], float (&gk)[2]) {
  const int nkt = j.K >> 6; const int tn = j.tile / nkt, tk = j.tile % nkt; const int n0 = tn * 64, k0 = tk * 64;
#pragma unroll
  for (int i = 0; i < 2; ++i) {
    const int e = tid0 + NTHREADS * i; const int kk = e >> 4, n4 = (e & 15) * 4;
    v[i] = make_float4(0.f, 0.f, 0.f, 0.f);
    if (n0 + n4 < j.ncols) v[i] = *(const float4*)(j.src + (size_t)(k0 + kk) * j.ld + j.col0 + n0 + n4);
    gk[i] = j.gain ? j.gain[k0 + kk] : 1.f;
  }
}
DI void phase_prep(const Params& p, unsigned char* smem, int ustart, int uend, int ustride) {
  float* sm = (float*)smem;
  const int tid0 = otid();
  int u = ustart;
  if (u >= uend) return;
  WJob j = wprep_job(p, u);
  float4 v[2]; float gk[2];
  wprep_load(j, tid0, v, gk);
  for (;;) {
#pragma unroll
    for (int i = 0; i < 2; ++i) {
      const int e = tid0 + NTHREADS * i; const int kk = e >> 4, n4 = (e & 15) * 4;
      float* d = sm + kk * 65 + n4;
      d[0] = v[i].x * gk[i]; d[1] = v[i].y * gk[i]; d[2] = v[i].z * gk[i]; d[3] = v[i].w * gk[i];
    }
    __syncthreads();
    const WJob jc = j;
    const int un = u + ustride; const bool more = (un < uend);
    if (more) { j = wprep_job(p, un); wprep_load(j, tid0, v, gk); }
    {
      const int nkt = jc.K >> 6; const int tn = jc.tile / nkt, tk = jc.tile % nkt; const int n0 = tn * 64, k0 = tk * 64;
      const int nn = tid0 >> 3, kc = (tid0 & 7) * 8;
      uint4 o;
      o.x = pk2(sm[(kc + 0) * 65 + nn], sm[(kc + 1) * 65 + nn]); o.y = pk2(sm[(kc + 2) * 65 + nn], sm[(kc + 3) * 65 + nn]);
      o.z = pk2(sm[(kc + 4) * 65 + nn], sm[(kc + 5) * 65 + nn]); o.w = pk2(sm[(kc + 6) * 65 + nn], sm[(kc + 7) * 65 + nn]);
      *(uint4*)(jc.dst + (size_t)(n0 + nn) * jc.K + k0 + kc) = o;
    }
    __syncthreads();
    if (!more) break;
    u = un;
  }
}

DI void phase_rope_tables(const Params& p, int blk, int nblk) {
  float* COS = (float*)(p.ws + OFF_COS); float* SIN = (float*)(p.ws + OFF_SIN);
  for (int e = blk * NTHREADS + otid(); e < T * 16; e += nblk * NTHREADS) {
    const int t = e >> 4, i = e & 15;
    const float ang = (float)p.pos[t] * powf(10000.f, -(float)(2 * i) / 32.f);
    COS[e] = cosf(ang); SIN[e] = sinf(ang);
  }
  float* SSQ = (float*)(p.ws + OFF_SSQ);
  for (int e = blk * NTHREADS + otid(); e < 3 * T; e += nblk * NTHREADS) SSQ[e] = 0.f;
}

DI void phase_rmsnorm_rows(const float* __restrict__ src, bf16_t* __restrict__ dst) {
  const int tid = otid(); const int lane = tid & 63, w = tid >> 6;
  for (int row = (blockIdx.x * 8 + w) * 2; row < T; row += gridDim.x * 16) {
    float4 v[2][4]; float ss[2] = {0.f, 0.f};
#pragma unroll
    for (int u = 0; u < 2; ++u)
#pragma unroll
      for (int i = 0; i < 4; ++i) v[u][i] = ((const float4*)(src + (size_t)(row + u) * DM))[lane + 64 * i];
#pragma unroll
    for (int u = 0; u < 2; ++u) {
#pragma unroll
      for (int i = 0; i < 4; ++i) ss[u] += v[u][i].x * v[u][i].x + v[u][i].y * v[u][i].y + v[u][i].z * v[u][i].z + v[u][i].w * v[u][i].w;
      ss[u] = wave_sum(ss[u]);
      const float r = rsqrtf(ss[u] * (1.f / 1024.f) + 1e-6f);
#pragma unroll
      for (int i = 0; i < 4; ++i) {
        uint2 o; o.x = pk2(v[u][i].x * r, v[u][i].y * r); o.y = pk2(v[u][i].z * r, v[u][i].w * r);
        *(uint2*)(dst + (size_t)(row + u) * DM + (lane + 64 * i) * 4) = o;
      }
    }
  }
}

enum { EPI_SSM_IN = 0, EPI_OUT1 = 1, EPI_MLA_IN = 2, EPI_KVUP = 3, EPI_QUP = 4, EPI_OUT2 = 5 };


typedef float f32x4 __attribute__((ext_vector_type(4)));
constexpr int EPI_WAVE_BYTES = 8704;
constexpr int TM_ROW = 72;
constexpr int CM_ROW = 40;
constexpr int F32_ROW = 68;

template <bool SILU>
DI void stage_tm(const f32x4 (&a)[4][2], bf16_t* wl, int fr, int fq) {
#pragma unroll
  for (int m = 0; m < 4; ++m)
#pragma unroll
    for (int n = 0; n < 2; ++n) {
      float v0 = a[m][n][0], v1 = a[m][n][1], v2 = a[m][n][2], v3 = a[m][n][3];
      if (SILU) { v0 = silu_f(v0); v1 = silu_f(v1); v2 = silu_f(v2); v3 = silu_f(v3); }
      uint2 o; o.x = pk2(v0, v1); o.y = pk2(v2, v3);
      *(uint2*)(wl + (n * 16 + fr) * TM_ROW + m * 16 + fq * 4) = o;
    }
}
DI void readout_tm(const bf16_t* wl, bf16_t* gdst, size_t ld, int lane) {
#pragma unroll
  for (int it = 0; it < 4; ++it) {
    const int idx = lane + 64 * it; const int row = idx >> 3, ch = idx & 7;
    *(uint4*)(gdst + (size_t)row * ld + ch * 8) = *(const uint4*)(wl + row * TM_ROW + ch * 8);
  }
}
DI void stage_cm(const f32x4 (&a)[4][2], bf16_t* wl, int fr, int fq) {
#pragma unroll
  for (int m = 0; m < 4; ++m)
#pragma unroll
    for (int n = 0; n < 2; ++n)
#pragma unroll
      for (int j = 0; j < 4; ++j) wl[(m * 16 + fq * 4 + j) * CM_ROW + n * 16 + fr] = f2bf(a[m][n][j]);
}
DI void readout_cm(const bf16_t* wl, bf16_t* gdst, int lane) {
#pragma unroll
  for (int it = 0; it < 4; ++it) {
    const int idx = lane + 64 * it; const int row = idx >> 2, ch = idx & 3;
    *(uint4*)(gdst + (size_t)row * SEQ + ch * 8) = *(const uint4*)(wl + row * CM_ROW + ch * 8);
  }
}
constexpr int CMP_ROW = 72;
DI void stage_cm_pair(const f32x4 (&a)[4][2], bf16_t* wlp, int par, int fr, int fq) {
#pragma unroll
  for (int m = 0; m < 4; ++m)
#pragma unroll
    for (int n = 0; n < 2; ++n)
#pragma unroll
      for (int j = 0; j < 4; ++j) wlp[(m * 16 + fq * 4 + j) * CMP_ROW + par * 32 + n * 16 + fr] = f2bf(a[m][n][j]);
}
DI void readout_cm_pair(const bf16_t* wlp, bf16_t* gdst, int par, int lane) {
#pragma unroll
  for (int it = 0; it < 4; ++it) {
    const int idx = lane + 64 * it; const int row = par * 32 + (idx >> 3), ch = idx & 7;
    *(uint4*)(gdst + (size_t)row * SEQ + ch * 8) = *(const uint4*)(wlp + row * CMP_ROW + ch * 8);
  }
}
DI void stage_f32(const f32x4 (&a)[4][2], float* wl, int fr, int fq) {
#pragma unroll
  for (int m = 0; m < 4; ++m)
#pragma unroll
    for (int n = 0; n < 2; ++n) *(f32x4*)(wl + (n * 16 + fr) * F32_ROW + m * 16 + fq * 4) = a[m][n];
}
DI void readout_f32_resid(const float* wl, const float* __restrict__ resid, float* __restrict__ gdst, int lane) {
#pragma unroll 4
  for (int it = 0; it < 8; ++it) {
    const int idx = lane + 64 * it; const int row = idx >> 4, ch = idx & 15;
    const float4 v = *(const float4*)(wl + row * F32_ROW + ch * 4);
    const float4 r = *(const float4*)(resid + (size_t)row * DM + ch * 4);
    *(float4*)(gdst + (size_t)row * DM + ch * 4) = make_float4(v.x + r.x, v.y + r.y, v.z + r.z, v.w + r.w);
  }
}

DI void readout_f32_resid_ssq(const float* wl, const float* __restrict__ resid, float* __restrict__ gdst, bf16_t* __restrict__ hs, float* __restrict__ ssq, int lane) {
#pragma unroll 4
  for (int it = 0; it < 8; ++it) {
    const int idx = lane + 64 * it; const int row = idx >> 4, ch = idx & 15;
    const float4 v = *(const float4*)(wl + row * F32_ROW + ch * 4);
    const float4 r = *(const float4*)(resid + (size_t)row * DM + ch * 4);
    const float4 h = make_float4(v.x + r.x, v.y + r.y, v.z + r.z, v.w + r.w);
    *(float4*)(gdst + (size_t)row * DM + ch * 4) = h;
    uint2 o; o.x = pk2(h.x, h.y); o.y = pk2(h.z, h.w);
    *(uint2*)(hs + (size_t)row * DM + ch * 4) = o;
    float q = h.x * h.x + h.y * h.y + h.z * h.z + h.w * h.w;
    q += swz_xor<1>(q); q += swz_xor<2>(q); q += swz_xor<4>(q); q += swz_xor<8>(q);
    if (ch == 0) atomicAdd(ssq + row, q);
  }
}

template <int EPI>
DI void epilogue_block(const Params& p, const f32x4 (&a)[4][2], int c0, int mt, bf16_t* wl, bf16_t* wlp, int par, int lane, int fr, int fq) {
  unsigned char* ws = p.ws;
  const int b = mt >> 13, tok0 = mt & 8191;
  const int tok0p = tok0 - par * 32;
  if (EPI == EPI_SSM_IN) {
    if (c0 < 2048 || (c0 >= 4096 && c0 < 5120)) stage_tm<false>(a, wl, fr, fq);
    else if (c0 < 4096) stage_cm_pair(a, wlp, par, fr, fq);
    __syncthreads();
    if (c0 < 2048) readout_tm(wl, (bf16_t*)p.out + (size_t)mt * 2048 + c0, 2048, lane);
    else if (c0 < 4096) readout_cm_pair(wlp, (bf16_t*)(ws + OFF_XT) + ((size_t)(b * 2048 + (c0 - 2048))) * SEQ + tok0p, par, lane);
    else if (c0 < 4608) readout_tm(wl, (bf16_t*)(ws + OFF_BR) + (size_t)mt * 512 + (c0 - 4096), 512, lane);
    else if (c0 < 5120) readout_tm(wl, (bf16_t*)(ws + OFF_CR) + (size_t)mt * 512 + (c0 - 4608), 512, lane);
    else if (c0 == 5120) {
#pragma unroll
      for (int m = 0; m < 2; ++m)
#pragma unroll
        for (int n = 0; n < 2; ++n) {
          const int h = m * 16 + fq * 4;
          float4 o; float* op = (float*)&o;
#pragma unroll
          for (int j = 0; j < 4; ++j) { const float t = a[m][n][j] + p.dt_bias[h + j]; op[j] = (t > 20.f) ? t : log1pf(__expf(t)); }
          *(float4*)((float*)(ws + OFF_DT) + (size_t)(mt + n * 16 + fr) * 32 + h) = o;
        }
    }
    __syncthreads();
    if (c0 >= 4096 && c0 < 4608) stage_cm_pair(a, wlp, par, fr, fq);
    __syncthreads();
    if (c0 >= 4096 && c0 < 4608) readout_cm_pair(wlp, (bf16_t*)(ws + OFF_BT) + ((size_t)(b * 512 + (c0 - 4096))) * SEQ + tok0p, par, lane);
    __syncthreads();
  } else if (EPI == EPI_OUT1 || EPI == EPI_OUT2) {
    const float* resid = (EPI == EPI_OUT1) ? p.x : (const float*)(ws + OFF_XT);
    float* dst = (EPI == EPI_OUT1) ? (float*)(ws + OFF_XT) : p.out;
    stage_f32(a, (float*)wl, fr, fq); __syncthreads();
    if (EPI == EPI_OUT1) readout_f32_resid_ssq((const float*)wl, resid + (size_t)mt * DM + c0, dst + (size_t)mt * DM + c0, (bf16_t*)(ws + OFF_XN) + (size_t)mt * DM + c0, (float*)(ws + OFF_SSQ) + mt, lane);
    else readout_f32_resid((const float*)wl, resid + (size_t)mt * DM + c0, dst + (size_t)mt * DM + c0, lane);
    __syncthreads();
  } else if (EPI == EPI_MLA_IN) {
    const float* SSQ = (const float*)(ws + OFF_SSQ);
    f32x4 a2[4][2];
    float rs[2];
#pragma unroll
    for (int n = 0; n < 2; ++n) rs[n] = rsqrtf(SSQ[mt + n * 16 + fr] * (1.f / 1024.f) + 1e-6f);
#pragma unroll
    for (int m = 0; m < 4; ++m)
#pragma unroll
      for (int n = 0; n < 2; ++n) a2[m][n] = a[m][n] * rs[n];
    if (c0 < 640) {
      float* dstq = (float*)(ws + OFF_SSQ) + (c0 < 256 ? T : 2 * T);
#pragma unroll
      for (int n = 0; n < 2; ++n) {
        float q = 0.f;
#pragma unroll
        for (int m = 0; m < 4; ++m) q += a2[m][n][0] * a2[m][n][0] + a2[m][n][1] * a2[m][n][1] + a2[m][n][2] * a2[m][n][2] + a2[m][n][3] * a2[m][n][3];
        q += swz_xor<16>(q); q += __shfl_xor(q, 32);
        if (fq == 0) atomicAdd(dstq + mt + n * 16 + fr, q);
      }
    }
    const f32x4 (&a)[4][2] = a2;
    if (c0 < 640) stage_tm<false>(a, wl, fr, fq);
    else if (c0 < 1664) stage_tm<true>(a, wl, fr, fq);
    __syncthreads();
    if (c0 < 256) readout_tm(wl, (bf16_t*)(ws + OFF_ST + 32 * MiB) + (size_t)mt * 256 + c0, 256, lane);
    else if (c0 < 640) readout_tm(wl, (bf16_t*)(ws + OFF_ST + 40 * MiB) + (size_t)mt * 384 + (c0 - 256), 384, lane);
    else if (c0 < 1664) readout_tm(wl, (bf16_t*)(ws + OFF_ST) + (size_t)mt * 1024 + (c0 - 640), 1024, lane);
    else if (c0 == 1664) {
      const float* COS = (const float*)(ws + OFF_COS); const float* SIN = (const float*)(ws + OFF_SIN);
      bf16_t* KROPE = (bf16_t*)(ws + OFF_DEC);
#pragma unroll
      for (int n = 0; n < 2; ++n) {
        const int t = mt + n * 16 + fr;
        const f32x4 cs = *(const f32x4*)(COS + (size_t)t * 16 + fq * 4), sn = *(const f32x4*)(SIN + (size_t)t * 16 + fq * 4);
        const f32x4 x1 = a[0][n], x2 = a[1][n];
        const f32x4 r1 = x1 * cs - x2 * sn, r2 = x1 * sn + x2 * cs;
        uint2 o1, o2; o1.x = pk2(r1[0], r1[1]); o1.y = pk2(r1[2], r1[3]); o2.x = pk2(r2[0], r2[1]); o2.y = pk2(r2[2], r2[3]);
        *(uint2*)(KROPE + (size_t)t * 32 + fq * 4) = o1; *(uint2*)(KROPE + (size_t)t * 32 + 16 + fq * 4) = o2;
      }
    }
    __syncthreads();
  } else if (EPI == EPI_KVUP) {
    const int head = c0 >> 7; const bool isv = (c0 & 64) != 0;
    const float* SSQ = (const float*)(ws + OFF_SSQ) + T;
    f32x4 a2[4][2];
#pragma unroll
    for (int n = 0; n < 2; ++n) {
      const float rsn = rsqrtf(SSQ[mt + n * 16 + fr] * (1.f / 256.f) + 1e-6f);
#pragma unroll
      for (int m = 0; m < 4; ++m) a2[m][n] = a[m][n] * rsn;
    }
    const f32x4 (&a)[4][2] = a2;
    if (!isv) stage_tm<false>(a, wl, fr, fq); else stage_cm_pair(a, wlp, par, fr, fq);
    __syncthreads();
    if (!isv) readout_tm(wl, (bf16_t*)(ws + OFF_XN) + (size_t)mt * 1024 + head * 64, 1024, lane);
    else readout_cm_pair(wlp, (bf16_t*)(ws + OFF_BT) + ((size_t)((b * 16 + head) * 64)) * SEQ + tok0p, par, lane);
    __syncthreads();
  } else if (EPI == EPI_QUP) {
    const float SC = 0.10206207261596575f * 1.4426950408889634f;
    const float* SSQ = (const float*)(ws + OFF_SSQ) + 2 * T;
    f32x4 v[4][2];
#pragma unroll
    for (int n = 0; n < 2; ++n) {
      const float rsn = rsqrtf(SSQ[mt + n * 16 + fr] * (1.f / 384.f) + 1e-6f) * SC;
#pragma unroll
      for (int m = 0; m < 4; ++m) v[m][n] = a[m][n] * rsn;
    }
    const int ph = c0 % 96;
    if (ph != 0) {
      const float* COS = (const float*)(ws + OFF_COS); const float* SIN = (const float*)(ws + OFF_SIN);
#pragma unroll
      for (int n = 0; n < 2; ++n) {
        const int t = mt + n * 16 + fr;
        const f32x4 cs = *(const f32x4*)(COS + (size_t)t * 16 + fq * 4), sn = *(const f32x4*)(SIN + (size_t)t * 16 + fq * 4);
        if (ph == 64) { const f32x4 x1 = v[0][n], x2 = v[1][n]; v[0][n] = x1 * cs - x2 * sn; v[1][n] = x1 * sn + x2 * cs; }
        else          { const f32x4 x1 = v[2][n], x2 = v[3][n]; v[2][n] = x1 * cs - x2 * sn; v[3][n] = x1 * sn + x2 * cs; }
      }
    }
    stage_tm<false>(v, wl, fr, fq); __syncthreads();
    readout_tm(wl, (bf16_t*)p.out + (size_t)mt * 1536 + c0, 1536, lane);
    __syncthreads();
  }
}

constexpr int G8_BK = 64, G8_HALF = 128, G8_HT = G8_HALF * G8_BK;
constexpr int LDS_BYTES = 143360;
DI int g8_lds_byte(int r, int c) { const int st = (r >> 4) * 2 + (c >> 5), rr = r & 15, cc = c & 31, ob = rr * 64 + cc * 2; return st * 1024 + (ob ^ (((ob >> 9) & 1) << 5)); }
DI void g8_stage_rc(int b, int& R, int& C) { const int st = b / 1024, sb = b % 1024, swz = sb ^ (((sb >> 9) & 1) << 5); R = (st >> 1) * 16 + swz / 64; C = (st & 1) * 32 + (swz % 64) / 2; }

template <int EPI, int K>
DI void gemm_tile(const Params& p, const bf16_t* __restrict__ A, const bf16_t* __restrict__ Bt, int brow, int bcol, unsigned char* smem) {
  bf16_t* shm = (bf16_t*)smem;
#define SA(b, h) (shm + ((b) * 2 + (h)) * G8_HT)
#define SB(b, h) (shm + (4 + (b) * 2 + (h)) * G8_HT)
#define STAGE(P, BASE, br, kt) do { const long _g = (long)(br) * K + (long)(kt) * G8_BK; \
    _Pragma("unroll") for (int _i = 0; _i < 2; ++_i) { const int _b = tid * 16 + _i * 8192; int _r, _c; g8_stage_rc(_b, _r, _c); \
      __builtin_amdgcn_global_load_lds((const unsigned*)(BASE + _g + (long)_r * K + _c), (unsigned*)((char*)(P) + _b), 16, 0, 0); } } while (0)
#define LDA(dst, b, h) _Pragma("unroll") for (int m = 0; m < 4; ++m) _Pragma("unroll") for (int k = 0; k < 2; ++k) \
    dst[m][k] = *reinterpret_cast<const bf16x8*>((const char*)SA(b, h) + g8_lds_byte(wr * 64 + m * 16 + fr, k * 32 + fq * 8))
#define LDB(dst, b, h) _Pragma("unroll") for (int n = 0; n < 2; ++n) _Pragma("unroll") for (int k = 0; k < 2; ++k) \
    dst[n][k] = *reinterpret_cast<const bf16x8*>((const char*)SB(b, h) + g8_lds_byte(wc * 32 + n * 16 + fr, k * 32 + fq * 8))
#define MMA(ai, bj, At_, Bt_) do { __builtin_amdgcn_s_setprio(1); \
    _Pragma("unroll") for (int m = 0; m < 4; ++m) _Pragma("unroll") for (int n = 0; n < 2; ++n) _Pragma("unroll") for (int k = 0; k < 2; ++k) \
      acc[ai][bj][m][n] = __builtin_amdgcn_mfma_f32_16x16x32_bf16(At_[m][k], Bt_[n][k], acc[ai][bj][m][n], 0, 0, 0); \
    __builtin_amdgcn_s_setprio(0); } while (0)
#define WAIT_V(n) asm volatile("s_waitcnt vmcnt(" #n ")" ::: "memory")
#define WAIT_L(n) asm volatile("s_waitcnt lgkmcnt(" #n ")" ::: "memory")
#define BAR __builtin_amdgcn_s_barrier()
#define SCHED __builtin_amdgcn_sched_barrier(0)
  const int tid = otid();
  const int wid = tid >> 6, lane = tid & 63, wr = wid >> 2, wc = wid & 3, fr = lane & 15, fq = lane >> 4;
  f32x4 acc[2][2][4][2];
#pragma unroll
  for (int a_ = 0; a_ < 2; ++a_)
#pragma unroll
    for (int b_ = 0; b_ < 2; ++b_)
#pragma unroll
      for (int m = 0; m < 4; ++m)
#pragma unroll
        for (int n = 0; n < 2; ++n) acc[a_][b_][m][n] = (f32x4){0.f, 0.f, 0.f, 0.f};
  bf16x8 At[4][2], B0[2][2], B1[2][2];
  constexpr int nt = K / G8_BK;
  STAGE(SB(0, 0), Bt, bcol, 0); STAGE(SA(0, 0), A, brow, 0);
  STAGE(SB(0, 1), Bt, bcol + G8_HALF, 0); STAGE(SA(0, 1), A, brow + G8_HALF, 0);
  if (wr == 1) BAR;
  WAIT_V(4); BAR;
  STAGE(SB(1, 0), Bt, bcol, 1); STAGE(SA(1, 0), A, brow, 1); STAGE(SB(1, 1), Bt, bcol + G8_HALF, 1);
  WAIT_V(6); BAR;
  for (int t = 0; t < nt - 2; t += 2) {
    LDB(B0, 0, 0); SCHED; LDA(At, 0, 0); STAGE(SA(1, 1), A, brow + G8_HALF, t + 1);
    WAIT_L(8); BAR; WAIT_L(0); MMA(0, 0, At, B0); BAR; SCHED;
    LDB(B1, 0, 1); STAGE(SB(0, 0), Bt, bcol, t + 2);
    BAR; WAIT_L(0); MMA(0, 1, At, B1); BAR;
    LDA(At, 0, 1); STAGE(SA(0, 0), A, brow, t + 2);
    BAR; WAIT_L(0); MMA(1, 0, At, B0); BAR; SCHED;
    STAGE(SB(0, 1), Bt, bcol + G8_HALF, t + 2);
    WAIT_V(6); BAR; MMA(1, 1, At, B1); BAR;
    LDB(B0, 1, 0); SCHED; LDA(At, 1, 0); STAGE(SA(0, 1), A, brow + G8_HALF, t + 2);
    WAIT_L(8); BAR; WAIT_L(0); MMA(0, 0, At, B0); BAR; SCHED;
    LDB(B1, 1, 1); STAGE(SB(1, 0), Bt, bcol, t + 3);
    BAR; WAIT_L(0); MMA(0, 1, At, B1); BAR;
    LDA(At, 1, 1); STAGE(SA(1, 0), A, brow, t + 3);
    BAR; WAIT_L(0); MMA(1, 0, At, B0); BAR; SCHED;
    STAGE(SB(1, 1), Bt, bcol + G8_HALF, t + 3);
    WAIT_V(6); BAR; MMA(1, 1, At, B1); BAR;
  }
  { LDB(B0, 0, 0); LDA(At, 0, 0); STAGE(SA(1, 1), A, brow + G8_HALF, nt - 1);
    BAR; WAIT_L(0); MMA(0, 0, At, B0); BAR;
    LDB(B1, 0, 1); BAR; WAIT_L(0); MMA(0, 1, At, B1); BAR;
    LDA(At, 0, 1); WAIT_V(4); BAR; WAIT_L(0); MMA(1, 0, At, B0); MMA(1, 1, At, B1); BAR; }
  { LDB(B0, 1, 0); LDA(At, 1, 0); WAIT_V(2); BAR; WAIT_L(0); MMA(0, 0, At, B0); BAR;
    LDB(B1, 1, 1); WAIT_V(0); BAR; WAIT_L(0); MMA(0, 1, At, B1); BAR;
    LDA(At, 1, 1); BAR; WAIT_L(0); MMA(1, 0, At, B0); MMA(1, 1, At, B1); BAR; }
  if (wr == 0) BAR;
  __syncthreads();
  int t2 = tid; asm volatile("" : "+v"(t2));
  const int wid2 = t2 >> 6, lane2 = t2 & 63, wr2 = wid2 >> 2, wc2 = wid2 & 3, fr2 = lane2 & 15, fq2 = lane2 >> 4;
  bf16_t* wl = (bf16_t*)(smem + wid2 * EPI_WAVE_BYTES);
  bf16_t* wlp = (bf16_t*)(smem + (wid2 & ~1) * EPI_WAVE_BYTES);
#pragma unroll
  for (int ai = 0; ai < 2; ++ai)
#pragma unroll
    for (int bj = 0; bj < 2; ++bj)
      epilogue_block<EPI>(p, acc[ai][bj], brow + ai * 128 + wr2 * 64, bcol + bj * 128 + wc2 * 32, wl, wlp, wc2 & 1, lane2, fr2, fq2);
#undef SA
#undef SB
#undef STAGE
#undef LDA
#undef LDB
#undef MMA
#undef WAIT_V
#undef WAIT_L
#undef BAR
#undef SCHED
}

template <int EPI, int K>
DI void gemm_phase(const Params& p, const bf16_t* Wt, const bf16_t* X, int ntn, unsigned char* smem) {
  const bool xa = (gridDim.x == 256);
  const int xcd = blockIdx.x & 7, li = blockIdx.x >> 3;
  const int per_half = 4 * ntn;
  const int start = xa ? li : (int)blockIdx.x, step = xa ? 32 : (int)gridDim.x, total = ntn * (xa ? 8 : 64);
  for (int t = start; t < total; t += step) {
    int tm, tn;
    if (xa) { const int h = t / per_half, tp = t - h * per_half; tn = tp >> 2; tm = xcd * 8 + h * 4 + (tp & 3); }
    else { tm = t / ntn; tn = t % ntn; }
    gemm_tile<EPI, K>(p, Wt, X, tn * 256, tm * 256, smem);
  }
}

DI void conv8_load(const bf16_t* rp, bool has_prev, uint4& cur, uint2& prv) {
  cur = *(const uint4*)rp; prv = make_uint2(0u, 0u);
  if (has_prev) prv = *(const uint2*)(rp - 4);
}
DI float fast_silu(float v) { return v * __builtin_amdgcn_rcpf(1.f + __expf(-v)); }
DI void conv8_compute(const uint4 cur, const uint2 prv, float w0, float w1, float w2, float w3, float bias, float (&out)[8]) {
  float r[11];
  r[0] = hi16(prv.x); r[1] = lo16(prv.y); r[2] = hi16(prv.y);
  r[3] = lo16(cur.x); r[4] = hi16(cur.x); r[5] = lo16(cur.y); r[6] = hi16(cur.y); r[7] = lo16(cur.z); r[8] = hi16(cur.z); r[9] = lo16(cur.w); r[10] = hi16(cur.w);
#pragma unroll
  for (int j = 0; j < 8; ++j) out[j] = fast_silu(bias + w0 * r[j] + w1 * r[j + 1] + w2 * r[j + 2] + w3 * r[j + 3]);
}
DI void conv8(const bf16_t* rp, bool has_prev, float w0, float w1, float w2, float w3, float bias, float (&out)[8]) {
  uint4 cur; uint2 prv; conv8_load(rp, has_prev, cur, prv); conv8_compute(cur, prv, w0, w1, w2, w3, bias, out);
}
DI bf16x8 pack8(const float (&v)[8]) {
  uint4 u; u.x = pk2(v[0], v[1]); u.y = pk2(v[2], v[3]); u.z = pk2(v[4], v[5]); u.w = pk2(v[6], v[7]);
  return __builtin_bit_cast(bf16x8, u);
}
DI void chunk_cumsum(const float* __restrict__ DTp, size_t tk0, int hd, float A, int lane, float (&d4)[4], float (&c4)[4], float& last) {
#pragma unroll
  for (int i = 0; i < 4; ++i) d4[i] = DTp[(tk0 + 4 * lane + i) * 32 + hd];
  c4[0] = d4[0] * A; c4[1] = c4[0] + d4[1] * A; c4[2] = c4[1] + d4[2] * A; c4[3] = c4[2] + d4[3] * A;
  const float tot = c4[3];
  float sum = tot, ex = 0.f, t;
  t = swz_xor<1>(sum);  if (lane & 1) ex += t;  sum += t;
  t = swz_xor<2>(sum);  if (lane & 2) ex += t;  sum += t;
  t = swz_xor<4>(sum);  if (lane & 4) ex += t;  sum += t;
  t = swz_xor<8>(sum);  if (lane & 8) ex += t;  sum += t;
  t = swz_xor<16>(sum); if (lane & 16) ex += t; sum += t;
  t = __shfl_xor(sum, 32); if (lane & 32) ex += t; sum += t;
#pragma unroll
  for (int i = 0; i < 4; ++i) c4[i] += ex;
  last = sum;
}

constexpr int BT_ROW = 264;
constexpr int CN_ROW = 136;

DI void phase_ssd_state(const Params& p, unsigned char* smem) {
  const bf16_t* XT = (const bf16_t*)(p.ws + OFF_XT); const bf16_t* BT = (const bf16_t*)(p.ws + OFF_BT); const float* DTp = (const float*)(p.ws + OFF_DT);
  float* ST = (float*)(p.ws + OFF_ST); float* DEC = (float*)(p.ws + OFF_DEC);
  bf16_t* BTs = (bf16_t*)smem; float* wgt = (float*)(smem + 128 * BT_ROW * 2);
  const int tid = otid(), lane = tid & 63, w = tid >> 6, l31 = lane & 31, lh = lane >> 5;
  for (int u = blockIdx.x; u < 256; u += gridDim.x) {
    const int b = u >> 7, c = (u >> 2) & 31, g = u & 3; const int hd = 8 * g + w;
    bf16_t* XTC = (bf16_t*)(p.ws + (b ? OFF_ST + 32 * MiB : OFF_XN));
    {
      float d4[4], c4[4], last; chunk_cumsum(DTp, (size_t)b * SEQ + c * 256, hd, -__expf(p.A_log[hd]), lane, d4, c4, last);
      float4 o = {__expf(last - c4[0]) * d4[0], __expf(last - c4[1]) * d4[1], __expf(last - c4[2]) * d4[2], __expf(last - c4[3]) * d4[3]};
      *(float4*)(wgt + w * 256 + 4 * lane) = o;
      if (lane == 0) DEC[(b * 32 + c) * 32 + hd] = __expf(last);
    }
#pragma unroll 2
    for (int i = 0; i < 8; ++i) {
      const int chunk = tid + 512 * i; const int s8 = (chunk & 31) * 8, n = chunk >> 5; const int ch = 2048 + g * 128 + n;
      float v[8];
      conv8(BT + ((size_t)(b * 512 + g * 128 + n)) * SEQ + c * 256 + s8, !(c == 0 && s8 == 0),
            p.conv_w[ch], p.conv_w[3072 + ch], p.conv_w[2 * 3072 + ch], p.conv_w[3 * 3072 + ch], p.conv_b[ch], v);
      *(bf16x8*)(BTs + n * BT_ROW + s8) = pack8(v);
    }
    __syncthreads();
    f32x16 acc[2][4];
#pragma unroll
    for (int a = 0; a < 2; ++a)
#pragma unroll
      for (int q = 0; q < 4; ++q)
#pragma unroll
        for (int i = 0; i < 16; ++i) acc[a][q][i] = 0.f;
    float xw[2][4], xb[2];
#pragma unroll
    for (int pt = 0; pt < 2; ++pt) {
      const int ch = hd * 64 + pt * 32 + l31;
#pragma unroll
      for (int k = 0; k < 4; ++k) xw[pt][k] = p.conv_w[k * 3072 + ch];
      xb[pt] = p.conv_b[ch];
    }
    for (int kb = 0; kb < 16; kb += 2) {
      uint4 rc[2][2]; uint2 rp[2][2];
#pragma unroll
      for (int i = 0; i < 2; ++i)
#pragma unroll
        for (int pt = 0; pt < 2; ++pt) {
          const int s0 = (kb + i) * 16 + 8 * lh;
          conv8_load(XT + ((size_t)(b * 2048 + hd * 64 + pt * 32 + l31)) * SEQ + c * 256 + s0, !(c == 0 && s0 == 0), rc[i][pt], rp[i][pt]);
        }
#pragma unroll
      for (int i = 0; i < 2; ++i) {
        const int ks = kb + i; const int s0 = ks * 16 + 8 * lh;
        const float4 g0 = *(const float4*)(wgt + w * 256 + s0), g1 = *(const float4*)(wgt + w * 256 + s0 + 4);
        const float wg[8] = {g0.x, g0.y, g0.z, g0.w, g1.x, g1.y, g1.z, g1.w};
        bf16x8 afr[2];
#pragma unroll
        for (int pt = 0; pt < 2; ++pt) {
          float v[8];
          conv8_compute(rc[i][pt], rp[i][pt], xw[pt][0], xw[pt][1], xw[pt][2], xw[pt][3], xb[pt], v);
          *(bf16x8*)(XTC + ((size_t)(hd * 64 + pt * 32 + l31)) * SEQ + c * 256 + s0) = pack8(v);
#pragma unroll
          for (int j = 0; j < 8; ++j) v[j] *= wg[j];
          afr[pt] = pack8(v);
        }
#pragma unroll
        for (int nt = 0; nt < 4; ++nt) {
          const bf16x8 bfr = *(const bf16x8*)(BTs + (nt * 32 + l31) * BT_ROW + ks * 16 + 8 * lh);
#pragma unroll
          for (int pt = 0; pt < 2; ++pt) acc[pt][nt] = MFMA32(afr[pt], bfr, acc[pt][nt]);
        }
      }
    }
    bf16_t* Sp = (bf16_t*)ST + (((size_t)(b * 32 + c) * 32 + hd) * 64) * 128;
#pragma unroll
    for (int pt = 0; pt < 2; ++pt)
#pragma unroll
      for (int nt = 0; nt < 4; ++nt)
#pragma unroll
        for (int r = 0; r < 16; ++r) Sp[(pt * 32 + (r & 3) + 8 * (r >> 2) + 4 * lh) * 128 + nt * 32 + l31] = f2bf(acc[pt][nt][r]);
    __syncthreads();
  }
}

DI void phase_ssd_scan(const Params& p) {
  bf16_t* ST = (bf16_t*)(p.ws + OFF_ST); const float* DEC = (const float*)(p.ws + OFF_DEC);
  for (int idx = blockIdx.x * NTHREADS + otid(); idx < 131072; idx += gridDim.x * NTHREADS) {
    const int n4 = idx & 31, pp = (idx >> 5) & 63, h = (idx >> 11) & 31, b = idx >> 16;
    float run[4] = {0.f, 0.f, 0.f, 0.f};
    bf16_t* base = ST + (((size_t)(b * 32) * 32 + h) * 64 + pp) * 128 + n4 * 4;
    const float* dbase = DEC + (b * 32) * 32 + h;
    for (int c0 = 0; c0 < 32; c0 += 16) {
      uint2 loc[16]; float d[16];
#pragma unroll
      for (int i = 0; i < 16; ++i) { loc[i] = *(const uint2*)(base + (size_t)(c0 + i) * (32 * 64 * 128)); d[i] = dbase[(c0 + i) * 32]; }
#pragma unroll
      for (int i = 0; i < 16; ++i) {
        uint2 o; o.x = pk2(run[0], run[1]); o.y = pk2(run[2], run[3]);
        *(uint2*)(base + (size_t)(c0 + i) * (32 * 64 * 128)) = o;
        run[0] = run[0] * d[i] + lo16(loc[i].x); run[1] = run[1] * d[i] + hi16(loc[i].x);
        run[2] = run[2] * d[i] + lo16(loc[i].y); run[3] = run[3] * d[i] + hi16(loc[i].y);
      }
    }
  }
}

DI void stage_tokmajor(const Params& p, const bf16_t* __restrict__ RAW, int b, int tok0, int nrows, int g, int cbase, bf16_t* dst, int tid_) {
  const int tid = otid(); (void)tid_;
  const int n8 = (tid & 15) * 8; const int ch = cbase + g * 128 + n8;
  float cw[4][8], cb[8];
#pragma unroll
  for (int k = 0; k < 4; ++k) {
    const float4 a = *(const float4*)(p.conv_w + k * 3072 + ch), bq = *(const float4*)(p.conv_w + k * 3072 + ch + 4);
    cw[k][0] = a.x; cw[k][1] = a.y; cw[k][2] = a.z; cw[k][3] = a.w; cw[k][4] = bq.x; cw[k][5] = bq.y; cw[k][6] = bq.z; cw[k][7] = bq.w;
  }
  { const float4 a = *(const float4*)(p.conv_b + ch), bq = *(const float4*)(p.conv_b + ch + 4);
    cb[0] = a.x; cb[1] = a.y; cb[2] = a.z; cb[3] = a.w; cb[4] = bq.x; cb[5] = bq.y; cb[6] = bq.z; cb[7] = bq.w; }
  for (int t = tid >> 4; t < nrows; t += 64) {
    uint4 r[2][4];
#pragma unroll
    for (int u = 0; u < 2; ++u)
#pragma unroll
      for (int k = 0; k < 4; ++k) {
        const int tk = tok0 + t + 32 * u - 3 + k;
        r[u][k] = make_uint4(0u, 0u, 0u, 0u);
        if (tk >= 0) r[u][k] = *(const uint4*)(RAW + ((size_t)b * SEQ + tk) * 512 + g * 128 + n8);
      }
#pragma unroll
    for (int u = 0; u < 2; ++u) {
      float acc[8];
#pragma unroll
      for (int j = 0; j < 8; ++j) acc[j] = cb[j];
#pragma unroll
      for (int k = 0; k < 4; ++k) {
        const uint4 q = r[u][k];
        acc[0] += cw[k][0] * lo16(q.x); acc[1] += cw[k][1] * hi16(q.x); acc[2] += cw[k][2] * lo16(q.y); acc[3] += cw[k][3] * hi16(q.y);
        acc[4] += cw[k][4] * lo16(q.z); acc[5] += cw[k][5] * hi16(q.z); acc[6] += cw[k][6] * lo16(q.w); acc[7] += cw[k][7] * hi16(q.w);
      }
#pragma unroll
      for (int j = 0; j < 8; ++j) acc[j] = fast_silu(acc[j]);
      *(bf16x8*)(dst + (t + 32 * u) * CN_ROW + n8) = pack8(acc);
    }
  }
}

constexpr int S3_CS = 0, S3_BS = 64 * CN_ROW * 2, S3_CB = S3_BS + 256 * CN_ROW * 2, S3_CUM = S3_CB + 64 * BT_ROW * 2, S3_DTS = S3_CUM + 8192,
              S3_PART = S3_DTS + 8192, S3_RSTD = S3_PART + 2048, S3_END = S3_RSTD + 256;

DI void phase_ssd_out(const Params& p, unsigned char* smem) {
  const bf16_t* XT = (const bf16_t*)(p.ws + OFF_XT); const bf16_t* BR = (const bf16_t*)(p.ws + OFF_BR); const bf16_t* CR = (const bf16_t*)(p.ws + OFF_CR);
  const float* DTp = (const float*)(p.ws + OFF_DT); const float* ST = (const float*)(p.ws + OFF_ST); bf16_t* Z = (bf16_t*)p.out;
  bf16_t* Cs = (bf16_t*)(smem + S3_CS); bf16_t* Bs = (bf16_t*)(smem + S3_BS); bf16_t* CBs = (bf16_t*)(smem + S3_CB);
  float* cumA = (float*)(smem + S3_CUM); float* dts = (float*)(smem + S3_DTS); float* part = (float*)(smem + S3_PART); float* rstd = (float*)(smem + S3_RSTD);
  const int tid = otid(), lane = tid & 63, w = tid >> 6, l31 = lane & 31, lh = lane >> 5;
  const bool persist = (gridDim.x == 256);
  for (int u = blockIdx.x; u < 1024; u += gridDim.x) {
    const int tq = u >> 8, rest = u & 255; const int b = rest >> 7, c = (rest >> 2) & 31, g = rest & 3; const int hd = 8 * g + w;
    const int ns = (tq + 1) * 64;
    if (!persist || tq == 0) {
      float d4[4], c4[4], last; chunk_cumsum(DTp, (size_t)b * SEQ + c * 256, hd, -__expf(p.A_log[hd]), lane, d4, c4, last);
      *(float4*)(cumA + w * 256 + 4 * lane) = make_float4(c4[0], c4[1], c4[2], c4[3]);
      *(float4*)(dts + w * 256 + 4 * lane) = make_float4(d4[0], d4[1], d4[2], d4[3]);
    }
    stage_tokmajor(p, CR, b, c * 256 + tq * 64, 64, g, 2560, Cs, tid);
    { const int r0 = persist ? tq * 64 : 0; stage_tokmajor(p, BR, b, c * 256 + r0, ns - r0, g, 2048, Bs + r0 * CN_ROW, tid); }
    __syncthreads();
    if (32 * w < ns) {
      f32x16 a2[2];
#pragma unroll
      for (int a = 0; a < 2; ++a)
#pragma unroll
        for (int i = 0; i < 16; ++i) a2[a][i] = 0.f;
#pragma unroll
      for (int ks = 0; ks < 8; ++ks) {
        const bf16x8 af = *(const bf16x8*)(Bs + (32 * w + l31) * CN_ROW + ks * 16 + 8 * lh);
#pragma unroll
        for (int tt = 0; tt < 2; ++tt) {
          const bf16x8 bq = *(const bf16x8*)(Cs + (tt * 32 + l31) * CN_ROW + ks * 16 + 8 * lh);
          a2[tt] = MFMA32(af, bq, a2[tt]);
        }
      }
#pragma unroll
      for (int tt = 0; tt < 2; ++tt)
#pragma unroll
        for (int rg = 0; rg < 4; ++rg) {
          uint2 o; o.x = pk2(a2[tt][4 * rg], a2[tt][4 * rg + 1]); o.y = pk2(a2[tt][4 * rg + 2], a2[tt][4 * rg + 3]);
          *(uint2*)(CBs + (tt * 32 + l31) * BT_ROW + 32 * w + 8 * rg + 4 * lh) = o;
        }
    }
    __syncthreads();
    f32x16 acc[2][2];
#pragma unroll
    for (int a = 0; a < 2; ++a)
#pragma unroll
      for (int q = 0; q < 2; ++q)
#pragma unroll
        for (int i = 0; i < 16; ++i) acc[a][q][i] = 0.f;
    {
      const bf16_t* Sp = (const bf16_t*)ST + (((size_t)(b * 32 + c) * 32 + hd) * 64) * 128;
      for (int kb = 0; kb < 8; kb += 4) {
        bf16x8 bfr[4][2];
#pragma unroll
        for (int i = 0; i < 4; ++i)
#pragma unroll
          for (int pt = 0; pt < 2; ++pt) bfr[i][pt] = *(const bf16x8*)(Sp + (pt * 32 + l31) * 128 + (kb + i) * 16 + 8 * lh);
#pragma unroll
        for (int i = 0; i < 4; ++i) {
          const int ks = kb + i;
#pragma unroll
          for (int tt = 0; tt < 2; ++tt) {
            const bf16x8 af = *(const bf16x8*)(Cs + (tt * 32 + l31) * CN_ROW + ks * 16 + 8 * lh);
#pragma unroll
            for (int pt = 0; pt < 2; ++pt) acc[tt][pt] = MFMA32(af, bfr[i][pt], acc[tt][pt]);
          }
        }
      }
#pragma unroll
      for (int tt = 0; tt < 2; ++tt)
#pragma unroll
        for (int r = 0; r < 16; ++r) {
          const float e = __expf(cumA[w * 256 + tq * 64 + tt * 32 + (r & 3) + 8 * (r >> 2) + 4 * lh]);
          acc[tt][0][r] *= e; acc[tt][1][r] *= e;
        }
    }
    {
      const float Dh = p.Dskip[hd];
      const int tl0 = tq * 64 + l31, tl1 = tq * 64 + 32 + l31;
      const float ct0 = cumA[w * 256 + tl0], ct1 = cumA[w * 256 + tl1];
      const bf16_t* XTC = (const bf16_t*)(p.ws + (b ? OFF_ST + 32 * MiB : OFF_XN)) + ((size_t)(hd * 64 + l31)) * SEQ + c * 256 + 8 * lh;
      const int nks = ns >> 4;
      for (int kb = 0; kb < nks; kb += 4) {
        bf16x8 xq[4][2];
#pragma unroll
        for (int i = 0; i < 4; ++i)
#pragma unroll
          for (int pt = 0; pt < 2; ++pt) xq[i][pt] = *(const bf16x8*)(XTC + (size_t)pt * 32 * SEQ + (kb + i) * 16);
#pragma unroll
        for (int i = 0; i < 4; ++i) {
          const int ks = kb + i; const int s0 = ks * 16 + 8 * lh;
          const float4 c0 = *(const float4*)(cumA + w * 256 + s0), c1 = *(const float4*)(cumA + w * 256 + s0 + 4);
          const float4 d0 = *(const float4*)(dts + w * 256 + s0), d1 = *(const float4*)(dts + w * 256 + s0 + 4);
          const float cs[8] = {c0.x, c0.y, c0.z, c0.w, c1.x, c1.y, c1.z, c1.w};
          const float ds[8] = {d0.x, d0.y, d0.z, d0.w, d1.x, d1.y, d1.z, d1.w};
          const float cref = cumA[w * 256 + ks * 16];
          const bool steep = (cref - cumA[w * 256 + ks * 16 + 15]) > 60.f;
          float Fs[8];
#pragma unroll
          for (int j = 0; j < 8; ++j) Fs[j] = __expf(fminf(cref - cs[j], 64.f)) * ds[j];
#pragma unroll
          for (int tt = 0; tt < 2; ++tt) {
            if (ks * 16 <= tq * 64 + tt * 32 + 31) {
              const int tl = tt ? tl1 : tl0; const float ct = tt ? ct1 : ct0;
              const float Et = __expf(fminf(ct - cref, 0.f));
              const uint4 cbv = *(const uint4*)(CBs + (tt * 32 + l31) * BT_ROW + s0);
              const float cb[8] = {lo16(cbv.x), hi16(cbv.x), lo16(cbv.y), hi16(cbv.y), lo16(cbv.z), hi16(cbv.z), lo16(cbv.w), hi16(cbv.w)};
              float mv[8];
              if (steep) {
#pragma unroll
                for (int j = 0; j < 8; ++j) {
                  const int sidx = s0 + j;
                  float v = cb[j] * __expf(fminf(ct - cs[j], 0.f)) * ds[j];
                  v = (sidx <= tl) ? v : 0.f;
                  if (sidx == tl) v += Dh;
                  mv[j] = v;
                }
              } else if (ks * 16 + 15 > tq * 64 + tt * 32) {
#pragma unroll
                for (int j = 0; j < 8; ++j) {
                  const int sidx = s0 + j;
                  float v = cb[j] * (Et * Fs[j]);
                  v = (sidx <= tl) ? v : 0.f;
                  if (sidx == tl) v += Dh;
                  mv[j] = v;
                }
              } else {
#pragma unroll
                for (int j = 0; j < 8; ++j) mv[j] = cb[j] * (Et * Fs[j]);
              }
              const bf16x8 af = pack8(mv);
#pragma unroll
              for (int pt = 0; pt < 2; ++pt) acc[tt][pt] = MFMA32(af, xq[i][pt], acc[tt][pt]);
            }
          }
        }
      }
    }
    const size_t tokb = (size_t)b * SEQ + c * 256 + tq * 64;
#pragma unroll
    for (int tt = 0; tt < 2; ++tt)
#pragma unroll
      for (int r = 0; r < 16; ++r) {
        const int tloc = tt * 32 + (r & 3) + 8 * (r >> 2) + 4 * lh;
        const bf16_t* zp = Z + (tokb + tloc) * 2048 + hd * 64 + l31;
        const float y0 = acc[tt][0][r] * silu_f(bf2f(zp[0])), y1 = acc[tt][1][r] * silu_f(bf2f(zp[32]));
        acc[tt][0][r] = y0; acc[tt][1][r] = y1;
        float v = y0 * y0 + y1 * y1;
        v += swz_xor<1>(v); v += swz_xor<2>(v); v += swz_xor<4>(v); v += swz_xor<8>(v); v += swz_xor<16>(v);
        if (l31 == 0) part[w * 64 + tloc] = v;
      }
    __syncthreads();
    if (tid < 64) {
      float sres = 0.f;
#pragma unroll
      for (int ww = 0; ww < 8; ++ww) sres += part[ww * 64 + tid];
      rstd[tid] = rsqrtf(sres * (1.f / 512.f) + 1e-6f);
    }
    __syncthreads();
#pragma unroll
    for (int tt = 0; tt < 2; ++tt)
#pragma unroll
      for (int r = 0; r < 16; ++r) {
        const int tloc = tt * 32 + (r & 3) + 8 * (r >> 2) + 4 * lh;
        const float rs = rstd[tloc];
        bf16_t* zp = Z + (tokb + tloc) * 2048 + hd * 64 + l31;
        zp[0] = f2bf(acc[tt][0][r] * rs); zp[32] = f2bf(acc[tt][1][r] * rs);
      }
    __syncthreads();
  }
}

constexpr int KROW = 104;
constexpr int VROW = 68;
constexpr int ATT_K_BYTES = 64 * KROW * 2;
constexpr int ATT_V_BYTES = 64 * VROW * 2;
constexpr int ATT_STAGE = ATT_K_BYTES + ATT_V_BYTES;

DI void attn_kload(const bf16_t* sK, bf16x8 (&kf)[2][6], int l31, int lh) {
#pragma unroll
  for (int sub = 0; sub < 2; ++sub)
#pragma unroll
    for (int ks = 0; ks < 6; ++ks) kf[sub][ks] = *(const bf16x8*)(sK + (sub * 32 + l31) * KROW + ks * 16 + lh * 8);
}
DI void attn_qkmma(const bf16x8 (&kf)[2][6], const bf16x8 (&qf)[6], f32x16 (&sc)[2]) {
#pragma unroll
  for (int sub = 0; sub < 2; ++sub)
#pragma unroll
    for (int i = 0; i < 16; ++i) sc[sub][i] = 0.f;
#pragma unroll
  for (int ks = 0; ks < 6; ++ks)
#pragma unroll
    for (int sub = 0; sub < 2; ++sub) sc[sub] = MFMA32(kf[sub][ks], qf[ks], sc[sub]);
}
DI void attn_qk(const bf16_t* sK, const bf16x8 (&qf)[6], f32x16 (&sc)[2], int l31, int lh) {
  bf16x8 kf[2][6]; attn_kload(sK, kf, l31, lh); attn_qkmma(kf, qf, sc);
}

template <bool MASK>
DI void attn_softmax(f32x16 (&sc)[2], f32x16 (&o)[2], float& m, float& l, int kt, int myq, int lh) {
  float tmax = -1e30f;
#pragma unroll
  for (int sub = 0; sub < 2; ++sub)
#pragma unroll
    for (int r = 0; r < 16; ++r) {
      if (MASK) { const int key = kt * 64 + sub * 32 + (r & 3) + 8 * (r >> 2) + 4 * lh; if (key > myq) sc[sub][r] = -1e30f; }
      tmax = fmaxf(tmax, sc[sub][r]);
    }
  tmax = fmaxf(tmax, __shfl_xor(tmax, 32));
  if (__builtin_amdgcn_ballot_w64(tmax - m > 8.f) != 0) {
    const float mn = fmaxf(m, tmax); const float al = __builtin_amdgcn_exp2f(m - mn); m = mn;
    l *= al;
#pragma unroll
    for (int a = 0; a < 2; ++a)
#pragma unroll
      for (int i = 0; i < 16; ++i) o[a][i] *= al;
  }
  f32x2 ps2 = {0.f, 0.f}; const f32x2 mn2 = {m, m};
#pragma unroll
  for (int sub = 0; sub < 2; ++sub)
#pragma unroll
    for (int r = 0; r < 16; r += 2) {
      f32x2 d = {sc[sub][r], sc[sub][r + 1]}; d = d - mn2;
      f32x2 pe; pe.x = __builtin_amdgcn_exp2f(d.x); pe.y = __builtin_amdgcn_exp2f(d.y);
      sc[sub][r] = pe.x; sc[sub][r + 1] = pe.y; ps2 = ps2 + pe;
    }
  l += ps2.x + ps2.y;
}
DI void attn_pv(const f32x16 (&sc)[2], f32x16 (&o)[2], const bf16_t* sV, int l31, int lh) {
#pragma unroll
  for (int sub = 0; sub < 2; ++sub)
#pragma unroll
    for (int s2 = 0; s2 < 2; ++s2) {
      uint4 pu; pu.x = pk2(sc[sub][8 * s2], sc[sub][8 * s2 + 1]); pu.y = pk2(sc[sub][8 * s2 + 2], sc[sub][8 * s2 + 3]);
      pu.z = pk2(sc[sub][8 * s2 + 4], sc[sub][8 * s2 + 5]); pu.w = pk2(sc[sub][8 * s2 + 6], sc[sub][8 * s2 + 7]);
      const bf16x8 pb = __builtin_bit_cast(bf16x8, pu);
#pragma unroll
      for (int dvt = 0; dvt < 2; ++dvt) {
        const bf16_t* vp = sV + (dvt * 32 + l31) * VROW + sub * 32 + 16 * s2 + 4 * lh;
        const uint2 lo = *(const uint2*)vp, hi = *(const uint2*)(vp + 8);
        uint4 vu = {lo.x, lo.y, hi.x, hi.y};
        o[dvt] = MFMA32(__builtin_bit_cast(bf16x8, vu), pb, o[dvt]);
      }
    }
}

DI void attn_unit(const Params& p, int b, int h, int qb, unsigned char* smem) {
  const bf16_t* Q = (const bf16_t*)p.out; const bf16_t* KN = (const bf16_t*)(p.ws + OFF_XN); const bf16_t* VT = (const bf16_t*)(p.ws + OFF_BT);
  const bf16_t* KROPE = (const bf16_t*)(p.ws + OFF_DEC); const bf16_t* GATE = (const bf16_t*)(p.ws + OFF_ST); bf16_t* O = (bf16_t*)(p.ws + OFF_ST + 32 * MiB);
  const int tid = otid(), lane = tid & 63, w = tid >> 6, l31 = lane & 31, lh = lane >> 5;
  const int q0 = qb * 256, qw0 = q0 + 32 * w, myq = qw0 + l31;
  const size_t tq = (size_t)b * SEQ + myq;
  bf16x8 qf[6];
#pragma unroll
  for (int ks = 0; ks < 6; ++ks) qf[ks] = *(const bf16x8*)(Q + tq * 1536 + h * 96 + ks * 16 + lh * 8);
  f32x16 o[2];
#pragma unroll
  for (int a = 0; a < 2; ++a)
#pragma unroll
    for (int i = 0; i < 16; ++i) o[a][i] = 0.f;
  float m = -1e30f, l = 0.f;
  const int ntiles = 4 * qb + 4;
  const int nact = (qw0 + 31) / 64 + 1;
  const int kr = tid >> 3, kc = (tid & 7) * 8;
  const int rr = (tid & 255) >> 2, rc = (tid & 3) * 8;
  const bf16_t* gK = KN + ((size_t)b * SEQ + kr) * 1024 + h * 64 + kc;
  const bf16_t* gR = KROPE + ((size_t)b * SEQ + rr) * 32 + rc;
  const bf16_t* gV = VT + ((size_t)((b * 16 + h) * 64 + kr)) * SEQ + kc;
  uint4 rk, rr4, rv;
#define ATT_LOAD(T) do { rk = *(const uint4*)(gK + (size_t)(T) * 64 * 1024); rr4 = *(const uint4*)(gR + (size_t)(T) * 64 * 32); rv = *(const uint4*)(gV + (T) * 64); } while (0)
#define ATT_STORE(ST_) do { bf16_t* dK_ = (bf16_t*)(smem + (ST_) * ATT_STAGE); bf16_t* dV_ = (bf16_t*)(smem + (ST_) * ATT_STAGE + ATT_K_BYTES); \
    *(uint4*)(dK_ + kr * KROW + kc) = rk; *(uint4*)(dK_ + rr * KROW + 64 + rc) = rr4; \
    *(uint2*)(dV_ + kr * VROW + kc) = make_uint2(rv.x, rv.y); *(uint2*)(dV_ + kr * VROW + kc + 4) = make_uint2(rv.z, rv.w); } while (0)
  ATT_LOAD(0); ATT_STORE(0);
  ATT_LOAD(1); ATT_STORE(1);
  __syncthreads();
  f32x16 sc[2], sn[2];
  attn_qk((const bf16_t*)smem, qf, sc, l31, lh);
  int st = 0;
  int kt = 0;
  for (; kt < nact - 1; ++kt) {
    const int st1 = (st == 2) ? 0 : st + 1, st2 = (st1 == 2) ? 0 : st1 + 1;
    const int tl = (kt + 2 < ntiles) ? kt + 2 : ntiles - 1;
    ATT_LOAD(tl);
    attn_qk((const bf16_t*)(smem + st1 * ATT_STAGE), qf, sn, l31, lh);
    attn_softmax<false>(sc, o, m, l, kt, myq, lh);
    attn_pv(sc, o, (const bf16_t*)(smem + st * ATT_STAGE + ATT_K_BYTES), l31, lh);
    ATT_STORE(st2);
    __syncthreads();
#pragma unroll
    for (int sub = 0; sub < 2; ++sub) sc[sub] = sn[sub];
    st = st1;
  }
  {
    const int st1 = (st == 2) ? 0 : st + 1, st2 = (st1 == 2) ? 0 : st1 + 1;
    const int tl = (kt + 2 < ntiles) ? kt + 2 : ntiles - 1;
    ATT_LOAD(tl);
    attn_softmax<true>(sc, o, m, l, kt, myq, lh);
    attn_pv(sc, o, (const bf16_t*)(smem + st * ATT_STAGE + ATT_K_BYTES), l31, lh);
    ATT_STORE(st2);
    __syncthreads();
    st = st1; ++kt;
  }
  for (; kt < ntiles; ++kt) {
    const int st1 = (st == 2) ? 0 : st + 1, st2 = (st1 == 2) ? 0 : st1 + 1;
    const int tl = (kt + 2 < ntiles) ? kt + 2 : ntiles - 1;
    ATT_LOAD(tl);
    ATT_STORE(st2);
    __syncthreads();
    st = st1;
  }
#undef ATT_LOAD
#undef ATT_STORE
  l += __shfl_xor(l, 32);
  const float il = 1.f / l;
#pragma unroll
  for (int dvt = 0; dvt < 2; ++dvt)
#pragma unroll
    for (int rg = 0; rg < 4; ++rg) {
      const int dv = dvt * 32 + 8 * rg + 4 * lh;
      const uint2 gv = *(const uint2*)(GATE + tq * 1024 + h * 64 + dv);
      const float g0 = __uint_as_float(gv.x << 16), g1 = __uint_as_float(gv.x & 0xffff0000u), g2 = __uint_as_float(gv.y << 16), g3 = __uint_as_float(gv.y & 0xffff0000u);
      uint2 ov; ov.x = pk2(o[dvt][4 * rg] * il * g0, o[dvt][4 * rg + 1] * il * g1); ov.y = pk2(o[dvt][4 * rg + 2] * il * g2, o[dvt][4 * rg + 3] * il * g3);
      *(uint2*)(O + tq * 1024 + h * 64 + dv) = ov;
    }
}

DI void phase_attn(const Params& p, unsigned char* smem) {
  for (int u = blockIdx.x; u < 512; u += gridDim.x) {
    int pu = u;
    if (gridDim.x == 256) {
      const int xcd = blockIdx.x & 7, li = blockIdx.x >> 3, r = u >> 8;
      pu = (r * 16 + xcd * 2 + (li >> 4)) * 16 + (li & 15);
    }
    const int bh = pu >> 4, x = pu & 15;
    for (int half = 0; half < 2; ++half) attn_unit(p, bh >> 4, bh & 15, half ? x : 31 - x, smem);
  }
}

DI void phase_final_norm(const Params& p) {
  const int tid = otid(); const int lane = tid & 63, w = tid >> 6;
  float4 g[4];
#pragma unroll
  for (int i = 0; i < 4; ++i) g[i] = ((const float4*)p.g_final)[lane + 64 * i];
  for (int row = (blockIdx.x * 8 + w) * 2; row < T; row += gridDim.x * 16) {
    float4 v[2][4]; float ss[2] = {0.f, 0.f};
#pragma unroll
    for (int u = 0; u < 2; ++u)
#pragma unroll
      for (int i = 0; i < 4; ++i) v[u][i] = ((const float4*)(p.out + (size_t)(row + u) * DM))[lane + 64 * i];
#pragma unroll
    for (int u = 0; u < 2; ++u) {
#pragma unroll
      for (int i = 0; i < 4; ++i) ss[u] += v[u][i].x * v[u][i].x + v[u][i].y * v[u][i].y + v[u][i].z * v[u][i].z + v[u][i].w * v[u][i].w;
      ss[u] = wave_sum(ss[u]);
      const float r = rsqrtf(ss[u] * (1.f / 1024.f) + 1e-6f);
#pragma unroll
      for (int i = 0; i < 4; ++i)
        ((float4*)(p.out + (size_t)(row + u) * DM))[lane + 64 * i] = make_float4(v[u][i].x * r * g[i].x, v[u][i].y * r * g[i].y, v[u][i].z * r * g[i].z, v[u][i].w * r * g[i].w);
    }
  }
}

__global__ void __launch_bounds__(NTHREADS) mega(Params p) {
  cg::grid_group grid = cg::this_grid();
  extern __shared__ __attribute__((aligned(16))) unsigned char smem[];
  unsigned char* ws = p.ws;
  __shared__ unsigned bar_st[4];
  if (threadIdx.x < 4) bar_st[threadIdx.x] = 0u;
  __syncthreads();
  const XcdBarrier xb = xcd_barrier_post((unsigned*)(ws + OFF_BAR), bar_st);
  const bool tailfill = (gridDim.x == 256);
  phase_prep(p, smem, blockIdx.x, tailfill ? 1344 : 2832, gridDim.x);
  if (!tailfill) phase_rope_tables(p, blockIdx.x, gridDim.x);
  phase_rmsnorm_rows(p.x, (bf16_t*)(ws + OFF_XN));
  if (p.out == nullptr) grid.sync();
  xcd_barrier(xb);
  gemm_phase<EPI_SSM_IN, 1024>(p, (const bf16_t*)(ws + OFF_W1), (const bf16_t*)(ws + OFF_XN), 21, smem);
  if (tailfill && (blockIdx.x >> 3) >= 8) {
    const int tj = (blockIdx.x & 7) * 24 + ((blockIdx.x >> 3) - 8);
    phase_prep(p, smem, 1344 + tj, 2832, 192);
    phase_rope_tables(p, tj, 192);
  }
  xcd_barrier(xb);
  phase_ssd_state(p, smem);
  xcd_barrier(xb);
  phase_ssd_scan(p);
  xcd_barrier(xb);
  phase_ssd_out(p, smem);
  xcd_barrier(xb);
  gemm_phase<EPI_OUT1, 2048>(p, (const bf16_t*)(ws + OFF_W2), (const bf16_t*)p.out, 4, smem);
  xcd_barrier(xb);
  gemm_phase<EPI_MLA_IN, 1024>(p, (const bf16_t*)(ws + OFF_W3), (const bf16_t*)(ws + OFF_XN), 7, smem);
  xcd_barrier(xb);
  gemm_phase<EPI_KVUP, 256>(p, (const bf16_t*)(ws + OFF_W4), (const bf16_t*)(ws + OFF_ST + 32 * MiB), 8, smem);
  gemm_phase<EPI_QUP, 384>(p, (const bf16_t*)(ws + OFF_W5), (const bf16_t*)(ws + OFF_ST + 40 * MiB), 6, smem);
  xcd_barrier(xb);
  phase_attn(p, smem);
  xcd_barrier(xb);
  gemm_phase<EPI_OUT2, 1024>(p, (const bf16_t*)(ws + OFF_W6), (const bf16_t*)(ws + OFF_ST + 32 * MiB), 4, smem);
  xcd_barrier(xb);
  phase_final_norm(p);
}

extern "C" void kernel_launch(void* const* d_in, const int* in_sizes, int n_in, void* d_out, int out_size, void* d_ws, size_t ws_size, hipStream_t stream) {
  static int grid = 0;
  if (grid == 0) {
    if (n_in != 20 || ws_size < WS_NEED) { fprintf(stderr, "kernel_launch: unexpected n_in %d / ws_size %zu\n", n_in, ws_size); grid = -1; return; }
    int dev = 0, cus = 0, per_cu = 0;
    hipGetDevice(&dev);
    hipDeviceGetAttribute(&cus, hipDeviceAttributeMultiprocessorCount, dev);
    if (hipFuncSetAttribute((const void*)mega, hipFuncAttributeMaxDynamicSharedMemorySize, LDS_BYTES) != hipSuccess) { fprintf(stderr, "hipFuncSetAttribute failed\n"); grid = -1; return; }
    hipOccupancyMaxActiveBlocksPerMultiprocessor(&per_cu, (const void*)mega, NTHREADS, LDS_BYTES);
    if (per_cu < 1) per_cu = 1;
    (void)hipGetLastError();
    grid = cus;
  }
  if (grid < 0) return;
  Params p{};
  p.x = (const float*)d_in[0]; p.pos = (const int*)d_in[1]; p.g_pre = (const float*)d_in[2]; p.ssm_w_in = (const float*)d_in[3];
  p.conv_w = (const float*)d_in[4]; p.conv_b = (const float*)d_in[5]; p.dt_bias = (const float*)d_in[6]; p.A_log = (const float*)d_in[7];
  p.Dskip = (const float*)d_in[8]; p.g_out = (const float*)d_in[9]; p.ssm_w_out = (const float*)d_in[10]; p.kv_g_in = (const float*)d_in[11];
  p.kv_w_down = (const float*)d_in[12]; p.kv_g_lat = (const float*)d_in[13]; p.kv_w_up = (const float*)d_in[14]; p.mla_w_in = (const float*)d_in[15];
  p.mla_g_q = (const float*)d_in[16]; p.mla_w_uq = (const float*)d_in[17]; p.mla_w_out = (const float*)d_in[18]; p.g_final = (const float*)d_in[19];
  p.out = (float*)d_out; p.ws = (unsigned char*)d_ws;
  if (hipMemsetAsync((char*)d_ws + OFF_BAR, 0, XCD_BAR_WORDS * sizeof(unsigned), stream) != hipSuccess) { fprintf(stderr, "memset of barrier words failed\n"); return; }
  void* args[] = {&p};
  hipError_t e = hipLaunchCooperativeKernel((const void*)mega, dim3(grid), dim3(NTHREADS), args, LDS_BYTES, stream);
  if (e != hipSuccess) fprintf(stderr, "cooperative launch failed: %s (grid %d)\n", hipGetErrorString(e), grid);
}
```

```cpp
#include <hip/hip_runtime.h>
#include <hip/hip_cooperative_groups.h>
#include <cstdio>
#include <cstdint>
namespace cg = cooperative_groups;

typedef unsigned short bf16_t;
typedef short bf16x8 __attribute__((ext_vector_type(8)));
typedef float f32x16 __attribute__((ext_vector_type(16)));
#define DI __device__ __forceinline__
#define MFMA32(a, b, c) __builtin_amdgcn_mfma_f32_32x32x16_bf16((a), (b), (c), 0, 0, 0)

constexpr int T = 16384, SEQ = 8192, DM = 1024;
constexpr int NTHREADS = 512;
constexpr size_t MiB = 1024 * 1024;
constexpr size_t OFF_W1 = 0;
constexpr size_t OFF_W2 = OFF_W1 + (size_t)5376 * 1024 * 2;
constexpr size_t OFF_W3 = OFF_W2 + (size_t)1024 * 2048 * 2;
constexpr size_t OFF_W4 = OFF_W3 + (size_t)1792 * 1024 * 2;
constexpr size_t OFF_W5 = OFF_W4 + (size_t)2048 * 256 * 2;
constexpr size_t OFF_W6 = OFF_W5 + (size_t)1536 * 384 * 2;
constexpr size_t OFF_XN = 24 * MiB;
constexpr size_t OFF_XT = 56 * MiB;
constexpr size_t OFF_BT = 120 * MiB;
constexpr size_t OFF_BR = 136 * MiB;
constexpr size_t OFF_CR = 152 * MiB;
constexpr size_t OFF_DT = 168 * MiB;
constexpr size_t OFF_ST = 170 * MiB;
constexpr size_t OFF_DEC = 234 * MiB;
constexpr size_t OFF_BAR = 236 * MiB;
constexpr size_t OFF_COS = 238 * MiB;
constexpr size_t OFF_SIN = 239 * MiB;
constexpr size_t OFF_SSQ = 240 * MiB;
constexpr size_t WS_NEED = 241 * MiB;

struct Params {
  const float* x; const int* pos; const float* g_pre; const float* ssm_w_in; const float* conv_w; const float* conv_b;
  const float* dt_bias; const float* A_log; const float* Dskip; const float* g_out; const float* ssm_w_out;
  const float* kv_g_in; const float* kv_w_down; const float* kv_g_lat; const float* kv_w_up;
  const float* mla_w_in; const float* mla_g_q; const float* mla_w_uq; const float* mla_w_out; const float* g_final;
  float* out; unsigned char* ws;
};

DI bf16_t f2bf(float x) { unsigned u = __float_as_uint(x); u += 0x7fffu + ((u >> 16) & 1u); return (bf16_t)(u >> 16); }
DI float bf2f(bf16_t b) { return __uint_as_float(((unsigned)b) << 16); }
DI float lo16(unsigned u) { return __uint_as_float(u << 16); }
DI float hi16(unsigned u) { return __uint_as_float(u & 0xffff0000u); }
typedef float f32x2 __attribute__((ext_vector_type(2)));
typedef __bf16 bf16x2_t __attribute__((ext_vector_type(2)));
DI unsigned pk2(float a, float b) { f32x2 v = {a, b}; bf16x2_t r = __builtin_convertvector(v, bf16x2_t); return __builtin_bit_cast(unsigned, r); }
DI float wave_sum(float v) {
#pragma unroll
  for (int o = 32; o >= 1; o >>= 1) v += __shfl_xor(v, o);
  return v;
}
DI int otid() { int t = threadIdx.x; asm volatile("" : "+v"(t)); return t; }
template <int K> DI float swz_xor(float v) {
  return __int_as_float(__builtin_amdgcn_ds_swizzle(__float_as_int(v), (K << 10) | 0x1f));
}
DI float silu_f(float v) { return v * __builtin_amdgcn_rcpf(1.f + __expf(-v)); }


#define XB_TMO      128
#define XB_XCNT(j)  (256  + 64 * (j))
#define XB_XSUB(j)  (1280 + 64 * (j))
#define XB_XGEN(j)  (2304 + 64 * (j))
#define XB_TOP      3328
#define XB_TOPGEN   3392
#define XCD_BAR_WORDS 3456
#define XB_SPIN_CAP (1u << 18)
DI unsigned xb_ld(unsigned* p)              { return __hip_atomic_load(p, __ATOMIC_RELAXED, __HIP_MEMORY_SCOPE_AGENT); }
DI unsigned xb_add(unsigned* p, unsigned v) { return __hip_atomic_fetch_add(p, v, __ATOMIC_RELAXED, __HIP_MEMORY_SCOPE_AGENT); }
DI unsigned xb_xcc_id() { return (unsigned)__builtin_amdgcn_s_getreg((3 << 11) | 20) & 0xFu; }
#define XB_SPIN(cond, bar) do { unsigned _sp = 0; while (cond) { __builtin_amdgcn_s_sleep(1); \
    if ((++_sp & 255u) == 0u) { if (xb_ld(&(bar)[XB_TMO])) break; if (_sp > XB_SPIN_CAP) { atomicAdd(&(bar)[XB_TMO], 1u); break; } } } } while (0)
struct XcdBarrier { unsigned* bar; unsigned x; volatile unsigned* st; };
DI XcdBarrier xcd_barrier_post(unsigned* bar, volatile unsigned* st) {
  XcdBarrier b; b.bar = bar; b.x = xb_xcc_id(); b.st = st;
  if (threadIdx.x == 0) (void)xb_add(&bar[XB_XCNT(b.x)], 1u);
  return b;
}
DI void xcd_barrier_complete(unsigned* bar, unsigned x, unsigned& nloc, unsigned& nx) {
  const unsigned G = gridDim.x * gridDim.y * gridDim.z;
  unsigned sum, cnt, mine, sp = 0u;
  for (;;) {
    sum = 0u; cnt = 0u; mine = 0u;
#pragma unroll
    for (unsigned j = 0; j < 16; ++j) { const unsigned c = xb_ld(&bar[XB_XCNT(j)]); sum += c; cnt += (c > 0u) ? 1u : 0u; mine = (j == x) ? c : mine; }
    if (sum == G) break;
    __builtin_amdgcn_s_sleep(1);
    if ((++sp & 255u) == 0u) { if (xb_ld(&bar[XB_TMO])) break; if (sp > XB_SPIN_CAP) { atomicAdd(&bar[XB_TMO], 1u); break; } }
  }
  nloc = mine > 0u ? mine : 1u; nx = cnt > 0u ? cnt : 1u;
}
DI void xcd_barrier(const XcdBarrier& b) {
  asm volatile("s_waitcnt vmcnt(0)" ::: "memory");
  __syncthreads();
  if (threadIdx.x == 0) {
    unsigned* bar = b.bar;
    __builtin_amdgcn_s_waitcnt(0);
    unsigned nloc = b.st[0], nx = b.st[1];
    if (nloc == 0u) { xcd_barrier_complete(bar, b.x, nloc, nx); b.st[0] = nloc; b.st[1] = nx; }
    const unsigned old = xb_add(&bar[XB_XSUB(b.x)], 1u);
    const unsigned gen = old / nloc;
    if (old + 1u == (gen + 1u) * nloc) {
      __builtin_amdgcn_fence(__ATOMIC_RELEASE, "agent");
      asm volatile("s_waitcnt vmcnt(0)" ::: "memory");
      const unsigned og = xb_add(&bar[XB_TOP], 1u);
      const unsigned tg = og / nx;
      if (og + 1u == (tg + 1u) * nx) xb_add(&bar[XB_TOPGEN], 1u);
      else XB_SPIN(xb_ld(&bar[XB_TOPGEN]) == tg, bar);
      __builtin_amdgcn_fence(__ATOMIC_ACQUIRE, "agent");
      xb_add(&bar[XB_XGEN(b.x)], 1u);
      asm volatile("s_waitcnt vmcnt(0)" ::: "memory");
    } else {
      XB_SPIN(xb_ld(&bar[XB_XGEN(b.x)]) == gen, bar);
      __builtin_amdgcn_fence(__ATOMIC_ACQUIRE, "agent");
      asm volatile("s_waitcnt vmcnt(0)" ::: "memory");
    }
  }
  __syncthreads();
}

struct WJob { const float* src; const float* gain; bf16_t* dst; int ld, col0, ncols, K, tile; };
DI WJob wprep_job(const Params& p, int u) {
  bf16_t* W1 = (bf16_t*)(p.ws + OFF_W1); bf16_t* W2 = (bf16_t*)(p.ws + OFF_W2); bf16_t* W3 = (bf16_t*)(p.ws + OFF_W3);
  bf16_t* W4 = (bf16_t*)(p.ws + OFF_W4); bf16_t* W5 = (bf16_t*)(p.ws + OFF_W5); bf16_t* W6 = (bf16_t*)(p.ws + OFF_W6);
  int t = u; WJob j;
  if (t < 1344) { j = {p.ssm_w_in, p.g_pre, W1, 5152, 0, 5152, 1024, t}; return j; } t -= 1344;
  if (t < 512) { j = {p.ssm_w_out, p.g_out, W2, 1024, 0, 1024, 2048, t}; return j; } t -= 512;
  if (t < 64) { j = {p.kv_w_down, p.kv_g_in, W3, 288, 0, 256, 1024, t}; return j; } t -= 64;
  if (t < 96) { j = {p.mla_w_in, p.g_pre + 1024, W3 + (size_t)256 * 1024, 1408, 0, 384, 1024, t}; return j; } t -= 96;
  if (t < 256) { j = {p.mla_w_in, p.g_pre + 1024, W3 + (size_t)640 * 1024, 1408, 384, 1024, 1024, t}; return j; } t -= 256;
  if (t < 32) { j = {p.kv_w_down, p.kv_g_in, W3 + (size_t)1664 * 1024, 288, 256, 32, 1024, t}; return j; } t -= 32;
  if (t < 128) { j = {p.kv_w_up, p.kv_g_lat, W4, 2048, 0, 2048, 256, t}; return j; } t -= 128;
  if (t < 144) { j = {p.mla_w_uq, p.mla_g_q, W5, 1536, 0, 1536, 384, t}; return j; } t -= 144;
  j = {p.mla_w_out, nullptr, W6, 1024, 0, 1024, 1024, t}; return j;
}
DI void wprep_load(const WJob& j, int tid0, float4 (&v)[2], float (&gk)[2]) {
  const int nkt = j.K >> 6; const int tn = j.tile / nkt, tk = j.tile % nkt; const int n0 = tn * 64, k0 = tk * 64;
#pragma unroll
  for (int i = 0; i < 2; ++i) {
    const int e = tid0 + NTHREADS * i; const int kk = e >> 4, n4 = (e & 15) * 4;
    v[i] = make_float4(0.f, 0.f, 0.f, 0.f);
    if (n0 + n4 < j.ncols) v[i] = *(const float4*)(j.src + (size_t)(k0 + kk) * j.ld + j.col0 + n0 + n4);
    gk[i] = j.gain ? j.gain[k0 + kk] : 1.f;
  }
}
DI void phase_prep(const Params& p, unsigned char* smem, int ustart, int uend, int ustride) {
  float* sm = (float*)smem;
  const int tid0 = otid();
  int u = ustart;
  if (u >= uend) return;
  WJob j = wprep_job(p, u);
  float4 v[2]; float gk[2];
  wprep_load(j, tid0, v, gk);
  for (;;) {
#pragma unroll
    for (int i = 0; i < 2; ++i) {
      const int e = tid0 + NTHREADS * i; const int kk = e >> 4, n4 = (e & 15) * 4;
      float* d = sm + kk * 65 + n4;
      d[0] = v[i].x * gk[i]; d[1] = v[i].y * gk[i]; d[2] = v[i].z * gk[i]; d[3] = v[i].w * gk[i];
    }
    __syncthreads();
    const WJob jc = j;
    const int un = u + ustride; const bool more = (un < uend);
    if (more) { j = wprep_job(p, un); wprep_load(j, tid0, v, gk); }
    {
      const int nkt = jc.K >> 6; const int tn = jc.tile / nkt, tk = jc.tile % nkt; const int n0 = tn * 64, k0 = tk * 64;
      const int nn = tid0 >> 3, kc = (tid0 & 7) * 8;
      uint4 o;
      o.x = pk2(sm[(kc + 0) * 65 + nn], sm[(kc + 1) * 65 + nn]); o.y = pk2(sm[(kc + 2) * 65 + nn], sm[(kc + 3) * 65 + nn]);
      o.z = pk2(sm[(kc + 4) * 65 + nn], sm[(kc + 5) * 65 + nn]); o.w = pk2(sm[(kc + 6) * 65 + nn], sm[(kc + 7) * 65 + nn]);
      *(uint4*)(jc.dst + (size_t)(n0 + nn) * jc.K + k0 + kc) = o;
    }
    __syncthreads();
    if (!more) break;
    u = un;
  }
}

DI void phase_rope_tables(const Params& p, int blk, int nblk) {
  float* COS = (float*)(p.ws + OFF_COS); float* SIN = (float*)(p.ws + OFF_SIN);
  for (int e = blk * NTHREADS + otid(); e < T * 16; e += nblk * NTHREADS) {
    const int t = e >> 4, i = e & 15;
    const float ang = (float)p.pos[t] * powf(10000.f, -(float)(2 * i) / 32.f);
    COS[e] = cosf(ang); SIN[e] = sinf(ang);
  }
  float* SSQ = (float*)(p.ws + OFF_SSQ);
  for (int e = blk * NTHREADS + otid(); e < 3 * T; e += nblk * NTHREADS) SSQ[e] = 0.f;
}

DI void phase_rmsnorm_rows(const float* __restrict__ src, bf16_t* __restrict__ dst) {
  const int tid = otid(); const int lane = tid & 63, w = tid >> 6;
  for (int row = (blockIdx.x * 8 + w) * 2; row < T; row += gridDim.x * 16) {
    float4 v[2][4]; float ss[2] = {0.f, 0.f};
#pragma unroll
    for (int u = 0; u < 2; ++u)
#pragma unroll
      for (int i = 0; i < 4; ++i) v[u][i] = ((const float4*)(src + (size_t)(row + u) * DM))[lane + 64 * i];
#pragma unroll
    for (int u = 0; u < 2; ++u) {
#pragma unroll
      for (int i = 0; i < 4; ++i) ss[u] += v[u][i].x * v[u][i].x + v[u][i].y * v[u][i].y + v[u][i].z * v[u][i].z + v[u][i].w * v[u][i].w;
      ss[u] = wave_sum(ss[u]);
      const float r = rsqrtf(ss[u] * (1.f / 1024.f) + 1e-6f);
#pragma unroll
      for (int i = 0; i < 4; ++i) {
        uint2 o; o.x = pk2(v[u][i].x * r, v[u][i].y * r); o.y = pk2(v[u][i].z * r, v[u][i].w * r);
        *(uint2*)(dst + (size_t)(row + u) * DM + (lane + 64 * i) * 4) = o;
      }
    }
  }
}

enum { EPI_SSM_IN = 0, EPI_OUT1 = 1, EPI_MLA_IN = 2, EPI_KVUP = 3, EPI_QUP = 4, EPI_OUT2 = 5 };


typedef float f32x4 __attribute__((ext_vector_type(4)));
constexpr int EPI_WAVE_BYTES = 8704;
constexpr int TM_ROW = 72;
constexpr int CM_ROW = 40;
constexpr int F32_ROW = 68;

template <bool SILU>
DI void stage_tm(const f32x4 (&a)[4][2], bf16_t* wl, int fr, int fq) {
#pragma unroll
  for (int m = 0; m < 4; ++m)
#pragma unroll
    for (int n = 0; n < 2; ++n) {
      float v0 = a[m][n][0], v1 = a[m][n][1], v2 = a[m][n][2], v3 = a[m][n][3];
      if (SILU) { v0 = silu_f(v0); v1 = silu_f(v1); v2 = silu_f(v2); v3 = silu_f(v3); }
      uint2 o; o.x = pk2(v0, v1); o.y = pk2(v2, v3);
      *(uint2*)(wl + (n * 16 + fr) * TM_ROW + m * 16 + fq * 4) = o;
    }
}
DI void readout_tm(const bf16_t* wl, bf16_t* gdst, size_t ld, int lane) {
#pragma unroll
  for (int it = 0; it < 4; ++it) {
    const int idx = lane + 64 * it; const int row = idx >> 3, ch = idx & 7;
    *(uint4*)(gdst + (size_t)row * ld + ch * 8) = *(const uint4*)(wl + row * TM_ROW + ch * 8);
  }
}
DI void stage_cm(const f32x4 (&a)[4][2], bf16_t* wl, int fr, int fq) {
#pragma unroll
  for (int m = 0; m < 4; ++m)
#pragma unroll
    for (int n = 0; n < 2; ++n)
#pragma unroll
      for (int j = 0; j < 4; ++j) wl[(m * 16 + fq * 4 + j) * CM_ROW + n * 16 + fr] = f2bf(a[m][n][j]);
}
DI void readout_cm(const bf16_t* wl, bf16_t* gdst, int lane) {
#pragma unroll
  for (int it = 0; it < 4; ++it) {
    const int idx = lane + 64 * it; const int row = idx >> 2, ch = idx & 3;
    *(uint4*)(gdst + (size_t)row * SEQ + ch * 8) = *(const uint4*)(wl + row * CM_ROW + ch * 8);
  }
}
constexpr int CMP_ROW = 72;
DI void stage_cm_pair(const f32x4 (&a)[4][2], bf16_t* wlp, int par, int fr, int fq) {
#pragma unroll
  for (int m = 0; m < 4; ++m)
#pragma unroll
    for (int n = 0; n < 2; ++n)
#pragma unroll
      for (int j = 0; j < 4; ++j) wlp[(m * 16 + fq * 4 + j) * CMP_ROW + par * 32 + n * 16 + fr] = f2bf(a[m][n][j]);
}
DI void readout_cm_pair(const bf16_t* wlp, bf16_t* gdst, int par, int lane) {
#pragma unroll
  for (int it = 0; it < 4; ++it) {
    const int idx = lane + 64 * it; const int row = par * 32 + (idx >> 3), ch = idx & 7;
    *(uint4*)(gdst + (size_t)row * SEQ + ch * 8) = *(const uint4*)(wlp + row * CMP_ROW + ch * 8);
  }
}
DI void stage_f32(const f32x4 (&a)[4][2], float* wl, int fr, int fq) {
#pragma unroll
  for (int m = 0; m < 4; ++m)
#pragma unroll
    for (int n = 0; n < 2; ++n) *(f32x4*)(wl + (n * 16 + fr) * F32_ROW + m * 16 + fq * 4) = a[m][n];
}
DI void readout_f32_resid(const float* wl, const float* __restrict__ resid, float* __restrict__ gdst, int lane) {
#pragma unroll 4
  for (int it = 0; it < 8; ++it) {
    const int idx = lane + 64 * it; const int row = idx >> 4, ch = idx & 15;
    const float4 v = *(const float4*)(wl + row * F32_ROW + ch * 4);
    const float4 r = *(const float4*)(resid + (size_t)row * DM + ch * 4);
    *(float4*)(gdst + (size_t)row * DM + ch * 4) = make_float4(v.x + r.x, v.y + r.y, v.z + r.z, v.w + r.w);
  }
}

DI void readout_f32_resid_ssq(const float* wl, const float* __restrict__ resid, float* __restrict__ gdst, bf16_t* __restrict__ hs, float* __restrict__ ssq, int lane) {
#pragma unroll 4
  for (int it = 0; it < 8; ++it) {
    const int idx = lane + 64 * it; const int row = idx >> 4, ch = idx & 15;
    const float4 v = *(const float4*)(wl + row * F32_ROW + ch * 4);
    const float4 r = *(const float4*)(resid + (size_t)row * DM + ch * 4);
    const float4 h = make_float4(v.x + r.x, v.y + r.y, v.z + r.z, v.w + r.w);
    *(float4*)(gdst + (size_t)row * DM + ch * 4) = h;
    uint2 o; o.x = pk2(h.x, h.y); o.y = pk2(h.z, h.w);
    *(uint2*)(hs + (size_t)row * DM + ch * 4) = o;
    float q = h.x * h.x + h.y * h.y + h.z * h.z + h.w * h.w;
    q += swz_xor<1>(q); q += swz_xor<2>(q); q += swz_xor<4>(q); q += swz_xor<8>(q);
    if (ch == 0) atomicAdd(ssq + row, q);
  }
}

DI void wave_lds_sync() { asm volatile("s_waitcnt lgkmcnt(0)" ::: "memory"); }

template <int EPI>
DI void epilogue_block(const Params& p, const f32x4 (&a)[4][2], int c0, int mt, bf16_t* wl, bf16_t* wlp, int par, int lane, int fr, int fq) {
  unsigned char* ws = p.ws;
  const int b = mt >> 13, tok0 = mt & 8191;
  const int tok0p = tok0 - par * 32;
  if (EPI == EPI_SSM_IN) {
    if (c0 < 2048 || (c0 >= 4096 && c0 < 5120)) stage_tm<false>(a, wl, fr, fq);
    else if (c0 < 4096) stage_cm_pair(a, wlp, par, fr, fq);
    __syncthreads();
    if (c0 < 2048) readout_tm(wl, (bf16_t*)p.out + (size_t)mt * 2048 + c0, 2048, lane);
    else if (c0 < 4096) readout_cm_pair(wlp, (bf16_t*)(ws + OFF_XT) + ((size_t)(b * 2048 + (c0 - 2048))) * SEQ + tok0p, par, lane);
    else if (c0 < 4608) readout_tm(wl, (bf16_t*)(ws + OFF_BR) + (size_t)mt * 512 + (c0 - 4096), 512, lane);
    else if (c0 < 5120) readout_tm(wl, (bf16_t*)(ws + OFF_CR) + (size_t)mt * 512 + (c0 - 4608), 512, lane);
    else if (c0 == 5120) {
#pragma unroll
      for (int m = 0; m < 2; ++m)
#pragma unroll
        for (int n = 0; n < 2; ++n) {
          const int h = m * 16 + fq * 4;
          float4 o; float* op = (float*)&o;
#pragma unroll
          for (int j = 0; j < 4; ++j) { const float t = a[m][n][j] + p.dt_bias[h + j]; op[j] = (t > 20.f) ? t : log1pf(__expf(t)); }
          *(float4*)((float*)(ws + OFF_DT) + (size_t)(mt + n * 16 + fr) * 32 + h) = o;
        }
    }
    __syncthreads();
    if (c0 >= 4096 && c0 < 4608) stage_cm_pair(a, wlp, par, fr, fq);
    __syncthreads();
    if (c0 >= 4096 && c0 < 4608) readout_cm_pair(wlp, (bf16_t*)(ws + OFF_BT) + ((size_t)(b * 512 + (c0 - 4096))) * SEQ + tok0p, par, lane);
    __syncthreads();
  } else if (EPI == EPI_OUT1 || EPI == EPI_OUT2) {
    const float* resid = (EPI == EPI_OUT1) ? p.x : (const float*)(ws + OFF_XT);
    float* dst = (EPI == EPI_OUT1) ? (float*)(ws + OFF_XT) : p.out;
    stage_f32(a, (float*)wl, fr, fq); wave_lds_sync();
    if (EPI == EPI_OUT1) readout_f32_resid_ssq((const float*)wl, resid + (size_t)mt * DM + c0, dst + (size_t)mt * DM + c0, (bf16_t*)(ws + OFF_XN) + (size_t)mt * DM + c0, (float*)(ws + OFF_SSQ) + mt, lane);
    else readout_f32_resid((const float*)wl, resid + (size_t)mt * DM + c0, dst + (size_t)mt * DM + c0, lane);
    wave_lds_sync();
  } else if (EPI == EPI_MLA_IN) {
    const float* SSQ = (const float*)(ws + OFF_SSQ);
    f32x4 a2[4][2];
    float rs[2];
#pragma unroll
    for (int n = 0; n < 2; ++n) rs[n] = rsqrtf(SSQ[mt + n * 16 + fr] * (1.f / 1024.f) + 1e-6f);
#pragma unroll
    for (int m = 0; m < 4; ++m)
#pragma unroll
      for (int n = 0; n < 2; ++n) a2[m][n] = a[m][n] * rs[n];
    if (c0 < 640) {
      float* dstq = (float*)(ws + OFF_SSQ) + (c0 < 256 ? T : 2 * T);
#pragma unroll
      for (int n = 0; n < 2; ++n) {
        float q = 0.f;
#pragma unroll
        for (int m = 0; m < 4; ++m) q += a2[m][n][0] * a2[m][n][0] + a2[m][n][1] * a2[m][n][1] + a2[m][n][2] * a2[m][n][2] + a2[m][n][3] * a2[m][n][3];
        q += swz_xor<16>(q); q += __shfl_xor(q, 32);
        if (fq == 0) atomicAdd(dstq + mt + n * 16 + fr, q);
      }
    }
    const f32x4 (&a)[4][2] = a2;
    if (c0 < 640) stage_tm<false>(a, wl, fr, fq);
    else if (c0 < 1664) stage_tm<true>(a, wl, fr, fq);
    __syncthreads();
    if (c0 < 256) readout_tm(wl, (bf16_t*)(ws + OFF_ST + 32 * MiB) + (size_t)mt * 256 + c0, 256, lane);
    else if (c0 < 640) readout_tm(wl, (bf16_t*)(ws + OFF_ST + 40 * MiB) + (size_t)mt * 384 + (c0 - 256), 384, lane);
    else if (c0 < 1664) readout_tm(wl, (bf16_t*)(ws + OFF_ST) + (size_t)mt * 1024 + (c0 - 640), 1024, lane);
    else if (c0 == 1664) {
      const float* COS = (const float*)(ws + OFF_COS); const float* SIN = (const float*)(ws + OFF_SIN);
      bf16_t* KROPE = (bf16_t*)(ws + OFF_DEC);
#pragma unroll
      for (int n = 0; n < 2; ++n) {
        const int t = mt + n * 16 + fr;
        const f32x4 cs = *(const f32x4*)(COS + (size_t)t * 16 + fq * 4), sn = *(const f32x4*)(SIN + (size_t)t * 16 + fq * 4);
        const f32x4 x1 = a[0][n], x2 = a[1][n];
        const f32x4 r1 = x1 * cs - x2 * sn, r2 = x1 * sn + x2 * cs;
        uint2 o1, o2; o1.x = pk2(r1[0], r1[1]); o1.y = pk2(r1[2], r1[3]); o2.x = pk2(r2[0], r2[1]); o2.y = pk2(r2[2], r2[3]);
        *(uint2*)(KROPE + (size_t)t * 32 + fq * 4) = o1; *(uint2*)(KROPE + (size_t)t * 32 + 16 + fq * 4) = o2;
      }
    }
    __syncthreads();
  } else if (EPI == EPI_KVUP) {
    const int head = c0 >> 7; const bool isv = (c0 & 64) != 0;
    const float* SSQ = (const float*)(ws + OFF_SSQ) + T;
    f32x4 a2[4][2];
#pragma unroll
    for (int n = 0; n < 2; ++n) {
      const float rsn = rsqrtf(SSQ[mt + n * 16 + fr] * (1.f / 256.f) + 1e-6f);
#pragma unroll
      for (int m = 0; m < 4; ++m) a2[m][n] = a[m][n] * rsn;
    }
    const f32x4 (&a)[4][2] = a2;
    if (!isv) stage_tm<false>(a, wl, fr, fq); else stage_cm_pair(a, wlp, par, fr, fq);
    __syncthreads();
    if (!isv) readout_tm(wl, (bf16_t*)(ws + OFF_XN) + (size_t)mt * 1024 + head * 64, 1024, lane);
    else readout_cm_pair(wlp, (bf16_t*)(ws + OFF_BT) + ((size_t)((b * 16 + head) * 64)) * SEQ + tok0p, par, lane);
    __syncthreads();
  } else if (EPI == EPI_QUP) {
    const float SC = 0.10206207261596575f * 1.4426950408889634f;
    const float* SSQ = (const float*)(ws + OFF_SSQ) + 2 * T;
    f32x4 v[4][2];
#pragma unroll
    for (int n = 0; n < 2; ++n) {
      const float rsn = rsqrtf(SSQ[mt + n * 16 + fr] * (1.f / 384.f) + 1e-6f) * SC;
#pragma unroll
      for (int m = 0; m < 4; ++m) v[m][n] = a[m][n] * rsn;
    }
    const int ph = c0 % 96;
    if (ph != 0) {
      const float* COS = (const float*)(ws + OFF_COS); const float* SIN = (const float*)(ws + OFF_SIN);
#pragma unroll
      for (int n = 0; n < 2; ++n) {
        const int t = mt + n * 16 + fr;
        const f32x4 cs = *(const f32x4*)(COS + (size_t)t * 16 + fq * 4), sn = *(const f32x4*)(SIN + (size_t)t * 16 + fq * 4);
        if (ph == 64) { const f32x4 x1 = v[0][n], x2 = v[1][n]; v[0][n] = x1 * cs - x2 * sn; v[1][n] = x1 * sn + x2 * cs; }
        else          { const f32x4 x1 = v[2][n], x2 = v[3][n]; v[2][n] = x1 * cs - x2 * sn; v[3][n] = x1 * sn + x2 * cs; }
      }
    }
    stage_tm<false>(v, wl, fr, fq); wave_lds_sync();
    readout_tm(wl, (bf16_t*)p.out + (size_t)mt * 1536 + c0, 1536, lane);
    wave_lds_sync();
  }
}

constexpr int G8_BK = 64, G8_HALF = 128, G8_HT = G8_HALF * G8_BK;
constexpr int LDS_BYTES = 143360;
DI int g8_lds_byte(int r, int c) { const int st = (r >> 4) * 2 + (c >> 5), rr = r & 15, cc = c & 31, ob = rr * 64 + cc * 2; return st * 1024 + (ob ^ (((ob >> 9) & 1) << 5)); }
DI void g8_stage_rc(int b, int& R, int& C) { const int st = b / 1024, sb = b % 1024, swz = sb ^ (((sb >> 9) & 1) << 5); R = (st >> 1) * 16 + swz / 64; C = (st & 1) * 32 + (swz % 64) / 2; }

template <int EPI, int K>
DI void gemm_tile(const Params& p, const bf16_t* __restrict__ A, const bf16_t* __restrict__ Bt, int brow, int bcol, unsigned char* smem) {
  bf16_t* shm = (bf16_t*)smem;
#define SA(b, h) (shm + ((b) * 2 + (h)) * G8_HT)
#define SB(b, h) (shm + (4 + (b) * 2 + (h)) * G8_HT)
#define STAGE(P, BASE, br, kt) do { const long _g = (long)(br) * K + (long)(kt) * G8_BK; \
    _Pragma("unroll") for (int _i = 0; _i < 2; ++_i) { const int _b = tid * 16 + _i * 8192; int _r, _c; g8_stage_rc(_b, _r, _c); \
      __builtin_amdgcn_global_load_lds((const unsigned*)(BASE + _g + (long)_r * K + _c), (unsigned*)((char*)(P) + _b), 16, 0, 0); } } while (0)
#define LDA(dst, b, h) _Pragma("unroll") for (int m = 0; m < 4; ++m) _Pragma("unroll") for (int k = 0; k < 2; ++k) \
    dst[m][k] = *reinterpret_cast<const bf16x8*>((const char*)SA(b, h) + g8_lds_byte(wr * 64 + m * 16 + fr, k * 32 + fq * 8))
#define LDB(dst, b, h) _Pragma("unroll") for (int n = 0; n < 2; ++n) _Pragma("unroll") for (int k = 0; k < 2; ++k) \
    dst[n][k] = *reinterpret_cast<const bf16x8*>((const char*)SB(b, h) + g8_lds_byte(wc * 32 + n * 16 + fr, k * 32 + fq * 8))
#define MMA(ai, bj, At_, Bt_) do { __builtin_amdgcn_s_setprio(1); \
    _Pragma("unroll") for (int m = 0; m < 4; ++m) _Pragma("unroll") for (int n = 0; n < 2; ++n) _Pragma("unroll") for (int k = 0; k < 2; ++k) \
      acc[ai][bj][m][n] = __builtin_amdgcn_mfma_f32_16x16x32_bf16(At_[m][k], Bt_[n][k], acc[ai][bj][m][n], 0, 0, 0); \
    __builtin_amdgcn_s_setprio(0); } while (0)
#define WAIT_V(n) asm volatile("s_waitcnt vmcnt(" #n ")" ::: "memory")
#define WAIT_L(n) asm volatile("s_waitcnt lgkmcnt(" #n ")" ::: "memory")
#define BAR __builtin_amdgcn_s_barrier()
#define SCHED __builtin_amdgcn_sched_barrier(0)
  const int tid = otid();
  const int wid = tid >> 6, lane = tid & 63, wr = wid >> 2, wc = wid & 3, fr = lane & 15, fq = lane >> 4;
  f32x4 acc[2][2][4][2];
#pragma unroll
  for (int a_ = 0; a_ < 2; ++a_)
#pragma unroll
    for (int b_ = 0; b_ < 2; ++b_)
#pragma unroll
      for (int m = 0; m < 4; ++m)
#pragma unroll
        for (int n = 0; n < 2; ++n) acc[a_][b_][m][n] = (f32x4){0.f, 0.f, 0.f, 0.f};
  bf16x8 At[4][2], B0[2][2], B1[2][2];
  constexpr int nt = K / G8_BK;
  STAGE(SB(0, 0), Bt, bcol, 0); STAGE(SA(0, 0), A, brow, 0);
  STAGE(SB(0, 1), Bt, bcol + G8_HALF, 0); STAGE(SA(0, 1), A, brow + G8_HALF, 0);
  if (wr == 1) BAR;
  WAIT_V(4); BAR;
  STAGE(SB(1, 0), Bt, bcol, 1); STAGE(SA(1, 0), A, brow, 1); STAGE(SB(1, 1), Bt, bcol + G8_HALF, 1);
  WAIT_V(6); BAR;
  for (int t = 0; t < nt - 2; t += 2) {
    LDB(B0, 0, 0); SCHED; LDA(At, 0, 0); STAGE(SA(1, 1), A, brow + G8_HALF, t + 1);
    WAIT_L(8); BAR; WAIT_L(0); MMA(0, 0, At, B0); BAR; SCHED;
    LDB(B1, 0, 1); STAGE(SB(0, 0), Bt, bcol, t + 2);
    BAR; WAIT_L(0); MMA(0, 1, At, B1); BAR;
    LDA(At, 0, 1); STAGE(SA(0, 0), A, brow, t + 2);
    BAR; WAIT_L(0); MMA(1, 0, At, B0); BAR; SCHED;
    STAGE(SB(0, 1), Bt, bcol + G8_HALF, t + 2);
    WAIT_V(6); BAR; MMA(1, 1, At, B1); BAR;
    LDB(B0, 1, 0); SCHED; LDA(At, 1, 0); STAGE(SA(0, 1), A, brow + G8_HALF, t + 2);
    WAIT_L(8); BAR; WAIT_L(0); MMA(0, 0, At, B0); BAR; SCHED;
    LDB(B1, 1, 1); STAGE(SB(1, 0), Bt, bcol, t + 3);
    BAR; WAIT_L(0); MMA(0, 1, At, B1); BAR;
    LDA(At, 1, 1); STAGE(SA(1, 0), A, brow, t + 3);
    BAR; WAIT_L(0); MMA(1, 0, At, B0); BAR; SCHED;
    STAGE(SB(1, 1), Bt, bcol + G8_HALF, t + 3);
    WAIT_V(6); BAR; MMA(1, 1, At, B1); BAR;
  }
  { LDB(B0, 0, 0); LDA(At, 0, 0); STAGE(SA(1, 1), A, brow + G8_HALF, nt - 1);
    BAR; WAIT_L(0); MMA(0, 0, At, B0); BAR;
    LDB(B1, 0, 1); BAR; WAIT_L(0); MMA(0, 1, At, B1); BAR;
    LDA(At, 0, 1); WAIT_V(4); BAR; WAIT_L(0); MMA(1, 0, At, B0); MMA(1, 1, At, B1); BAR; }
  { LDB(B0, 1, 0); LDA(At, 1, 0); WAIT_V(2); BAR; WAIT_L(0); MMA(0, 0, At, B0); BAR;
    LDB(B1, 1, 1); WAIT_V(0); BAR; WAIT_L(0); MMA(0, 1, At, B1); BAR;
    LDA(At, 1, 1); BAR; WAIT_L(0); MMA(1, 0, At, B0); MMA(1, 1, At, B1); BAR; }
  if (wr == 0) BAR;
  __syncthreads();
  int t2 = tid; asm volatile("" : "+v"(t2));
  const int wid2 = t2 >> 6, lane2 = t2 & 63, wr2 = wid2 >> 2, wc2 = wid2 & 3, fr2 = lane2 & 15, fq2 = lane2 >> 4;
  bf16_t* wl = (bf16_t*)(smem + wid2 * EPI_WAVE_BYTES);
  bf16_t* wlp = (bf16_t*)(smem + (wid2 & ~1) * EPI_WAVE_BYTES);
#pragma unroll
  for (int ai = 0; ai < 2; ++ai)
#pragma unroll
    for (int bj = 0; bj < 2; ++bj)
      epilogue_block<EPI>(p, acc[ai][bj], brow + ai * 128 + wr2 * 64, bcol + bj * 128 + wc2 * 32, wl, wlp, wc2 & 1, lane2, fr2, fq2);
  __syncthreads();
#undef SA
#undef SB
#undef STAGE
#undef LDA
#undef LDB
#undef MMA
#undef WAIT_V
#undef WAIT_L
#undef BAR
#undef SCHED
}

template <int EPI, int K>
DI void gemm_phase(const Params& p, const bf16_t* Wt, const bf16_t* X, int ntn, unsigned char* smem) {
  const bool xa = (gridDim.x == 256);
  const int xcd = blockIdx.x & 7, li = blockIdx.x >> 3;
  const int per_half = 4 * ntn;
  const int start = xa ? li : (int)blockIdx.x, step = xa ? 32 : (int)gridDim.x, total = ntn * (xa ? 8 : 64);
  for (int t = start; t < total; t += step) {
    int tm, tn;
    if (xa) { const int h = t / per_half, tp = t - h * per_half; tn = tp >> 2; tm = xcd * 8 + h * 4 + (tp & 3); }
    else { tm = t / ntn; tn = t % ntn; }
    gemm_tile<EPI, K>(p, Wt, X, tn * 256, tm * 256, smem);
  }
}

DI void conv8_load(const bf16_t* rp, bool has_prev, uint4& cur, uint2& prv) {
  cur = *(const uint4*)rp; prv = make_uint2(0u, 0u);
  if (has_prev) prv = *(const uint2*)(rp - 4);
}
DI float fast_silu(float v) { return v * __builtin_amdgcn_rcpf(1.f + __expf(-v)); }
DI void conv8_compute(const uint4 cur, const uint2 prv, float w0, float w1, float w2, float w3, float bias, float (&out)[8]) {
  float r[11];
  r[0] = hi16(prv.x); r[1] = lo16(prv.y); r[2] = hi16(prv.y);
  r[3] = lo16(cur.x); r[4] = hi16(cur.x); r[5] = lo16(cur.y); r[6] = hi16(cur.y); r[7] = lo16(cur.z); r[8] = hi16(cur.z); r[9] = lo16(cur.w); r[10] = hi16(cur.w);
#pragma unroll
  for (int j = 0; j < 8; ++j) out[j] = fast_silu(bias + w0 * r[j] + w1 * r[j + 1] + w2 * r[j + 2] + w3 * r[j + 3]);
}
DI void conv8(const bf16_t* rp, bool has_prev, float w0, float w1, float w2, float w3, float bias, float (&out)[8]) {
  uint4 cur; uint2 prv; conv8_load(rp, has_prev, cur, prv); conv8_compute(cur, prv, w0, w1, w2, w3, bias, out);
}
DI bf16x8 pack8(const float (&v)[8]) {
  uint4 u; u.x = pk2(v[0], v[1]); u.y = pk2(v[2], v[3]); u.z = pk2(v[4], v[5]); u.w = pk2(v[6], v[7]);
  return __builtin_bit_cast(bf16x8, u);
}
DI void chunk_cumsum(const float* __restrict__ DTp, size_t tk0, int hd, float A, int lane, float (&d4)[4], float (&c4)[4], float& last) {
#pragma unroll
  for (int i = 0; i < 4; ++i) d4[i] = DTp[(tk0 + 4 * lane + i) * 32 + hd];
  c4[0] = d4[0] * A; c4[1] = c4[0] + d4[1] * A; c4[2] = c4[1] + d4[2] * A; c4[3] = c4[2] + d4[3] * A;
  const float tot = c4[3];
  float sum = tot, ex = 0.f, t;
  t = swz_xor<1>(sum);  if (lane & 1) ex += t;  sum += t;
  t = swz_xor<2>(sum);  if (lane & 2) ex += t;  sum += t;
  t = swz_xor<4>(sum);  if (lane & 4) ex += t;  sum += t;
  t = swz_xor<8>(sum);  if (lane & 8) ex += t;  sum += t;
  t = swz_xor<16>(sum); if (lane & 16) ex += t; sum += t;
  t = __shfl_xor(sum, 32); if (lane & 32) ex += t; sum += t;
#pragma unroll
  for (int i = 0; i < 4; ++i) c4[i] += ex;
  last = sum;
}

constexpr int BT_ROW = 264;
constexpr int CN_ROW = 136;

DI void phase_ssd_state(const Params& p, unsigned char* smem) {
  const bf16_t* XT = (const bf16_t*)(p.ws + OFF_XT); const bf16_t* BT = (const bf16_t*)(p.ws + OFF_BT); const float* DTp = (const float*)(p.ws + OFF_DT);
  float* ST = (float*)(p.ws + OFF_ST); float* DEC = (float*)(p.ws + OFF_DEC);
  bf16_t* BTs = (bf16_t*)smem; float* wgt = (float*)(smem + 128 * BT_ROW * 2);
  const int tid = otid(), lane = tid & 63, w = tid >> 6, l31 = lane & 31, lh = lane >> 5;
  for (int u = blockIdx.x; u < 256; u += gridDim.x) {
    const int b = u >> 7, c = (u >> 2) & 31, g = u & 3; const int hd = 8 * g + w;
    bf16_t* XTC = (bf16_t*)(p.ws + (b ? OFF_ST + 32 * MiB : OFF_XN));
    {
      float d4[4], c4[4], last; chunk_cumsum(DTp, (size_t)b * SEQ + c * 256, hd, -__expf(p.A_log[hd]), lane, d4, c4, last);
      float4 o = {__expf(last - c4[0]) * d4[0], __expf(last - c4[1]) * d4[1], __expf(last - c4[2]) * d4[2], __expf(last - c4[3]) * d4[3]};
      *(float4*)(wgt + w * 256 + 4 * lane) = o;
      if (lane == 0) DEC[(b * 32 + c) * 32 + hd] = __expf(last);
    }
#pragma unroll 2
    for (int i = 0; i < 8; ++i) {
      const int chunk = tid + 512 * i; const int s8 = (chunk & 31) * 8, n = chunk >> 5; const int ch = 2048 + g * 128 + n;
      float v[8];
      conv8(BT + ((size_t)(b * 512 + g * 128 + n)) * SEQ + c * 256 + s8, !(c == 0 && s8 == 0),
            p.conv_w[ch], p.conv_w[3072 + ch], p.conv_w[2 * 3072 + ch], p.conv_w[3 * 3072 + ch], p.conv_b[ch], v);
      *(bf16x8*)(BTs + n * BT_ROW + s8) = pack8(v);
    }
    __syncthreads();
    f32x16 acc[2][4];
#pragma unroll
    for (int a = 0; a < 2; ++a)
#pragma unroll
      for (int q = 0; q < 4; ++q)
#pragma unroll
        for (int i = 0; i < 16; ++i) acc[a][q][i] = 0.f;
    float xw[2][4], xb[2];
#pragma unroll
    for (int pt = 0; pt < 2; ++pt) {
      const int ch = hd * 64 + pt * 32 + l31;
#pragma unroll
      for (int k = 0; k < 4; ++k) xw[pt][k] = p.conv_w[k * 3072 + ch];
      xb[pt] = p.conv_b[ch];
    }
    for (int kb = 0; kb < 16; kb += 2) {
      uint4 rc[2][2]; uint2 rp[2][2];
#pragma unroll
      for (int i = 0; i < 2; ++i)
#pragma unroll
        for (int pt = 0; pt < 2; ++pt) {
          const int s0 = (kb + i) * 16 + 8 * lh;
          conv8_load(XT + ((size_t)(b * 2048 + hd * 64 + pt * 32 + l31)) * SEQ + c * 256 + s0, !(c == 0 && s0 == 0), rc[i][pt], rp[i][pt]);
        }
#pragma unroll
      for (int i = 0; i < 2; ++i) {
        const int ks = kb + i; const int s0 = ks * 16 + 8 * lh;
        const float4 g0 = *(const float4*)(wgt + w * 256 + s0), g1 = *(const float4*)(wgt + w * 256 + s0 + 4);
        const float wg[8] = {g0.x, g0.y, g0.z, g0.w, g1.x, g1.y, g1.z, g1.w};
        bf16x8 afr[2];
#pragma unroll
        for (int pt = 0; pt < 2; ++pt) {
          float v[8];
          conv8_compute(rc[i][pt], rp[i][pt], xw[pt][0], xw[pt][1], xw[pt][2], xw[pt][3], xb[pt], v);
          *(bf16x8*)(XTC + ((size_t)(hd * 64 + pt * 32 + l31)) * SEQ + c * 256 + s0) = pack8(v);
#pragma unroll
          for (int j = 0; j < 8; ++j) v[j] *= wg[j];
          afr[pt] = pack8(v);
        }
#pragma unroll
        for (int nt = 0; nt < 4; ++nt) {
          const bf16x8 bfr = *(const bf16x8*)(BTs + (nt * 32 + l31) * BT_ROW + ks * 16 + 8 * lh);
#pragma unroll
          for (int pt = 0; pt < 2; ++pt) acc[pt][nt] = MFMA32(afr[pt], bfr, acc[pt][nt]);
        }
      }
    }
    bf16_t* Sp = (bf16_t*)ST + (((size_t)(b * 32 + c) * 32 + hd) * 64) * 128;
#pragma unroll
    for (int pt = 0; pt < 2; ++pt)
#pragma unroll
      for (int nt = 0; nt < 4; ++nt)
#pragma unroll
        for (int r = 0; r < 16; ++r) Sp[(pt * 32 + (r & 3) + 8 * (r >> 2) + 4 * lh) * 128 + nt * 32 + l31] = f2bf(acc[pt][nt][r]);
    __syncthreads();
  }
}

DI void phase_ssd_scan(const Params& p) {
  bf16_t* ST = (bf16_t*)(p.ws + OFF_ST); const float* DEC = (const float*)(p.ws + OFF_DEC);
  for (int idx = blockIdx.x * NTHREADS + otid(); idx < 131072; idx += gridDim.x * NTHREADS) {
    const int n4 = idx & 31, pp = (idx >> 5) & 63, h = (idx >> 11) & 31, b = idx >> 16;
    float run[4] = {0.f, 0.f, 0.f, 0.f};
    bf16_t* base = ST + (((size_t)(b * 32) * 32 + h) * 64 + pp) * 128 + n4 * 4;
    const float* dbase = DEC + (b * 32) * 32 + h;
    for (int c0 = 0; c0 < 32; c0 += 16) {
      uint2 loc[16]; float d[16];
#pragma unroll
      for (int i = 0; i < 16; ++i) { loc[i] = *(const uint2*)(base + (size_t)(c0 + i) * (32 * 64 * 128)); d[i] = dbase[(c0 + i) * 32]; }
#pragma unroll
      for (int i = 0; i < 16; ++i) {
        uint2 o; o.x = pk2(run[0], run[1]); o.y = pk2(run[2], run[3]);
        *(uint2*)(base + (size_t)(c0 + i) * (32 * 64 * 128)) = o;
        run[0] = run[0] * d[i] + lo16(loc[i].x); run[1] = run[1] * d[i] + hi16(loc[i].x);
        run[2] = run[2] * d[i] + lo16(loc[i].y); run[3] = run[3] * d[i] + hi16(loc[i].y);
      }
    }
  }
}

DI void stage_tokmajor(const Params& p, const bf16_t* __restrict__ RAW, int b, int tok0, int nrows, int g, int cbase, bf16_t* dst, int tid_) {
  const int tid = otid(); (void)tid_;
  const int n8 = (tid & 15) * 8; const int ch = cbase + g * 128 + n8;
  float cw[4][8], cb[8];
#pragma unroll
  for (int k = 0; k < 4; ++k) {
    const float4 a = *(const float4*)(p.conv_w + k * 3072 + ch), bq = *(const float4*)(p.conv_w + k * 3072 + ch + 4);
    cw[k][0] = a.x; cw[k][1] = a.y; cw[k][2] = a.z; cw[k][3] = a.w; cw[k][4] = bq.x; cw[k][5] = bq.y; cw[k][6] = bq.z; cw[k][7] = bq.w;
  }
  { const float4 a = *(const float4*)(p.conv_b + ch), bq = *(const float4*)(p.conv_b + ch + 4);
    cb[0] = a.x; cb[1] = a.y; cb[2] = a.z; cb[3] = a.w; cb[4] = bq.x; cb[5] = bq.y; cb[6] = bq.z; cb[7] = bq.w; }
  for (int t = tid >> 4; t < nrows; t += 64) {
    uint4 r[2][4];
#pragma unroll
    for (int u = 0; u < 2; ++u)
#pragma unroll
      for (int k = 0; k < 4; ++k) {
        const int tk = tok0 + t + 32 * u - 3 + k;
        r[u][k] = make_uint4(0u, 0u, 0u, 0u);
        if (tk >= 0) r[u][k] = *(const uint4*)(RAW + ((size_t)b * SEQ + tk) * 512 + g * 128 + n8);
      }
#pragma unroll
    for (int u = 0; u < 2; ++u) {
      float acc[8];
#pragma unroll
      for (int j = 0; j < 8; ++j) acc[j] = cb[j];
#pragma unroll
      for (int k = 0; k < 4; ++k) {
        const uint4 q = r[u][k];
        acc[0] += cw[k][0] * lo16(q.x); acc[1] += cw[k][1] * hi16(q.x); acc[2] += cw[k][2] * lo16(q.y); acc[3] += cw[k][3] * hi16(q.y);
        acc[4] += cw[k][4] * lo16(q.z); acc[5] += cw[k][5] * hi16(q.z); acc[6] += cw[k][6] * lo16(q.w); acc[7] += cw[k][7] * hi16(q.w);
      }
#pragma unroll
      for (int j = 0; j < 8; ++j) acc[j] = fast_silu(acc[j]);
      *(bf16x8*)(dst + (t + 32 * u) * CN_ROW + n8) = pack8(acc);
    }
  }
}

constexpr int S3_CS = 0, S3_BS = 64 * CN_ROW * 2, S3_CB = S3_BS + 256 * CN_ROW * 2, S3_CUM = S3_CB + 64 * BT_ROW * 2, S3_DTS = S3_CUM + 8192,
              S3_PART = S3_DTS + 8192, S3_RSTD = S3_PART + 2048, S3_END = S3_RSTD + 256;

DI void phase_ssd_out(const Params& p, unsigned char* smem) {
  const bf16_t* XT = (const bf16_t*)(p.ws + OFF_XT); const bf16_t* BR = (const bf16_t*)(p.ws + OFF_BR); const bf16_t* CR = (const bf16_t*)(p.ws + OFF_CR);
  const float* DTp = (const float*)(p.ws + OFF_DT); const float* ST = (const float*)(p.ws + OFF_ST); bf16_t* Z = (bf16_t*)p.out;
  bf16_t* Cs = (bf16_t*)(smem + S3_CS); bf16_t* Bs = (bf16_t*)(smem + S3_BS); bf16_t* CBs = (bf16_t*)(smem + S3_CB);
  float* cumA = (float*)(smem + S3_CUM); float* dts = (float*)(smem + S3_DTS); float* part = (float*)(smem + S3_PART); float* rstd = (float*)(smem + S3_RSTD);
  const int tid = otid(), lane = tid & 63, w = tid >> 6, l31 = lane & 31, lh = lane >> 5;
  const bool persist = (gridDim.x == 256);
  for (int u = blockIdx.x; u < 1024; u += gridDim.x) {
    const int tq = u >> 8, rest = u & 255; const int b = rest >> 7, c = (rest >> 2) & 31, g = rest & 3; const int hd = 8 * g + w;
    const int ns = (tq + 1) * 64;
    if (!persist || tq == 0) {
      float d4[4], c4[4], last; chunk_cumsum(DTp, (size_t)b * SEQ + c * 256, hd, -__expf(p.A_log[hd]), lane, d4, c4, last);
      *(float4*)(cumA + w * 256 + 4 * lane) = make_float4(c4[0], c4[1], c4[2], c4[3]);
      *(float4*)(dts + w * 256 + 4 * lane) = make_float4(d4[0], d4[1], d4[2], d4[3]);
    }
    stage_tokmajor(p, CR, b, c * 256 + tq * 64, 64, g, 2560, Cs, tid);
    { const int r0 = persist ? tq * 64 : 0; stage_tokmajor(p, BR, b, c * 256 + r0, ns - r0, g, 2048, Bs + r0 * CN_ROW, tid); }
    __syncthreads();
    if (32 * w < ns) {
      f32x16 a2[2];
#pragma unroll
      for (int a = 0; a < 2; ++a)
#pragma unroll
        for (int i = 0; i < 16; ++i) a2[a][i] = 0.f;
#pragma unroll
      for (int ks = 0; ks < 8; ++ks) {
        const bf16x8 af = *(const bf16x8*)(Bs + (32 * w + l31) * CN_ROW + ks * 16 + 8 * lh);
#pragma unroll
        for (int tt = 0; tt < 2; ++tt) {
          const bf16x8 bq = *(const bf16x8*)(Cs + (tt * 32 + l31) * CN_ROW + ks * 16 + 8 * lh);
          a2[tt] = MFMA32(af, bq, a2[tt]);
        }
      }
#pragma unroll
      for (int tt = 0; tt < 2; ++tt)
#pragma unroll
        for (int rg = 0; rg < 4; ++rg) {
          uint2 o; o.x = pk2(a2[tt][4 * rg], a2[tt][4 * rg + 1]); o.y = pk2(a2[tt][4 * rg + 2], a2[tt][4 * rg + 3]);
          *(uint2*)(CBs + (tt * 32 + l31) * BT_ROW + 32 * w + 8 * rg + 4 * lh) = o;
        }
    }
    __syncthreads();
    f32x16 acc[2][2];
#pragma unroll
    for (int a = 0; a < 2; ++a)
#pragma unroll
      for (int q = 0; q < 2; ++q)
#pragma unroll
        for (int i = 0; i < 16; ++i) acc[a][q][i] = 0.f;
    {
      const bf16_t* Sp = (const bf16_t*)ST + (((size_t)(b * 32 + c) * 32 + hd) * 64) * 128;
      for (int kb = 0; kb < 8; kb += 4) {
        bf16x8 bfr[4][2];
#pragma unroll
        for (int i = 0; i < 4; ++i)
#pragma unroll
          for (int pt = 0; pt < 2; ++pt) bfr[i][pt] = *(const bf16x8*)(Sp + (pt * 32 + l31) * 128 + (kb + i) * 16 + 8 * lh);
#pragma unroll
        for (int i = 0; i < 4; ++i) {
          const int ks = kb + i;
#pragma unroll
          for (int tt = 0; tt < 2; ++tt) {
            const bf16x8 af = *(const bf16x8*)(Cs + (tt * 32 + l31) * CN_ROW + ks * 16 + 8 * lh);
#pragma unroll
            for (int pt = 0; pt < 2; ++pt) acc[tt][pt] = MFMA32(af, bfr[i][pt], acc[tt][pt]);
          }
        }
      }
#pragma unroll
      for (int tt = 0; tt < 2; ++tt)
#pragma unroll
        for (int r = 0; r < 16; ++r) {
          const float e = __expf(cumA[w * 256 + tq * 64 + tt * 32 + (r & 3) + 8 * (r >> 2) + 4 * lh]);
          acc[tt][0][r] *= e; acc[tt][1][r] *= e;
        }
    }
    {
      const float Dh = p.Dskip[hd];
      const int tl0 = tq * 64 + l31, tl1 = tq * 64 + 32 + l31;
      const float ct0 = cumA[w * 256 + tl0], ct1 = cumA[w * 256 + tl1];
      const bf16_t* XTC = (const bf16_t*)(p.ws + (b ? OFF_ST + 32 * MiB : OFF_XN)) + ((size_t)(hd * 64 + l31)) * SEQ + c * 256 + 8 * lh;
      const int nks = ns >> 4;
      for (int kb = 0; kb < nks; kb += 4) {
        bf16x8 xq[4][2];
#pragma unroll
        for (int i = 0; i < 4; ++i)
#pragma unroll
          for (int pt = 0; pt < 2; ++pt) xq[i][pt] = *(const bf16x8*)(XTC + (size_t)pt * 32 * SEQ + (kb + i) * 16);
#pragma unroll
        for (int i = 0; i < 4; ++i) {
          const int ks = kb + i; const int s0 = ks * 16 + 8 * lh;
          const float4 c0 = *(const float4*)(cumA + w * 256 + s0), c1 = *(const float4*)(cumA + w * 256 + s0 + 4);
          const float4 d0 = *(const float4*)(dts + w * 256 + s0), d1 = *(const float4*)(dts + w * 256 + s0 + 4);
          const float cs[8] = {c0.x, c0.y, c0.z, c0.w, c1.x, c1.y, c1.z, c1.w};
          const float ds[8] = {d0.x, d0.y, d0.z, d0.w, d1.x, d1.y, d1.z, d1.w};
          const float cref = cumA[w * 256 + ks * 16];
          const bool steep = (cref - cumA[w * 256 + ks * 16 + 15]) > 60.f;
          float Fs[8];
#pragma unroll
          for (int j = 0; j < 8; ++j) Fs[j] = __expf(fminf(cref - cs[j], 64.f)) * ds[j];
#pragma unroll
          for (int tt = 0; tt < 2; ++tt) {
            if (ks * 16 <= tq * 64 + tt * 32 + 31) {
              const int tl = tt ? tl1 : tl0; const float ct = tt ? ct1 : ct0;
              const float Et = __expf(fminf(ct - cref, 0.f));
              const uint4 cbv = *(const uint4*)(CBs + (tt * 32 + l31) * BT_ROW + s0);
              const float cb[8] = {lo16(cbv.x), hi16(cbv.x), lo16(cbv.y), hi16(cbv.y), lo16(cbv.z), hi16(cbv.z), lo16(cbv.w), hi16(cbv.w)};
              float mv[8];
              if (steep) {
#pragma unroll
                for (int j = 0; j < 8; ++j) {
                  const int sidx = s0 + j;
                  float v = cb[j] * __expf(fminf(ct - cs[j], 0.f)) * ds[j];
                  v = (sidx <= tl) ? v : 0.f;
                  if (sidx == tl) v += Dh;
                  mv[j] = v;
                }
              } else if (ks * 16 + 15 > tq * 64 + tt * 32) {
#pragma unroll
                for (int j = 0; j < 8; ++j) {
                  const int sidx = s0 + j;
                  float v = cb[j] * (Et * Fs[j]);
                  v = (sidx <= tl) ? v : 0.f;
                  if (sidx == tl) v += Dh;
                  mv[j] = v;
                }
              } else {
#pragma unroll
                for (int j = 0; j < 8; ++j) mv[j] = cb[j] * (Et * Fs[j]);
              }
              const bf16x8 af = pack8(mv);
#pragma unroll
              for (int pt = 0; pt < 2; ++pt) acc[tt][pt] = MFMA32(af, xq[i][pt], acc[tt][pt]);
            }
          }
        }
      }
    }
    const size_t tokb = (size_t)b * SEQ + c * 256 + tq * 64;
#pragma unroll
    for (int tt = 0; tt < 2; ++tt)
#pragma unroll
      for (int r = 0; r < 16; ++r) {
        const int tloc = tt * 32 + (r & 3) + 8 * (r >> 2) + 4 * lh;
        const bf16_t* zp = Z + (tokb + tloc) * 2048 + hd * 64 + l31;
        const float y0 = acc[tt][0][r] * silu_f(bf2f(zp[0])), y1 = acc[tt][1][r] * silu_f(bf2f(zp[32]));
        acc[tt][0][r] = y0; acc[tt][1][r] = y1;
        float v = y0 * y0 + y1 * y1;
        v += swz_xor<1>(v); v += swz_xor<2>(v); v += swz_xor<4>(v); v += swz_xor<8>(v); v += swz_xor<16>(v);
        if (l31 == 0) part[w * 64 + tloc] = v;
      }
    __syncthreads();
    if (tid < 64) {
      float sres = 0.f;
#pragma unroll
      for (int ww = 0; ww < 8; ++ww) sres += part[ww * 64 + tid];
      rstd[tid] = rsqrtf(sres * (1.f / 512.f) + 1e-6f);
    }
    __syncthreads();
#pragma unroll
    for (int tt = 0; tt < 2; ++tt)
#pragma unroll
      for (int r = 0; r < 16; ++r) {
        const int tloc = tt * 32 + (r & 3) + 8 * (r >> 2) + 4 * lh;
        const float rs = rstd[tloc];
        bf16_t* zp = Z + (tokb + tloc) * 2048 + hd * 64 + l31;
        zp[0] = f2bf(acc[tt][0][r] * rs); zp[32] = f2bf(acc[tt][1][r] * rs);
      }
    __syncthreads();
  }
}

constexpr int KROW = 104;
constexpr int VROW = 68;
constexpr int ATT_K_BYTES = 64 * KROW * 2;
constexpr int ATT_V_BYTES = 64 * VROW * 2;
constexpr int ATT_STAGE = ATT_K_BYTES + ATT_V_BYTES;

DI void attn_kload(const bf16_t* sK, bf16x8 (&kf)[2][6], int l31, int lh) {
#pragma unroll
  for (int sub = 0; sub < 2; ++sub)
#pragma unroll
    for (int ks = 0; ks < 6; ++ks) kf[sub][ks] = *(const bf16x8*)(sK + (sub * 32 + l31) * KROW + ks * 16 + lh * 8);
}
DI void attn_qkmma(const bf16x8 (&kf)[2][6], const bf16x8 (&qf)[6], f32x16 (&sc)[2]) {
#pragma unroll
  for (int sub = 0; sub < 2; ++sub)
#pragma unroll
    for (int i = 0; i < 16; ++i) sc[sub][i] = 0.f;
#pragma unroll
  for (int ks = 0; ks < 6; ++ks)
#pragma unroll
    for (int sub = 0; sub < 2; ++sub) sc[sub] = MFMA32(kf[sub][ks], qf[ks], sc[sub]);
}
DI void attn_qk(const bf16_t* sK, const bf16x8 (&qf)[6], f32x16 (&sc)[2], int l31, int lh) {
  bf16x8 kf[2][6]; attn_kload(sK, kf, l31, lh); attn_qkmma(kf, qf, sc);
}

template <bool MASK>
DI void attn_softmax(f32x16 (&sc)[2], f32x16 (&o)[2], float& m, float& l, int kt, int myq, int lh) {
  float tmax = -1e30f;
#pragma unroll
  for (int sub = 0; sub < 2; ++sub)
#pragma unroll
    for (int r = 0; r < 16; ++r) {
      if (MASK) { const int key = kt * 64 + sub * 32 + (r & 3) + 8 * (r >> 2) + 4 * lh; if (key > myq) sc[sub][r] = -1e30f; }
      tmax = fmaxf(tmax, sc[sub][r]);
    }
  tmax = fmaxf(tmax, __shfl_xor(tmax, 32));
  if (__builtin_amdgcn_ballot_w64(tmax - m > 8.f) != 0) {
    const float mn = fmaxf(m, tmax); const float al = __builtin_amdgcn_exp2f(m - mn); m = mn;
    l *= al;
#pragma unroll
    for (int a = 0; a < 2; ++a)
#pragma unroll
      for (int i = 0; i < 16; ++i) o[a][i] *= al;
  }
  f32x2 ps2 = {0.f, 0.f}; const f32x2 mn2 = {m, m};
#pragma unroll
  for (int sub = 0; sub < 2; ++sub)
#pragma unroll
    for (int r = 0; r < 16; r += 2) {
      f32x2 d = {sc[sub][r], sc[sub][r + 1]}; d = d - mn2;
      f32x2 pe; pe.x = __builtin_amdgcn_exp2f(d.x); pe.y = __builtin_amdgcn_exp2f(d.y);
      sc[sub][r] = pe.x; sc[sub][r + 1] = pe.y; ps2 = ps2 + pe;
    }
  l += ps2.x + ps2.y;
}
DI void attn_pv(const f32x16 (&sc)[2], f32x16 (&o)[2], const bf16_t* sV, int l31, int lh) {
#pragma unroll
  for (int sub = 0; sub < 2; ++sub)
#pragma unroll
    for (int s2 = 0; s2 < 2; ++s2) {
      uint4 pu; pu.x = pk2(sc[sub][8 * s2], sc[sub][8 * s2 + 1]); pu.y = pk2(sc[sub][8 * s2 + 2], sc[sub][8 * s2 + 3]);
      pu.z = pk2(sc[sub][8 * s2 + 4], sc[sub][8 * s2 + 5]); pu.w = pk2(sc[sub][8 * s2 + 6], sc[sub][8 * s2 + 7]);
      const bf16x8 pb = __builtin_bit_cast(bf16x8, pu);
#pragma unroll
      for (int dvt = 0; dvt < 2; ++dvt) {
        const bf16_t* vp = sV + (dvt * 32 + l31) * VROW + sub * 32 + 16 * s2 + 4 * lh;
        const uint2 lo = *(const uint2*)vp, hi = *(const uint2*)(vp + 8);
        uint4 vu = {lo.x, lo.y, hi.x, hi.y};
        o[dvt] = MFMA32(__builtin_bit_cast(bf16x8, vu), pb, o[dvt]);
      }
    }
}

DI void attn_unit(const Params& p, int b, int h, int qb, unsigned char* smem) {
  const bf16_t* Q = (const bf16_t*)p.out; const bf16_t* KN = (const bf16_t*)(p.ws + OFF_XN); const bf16_t* VT = (const bf16_t*)(p.ws + OFF_BT);
  const bf16_t* KROPE = (const bf16_t*)(p.ws + OFF_DEC); const bf16_t* GATE = (const bf16_t*)(p.ws + OFF_ST); bf16_t* O = (bf16_t*)(p.ws + OFF_ST + 32 * MiB);
  const int tid = otid(), lane = tid & 63, w = tid >> 6, l31 = lane & 31, lh = lane >> 5;
  const int q0 = qb * 256, qw0 = q0 + 32 * w, myq = qw0 + l31;
  const size_t tq = (size_t)b * SEQ + myq;
  bf16x8 qf[6];
#pragma unroll
  for (int ks = 0; ks < 6; ++ks) qf[ks] = *(const bf16x8*)(Q + tq * 1536 + h * 96 + ks * 16 + lh * 8);
  f32x16 o[2];
#pragma unroll
  for (int a = 0; a < 2; ++a)
#pragma unroll
    for (int i = 0; i < 16; ++i) o[a][i] = 0.f;
  float m = -1e30f, l = 0.f;
  const int ntiles = 4 * qb + 4;
  const int nact = (qw0 + 31) / 64 + 1;
  const int kr = tid >> 3, kc = (tid & 7) * 8;
  const int rr = (tid & 255) >> 2, rc = (tid & 3) * 8;
  const bf16_t* gK = KN + ((size_t)b * SEQ + kr) * 1024 + h * 64 + kc;
  const bf16_t* gR = KROPE + ((size_t)b * SEQ + rr) * 32 + rc;
  const bf16_t* gV = VT + ((size_t)((b * 16 + h) * 64 + kr)) * SEQ + kc;
  uint4 rk, rr4, rv;
#define ATT_LOAD(T) do { rk = *(const uint4*)(gK + (size_t)(T) * 64 * 1024); rr4 = *(const uint4*)(gR + (size_t)(T) * 64 * 32); rv = *(const uint4*)(gV + (T) * 64); } while (0)
#define ATT_STORE(ST_) do { bf16_t* dK_ = (bf16_t*)(smem + (ST_) * ATT_STAGE); bf16_t* dV_ = (bf16_t*)(smem + (ST_) * ATT_STAGE + ATT_K_BYTES); \
    *(uint4*)(dK_ + kr * KROW + kc) = rk; *(uint4*)(dK_ + rr * KROW + 64 + rc) = rr4; \
    *(uint2*)(dV_ + kr * VROW + kc) = make_uint2(rv.x, rv.y); *(uint2*)(dV_ + kr * VROW + kc + 4) = make_uint2(rv.z, rv.w); } while (0)
  ATT_LOAD(0); ATT_STORE(0);
  ATT_LOAD(1); ATT_STORE(1);
  __syncthreads();
  f32x16 sc[2], sn[2];
  attn_qk((const bf16_t*)smem, qf, sc, l31, lh);
  int st = 0;
  int kt = 0;
  for (; kt < nact - 1; ++kt) {
    const int st1 = (st == 2) ? 0 : st + 1, st2 = (st1 == 2) ? 0 : st1 + 1;
    const int tl = (kt + 2 < ntiles) ? kt + 2 : ntiles - 1;
    ATT_LOAD(tl);
    attn_qk((const bf16_t*)(smem + st1 * ATT_STAGE), qf, sn, l31, lh);
    attn_softmax<false>(sc, o, m, l, kt, myq, lh);
    attn_pv(sc, o, (const bf16_t*)(smem + st * ATT_STAGE + ATT_K_BYTES), l31, lh);
    ATT_STORE(st2);
    __syncthreads();
#pragma unroll
    for (int sub = 0; sub < 2; ++sub) sc[sub] = sn[sub];
    st = st1;
  }
  {
    const int st1 = (st == 2) ? 0 : st + 1, st2 = (st1 == 2) ? 0 : st1 + 1;
    const int tl = (kt + 2 < ntiles) ? kt + 2 : ntiles - 1;
    ATT_LOAD(tl);
    attn_softmax<true>(sc, o, m, l, kt, myq, lh);
    attn_pv(sc, o, (const bf16_t*)(smem + st * ATT_STAGE + ATT_K_BYTES), l31, lh);
    ATT_STORE(st2);
    __syncthreads();
    st = st1; ++kt;
  }
  for (; kt < ntiles; ++kt) {
    const int st1 = (st == 2) ? 0 : st + 1, st2 = (st1 == 2) ? 0 : st1 + 1;
    const int tl = (kt + 2 < ntiles) ? kt + 2 : ntiles - 1;
    ATT_LOAD(tl);
    ATT_STORE(st2);
    __syncthreads();
    st = st1;
  }
#undef ATT_LOAD
#undef ATT_STORE
  l += __shfl_xor(l, 32);
  const float il = 1.f / l;
#pragma unroll
  for (int dvt = 0; dvt < 2; ++dvt)
#pragma unroll
    for (int rg = 0; rg < 4; ++rg) {
      const int dv = dvt * 32 + 8 * rg + 4 * lh;
      const uint2 gv = *(const uint2*)(GATE + tq * 1024 + h * 64 + dv);
      const float g0 = __uint_as_float(gv.x << 16), g1 = __uint_as_float(gv.x & 0xffff0000u), g2 = __uint_as_float(gv.y << 16), g3 = __uint_as_float(gv.y & 0xffff0000u);
      uint2 ov; ov.x = pk2(o[dvt][4 * rg] * il * g0, o[dvt][4 * rg + 1] * il * g1); ov.y = pk2(o[dvt][4 * rg + 2] * il * g2, o[dvt][4 * rg + 3] * il * g3);
      *(uint2*)(O + tq * 1024 + h * 64 + dv) = ov;
    }
}

DI void phase_attn(const Params& p, unsigned char* smem) {
  for (int u = blockIdx.x; u < 512; u += gridDim.x) {
    int pu = u;
    if (gridDim.x == 256) {
      const int xcd = blockIdx.x & 7, li = blockIdx.x >> 3, r = u >> 8;
      pu = (r * 16 + xcd * 2 + (li >> 4)) * 16 + (li & 15);
    }
    const int bh = pu >> 4, x = pu & 15;
    for (int half = 0; half < 2; ++half) attn_unit(p, bh >> 4, bh & 15, half ? x : 31 - x, smem);
  }
}

DI void phase_final_norm(const Params& p) {
  const int tid = otid(); const int lane = tid & 63, w = tid >> 6;
  float4 g[4];
#pragma unroll
  for (int i = 0; i < 4; ++i) g[i] = ((const float4*)p.g_final)[lane + 64 * i];
  for (int row = (blockIdx.x * 8 + w) * 2; row < T; row += gridDim.x * 16) {
    float4 v[2][4]; float ss[2] = {0.f, 0.f};
#pragma unroll
    for (int u = 0; u < 2; ++u)
#pragma unroll
      for (int i = 0; i < 4; ++i) v[u][i] = ((const float4*)(p.out + (size_t)(row + u) * DM))[lane + 64 * i];
#pragma unroll
    for (int u = 0; u < 2; ++u) {
#pragma unroll
      for (int i = 0; i < 4; ++i) ss[u] += v[u][i].x * v[u][i].x + v[u][i].y * v[u][i].y + v[u][i].z * v[u][i].z + v[u][i].w * v[u][i].w;
      ss[u] = wave_sum(ss[u]);
      const float r = rsqrtf(ss[u] * (1.f / 1024.f) + 1e-6f);
#pragma unroll
      for (int i = 0; i < 4; ++i)
        ((float4*)(p.out + (size_t)(row + u) * DM))[lane + 64 * i] = make_float4(v[u][i].x * r * g[i].x, v[u][i].y * r * g[i].y, v[u][i].z * r * g[i].z, v[u][i].w * r * g[i].w);
    }
  }
}

__global__ void __launch_bounds__(NTHREADS) mega(Params p) {
  cg::grid_group grid = cg::this_grid();
  extern __shared__ __attribute__((aligned(16))) unsigned char smem[];
  unsigned char* ws = p.ws;
  __shared__ unsigned bar_st[4];
  if (threadIdx.x < 4) bar_st[threadIdx.x] = 0u;
  __syncthreads();
  const XcdBarrier xb = xcd_barrier_post((unsigned*)(ws + OFF_BAR), bar_st);
  const bool tailfill = (gridDim.x == 256);
  phase_prep(p, smem, blockIdx.x, tailfill ? 1344 : 2832, gridDim.x);
  if (!tailfill) phase_rope_tables(p, blockIdx.x, gridDim.x);
  phase_rmsnorm_rows(p.x, (bf16_t*)(ws + OFF_XN));
  if (p.out == nullptr) grid.sync();
  xcd_barrier(xb);
  gemm_phase<EPI_SSM_IN, 1024>(p, (const bf16_t*)(ws + OFF_W1), (const bf16_t*)(ws + OFF_XN), 21, smem);
  if (tailfill && (blockIdx.x >> 3) >= 8) {
    const int tj = (blockIdx.x & 7) * 24 + ((blockIdx.x >> 3) - 8);
    phase_prep(p, smem, 1344 + tj, 2832, 192);
    phase_rope_tables(p, tj, 192);
  }
  xcd_barrier(xb);
  phase_ssd_state(p, smem);
  xcd_barrier(xb);
  phase_ssd_scan(p);
  xcd_barrier(xb);
  phase_ssd_out(p, smem);
  xcd_barrier(xb);
  gemm_phase<EPI_OUT1, 2048>(p, (const bf16_t*)(ws + OFF_W2), (const bf16_t*)p.out, 4, smem);
  xcd_barrier(xb);
  gemm_phase<EPI_MLA_IN, 1024>(p, (const bf16_t*)(ws + OFF_W3), (const bf16_t*)(ws + OFF_XN), 7, smem);
  xcd_barrier(xb);
  gemm_phase<EPI_KVUP, 256>(p, (const bf16_t*)(ws + OFF_W4), (const bf16_t*)(ws + OFF_ST + 32 * MiB), 8, smem);
  gemm_phase<EPI_QUP, 384>(p, (const bf16_t*)(ws + OFF_W5), (const bf16_t*)(ws + OFF_ST + 40 * MiB), 6, smem);
  xcd_barrier(xb);
  phase_attn(p, smem);
  xcd_barrier(xb);
  gemm_phase<EPI_OUT2, 1024>(p, (const bf16_t*)(ws + OFF_W6), (const bf16_t*)(ws + OFF_ST + 32 * MiB), 4, smem);
  xcd_barrier(xb);
  phase_final_norm(p);
}

extern "C" void kernel_launch(void* const* d_in, const int* in_sizes, int n_in, void* d_out, int out_size, void* d_ws, size_t ws_size, hipStream_t stream) {
  static int grid = 0;
  if (grid == 0) {
    if (n_in != 20 || ws_size < WS_NEED) { fprintf(stderr, "kernel_launch: unexpected n_in %d / ws_size %zu\n", n_in, ws_size); grid = -1; return; }
    int dev = 0, cus = 0, per_cu = 0;
    hipGetDevice(&dev);
    hipDeviceGetAttribute(&cus, hipDeviceAttributeMultiprocessorCount, dev);
    if (hipFuncSetAttribute((const void*)mega, hipFuncAttributeMaxDynamicSharedMemorySize, LDS_BYTES) != hipSuccess) { fprintf(stderr, "hipFuncSetAttribute failed\n"); grid = -1; return; }
    hipOccupancyMaxActiveBlocksPerMultiprocessor(&per_cu, (const void*)mega, NTHREADS, LDS_BYTES);
    if (per_cu < 1) per_cu = 1;
    (void)hipGetLastError();
    grid = cus;
  }
  if (grid < 0) return;
  Params p{};
  p.x = (const float*)d_in[0]; p.pos = (const int*)d_in[1]; p.g_pre = (const float*)d_in[2]; p.ssm_w_in = (const float*)d_in[3];
  p.conv_w = (const float*)d_in[4]; p.conv_b = (const float*)d_in[5]; p.dt_bias = (const float*)d_in[6]; p.A_log = (const float*)d_in[7];
  p.Dskip = (const float*)d_in[8]; p.g_out = (const float*)d_in[9]; p.ssm_w_out = (const float*)d_in[10]; p.kv_g_in = (const float*)d_in[11];
  p.kv_w_down = (const float*)d_in[12]; p.kv_g_lat = (const float*)d_in[13]; p.kv_w_up = (const float*)d_in[14]; p.mla_w_in = (const float*)d_in[15];
  p.mla_g_q = (const float*)d_in[16]; p.mla_w_uq = (const float*)d_in[17]; p.mla_w_out = (const float*)d_in[18]; p.g_final = (const float*)d_in[19];
  p.out = (float*)d_out; p.ws = (unsigned char*)d_ws;
  if (hipMemsetAsync((char*)d_ws + OFF_BAR, 0, XCD_BAR_WORDS * sizeof(unsigned), stream) != hipSuccess) { fprintf(stderr, "memset of barrier words failed\n"); return; }
  void* args[] = {&p};
  hipError_t e = hipLaunchCooperativeKernel((const void*)mega, dim3(grid), dim3(NTHREADS), args, LDS_BYTES, stream);
  if (e != hipSuccess) fprintf(stderr, "cooperative launch failed: %s (grid %d)\n", hipGetErrorString(e), grid);
}
```

```cpp
#include <hip/hip_runtime.h>
#include <hip/hip_cooperative_groups.h>
#include <cstdio>
#include <cstdint>
namespace cg = cooperative_groups;

typedef unsigned short bf16_t;
typedef short bf16x8 __attribute__((ext_vector_type(8)));
typedef float f32x16 __attribute__((ext_vector_type(16)));
#define DI __device__ __forceinline__
#define MFMA32(a, b, c) __builtin_amdgcn_mfma_f32_32x32x16_bf16((a), (b), (c), 0, 0, 0)

constexpr int T = 16384, SEQ = 8192, DM = 1024;
constexpr int NTHREADS = 512;
constexpr size_t MiB = 1024 * 1024;
constexpr size_t OFF_W1 = 0;
constexpr size_t OFF_W2 = OFF_W1 + (size_t)5376 * 1024 * 2;
constexpr size_t OFF_W3 = OFF_W2 + (size_t)1024 * 2048 * 2;
constexpr size_t OFF_W4 = OFF_W3 + (size_t)1792 * 1024 * 2;
constexpr size_t OFF_W5 = OFF_W4 + (size_t)2048 * 256 * 2;
constexpr size_t OFF_W6 = OFF_W5 + (size_t)1536 * 384 * 2;
constexpr size_t OFF_XN = 24 * MiB;
constexpr size_t OFF_XT = 56 * MiB;
constexpr size_t OFF_BT = 120 * MiB;
constexpr size_t OFF_BR = 136 * MiB;
constexpr size_t OFF_CR = 152 * MiB;
constexpr size_t OFF_DT = 168 * MiB;
constexpr size_t OFF_ST = 170 * MiB;
constexpr size_t OFF_DEC = 234 * MiB;
constexpr size_t OFF_BAR = 236 * MiB;
constexpr size_t OFF_COS = 238 * MiB;
constexpr size_t OFF_SIN = 239 * MiB;
constexpr size_t OFF_SSQ = 240 * MiB;
constexpr size_t WS_NEED = 241 * MiB;

struct Params {
  const float* x; const int* pos; const float* g_pre; const float* ssm_w_in; const float* conv_w; const float* conv_b;
  const float* dt_bias; const float* A_log; const float* Dskip; const float* g_out; const float* ssm_w_out;
  const float* kv_g_in; const float* kv_w_down; const float* kv_g_lat; const float* kv_w_up;
  const float* mla_w_in; const float* mla_g_q; const float* mla_w_uq; const float* mla_w_out; const float* g_final;
  float* out; unsigned char* ws;
};

DI bf16_t f2bf(float x) { unsigned u = __float_as_uint(x); u += 0x7fffu + ((u >> 16) & 1u); return (bf16_t)(u >> 16); }
DI float bf2f(bf16_t b) { return __uint_as_float(((unsigned)b) << 16); }
DI float lo16(unsigned u) { return __uint_as_float(u << 16); }
DI float hi16(unsigned u) { return __uint_as_float(u & 0xffff0000u); }
typedef float f32x2 __attribute__((ext_vector_type(2)));
typedef __bf16 bf16x2_t __attribute__((ext_vector_type(2)));
DI unsigned pk2(float a, float b) { f32x2 v = {a, b}; bf16x2_t r = __builtin_convertvector(v, bf16x2_t); return __builtin_bit_cast(unsigned, r); }
DI float wave_sum(float v) {
#pragma unroll
  for (int o = 32; o >= 1; o >>= 1) v += __shfl_xor(v, o);
  return v;
}
DI int otid() { int t = threadIdx.x; asm volatile("" : "+v"(t)); return t; }
template <int K> DI float swz_xor(float v) {
  return __int_as_float(__builtin_amdgcn_ds_swizzle(__float_as_int(v), (K << 10) | 0x1f));
}
DI float silu_f(float v) { return v * __builtin_amdgcn_rcpf(1.f + __expf(-v)); }


#define XB_TMO      128
#define XB_XCNT(j)  (256  + 64 * (j))
#define XB_XSUB(j)  (1280 + 64 * (j))
#define XB_XGEN(j)  (2304 + 64 * (j))
#define XB_TOP      3328
#define XB_TOPGEN   3392
#define XCD_BAR_WORDS 3456
#define XB_SPIN_CAP (1u << 18)
DI unsigned xb_ld(unsigned* p)              { return __hip_atomic_load(p, __ATOMIC_RELAXED, __HIP_MEMORY_SCOPE_AGENT); }
DI unsigned xb_add(unsigned* p, unsigned v) { return __hip_atomic_fetch_add(p, v, __ATOMIC_RELAXED, __HIP_MEMORY_SCOPE_AGENT); }
DI unsigned xb_xcc_id() { return (unsigned)__builtin_amdgcn_s_getreg((3 << 11) | 20) & 0xFu; }
#define XB_SPIN(cond, bar) do { unsigned _sp = 0; while (cond) { __builtin_amdgcn_s_sleep(1); \
    if ((++_sp & 255u) == 0u) { if (xb_ld(&(bar)[XB_TMO])) break; if (_sp > XB_SPIN_CAP) { atomicAdd(&(bar)[XB_TMO], 1u); break; } } } } while (0)
struct XcdBarrier { unsigned* bar; unsigned x; volatile unsigned* st; };
DI XcdBarrier xcd_barrier_post(unsigned* bar, volatile unsigned* st) {
  XcdBarrier b; b.bar = bar; b.x = xb_xcc_id(); b.st = st;
  if (threadIdx.x == 0) (void)xb_add(&bar[XB_XCNT(b.x)], 1u);
  return b;
}
DI void xcd_barrier_complete(unsigned* bar, unsigned x, unsigned& nloc, unsigned& nx) {
  const unsigned G = gridDim.x * gridDim.y * gridDim.z;
  unsigned sum, cnt, mine, sp = 0u;
  for (;;) {
    sum = 0u; cnt = 0u; mine = 0u;
#pragma unroll
    for (unsigned j = 0; j < 16; ++j) { const unsigned c = xb_ld(&bar[XB_XCNT(j)]); sum += c; cnt += (c > 0u) ? 1u : 0u; mine = (j == x) ? c : mine; }
    if (sum == G) break;
    __builtin_amdgcn_s_sleep(1);
    if ((++sp & 255u) == 0u) { if (xb_ld(&bar[XB_TMO])) break; if (sp > XB_SPIN_CAP) { atomicAdd(&bar[XB_TMO], 1u); break; } }
  }
  nloc = mine > 0u ? mine : 1u; nx = cnt > 0u ? cnt : 1u;
}
DI void xcd_barrier(const XcdBarrier& b) {
  asm volatile("s_waitcnt vmcnt(0)" ::: "memory");
  __syncthreads();
  if (threadIdx.x == 0) {
    unsigned* bar = b.bar;
    __builtin_amdgcn_s_waitcnt(0);
    unsigned nloc = b.st[0], nx = b.st[1];
    if (nloc == 0u) { xcd_barrier_complete(bar, b.x, nloc, nx); b.st[0] = nloc; b.st[1] = nx; }
    const unsigned old = xb_add(&bar[XB_XSUB(b.x)], 1u);
    const unsigned gen = old / nloc;
    if (old + 1u == (gen + 1u) * nloc) {
      __builtin_amdgcn_fence(__ATOMIC_RELEASE, "agent");
      asm volatile("s_waitcnt vmcnt(0)" ::: "memory");
      const unsigned og = xb_add(&bar[XB_TOP], 1u);
      const unsigned tg = og / nx;
      if (og + 1u == (tg + 1u) * nx) xb_add(&bar[XB_TOPGEN], 1u);
      else XB_SPIN(xb_ld(&bar[XB_TOPGEN]) == tg, bar);
      __builtin_amdgcn_fence(__ATOMIC_ACQUIRE, "agent");
      xb_add(&bar[XB_XGEN(b.x)], 1u);
      asm volatile("s_waitcnt vmcnt(0)" ::: "memory");
    } else {
      XB_SPIN(xb_ld(&bar[XB_XGEN(b.x)]) == gen, bar);
      __builtin_amdgcn_fence(__ATOMIC_ACQUIRE, "agent");
      asm volatile("s_waitcnt vmcnt(0)" ::: "memory");
    }
  }
  __syncthreads();
}

struct WJob { const float* src; const float* gain; bf16_t* dst; int ld, col0, ncols, K, tile; };
DI WJob wprep_job(const Params& p, int u) {
  bf16_t* W1 = (bf16_t*)(p.ws + OFF_W1); bf16_t* W2 = (bf16_t*)(p.ws + OFF_W2); bf16_t* W3 = (bf16_t*)(p.ws + OFF_W3);
  bf16_t* W4 = (bf16_t*)(p.ws + OFF_W4); bf16_t* W5 = (bf16_t*)(p.ws + OFF_W5); bf16_t* W6 = (bf16_t*)(p.ws + OFF_W6);
  int t = u; WJob j;
  if (t < 1344) { j = {p.ssm_w_in, p.g_pre, W1, 5152, 0, 5152, 1024, t}; return j; } t -= 1344;
  if (t < 512) { j = {p.ssm_w_out, p.g_out, W2, 1024, 0, 1024, 2048, t}; return j; } t -= 512;
  if (t < 64) { j = {p.kv_w_down, p.kv_g_in, W3, 288, 0, 256, 1024, t}; return j; } t -= 64;
  if (t < 96) { j = {p.mla_w_in, p.g_pre + 1024, W3 + (size_t)256 * 1024, 1408, 0, 384, 1024, t}; return j; } t -= 96;
  if (t < 256) { j = {p.mla_w_in, p.g_pre + 1024, W3 + (size_t)640 * 1024, 1408, 384, 1024, 1024, t}; return j; } t -= 256;
  if (t < 32) { j = {p.kv_w_down, p.kv_g_in, W3 + (size_t)1664 * 1024, 288, 256, 32, 1024, t}; return j; } t -= 32;
  if (t < 128) { j = {p.kv_w_up, p.kv_g_lat, W4, 2048, 0, 2048, 256, t}; return j; } t -= 128;
  if (t < 144) { j = {p.mla_w_uq, p.mla_g_q, W5, 1536, 0, 1536, 384, t}; return j; } t -= 144;
  j = {p.mla_w_out, nullptr, W6, 1024, 0, 1024, 1024, t}; return j;
}
DI void wprep_load(const WJob& j, int tid0, float4 (&v)[2], float (&gk)[2]) {
  const int nkt = j.K >> 6; const int tn = j.tile / nkt, tk = j.tile % nkt; const int n0 = tn * 64, k0 = tk * 64;
#pragma unroll
  for (int i = 0; i < 2; ++i) {
    const int e = tid0 + NTHREADS * i; const int kk = e >> 4, n4 = (e & 15) * 4;
    v[i] = make_float4(0.f, 0.f, 0.f, 0.f);
    if (n0 + n4 < j.ncols) v[i] = *(const float4*)(j.src + (size_t)(k0 + kk) * j.ld + j.col0 + n0 + n4);
    gk[i] = j.gain ? j.gain[k0 + kk] : 1.f;
  }
}
DI void phase_prep(const Params& p, unsigned char* smem, int ustart, int uend, int ustride) {
  float* sm = (float*)smem;
  const int tid0 = otid();
  int u = ustart;
  if (u >= uend) return;
  WJob j = wprep_job(p, u);
  float4 v[2]; float gk[2];
  wprep_load(j, tid0, v, gk);
  for (;;) {
#pragma unroll
    for (int i = 0; i < 2; ++i) {
      const int e = tid0 + NTHREADS * i; const int kk = e >> 4, n4 = (e & 15) * 4;
      float* d = sm + kk * 65 + n4;
      d[0] = v[i].x * gk[i]; d[1] = v[i].y * gk[i]; d[2] = v[i].z * gk[i]; d[3] = v[i].w * gk[i];
    }
    __syncthreads();
    const WJob jc = j;
    const int un = u + ustride; const bool more = (un < uend);
    if (more) { j = wprep_job(p, un); wprep_load(j, tid0, v, gk); }
    {
      const int nkt = jc.K >> 6; const int tn = jc.tile / nkt, tk = jc.tile % nkt; const int n0 = tn * 64, k0 = tk * 64;
      const int nn = tid0 >> 3, kc = (tid0 & 7) * 8;
      uint4 o;
      o.x = pk2(sm[(kc + 0) * 65 + nn], sm[(kc + 1) * 65 + nn]); o.y = pk2(sm[(kc + 2) * 65 + nn], sm[(kc + 3) * 65 + nn]);
      o.z = pk2(sm[(kc + 4) * 65 + nn], sm[(kc + 5) * 65 + nn]); o.w = pk2(sm[(kc + 6) * 65 + nn], sm[(kc + 7) * 65 + nn]);
      *(uint4*)(jc.dst + (size_t)(n0 + nn) * jc.K + k0 + kc) = o;
    }
    __syncthreads();
    if (!more) break;
    u = un;
  }
}

DI void phase_rope_tables(const Params& p, int blk, int nblk) {
  float* COS = (float*)(p.ws + OFF_COS); float* SIN = (float*)(p.ws + OFF_SIN);
  for (int e = blk * NTHREADS + otid(); e < T * 16; e += nblk * NTHREADS) {
    const int t = e >> 4, i = e & 15;
    const float ang = (float)p.pos[t] * powf(10000.f, -(float)(2 * i) / 32.f);
    COS[e] = cosf(ang); SIN[e] = sinf(ang);
  }
  float* SSQ = (float*)(p.ws + OFF_SSQ);
  for (int e = blk * NTHREADS + otid(); e < 3 * T; e += nblk * NTHREADS) SSQ[e] = 0.f;
}

DI void phase_rmsnorm_rows(const float* __restrict__ src, bf16_t* __restrict__ dst) {
  const int tid = otid(); const int lane = tid & 63, w = tid >> 6;
  for (int row = (blockIdx.x * 8 + w) * 2; row < T; row += gridDim.x * 16) {
    float4 v[2][4]; float ss[2] = {0.f, 0.f};
#pragma unroll
    for (int u = 0; u < 2; ++u)
#pragma unroll
      for (int i = 0; i < 4; ++i) v[u][i] = ((const float4*)(src + (size_t)(row + u) * DM))[lane + 64 * i];
#pragma unroll
    for (int u = 0; u < 2; ++u) {
#pragma unroll
      for (int i = 0; i < 4; ++i) ss[u] += v[u][i].x * v[u][i].x + v[u][i].y * v[u][i].y + v[u][i].z * v[u][i].z + v[u][i].w * v[u][i].w;
      ss[u] = wave_sum(ss[u]);
      const float r = rsqrtf(ss[u] * (1.f / 1024.f) + 1e-6f);
#pragma unroll
      for (int i = 0; i < 4; ++i) {
        uint2 o; o.x = pk2(v[u][i].x * r, v[u][i].y * r); o.y = pk2(v[u][i].z * r, v[u][i].w * r);
        *(uint2*)(dst + (size_t)(row + u) * DM + (lane + 64 * i) * 4) = o;
      }
    }
  }
}

enum { EPI_SSM_IN = 0, EPI_OUT1 = 1, EPI_MLA_IN = 2, EPI_KVUP = 3, EPI_QUP = 4, EPI_OUT2 = 5 };


typedef float f32x4 __attribute__((ext_vector_type(4)));
constexpr int EPI_WAVE_BYTES = 8704;
constexpr int TM_ROW = 72;
constexpr int CM_ROW = 40;
constexpr int F32_ROW = 68;

template <bool SILU>
DI void stage_tm(const f32x4 (&a)[4][2], bf16_t* wl, int fr, int fq) {
#pragma unroll
  for (int m = 0; m < 4; ++m)
#pragma unroll
    for (int n = 0; n < 2; ++n) {
      float v0 = a[m][n][0], v1 = a[m][n][1], v2 = a[m][n][2], v3 = a[m][n][3];
      if (SILU) { v0 = silu_f(v0); v1 = silu_f(v1); v2 = silu_f(v2); v3 = silu_f(v3); }
      uint2 o; o.x = pk2(v0, v1); o.y = pk2(v2, v3);
      *(uint2*)(wl + (n * 16 + fr) * TM_ROW + m * 16 + fq * 4) = o;
    }
}
DI void readout_tm(const bf16_t* wl, bf16_t* gdst, size_t ld, int lane) {
#pragma unroll
  for (int it = 0; it < 4; ++it) {
    const int idx = lane + 64 * it; const int row = idx >> 3, ch = idx & 7;
    *(uint4*)(gdst + (size_t)row * ld + ch * 8) = *(const uint4*)(wl + row * TM_ROW + ch * 8);
  }
}
DI void stage_cm(const f32x4 (&a)[4][2], bf16_t* wl, int fr, int fq) {
#pragma unroll
  for (int m = 0; m < 4; ++m)
#pragma unroll
    for (int n = 0; n < 2; ++n)
#pragma unroll
      for (int j = 0; j < 4; ++j) wl[(m * 16 + fq * 4 + j) * CM_ROW + n * 16 + fr] = f2bf(a[m][n][j]);
}
DI void readout_cm(const bf16_t* wl, bf16_t* gdst, int lane) {
#pragma unroll
  for (int it = 0; it < 4; ++it) {
    const int idx = lane + 64 * it; const int row = idx >> 2, ch = idx & 3;
    *(uint4*)(gdst + (size_t)row * SEQ + ch * 8) = *(const uint4*)(wl + row * CM_ROW + ch * 8);
  }
}
constexpr int CMP_ROW = 72;
DI void stage_cm_pair(const f32x4 (&a)[4][2], bf16_t* wlp, int par, int fr, int fq) {
#pragma unroll
  for (int m = 0; m < 4; ++m)
#pragma unroll
    for (int n = 0; n < 2; ++n)
#pragma unroll
      for (int j = 0; j < 4; ++j) wlp[(m * 16 + fq * 4 + j) * CMP_ROW + par * 32 + n * 16 + fr] = f2bf(a[m][n][j]);
}
DI void readout_cm_pair(const bf16_t* wlp, bf16_t* gdst, int par, int lane) {
#pragma unroll
  for (int it = 0; it < 4; ++it) {
    const int idx = lane + 64 * it; const int row = par * 32 + (idx >> 3), ch = idx & 7;
    *(uint4*)(gdst + (size_t)row * SEQ + ch * 8) = *(const uint4*)(wlp + row * CMP_ROW + ch * 8);
  }
}
DI void stage_f32(const f32x4 (&a)[4][2], float* wl, int fr, int fq) {
#pragma unroll
  for (int m = 0; m < 4; ++m)
#pragma unroll
    for (int n = 0; n < 2; ++n) *(f32x4*)(wl + (n * 16 + fr) * F32_ROW + m * 16 + fq * 4) = a[m][n];
}
DI void readout_f32_resid(const float* wl, const float* __restrict__ resid, float* __restrict__ gdst, int lane) {
#pragma unroll 4
  for (int it = 0; it < 8; ++it) {
    const int idx = lane + 64 * it; const int row = idx >> 4, ch = idx & 15;
    const float4 v = *(const float4*)(wl + row * F32_ROW + ch * 4);
    const float4 r = *(const float4*)(resid + (size_t)row * DM + ch * 4);
    *(float4*)(gdst + (size_t)row * DM + ch * 4) = make_float4(v.x + r.x, v.y + r.y, v.z + r.z, v.w + r.w);
  }
}

DI void readout_f32_resid_ssq(const float* wl, const float* __restrict__ resid, float* __restrict__ gdst, bf16_t* __restrict__ hs, float* __restrict__ ssq, int lane) {
#pragma unroll 4
  for (int it = 0; it < 8; ++it) {
    const int idx = lane + 64 * it; const int row = idx >> 4, ch = idx & 15;
    const float4 v = *(const float4*)(wl + row * F32_ROW + ch * 4);
    const float4 r = *(const float4*)(resid + (size_t)row * DM + ch * 4);
    const float4 h = make_float4(v.x + r.x, v.y + r.y, v.z + r.z, v.w + r.w);
    *(float4*)(gdst + (size_t)row * DM + ch * 4) = h;
    uint2 o; o.x = pk2(h.x, h.y); o.y = pk2(h.z, h.w);
    *(uint2*)(hs + (size_t)row * DM + ch * 4) = o;
    float q = h.x * h.x + h.y * h.y + h.z * h.z + h.w * h.w;
    q += swz_xor<1>(q); q += swz_xor<2>(q); q += swz_xor<4>(q); q += swz_xor<8>(q);
    if (ch == 0) atomicAdd(ssq + row, q);
  }
}

DI void wave_lds_sync() { asm volatile("s_waitcnt lgkmcnt(0)" ::: "memory"); }

template <int EPI>
DI void epilogue_block(const Params& p, const f32x4 (&a)[4][2], int c0, int mt, bf16_t* wl, bf16_t* wlp, int par, int lane, int fr, int fq) {
  unsigned char* ws = p.ws;
  const int b = mt >> 13, tok0 = mt & 8191;
  const int tok0p = tok0 - par * 32;
  if (EPI == EPI_SSM_IN) {
    if (c0 < 2048) {
      stage_tm<false>(a, wl, fr, fq); wave_lds_sync();
      readout_tm(wl, (bf16_t*)p.out + (size_t)mt * 2048 + c0, 2048, lane); wave_lds_sync();
    } else if (c0 < 4096) {
      stage_cm_pair(a, wlp, par, fr, fq); __syncthreads();
      readout_cm_pair(wlp, (bf16_t*)(ws + OFF_XT) + ((size_t)(b * 2048 + (c0 - 2048))) * SEQ + tok0p, par, lane); __syncthreads();
    } else if (c0 < 4608) {
      stage_tm<false>(a, wl, fr, fq); wave_lds_sync();
      readout_tm(wl, (bf16_t*)(ws + OFF_BR) + (size_t)mt * 512 + (c0 - 4096), 512, lane); __syncthreads();
      stage_cm_pair(a, wlp, par, fr, fq); __syncthreads();
      readout_cm_pair(wlp, (bf16_t*)(ws + OFF_BT) + ((size_t)(b * 512 + (c0 - 4096))) * SEQ + tok0p, par, lane); __syncthreads();
    } else if (c0 < 5120) {
      stage_tm<false>(a, wl, fr, fq); wave_lds_sync();
      readout_tm(wl, (bf16_t*)(ws + OFF_CR) + (size_t)mt * 512 + (c0 - 4608), 512, lane); wave_lds_sync();
    } else if (c0 == 5120) {
#pragma unroll
      for (int m = 0; m < 2; ++m)
#pragma unroll
        for (int n = 0; n < 2; ++n) {
          const int h = m * 16 + fq * 4;
          float4 o; float* op = (float*)&o;
#pragma unroll
          for (int j = 0; j < 4; ++j) { const float t = a[m][n][j] + p.dt_bias[h + j]; op[j] = (t > 20.f) ? t : log1pf(__expf(t)); }
          *(float4*)((float*)(ws + OFF_DT) + (size_t)(mt + n * 16 + fr) * 32 + h) = o;
        }
    }
  } else if (EPI == EPI_OUT1 || EPI == EPI_OUT2) {
    const float* resid = (EPI == EPI_OUT1) ? p.x : (const float*)(ws + OFF_XT);
    float* dst = (EPI == EPI_OUT1) ? (float*)(ws + OFF_XT) : p.out;
    stage_f32(a, (float*)wl, fr, fq); wave_lds_sync();
    if (EPI == EPI_OUT1) readout_f32_resid_ssq((const float*)wl, resid + (size_t)mt * DM + c0, dst + (size_t)mt * DM + c0, (bf16_t*)(ws + OFF_XN) + (size_t)mt * DM + c0, (float*)(ws + OFF_SSQ) + mt, lane);
    else readout_f32_resid((const float*)wl, resid + (size_t)mt * DM + c0, dst + (size_t)mt * DM + c0, lane);
    wave_lds_sync();
  } else if (EPI == EPI_MLA_IN) {
    const float* SSQ = (const float*)(ws + OFF_SSQ);
    f32x4 a2[4][2];
    float rs[2];
#pragma unroll
    for (int n = 0; n < 2; ++n) rs[n] = rsqrtf(SSQ[mt + n * 16 + fr] * (1.f / 1024.f) + 1e-6f);
#pragma unroll
    for (int m = 0; m < 4; ++m)
#pragma unroll
      for (int n = 0; n < 2; ++n) a2[m][n] = a[m][n] * rs[n];
    if (c0 < 640) {
      float* dstq = (float*)(ws + OFF_SSQ) + (c0 < 256 ? T : 2 * T);
#pragma unroll
      for (int n = 0; n < 2; ++n) {
        float q = 0.f;
#pragma unroll
        for (int m = 0; m < 4; ++m) q += a2[m][n][0] * a2[m][n][0] + a2[m][n][1] * a2[m][n][1] + a2[m][n][2] * a2[m][n][2] + a2[m][n][3] * a2[m][n][3];
        q += swz_xor<16>(q); q += __shfl_xor(q, 32);
        if (fq == 0) atomicAdd(dstq + mt + n * 16 + fr, q);
      }
    }
    const f32x4 (&a)[4][2] = a2;
    if (c0 < 640) stage_tm<false>(a, wl, fr, fq);
    else if (c0 < 1664) stage_tm<true>(a, wl, fr, fq);
    wave_lds_sync();
    if (c0 < 256) readout_tm(wl, (bf16_t*)(ws + OFF_ST + 32 * MiB) + (size_t)mt * 256 + c0, 256, lane);
    else if (c0 < 640) readout_tm(wl, (bf16_t*)(ws + OFF_ST + 40 * MiB) + (size_t)mt * 384 + (c0 - 256), 384, lane);
    else if (c0 < 1664) readout_tm(wl, (bf16_t*)(ws + OFF_ST) + (size_t)mt * 1024 + (c0 - 640), 1024, lane);
    else if (c0 == 1664) {
      const float* COS = (const float*)(ws + OFF_COS); const float* SIN = (const float*)(ws + OFF_SIN);
      bf16_t* KROPE = (bf16_t*)(ws + OFF_DEC);
#pragma unroll
      for (int n = 0; n < 2; ++n) {
        const int t = mt + n * 16 + fr;
        const f32x4 cs = *(const f32x4*)(COS + (size_t)t * 16 + fq * 4), sn = *(const f32x4*)(SIN + (size_t)t * 16 + fq * 4);
        const f32x4 x1 = a[0][n], x2 = a[1][n];
        const f32x4 r1 = x1 * cs - x2 * sn, r2 = x1 * sn + x2 * cs;
        uint2 o1, o2; o1.x = pk2(r1[0], r1[1]); o1.y = pk2(r1[2], r1[3]); o2.x = pk2(r2[0], r2[1]); o2.y = pk2(r2[2], r2[3]);
        *(uint2*)(KROPE + (size_t)t * 32 + fq * 4) = o1; *(uint2*)(KROPE + (size_t)t * 32 + 16 + fq * 4) = o2;
      }
    }
    wave_lds_sync();
  } else if (EPI == EPI_KVUP) {
    const int head = c0 >> 7; const bool isv = (c0 & 64) != 0;
    const float* SSQ = (const float*)(ws + OFF_SSQ) + T;
    f32x4 a2[4][2];
#pragma unroll
    for (int n = 0; n < 2; ++n) {
      const float rsn = rsqrtf(SSQ[mt + n * 16 + fr] * (1.f / 256.f) + 1e-6f);
#pragma unroll
      for (int m = 0; m < 4; ++m) a2[m][n] = a[m][n] * rsn;
    }
    const f32x4 (&a)[4][2] = a2;
    if (!isv) stage_tm<false>(a, wl, fr, fq); else stage_cm_pair(a, wlp, par, fr, fq);
    __syncthreads();
    if (!isv) readout_tm(wl, (bf16_t*)(ws + OFF_XN) + (size_t)mt * 1024 + head * 64, 1024, lane);
    else readout_cm_pair(wlp, (bf16_t*)(ws + OFF_BT) + ((size_t)((b * 16 + head) * 64)) * SEQ + tok0p, par, lane);
    __syncthreads();
  } else if (EPI == EPI_QUP) {
    const float SC = 0.10206207261596575f * 1.4426950408889634f;
    const float* SSQ = (const float*)(ws + OFF_SSQ) + 2 * T;
    f32x4 v[4][2];
#pragma unroll
    for (int n = 0; n < 2; ++n) {
      const float rsn = rsqrtf(SSQ[mt + n * 16 + fr] * (1.f / 384.f) + 1e-6f) * SC;
#pragma unroll
      for (int m = 0; m < 4; ++m) v[m][n] = a[m][n] * rsn;
    }
    const int ph = c0 % 96;
    if (ph != 0) {
      const float* COS = (const float*)(ws + OFF_COS); const float* SIN = (const float*)(ws + OFF_SIN);
#pragma unroll
      for (int n = 0; n < 2; ++n) {
        const int t = mt + n * 16 + fr;
        const f32x4 cs = *(const f32x4*)(COS + (size_t)t * 16 + fq * 4), sn = *(const f32x4*)(SIN + (size_t)t * 16 + fq * 4);
        if (ph == 64) { const f32x4 x1 = v[0][n], x2 = v[1][n]; v[0][n] = x1 * cs - x2 * sn; v[1][n] = x1 * sn + x2 * cs; }
        else          { const f32x4 x1 = v[2][n], x2 = v[3][n]; v[2][n] = x1 * cs - x2 * sn; v[3][n] = x1 * sn + x2 * cs; }
      }
    }
    stage_tm<false>(v, wl, fr, fq); wave_lds_sync();
    readout_tm(wl, (bf16_t*)p.out + (size_t)mt * 1536 + c0, 1536, lane);
    wave_lds_sync();
  }
}

constexpr int G8_BK = 64, G8_HALF = 128, G8_HT = G8_HALF * G8_BK;
constexpr int LDS_BYTES = 143360;
DI int g8_lds_byte(int r, int c) { const int st = (r >> 4) * 2 + (c >> 5), rr = r & 15, cc = c & 31, ob = rr * 64 + cc * 2; return st * 1024 + (ob ^ (((ob >> 9) & 1) << 5)); }
DI void g8_stage_rc(int b, int& R, int& C) { const int st = b / 1024, sb = b % 1024, swz = sb ^ (((sb >> 9) & 1) << 5); R = (st >> 1) * 16 + swz / 64; C = (st & 1) * 32 + (swz % 64) / 2; }

template <int EPI, int K>
DI void gemm_tile(const Params& p, const bf16_t* __restrict__ A, const bf16_t* __restrict__ Bt, int brow, int bcol, unsigned char* smem) {
  bf16_t* shm = (bf16_t*)smem;
#define SA(b, h) (shm + ((b) * 2 + (h)) * G8_HT)
#define SB(b, h) (shm + (4 + (b) * 2 + (h)) * G8_HT)
#define STAGE(P, BASE, br, kt) do { const long _g = (long)(br) * K + (long)(kt) * G8_BK; \
    _Pragma("unroll") for (int _i = 0; _i < 2; ++_i) { const int _b = tid * 16 + _i * 8192; int _r, _c; g8_stage_rc(_b, _r, _c); \
      __builtin_amdgcn_global_load_lds((const unsigned*)(BASE + _g + (long)_r * K + _c), (unsigned*)((char*)(P) + _b), 16, 0, 0); } } while (0)
#define LDA(dst, b, h) _Pragma("unroll") for (int m = 0; m < 4; ++m) _Pragma("unroll") for (int k = 0; k < 2; ++k) \
    dst[m][k] = *reinterpret_cast<const bf16x8*>((const char*)SA(b, h) + g8_lds_byte(wr * 64 + m * 16 + fr, k * 32 + fq * 8))
#define LDB(dst, b, h) _Pragma("unroll") for (int n = 0; n < 2; ++n) _Pragma("unroll") for (int k = 0; k < 2; ++k) \
    dst[n][k] = *reinterpret_cast<const bf16x8*>((const char*)SB(b, h) + g8_lds_byte(wc * 32 + n * 16 + fr, k * 32 + fq * 8))
#define MMA(ai, bj, At_, Bt_) do { __builtin_amdgcn_s_setprio(1); \
    _Pragma("unroll") for (int m = 0; m < 4; ++m) _Pragma("unroll") for (int n = 0; n < 2; ++n) _Pragma("unroll") for (int k = 0; k < 2; ++k) \
      acc[ai][bj][m][n] = __builtin_amdgcn_mfma_f32_16x16x32_bf16(At_[m][k], Bt_[n][k], acc[ai][bj][m][n], 0, 0, 0); \
    __builtin_amdgcn_s_setprio(0); } while (0)
#define WAIT_V(n) asm volatile("s_waitcnt vmcnt(" #n ")" ::: "memory")
#define WAIT_L(n) asm volatile("s_waitcnt lgkmcnt(" #n ")" ::: "memory")
#define BAR __builtin_amdgcn_s_barrier()
#define SCHED __builtin_amdgcn_sched_barrier(0)
  const int tid = otid();
  const int wid = tid >> 6, lane = tid & 63, wr = wid >> 2, wc = wid & 3, fr = lane & 15, fq = lane >> 4;
  f32x4 acc[2][2][4][2];
#pragma unroll
  for (int a_ = 0; a_ < 2; ++a_)
#pragma unroll
    for (int b_ = 0; b_ < 2; ++b_)
#pragma unroll
      for (int m = 0; m < 4; ++m)
#pragma unroll
        for (int n = 0; n < 2; ++n) acc[a_][b_][m][n] = (f32x4){0.f, 0.f, 0.f, 0.f};
  bf16x8 At[4][2], B0[2][2], B1[2][2];
  constexpr int nt = K / G8_BK;
  STAGE(SB(0, 0), Bt, bcol, 0); STAGE(SA(0, 0), A, brow, 0);
  STAGE(SB(0, 1), Bt, bcol + G8_HALF, 0); STAGE(SA(0, 1), A, brow + G8_HALF, 0);
  if (wr == 1) BAR;
  WAIT_V(4); BAR;
  STAGE(SB(1, 0), Bt, bcol, 1); STAGE(SA(1, 0), A, brow, 1); STAGE(SB(1, 1), Bt, bcol + G8_HALF, 1);
  WAIT_V(6); BAR;
  for (int t = 0; t < nt - 2; t += 2) {
    LDB(B0, 0, 0); SCHED; LDA(At, 0, 0); STAGE(SA(1, 1), A, brow + G8_HALF, t + 1);
    WAIT_L(8); BAR; WAIT_L(0); MMA(0, 0, At, B0); BAR; SCHED;
    LDB(B1, 0, 1); STAGE(SB(0, 0), Bt, bcol, t + 2);
    BAR; WAIT_L(0); MMA(0, 1, At, B1); BAR;
    LDA(At, 0, 1); STAGE(SA(0, 0), A, brow, t + 2);
    BAR; WAIT_L(0); MMA(1, 0, At, B0); BAR; SCHED;
    STAGE(SB(0, 1), Bt, bcol + G8_HALF, t + 2);
    WAIT_V(6); BAR; MMA(1, 1, At, B1); BAR;
    LDB(B0, 1, 0); SCHED; LDA(At, 1, 0); STAGE(SA(0, 1), A, brow + G8_HALF, t + 2);
    WAIT_L(8); BAR; WAIT_L(0); MMA(0, 0, At, B0); BAR; SCHED;
    LDB(B1, 1, 1); STAGE(SB(1, 0), Bt, bcol, t + 3);
    BAR; WAIT_L(0); MMA(0, 1, At, B1); BAR;
    LDA(At, 1, 1); STAGE(SA(1, 0), A, brow, t + 3);
    BAR; WAIT_L(0); MMA(1, 0, At, B0); BAR; SCHED;
    STAGE(SB(1, 1), Bt, bcol + G8_HALF, t + 3);
    WAIT_V(6); BAR; MMA(1, 1, At, B1); BAR;
  }
  { LDB(B0, 0, 0); LDA(At, 0, 0); STAGE(SA(1, 1), A, brow + G8_HALF, nt - 1);
    BAR; WAIT_L(0); MMA(0, 0, At, B0); BAR;
    LDB(B1, 0, 1); BAR; WAIT_L(0); MMA(0, 1, At, B1); BAR;
    LDA(At, 0, 1); WAIT_V(4); BAR; WAIT_L(0); MMA(1, 0, At, B0); MMA(1, 1, At, B1); BAR; }
  { LDB(B0, 1, 0); LDA(At, 1, 0); WAIT_V(2); BAR; WAIT_L(0); MMA(0, 0, At, B0); BAR;
    LDB(B1, 1, 1); WAIT_V(0); BAR; WAIT_L(0); MMA(0, 1, At, B1); BAR;
    LDA(At, 1, 1); BAR; WAIT_L(0); MMA(1, 0, At, B0); MMA(1, 1, At, B1); BAR; }
  if (wr == 0) BAR;
  __syncthreads();
  int t2 = tid; asm volatile("" : "+v"(t2));
  const int wid2 = t2 >> 6, lane2 = t2 & 63, wr2 = wid2 >> 2, wc2 = wid2 & 3, fr2 = lane2 & 15, fq2 = lane2 >> 4;
  bf16_t* wl = (bf16_t*)(smem + wid2 * EPI_WAVE_BYTES);
  bf16_t* wlp = (bf16_t*)(smem + (wid2 & ~1) * EPI_WAVE_BYTES);
#pragma unroll
  for (int ai = 0; ai < 2; ++ai)
#pragma unroll
    for (int bj = 0; bj < 2; ++bj)
      epilogue_block<EPI>(p, acc[ai][bj], brow + ai * 128 + wr2 * 64, bcol + bj * 128 + wc2 * 32, wl, wlp, wc2 & 1, lane2, fr2, fq2);
  __syncthreads();
#undef SA
#undef SB
#undef STAGE
#undef LDA
#undef LDB
#undef MMA
#undef WAIT_V
#undef WAIT_L
#undef BAR
#undef SCHED
}

template <int EPI, int K>
DI void gemm_phase(const Params& p, const bf16_t* Wt, const bf16_t* X, int ntn, unsigned char* smem) {
  const bool xa = (gridDim.x == 256);
  const int xcd = blockIdx.x & 7, li = blockIdx.x >> 3;
  const int per_half = 4 * ntn;
  const int start = xa ? li : (int)blockIdx.x, step = xa ? 32 : (int)gridDim.x, total = ntn * (xa ? 8 : 64);
  for (int t = start; t < total; t += step) {
    int tm, tn;
    if (xa) { const int h = t / per_half, tp = t - h * per_half; tn = tp >> 2; tm = xcd * 8 + h * 4 + (tp & 3); }
    else { tm = t / ntn; tn = t % ntn; }
    gemm_tile<EPI, K>(p, Wt, X, tn * 256, tm * 256, smem);
  }
}

DI void conv8_load(const bf16_t* rp, bool has_prev, uint4& cur, uint2& prv) {
  cur = *(const uint4*)rp; prv = make_uint2(0u, 0u);
  if (has_prev) prv = *(const uint2*)(rp - 4);
}
DI float fast_silu(float v) { return v * __builtin_amdgcn_rcpf(1.f + __expf(-v)); }
DI void conv8_compute(const uint4 cur, const uint2 prv, float w0, float w1, float w2, float w3, float bias, float (&out)[8]) {
  float r[11];
  r[0] = hi16(prv.x); r[1] = lo16(prv.y); r[2] = hi16(prv.y);
  r[3] = lo16(cur.x); r[4] = hi16(cur.x); r[5] = lo16(cur.y); r[6] = hi16(cur.y); r[7] = lo16(cur.z); r[8] = hi16(cur.z); r[9] = lo16(cur.w); r[10] = hi16(cur.w);
#pragma unroll
  for (int j = 0; j < 8; ++j) out[j] = fast_silu(bias + w0 * r[j] + w1 * r[j + 1] + w2 * r[j + 2] + w3 * r[j + 3]);
}
DI void conv8(const bf16_t* rp, bool has_prev, float w0, float w1, float w2, float w3, float bias, float (&out)[8]) {
  uint4 cur; uint2 prv; conv8_load(rp, has_prev, cur, prv); conv8_compute(cur, prv, w0, w1, w2, w3, bias, out);
}
DI bf16x8 pack8(const float (&v)[8]) {
  uint4 u; u.x = pk2(v[0], v[1]); u.y = pk2(v[2], v[3]); u.z = pk2(v[4], v[5]); u.w = pk2(v[6], v[7]);
  return __builtin_bit_cast(bf16x8, u);
}
DI void chunk_cumsum(const float* __restrict__ DTp, size_t tk0, int hd, float A, int lane, float (&d4)[4], float (&c4)[4], float& last) {
#pragma unroll
  for (int i = 0; i < 4; ++i) d4[i] = DTp[(tk0 + 4 * lane + i) * 32 + hd];
  c4[0] = d4[0] * A; c4[1] = c4[0] + d4[1] * A; c4[2] = c4[1] + d4[2] * A; c4[3] = c4[2] + d4[3] * A;
  const float tot = c4[3];
  float sum = tot, ex = 0.f, t;
  t = swz_xor<1>(sum);  if (lane & 1) ex += t;  sum += t;
  t = swz_xor<2>(sum);  if (lane & 2) ex += t;  sum += t;
  t = swz_xor<4>(sum);  if (lane & 4) ex += t;  sum += t;
  t = swz_xor<8>(sum);  if (lane & 8) ex += t;  sum += t;
  t = swz_xor<16>(sum); if (lane & 16) ex += t; sum += t;
  t = __shfl_xor(sum, 32); if (lane & 32) ex += t; sum += t;
#pragma unroll
  for (int i = 0; i < 4; ++i) c4[i] += ex;
  last = sum;
}

constexpr int BT_ROW = 264;
constexpr int CN_ROW = 136;

DI void phase_ssd_state(const Params& p, unsigned char* smem) {
  const bf16_t* XT = (const bf16_t*)(p.ws + OFF_XT); const bf16_t* BT = (const bf16_t*)(p.ws + OFF_BT); const float* DTp = (const float*)(p.ws + OFF_DT);
  float* ST = (float*)(p.ws + OFF_ST); float* DEC = (float*)(p.ws + OFF_DEC);
  bf16_t* BTs = (bf16_t*)smem; float* wgt = (float*)(smem + 128 * BT_ROW * 2);
  const int tid = otid(), lane = tid & 63, w = tid >> 6, l31 = lane & 31, lh = lane >> 5;
  for (int u = blockIdx.x; u < 256; u += gridDim.x) {
    const int b = u >> 7, c = (u >> 2) & 31, g = u & 3; const int hd = 8 * g + w;
    bf16_t* XTC = (bf16_t*)(p.ws + (b ? OFF_ST + 32 * MiB : OFF_XN));
    {
      float d4[4], c4[4], last; chunk_cumsum(DTp, (size_t)b * SEQ + c * 256, hd, -__expf(p.A_log[hd]), lane, d4, c4, last);
      float4 o = {__expf(last - c4[0]) * d4[0], __expf(last - c4[1]) * d4[1], __expf(last - c4[2]) * d4[2], __expf(last - c4[3]) * d4[3]};
      *(float4*)(wgt + w * 256 + 4 * lane) = o;
      if (lane == 0) DEC[(b * 32 + c) * 32 + hd] = __expf(last);
    }
#pragma unroll 2
    for (int i = 0; i < 8; ++i) {
      const int chunk = tid + 512 * i; const int s8 = (chunk & 31) * 8, n = chunk >> 5; const int ch = 2048 + g * 128 + n;
      float v[8];
      conv8(BT + ((size_t)(b * 512 + g * 128 + n)) * SEQ + c * 256 + s8, !(c == 0 && s8 == 0),
            p.conv_w[ch], p.conv_w[3072 + ch], p.conv_w[2 * 3072 + ch], p.conv_w[3 * 3072 + ch], p.conv_b[ch], v);
      *(bf16x8*)(BTs + n * BT_ROW + s8) = pack8(v);
    }
    __syncthreads();
    f32x16 acc[2][4];
#pragma unroll
    for (int a = 0; a < 2; ++a)
#pragma unroll
      for (int q = 0; q < 4; ++q)
#pragma unroll
        for (int i = 0; i < 16; ++i) acc[a][q][i] = 0.f;
    float xw[2][4], xb[2];
#pragma unroll
    for (int pt = 0; pt < 2; ++pt) {
      const int ch = hd * 64 + pt * 32 + l31;
#pragma unroll
      for (int k = 0; k < 4; ++k) xw[pt][k] = p.conv_w[k * 3072 + ch];
      xb[pt] = p.conv_b[ch];
    }
    for (int kb = 0; kb < 16; kb += 2) {
      uint4 rc[2][2]; uint2 rp[2][2];
#pragma unroll
      for (int i = 0; i < 2; ++i)
#pragma unroll
        for (int pt = 0; pt < 2; ++pt) {
          const int s0 = (kb + i) * 16 + 8 * lh;
          conv8_load(XT + ((size_t)(b * 2048 + hd * 64 + pt * 32 + l31)) * SEQ + c * 256 + s0, !(c == 0 && s0 == 0), rc[i][pt], rp[i][pt]);
        }
#pragma unroll
      for (int i = 0; i < 2; ++i) {
        const int ks = kb + i; const int s0 = ks * 16 + 8 * lh;
        const float4 g0 = *(const float4*)(wgt + w * 256 + s0), g1 = *(const float4*)(wgt + w * 256 + s0 + 4);
        const float wg[8] = {g0.x, g0.y, g0.z, g0.w, g1.x, g1.y, g1.z, g1.w};
        bf16x8 afr[2];
#pragma unroll
        for (int pt = 0; pt < 2; ++pt) {
          float v[8];
          conv8_compute(rc[i][pt], rp[i][pt], xw[pt][0], xw[pt][1], xw[pt][2], xw[pt][3], xb[pt], v);
          *(bf16x8*)(XTC + ((size_t)(hd * 64 + pt * 32 + l31)) * SEQ + c * 256 + s0) = pack8(v);
#pragma unroll
          for (int j = 0; j < 8; ++j) v[j] *= wg[j];
          afr[pt] = pack8(v);
        }
#pragma unroll
        for (int nt = 0; nt < 4; ++nt) {
          const bf16x8 bfr = *(const bf16x8*)(BTs + (nt * 32 + l31) * BT_ROW + ks * 16 + 8 * lh);
#pragma unroll
          for (int pt = 0; pt < 2; ++pt) acc[pt][nt] = MFMA32(afr[pt], bfr, acc[pt][nt]);
        }
      }
    }
    bf16_t* Sp = (bf16_t*)ST + (((size_t)(b * 32 + c) * 32 + hd) * 64) * 128;
#pragma unroll
    for (int pt = 0; pt < 2; ++pt)
#pragma unroll
      for (int nt = 0; nt < 4; ++nt)
#pragma unroll
        for (int r = 0; r < 16; ++r) Sp[(pt * 32 + (r & 3) + 8 * (r >> 2) + 4 * lh) * 128 + nt * 32 + l31] = f2bf(acc[pt][nt][r]);
    __syncthreads();
  }
}

DI void phase_ssd_scan(const Params& p) {
  bf16_t* ST = (bf16_t*)(p.ws + OFF_ST); const float* DEC = (const float*)(p.ws + OFF_DEC);
  for (int idx = blockIdx.x * NTHREADS + otid(); idx < 131072; idx += gridDim.x * NTHREADS) {
    const int n4 = idx & 31, pp = (idx >> 5) & 63, h = (idx >> 11) & 31, b = idx >> 16;
    float run[4] = {0.f, 0.f, 0.f, 0.f};
    bf16_t* base = ST + (((size_t)(b * 32) * 32 + h) * 64 + pp) * 128 + n4 * 4;
    const float* dbase = DEC + (b * 32) * 32 + h;
    for (int c0 = 0; c0 < 32; c0 += 16) {
      uint2 loc[16]; float d[16];
#pragma unroll
      for (int i = 0; i < 16; ++i) { loc[i] = *(const uint2*)(base + (size_t)(c0 + i) * (32 * 64 * 128)); d[i] = dbase[(c0 + i) * 32]; }
#pragma unroll
      for (int i = 0; i < 16; ++i) {
        uint2 o; o.x = pk2(run[0], run[1]); o.y = pk2(run[2], run[3]);
        *(uint2*)(base + (size_t)(c0 + i) * (32 * 64 * 128)) = o;
        run[0] = run[0] * d[i] + lo16(loc[i].x); run[1] = run[1] * d[i] + hi16(loc[i].x);
        run[2] = run[2] * d[i] + lo16(loc[i].y); run[3] = run[3] * d[i] + hi16(loc[i].y);
      }
    }
  }
}

DI void stage_tokmajor(const Params& p, const bf16_t* __restrict__ RAW, int b, int tok0, int nrows, int g, int cbase, bf16_t* dst, int tid_) {
  const int tid = otid(); (void)tid_;
  const int n8 = (tid & 15) * 8; const int ch = cbase + g * 128 + n8;
  float cw[4][8], cb[8];
#pragma unroll
  for (int k = 0; k < 4; ++k) {
    const float4 a = *(const float4*)(p.conv_w + k * 3072 + ch), bq = *(const float4*)(p.conv_w + k * 3072 + ch + 4);
    cw[k][0] = a.x; cw[k][1] = a.y; cw[k][2] = a.z; cw[k][3] = a.w; cw[k][4] = bq.x; cw[k][5] = bq.y; cw[k][6] = bq.z; cw[k][7] = bq.w;
  }
  { const float4 a = *(const float4*)(p.conv_b + ch), bq = *(const float4*)(p.conv_b + ch + 4);
    cb[0] = a.x; cb[1] = a.y; cb[2] = a.z; cb[3] = a.w; cb[4] = bq.x; cb[5] = bq.y; cb[6] = bq.z; cb[7] = bq.w; }
  for (int t = tid >> 4; t < nrows; t += 64) {
    uint4 r[2][4];
#pragma unroll
    for (int u = 0; u < 2; ++u)
#pragma unroll
      for (int k = 0; k < 4; ++k) {
        const int tk = tok0 + t + 32 * u - 3 + k;
        r[u][k] = make_uint4(0u, 0u, 0u, 0u);
        if (tk >= 0) r[u][k] = *(const uint4*)(RAW + ((size_t)b * SEQ + tk) * 512 + g * 128 + n8);
      }
#pragma unroll
    for (int u = 0; u < 2; ++u) {
      float acc[8];
#pragma unroll
      for (int j = 0; j < 8; ++j) acc[j] = cb[j];
#pragma unroll
      for (int k = 0; k < 4; ++k) {
        const uint4 q = r[u][k];
        acc[0] += cw[k][0] * lo16(q.x); acc[1] += cw[k][1] * hi16(q.x); acc[2] += cw[k][2] * lo16(q.y); acc[3] += cw[k][3] * hi16(q.y);
        acc[4] += cw[k][4] * lo16(q.z); acc[5] += cw[k][5] * hi16(q.z); acc[6] += cw[k][6] * lo16(q.w); acc[7] += cw[k][7] * hi16(q.w);
      }
#pragma unroll
      for (int j = 0; j < 8; ++j) acc[j] = fast_silu(acc[j]);
      *(bf16x8*)(dst + (t + 32 * u) * CN_ROW + n8) = pack8(acc);
    }
  }
}

constexpr int S3_CS = 0, S3_BS = 64 * CN_ROW * 2, S3_CB = S3_BS + 256 * CN_ROW * 2, S3_CUM = S3_CB + 64 * BT_ROW * 2, S3_DTS = S3_CUM + 8192,
              S3_PART = S3_DTS + 8192, S3_RSTD = S3_PART + 2048, S3_END = S3_RSTD + 256;

DI void phase_ssd_out(const Params& p, unsigned char* smem) {
  const bf16_t* XT = (const bf16_t*)(p.ws + OFF_XT); const bf16_t* BR = (const bf16_t*)(p.ws + OFF_BR); const bf16_t* CR = (const bf16_t*)(p.ws + OFF_CR);
  const float* DTp = (const float*)(p.ws + OFF_DT); const float* ST = (const float*)(p.ws + OFF_ST); bf16_t* Z = (bf16_t*)p.out;
  bf16_t* Cs = (bf16_t*)(smem + S3_CS); bf16_t* Bs = (bf16_t*)(smem + S3_BS); bf16_t* CBs = (bf16_t*)(smem + S3_CB);
  float* cumA = (float*)(smem + S3_CUM); float* dts = (float*)(smem + S3_DTS); float* part = (float*)(smem + S3_PART); float* rstd = (float*)(smem + S3_RSTD);
  const int tid = otid(), lane = tid & 63, w = tid >> 6, l31 = lane & 31, lh = lane >> 5;
  const bool persist = (gridDim.x == 256);
  for (int u = blockIdx.x; u < 1024; u += gridDim.x) {
    const int tq = u >> 8, rest = u & 255; const int b = rest >> 7, c = (rest >> 2) & 31, g = rest & 3; const int hd = 8 * g + w;
    const int ns = (tq + 1) * 64;
    if (!persist || tq == 0) {
      float d4[4], c4[4], last; chunk_cumsum(DTp, (size_t)b * SEQ + c * 256, hd, -__expf(p.A_log[hd]), lane, d4, c4, last);
      *(float4*)(cumA + w * 256 + 4 * lane) = make_float4(c4[0], c4[1], c4[2], c4[3]);
      *(float4*)(dts + w * 256 + 4 * lane) = make_float4(d4[0], d4[1], d4[2], d4[3]);
    }
    stage_tokmajor(p, CR, b, c * 256 + tq * 64, 64, g, 2560, Cs, tid);
    { const int r0 = persist ? tq * 64 : 0; stage_tokmajor(p, BR, b, c * 256 + r0, ns - r0, g, 2048, Bs + r0 * CN_ROW, tid); }
    __syncthreads();
    if (32 * w < ns) {
      f32x16 a2[2];
#pragma unroll
      for (int a = 0; a < 2; ++a)
#pragma unroll
        for (int i = 0; i < 16; ++i) a2[a][i] = 0.f;
#pragma unroll
      for (int ks = 0; ks < 8; ++ks) {
        const bf16x8 af = *(const bf16x8*)(Bs + (32 * w + l31) * CN_ROW + ks * 16 + 8 * lh);
#pragma unroll
        for (int tt = 0; tt < 2; ++tt) {
          const bf16x8 bq = *(const bf16x8*)(Cs + (tt * 32 + l31) * CN_ROW + ks * 16 + 8 * lh);
          a2[tt] = MFMA32(af, bq, a2[tt]);
        }
      }
#pragma unroll
      for (int tt = 0; tt < 2; ++tt)
#pragma unroll
        for (int rg = 0; rg < 4; ++rg) {
          uint2 o; o.x = pk2(a2[tt][4 * rg], a2[tt][4 * rg + 1]); o.y = pk2(a2[tt][4 * rg + 2], a2[tt][4 * rg + 3]);
          *(uint2*)(CBs + (tt * 32 + l31) * BT_ROW + 32 * w + 8 * rg + 4 * lh) = o;
        }
    }
    __syncthreads();
    f32x16 acc[2][2];
#pragma unroll
    for (int a = 0; a < 2; ++a)
#pragma unroll
      for (int q = 0; q < 2; ++q)
#pragma unroll
        for (int i = 0; i < 16; ++i) acc[a][q][i] = 0.f;
    {
      const bf16_t* Sp = (const bf16_t*)ST + (((size_t)(b * 32 + c) * 32 + hd) * 64) * 128;
      for (int kb = 0; kb < 8; kb += 4) {
        bf16x8 bfr[4][2];
#pragma unroll
        for (int i = 0; i < 4; ++i)
#pragma unroll
          for (int pt = 0; pt < 2; ++pt) bfr[i][pt] = *(const bf16x8*)(Sp + (pt * 32 + l31) * 128 + (kb + i) * 16 + 8 * lh);
#pragma unroll
        for (int i = 0; i < 4; ++i) {
          const int ks = kb + i;
#pragma unroll
          for (int tt = 0; tt < 2; ++tt) {
            const bf16x8 af = *(const bf16x8*)(Cs + (tt * 32 + l31) * CN_ROW + ks * 16 + 8 * lh);
#pragma unroll
            for (int pt = 0; pt < 2; ++pt) acc[tt][pt] = MFMA32(af, bfr[i][pt], acc[tt][pt]);
          }
        }
      }
#pragma unroll
      for (int tt = 0; tt < 2; ++tt)
#pragma unroll
        for (int r = 0; r < 16; ++r) {
          const float e = __expf(cumA[w * 256 + tq * 64 + tt * 32 + (r & 3) + 8 * (r >> 2) + 4 * lh]);
          acc[tt][0][r] *= e; acc[tt][1][r] *= e;
        }
    }
    {
      const float Dh = p.Dskip[hd];
      const int tl0 = tq * 64 + l31, tl1 = tq * 64 + 32 + l31;
      const float ct0 = cumA[w * 256 + tl0], ct1 = cumA[w * 256 + tl1];
      const bf16_t* XTC = (const bf16_t*)(p.ws + (b ? OFF_ST + 32 * MiB : OFF_XN)) + ((size_t)(hd * 64 + l31)) * SEQ + c * 256 + 8 * lh;
      const int nks = ns >> 4;
      for (int kb = 0; kb < nks; kb += 4) {
        bf16x8 xq[4][2];
#pragma unroll
        for (int i = 0; i < 4; ++i)
#pragma unroll
          for (int pt = 0; pt < 2; ++pt) xq[i][pt] = *(const bf16x8*)(XTC + (size_t)pt * 32 * SEQ + (kb + i) * 16);
#pragma unroll
        for (int i = 0; i < 4; ++i) {
          const int ks = kb + i; const int s0 = ks * 16 + 8 * lh;
          const float4 c0 = *(const float4*)(cumA + w * 256 + s0), c1 = *(const float4*)(cumA + w * 256 + s0 + 4);
          const float4 d0 = *(const float4*)(dts + w * 256 + s0), d1 = *(const float4*)(dts + w * 256 + s0 + 4);
          const float cs[8] = {c0.x, c0.y, c0.z, c0.w, c1.x, c1.y, c1.z, c1.w};
          const float ds[8] = {d0.x, d0.y, d0.z, d0.w, d1.x, d1.y, d1.z, d1.w};
          const float cref = cumA[w * 256 + ks * 16];
          const bool steep = (cref - cumA[w * 256 + ks * 16 + 15]) > 60.f;
          float Fs[8];
#pragma unroll
          for (int j = 0; j < 8; ++j) Fs[j] = __expf(fminf(cref - cs[j], 64.f)) * ds[j];
#pragma unroll
          for (int tt = 0; tt < 2; ++tt) {
            if (ks * 16 <= tq * 64 + tt * 32 + 31) {
              const int tl = tt ? tl1 : tl0; const float ct = tt ? ct1 : ct0;
              const float Et = __expf(fminf(ct - cref, 0.f));
              const uint4 cbv = *(const uint4*)(CBs + (tt * 32 + l31) * BT_ROW + s0);
              const float cb[8] = {lo16(cbv.x), hi16(cbv.x), lo16(cbv.y), hi16(cbv.y), lo16(cbv.z), hi16(cbv.z), lo16(cbv.w), hi16(cbv.w)};
              float mv[8];
              if (steep) {
#pragma unroll
                for (int j = 0; j < 8; ++j) {
                  const int sidx = s0 + j;
                  float v = cb[j] * __expf(fminf(ct - cs[j], 0.f)) * ds[j];
                  v = (sidx <= tl) ? v : 0.f;
                  if (sidx == tl) v += Dh;
                  mv[j] = v;
                }
              } else if (ks * 16 + 15 > tq * 64 + tt * 32) {
#pragma unroll
                for (int j = 0; j < 8; ++j) {
                  const int sidx = s0 + j;
                  float v = cb[j] * (Et * Fs[j]);
                  v = (sidx <= tl) ? v : 0.f;
                  if (sidx == tl) v += Dh;
                  mv[j] = v;
                }
              } else {
#pragma unroll
                for (int j = 0; j < 8; ++j) mv[j] = cb[j] * (Et * Fs[j]);
              }
              const bf16x8 af = pack8(mv);
#pragma unroll
              for (int pt = 0; pt < 2; ++pt) acc[tt][pt] = MFMA32(af, xq[i][pt], acc[tt][pt]);
            }
          }
        }
      }
    }
    const size_t tokb = (size_t)b * SEQ + c * 256 + tq * 64;
#pragma unroll
    for (int tt = 0; tt < 2; ++tt)
#pragma unroll
      for (int r = 0; r < 16; ++r) {
        const int tloc = tt * 32 + (r & 3) + 8 * (r >> 2) + 4 * lh;
        const bf16_t* zp = Z + (tokb + tloc) * 2048 + hd * 64 + l31;
        const float y0 = acc[tt][0][r] * silu_f(bf2f(zp[0])), y1 = acc[tt][1][r] * silu_f(bf2f(zp[32]));
        acc[tt][0][r] = y0; acc[tt][1][r] = y1;
        float v = y0 * y0 + y1 * y1;
        v += swz_xor<1>(v); v += swz_xor<2>(v); v += swz_xor<4>(v); v += swz_xor<8>(v); v += swz_xor<16>(v);
        if (l31 == 0) part[w * 64 + tloc] = v;
      }
    __syncthreads();
    if (tid < 64) {
      float sres = 0.f;
#pragma unroll
      for (int ww = 0; ww < 8; ++ww) sres += part[ww * 64 + tid];
      rstd[tid] = rsqrtf(sres * (1.f / 512.f) + 1e-6f);
    }
    __syncthreads();
#pragma unroll
    for (int tt = 0; tt < 2; ++tt)
#pragma unroll
      for (int r = 0; r < 16; ++r) {
        const int tloc = tt * 32 + (r & 3) + 8 * (r >> 2) + 4 * lh;
        const float rs = rstd[tloc];
        bf16_t* zp = Z + (tokb + tloc) * 2048 + hd * 64 + l31;
        zp[0] = f2bf(acc[tt][0][r] * rs); zp[32] = f2bf(acc[tt][1][r] * rs);
      }
    __syncthreads();
  }
}

constexpr int KROW = 104;
constexpr int VROW = 68;
constexpr int ATT_K_BYTES = 64 * KROW * 2;
constexpr int ATT_V_BYTES = 64 * VROW * 2;
constexpr int ATT_STAGE = ATT_K_BYTES + ATT_V_BYTES;

DI void attn_kload(const bf16_t* sK, bf16x8 (&kf)[2][6], int l31, int lh) {
#pragma unroll
  for (int sub = 0; sub < 2; ++sub)
#pragma unroll
    for (int ks = 0; ks < 6; ++ks) kf[sub][ks] = *(const bf16x8*)(sK + (sub * 32 + l31) * KROW + ks * 16 + lh * 8);
}
DI void attn_qkmma(const bf16x8 (&kf)[2][6], const bf16x8 (&qf)[6], f32x16 (&sc)[2]) {
#pragma unroll
  for (int sub = 0; sub < 2; ++sub)
#pragma unroll
    for (int i = 0; i < 16; ++i) sc[sub][i] = 0.f;
#pragma unroll
  for (int ks = 0; ks < 6; ++ks)
#pragma unroll
    for (int sub = 0; sub < 2; ++sub) sc[sub] = MFMA32(kf[sub][ks], qf[ks], sc[sub]);
}
DI void attn_qk(const bf16_t* sK, const bf16x8 (&qf)[6], f32x16 (&sc)[2], int l31, int lh) {
  bf16x8 kf[2][6]; attn_kload(sK, kf, l31, lh); attn_qkmma(kf, qf, sc);
}

template <bool MASK>
DI void attn_softmax(f32x16 (&sc)[2], f32x16 (&o)[2], float& m, float& l, int kt, int myq, int lh) {
  float tmax = -1e30f;
#pragma unroll
  for (int sub = 0; sub < 2; ++sub)
#pragma unroll
    for (int r = 0; r < 16; ++r) {
      if (MASK) { const int key = kt * 64 + sub * 32 + (r & 3) + 8 * (r >> 2) + 4 * lh; if (key > myq) sc[sub][r] = -1e30f; }
      tmax = fmaxf(tmax, sc[sub][r]);
    }
  tmax = fmaxf(tmax, __shfl_xor(tmax, 32));
  if (__builtin_amdgcn_ballot_w64(tmax - m > 8.f) != 0) {
    const float mn = fmaxf(m, tmax); const float al = __builtin_amdgcn_exp2f(m - mn); m = mn;
    l *= al;
#pragma unroll
    for (int a = 0; a < 2; ++a)
#pragma unroll
      for (int i = 0; i < 16; ++i) o[a][i] *= al;
  }
  f32x2 ps2 = {0.f, 0.f}; const f32x2 mn2 = {m, m};
#pragma unroll
  for (int sub = 0; sub < 2; ++sub)
#pragma unroll
    for (int r = 0; r < 16; r += 2) {
      f32x2 d = {sc[sub][r], sc[sub][r + 1]}; d = d - mn2;
      f32x2 pe; pe.x = __builtin_amdgcn_exp2f(d.x); pe.y = __builtin_amdgcn_exp2f(d.y);
      sc[sub][r] = pe.x; sc[sub][r + 1] = pe.y; ps2 = ps2 + pe;
    }
  l += ps2.x + ps2.y;
}
DI void attn_pv(const f32x16 (&sc)[2], f32x16 (&o)[2], const bf16_t* sV, int l31, int lh) {
#pragma unroll
  for (int sub = 0; sub < 2; ++sub)
#pragma unroll
    for (int s2 = 0; s2 < 2; ++s2) {
      uint4 pu; pu.x = pk2(sc[sub][8 * s2], sc[sub][8 * s2 + 1]); pu.y = pk2(sc[sub][8 * s2 + 2], sc[sub][8 * s2 + 3]);
      pu.z = pk2(sc[sub][8 * s2 + 4], sc[sub][8 * s2 + 5]); pu.w = pk2(sc[sub][8 * s2 + 6], sc[sub][8 * s2 + 7]);
      const bf16x8 pb = __builtin_bit_cast(bf16x8, pu);
#pragma unroll
      for (int dvt = 0; dvt < 2; ++dvt) {
        const bf16_t* vp = sV + (dvt * 32 + l31) * VROW + sub * 32 + 16 * s2 + 4 * lh;
        const uint2 lo = *(const uint2*)vp, hi = *(const uint2*)(vp + 8);
        uint4 vu = {lo.x, lo.y, hi.x, hi.y};
        o[dvt] = MFMA32(__builtin_bit_cast(bf16x8, vu), pb, o[dvt]);
      }
    }
}

DI void attn_unit(const Params& p, int b, int h, int qb, unsigned char* smem) {
  const bf16_t* Q = (const bf16_t*)p.out; const bf16_t* KN = (const bf16_t*)(p.ws + OFF_XN); const bf16_t* VT = (const bf16_t*)(p.ws + OFF_BT);
  const bf16_t* KROPE = (const bf16_t*)(p.ws + OFF_DEC); const bf16_t* GATE = (const bf16_t*)(p.ws + OFF_ST); bf16_t* O = (bf16_t*)(p.ws + OFF_ST + 32 * MiB);
  const int tid = otid(), lane = tid & 63, w = tid >> 6, l31 = lane & 31, lh = lane >> 5;
  const int q0 = qb * 256, qw0 = q0 + 32 * w, myq = qw0 + l31;
  const size_t tq = (size_t)b * SEQ + myq;
  bf16x8 qf[6];
#pragma unroll
  for (int ks = 0; ks < 6; ++ks) qf[ks] = *(const bf16x8*)(Q + tq * 1536 + h * 96 + ks * 16 + lh * 8);
  f32x16 o[2];
#pragma unroll
  for (int a = 0; a < 2; ++a)
#pragma unroll
    for (int i = 0; i < 16; ++i) o[a][i] = 0.f;
  float m = -1e30f, l = 0.f;
  const int ntiles = 4 * qb + 4;
  const int nact = (qw0 + 31) / 64 + 1;
  const int kr = tid >> 3, kc = (tid & 7) * 8;
  const int rr = (tid & 255) >> 2, rc = (tid & 3) * 8;
  const bf16_t* gK = KN + ((size_t)b * SEQ + kr) * 1024 + h * 64 + kc;
  const bf16_t* gR = KROPE + ((size_t)b * SEQ + rr) * 32 + rc;
  const bf16_t* gV = VT + ((size_t)((b * 16 + h) * 64 + kr)) * SEQ + kc;
  uint4 rk, rr4, rv;
#define ATT_LOAD(T) do { rk = *(const uint4*)(gK + (size_t)(T) * 64 * 1024); rr4 = *(const uint4*)(gR + (size_t)(T) * 64 * 32); rv = *(const uint4*)(gV + (T) * 64); } while (0)
#define ATT_STORE(ST_) do { bf16_t* dK_ = (bf16_t*)(smem + (ST_) * ATT_STAGE); bf16_t* dV_ = (bf16_t*)(smem + (ST_) * ATT_STAGE + ATT_K_BYTES); \
    *(uint4*)(dK_ + kr * KROW + kc) = rk; *(uint4*)(dK_ + rr * KROW + 64 + rc) = rr4; \
    *(uint2*)(dV_ + kr * VROW + kc) = make_uint2(rv.x, rv.y); *(uint2*)(dV_ + kr * VROW + kc + 4) = make_uint2(rv.z, rv.w); } while (0)
  ATT_LOAD(0); ATT_STORE(0);
  ATT_LOAD(1); ATT_STORE(1);
  __syncthreads();
  f32x16 sc[2], sn[2];
  attn_qk((const bf16_t*)smem, qf, sc, l31, lh);
  int st = 0;
  int kt = 0;
  for (; kt < nact - 1; ++kt) {
    const int st1 = (st == 2) ? 0 : st + 1, st2 = (st1 == 2) ? 0 : st1 + 1;
    const int tl = (kt + 2 < ntiles) ? kt + 2 : ntiles - 1;
    ATT_LOAD(tl);
    attn_qk((const bf16_t*)(smem + st1 * ATT_STAGE), qf, sn, l31, lh);
    attn_softmax<false>(sc, o, m, l, kt, myq, lh);
    attn_pv(sc, o, (const bf16_t*)(smem + st * ATT_STAGE + ATT_K_BYTES), l31, lh);
    ATT_STORE(st2);
    __syncthreads();
#pragma unroll
    for (int sub = 0; sub < 2; ++sub) sc[sub] = sn[sub];
    st = st1;
  }
  {
    const int st1 = (st == 2) ? 0 : st + 1, st2 = (st1 == 2) ? 0 : st1 + 1;
    const int tl = (kt + 2 < ntiles) ? kt + 2 : ntiles - 1;
    ATT_LOAD(tl);
    attn_softmax<true>(sc, o, m, l, kt, myq, lh);
    attn_pv(sc, o, (const bf16_t*)(smem + st * ATT_STAGE + ATT_K_BYTES), l31, lh);
    ATT_STORE(st2);
    __syncthreads();
    st = st1; ++kt;
  }
  for (; kt < ntiles; ++kt) {
    const int st1 = (st == 2) ? 0 : st + 1, st2 = (st1 == 2) ? 0 : st1 + 1;
    const int tl = (kt + 2 < ntiles) ? kt + 2 : ntiles - 1;
    ATT_LOAD(tl);
    ATT_STORE(st2);
    __syncthreads();
    st = st1;
  }
#undef ATT_LOAD
#undef ATT_STORE
  l += __shfl_xor(l, 32);
  const float il = 1.f / l;
#pragma unroll
  for (int dvt = 0; dvt < 2; ++dvt)
#pragma unroll
    for (int rg = 0; rg < 4; ++rg) {
      const int dv = dvt * 32 + 8 * rg + 4 * lh;
      const uint2 gv = *(const uint2*)(GATE + tq * 1024 + h * 64 + dv);
      const float g0 = __uint_as_float(gv.x << 16), g1 = __uint_as_float(gv.x & 0xffff0000u), g2 = __uint_as_float(gv.y << 16), g3 = __uint_as_float(gv.y & 0xffff0000u);
      uint2 ov; ov.x = pk2(o[dvt][4 * rg] * il * g0, o[dvt][4 * rg + 1] * il * g1); ov.y = pk2(o[dvt][4 * rg + 2] * il * g2, o[dvt][4 * rg + 3] * il * g3);
      *(uint2*)(O + tq * 1024 + h * 64 + dv) = ov;
    }
}

DI void phase_attn(const Params& p, unsigned char* smem) {
  for (int u = blockIdx.x; u < 512; u += gridDim.x) {
    int pu = u;
    if (gridDim.x == 256) {
      const int xcd = blockIdx.x & 7, li = blockIdx.x >> 3, r = u >> 8;
      pu = (r * 16 + xcd * 2 + (li >> 4)) * 16 + (li & 15);
    }
    const int bh = pu >> 4, x = pu & 15;
    for (int half = 0; half < 2; ++half) attn_unit(p, bh >> 4, bh & 15, half ? x : 31 - x, smem);
  }
}

DI void phase_final_norm(const Params& p) {
  const int tid = otid(); const int lane = tid & 63, w = tid >> 6;
  float4 g[4];
#pragma unroll
  for (int i = 0; i < 4; ++i) g[i] = ((const float4*)p.g_final)[lane + 64 * i];
  for (int row = (blockIdx.x * 8 + w) * 2; row < T; row += gridDim.x * 16) {
    float4 v[2][4]; float ss[2] = {0.f, 0.f};
#pragma unroll
    for (int u = 0; u < 2; ++u)
#pragma unroll
      for (int i = 0; i < 4; ++i) v[u][i] = ((const float4*)(p.out + (size_t)(row + u) * DM))[lane + 64 * i];
#pragma unroll
    for (int u = 0; u < 2; ++u) {
#pragma unroll
      for (int i = 0; i < 4; ++i) ss[u] += v[u][i].x * v[u][i].x + v[u][i].y * v[u][i].y + v[u][i].z * v[u][i].z + v[u][i].w * v[u][i].w;
      ss[u] = wave_sum(ss[u]);
      const float r = rsqrtf(ss[u] * (1.f / 1024.f) + 1e-6f);
#pragma unroll
      for (int i = 0; i < 4; ++i)
        ((float4*)(p.out + (size_t)(row + u) * DM))[lane + 64 * i] = make_float4(v[u][i].x * r * g[i].x, v[u][i].y * r * g[i].y, v[u][i].z * r * g[i].z, v[u][i].w * r * g[i].w);
    }
  }
}

__global__ void __launch_bounds__(NTHREADS) mega(Params p) {
  cg::grid_group grid = cg::this_grid();
  extern __shared__ __attribute__((aligned(16))) unsigned char smem[];
  unsigned char* ws = p.ws;
  __shared__ unsigned bar_st[4];
  if (threadIdx.x < 4) bar_st[threadIdx.x] = 0u;
  __syncthreads();
  const XcdBarrier xb = xcd_barrier_post((unsigned*)(ws + OFF_BAR), bar_st);
  const bool tailfill = (gridDim.x == 256);
  phase_prep(p, smem, blockIdx.x, tailfill ? 1344 : 2832, gridDim.x);
  if (!tailfill) phase_rope_tables(p, blockIdx.x, gridDim.x);
  phase_rmsnorm_rows(p.x, (bf16_t*)(ws + OFF_XN));
  if (p.out == nullptr) grid.sync();
  xcd_barrier(xb);
  gemm_phase<EPI_SSM_IN, 1024>(p, (const bf16_t*)(ws + OFF_W1), (const bf16_t*)(ws + OFF_XN), 21, smem);
  if (tailfill && (blockIdx.x >> 3) >= 8) {
    const int tj = (blockIdx.x & 7) * 24 + ((blockIdx.x >> 3) - 8);
    phase_prep(p, smem, 1344 + tj, 2832, 192);
    phase_rope_tables(p, tj, 192);
  }
  xcd_barrier(xb);
  phase_ssd_state(p, smem);
  xcd_barrier(xb);
  phase_ssd_scan(p);
  xcd_barrier(xb);
  phase_ssd_out(p, smem);
  xcd_barrier(xb);
  gemm_phase<EPI_OUT1, 2048>(p, (const bf16_t*)(ws + OFF_W2), (const bf16_t*)p.out, 4, smem);
  xcd_barrier(xb);
  gemm_phase<EPI_MLA_IN, 1024>(p, (const bf16_t*)(ws + OFF_W3), (const bf16_t*)(ws + OFF_XN), 7, smem);
  xcd_barrier(xb);
  gemm_phase<EPI_KVUP, 256>(p, (const bf16_t*)(ws + OFF_W4), (const bf16_t*)(ws + OFF_ST + 32 * MiB), 8, smem);
  gemm_phase<EPI_QUP, 384>(p, (const bf16_t*)(ws + OFF_W5), (const bf16_t*)(ws + OFF_ST + 40 * MiB), 6, smem);
  xcd_barrier(xb);
  phase_attn(p, smem);
  xcd_barrier(xb);
  gemm_phase<EPI_OUT2, 1024>(p, (const bf16_t*)(ws + OFF_W6), (const bf16_t*)(ws + OFF_ST + 32 * MiB), 4, smem);
  xcd_barrier(xb);
  phase_final_norm(p);
}

extern "C" void kernel_launch(void* const* d_in, const int* in_sizes, int n_in, void* d_out, int out_size, void* d_ws, size_t ws_size, hipStream_t stream) {
  static int grid = 0;
  if (grid == 0) {
    if (n_in != 20 || ws_size < WS_NEED) { fprintf(stderr, "kernel_launch: unexpected n_in %d / ws_size %zu\n", n_in, ws_size); grid = -1; return; }
    int dev = 0, cus = 0, per_cu = 0;
    hipGetDevice(&dev);
    hipDeviceGetAttribute(&cus, hipDeviceAttributeMultiprocessorCount, dev);
    if (hipFuncSetAttribute((const void*)mega, hipFuncAttributeMaxDynamicSharedMemorySize, LDS_BYTES) != hipSuccess) { fprintf(stderr, "hipFuncSetAttribute failed\n"); grid = -1; return; }
    hipOccupancyMaxActiveBlocksPerMultiprocessor(&per_cu, (const void*)mega, NTHREADS, LDS_BYTES);
    if (per_cu < 1) per_cu = 1;
    (void)hipGetLastError();
    grid = cus;
  }
  if (grid < 0) return;
  Params p{};
  p.x = (const float*)d_in[0]; p.pos = (const int*)d_in[1]; p.g_pre = (const float*)d_in[2]; p.ssm_w_in = (const float*)d_in[3];
  p.conv_w = (const float*)d_in[4]; p.conv_b = (const float*)d_in[5]; p.dt_bias = (const float*)d_in[6]; p.A_log = (const float*)d_in[7];
  p.Dskip = (const float*)d_in[8]; p.g_out = (const float*)d_in[9]; p.ssm_w_out = (const float*)d_in[10]; p.kv_g_in = (const float*)d_in[11];
  p.kv_w_down = (const float*)d_in[12]; p.kv_g_lat = (const float*)d_in[13]; p.kv_w_up = (const float*)d_in[14]; p.mla_w_in = (const float*)d_in[15];
  p.mla_g_q = (const float*)d_in[16]; p.mla_w_uq = (const float*)d_in[17]; p.mla_w_out = (const float*)d_in[18]; p.g_final = (const float*)d_in[19];
  p.out = (float*)d_out; p.ws = (unsigned char*)d_ws;
  if (hipMemsetAsync((char*)d_ws + OFF_BAR, 0, XCD_BAR_WORDS * sizeof(unsigned), stream) != hipSuccess) { fprintf(stderr, "memset of barrier words failed\n"); return; }
  void* args[] = {&p};
  hipError_t e = hipLaunchCooperativeKernel((const void*)mega, dim3(grid), dim3(NTHREADS), args, LDS_BYTES, stream);
  if (e != hipSuccess) fprintf(stderr, "cooperative launch failed: %s (grid %d)\n", hipGetErrorString(e), grid);
}
```

```cpp
#include <hip/hip_runtime.h>
#include <hip/hip_cooperative_groups.h>
#include <cstdio>
#include <cstdint>
namespace cg = cooperative_groups;

typedef unsigned short bf16_t;
typedef short bf16x8 __attribute__((ext_vector_type(8)));
typedef float f32x16 __attribute__((ext_vector_type(16)));
#define DI __device__ __forceinline__
#define MFMA32(a, b, c) __builtin_amdgcn_mfma_f32_32x32x16_bf16((a), (b), (c), 0, 0, 0)

constexpr int T = 16384, SEQ = 8192, DM = 1024;
constexpr int NTHREADS = 512;
constexpr size_t MiB = 1024 * 1024;
constexpr size_t OFF_W1 = 0;
constexpr size_t OFF_W2 = OFF_W1 + (size_t)5376 * 1024 * 2;
constexpr size_t OFF_W3 = OFF_W2 + (size_t)1024 * 2048 * 2;
constexpr size_t OFF_W4 = OFF_W3 + (size_t)1792 * 1024 * 2;
constexpr size_t OFF_W5 = OFF_W4 + (size_t)2048 * 256 * 2;
constexpr size_t OFF_W6 = OFF_W5 + (size_t)1536 * 384 * 2;
constexpr size_t OFF_XN = 24 * MiB;
constexpr size_t OFF_XT = 56 * MiB;
constexpr size_t OFF_BT = 120 * MiB;
constexpr size_t OFF_BR = 136 * MiB;
constexpr size_t OFF_CR = 152 * MiB;
constexpr size_t OFF_DT = 168 * MiB;
constexpr size_t OFF_ST = 170 * MiB;
constexpr size_t OFF_DEC = 234 * MiB;
constexpr size_t OFF_BAR = 236 * MiB;
constexpr size_t OFF_COS = 238 * MiB;
constexpr size_t OFF_SIN = 239 * MiB;
constexpr size_t OFF_SSQ = 240 * MiB;
constexpr size_t WS_NEED = 241 * MiB;

struct Params {
  const float* x; const int* pos; const float* g_pre; const float* ssm_w_in; const float* conv_w; const float* conv_b;
  const float* dt_bias; const float* A_log; const float* Dskip; const float* g_out; const float* ssm_w_out;
  const float* kv_g_in; const float* kv_w_down; const float* kv_g_lat; const float* kv_w_up;
  const float* mla_w_in; const float* mla_g_q; const float* mla_w_uq; const float* mla_w_out; const float* g_final;
  float* out; unsigned char* ws;
};

DI bf16_t f2bf(float x) { unsigned u = __float_as_uint(x); u += 0x7fffu + ((u >> 16) & 1u); return (bf16_t)(u >> 16); }
DI float bf2f(bf16_t b) { return __uint_as_float(((unsigned)b) << 16); }
DI float lo16(unsigned u) { return __uint_as_float(u << 16); }
DI float hi16(unsigned u) { return __uint_as_float(u & 0xffff0000u); }
typedef float f32x2 __attribute__((ext_vector_type(2)));
typedef __bf16 bf16x2_t __attribute__((ext_vector_type(2)));
DI unsigned pk2(float a, float b) { f32x2 v = {a, b}; bf16x2_t r = __builtin_convertvector(v, bf16x2_t); return __builtin_bit_cast(unsigned, r); }
DI float wave_sum(float v) {
#pragma unroll
  for (int o = 32; o >= 1; o >>= 1) v += __shfl_xor(v, o);
  return v;
}
DI int otid() { int t = threadIdx.x; asm volatile("" : "+v"(t)); return t; }
template <int K> DI float swz_xor(float v) {
  return __int_as_float(__builtin_amdgcn_ds_swizzle(__float_as_int(v), (K << 10) | 0x1f));
}
DI float silu_f(float v) { return v * __builtin_amdgcn_rcpf(1.f + __expf(-v)); }


#define XB_TMO      128
#define XB_XCNT(j)  (256  + 64 * (j))
#define XB_XSUB(j)  (1280 + 64 * (j))
#define XB_XGEN(j)  (2304 + 64 * (j))
#define XB_TOP      3328
#define XB_TOPGEN   3392
#define XCD_BAR_WORDS 3456
#define XB_SPIN_CAP (1u << 18)
DI unsigned xb_ld(unsigned* p)              { return __hip_atomic_load(p, __ATOMIC_RELAXED, __HIP_MEMORY_SCOPE_AGENT); }
DI unsigned xb_add(unsigned* p, unsigned v) { return __hip_atomic_fetch_add(p, v, __ATOMIC_RELAXED, __HIP_MEMORY_SCOPE_AGENT); }
DI unsigned xb_xcc_id() { return (unsigned)__builtin_amdgcn_s_getreg((3 << 11) | 20) & 0xFu; }
#define XB_SPIN(cond, bar) do { unsigned _sp = 0; while (cond) { __builtin_amdgcn_s_sleep(1); \
    if ((++_sp & 255u) == 0u) { if (xb_ld(&(bar)[XB_TMO])) break; if (_sp > XB_SPIN_CAP) { atomicAdd(&(bar)[XB_TMO], 1u); break; } } } } while (0)
struct XcdBarrier { unsigned* bar; unsigned x; volatile unsigned* st; };
DI XcdBarrier xcd_barrier_post(unsigned* bar, volatile unsigned* st) {
  XcdBarrier b; b.bar = bar; b.x = xb_xcc_id(); b.st = st;
  if (threadIdx.x == 0) (void)xb_add(&bar[XB_XCNT(b.x)], 1u);
  return b;
}
DI void xcd_barrier_complete(unsigned* bar, unsigned x, unsigned& nloc, unsigned& nx) {
  const unsigned G = gridDim.x * gridDim.y * gridDim.z;
  unsigned sum, cnt, mine, sp = 0u;
  for (;;) {
    sum = 0u; cnt = 0u; mine = 0u;
#pragma unroll
    for (unsigned j = 0; j < 16; ++j) { const unsigned c = xb_ld(&bar[XB_XCNT(j)]); sum += c; cnt += (c > 0u) ? 1u : 0u; mine = (j == x) ? c : mine; }
    if (sum == G) break;
    __builtin_amdgcn_s_sleep(1);
    if ((++sp & 255u) == 0u) { if (xb_ld(&bar[XB_TMO])) break; if (sp > XB_SPIN_CAP) { atomicAdd(&bar[XB_TMO], 1u); break; } }
  }
  nloc = mine > 0u ? mine : 1u; nx = cnt > 0u ? cnt : 1u;
}
DI void xcd_barrier(const XcdBarrier& b) {
  asm volatile("s_waitcnt vmcnt(0)" ::: "memory");
  __syncthreads();
  if (threadIdx.x == 0) {
    unsigned* bar = b.bar;
    __builtin_amdgcn_s_waitcnt(0);
    unsigned nloc = b.st[0], nx = b.st[1];
    if (nloc == 0u) { xcd_barrier_complete(bar, b.x, nloc, nx); b.st[0] = nloc; b.st[1] = nx; }
    const unsigned old = xb_add(&bar[XB_XSUB(b.x)], 1u);
    const unsigned gen = old / nloc;
    if (old + 1u == (gen + 1u) * nloc) {
      __builtin_amdgcn_fence(__ATOMIC_RELEASE, "agent");
      asm volatile("s_waitcnt vmcnt(0)" ::: "memory");
      const unsigned og = xb_add(&bar[XB_TOP], 1u);
      const unsigned tg = og / nx;
      if (og + 1u == (tg + 1u) * nx) xb_add(&bar[XB_TOPGEN], 1u);
      else XB_SPIN(xb_ld(&bar[XB_TOPGEN]) == tg, bar);
      __builtin_amdgcn_fence(__ATOMIC_ACQUIRE, "agent");
      xb_add(&bar[XB_XGEN(b.x)], 1u);
      asm volatile("s_waitcnt vmcnt(0)" ::: "memory");
    } else {
      XB_SPIN(xb_ld(&bar[XB_XGEN(b.x)]) == gen, bar);
      __builtin_amdgcn_fence(__ATOMIC_ACQUIRE, "agent");
      asm volatile("s_waitcnt vmcnt(0)" ::: "memory");
    }
  }
  __syncthreads();
}

struct WJob { const float* src; const float* gain; bf16_t* dst; int ld, col0, ncols, K, tile; };
DI WJob wprep_job(const Params& p, int u) {
  bf16_t* W1 = (bf16_t*)(p.ws + OFF_W1); bf16_t* W2 = (bf16_t*)(p.ws + OFF_W2); bf16_t* W3 = (bf16_t*)(p.ws + OFF_W3);
  bf16_t* W4 = (bf16_t*)(p.ws + OFF_W4); bf16_t* W5 = (bf16_t*)(p.ws + OFF_W5); bf16_t* W6 = (bf16_t*)(p.ws + OFF_W6);
  int t = u; WJob j;
  if (t < 1344) { j = {p.ssm_w_in, p.g_pre, W1, 5152, 0, 5152, 1024, t}; return j; } t -= 1344;
  if (t < 512) { j = {p.ssm_w_out, p.g_out, W2, 1024, 0, 1024, 2048, t}; return j; } t -= 512;
  if (t < 64) { j = {p.kv_w_down, p.kv_g_in, W3, 288, 0, 256, 1024, t}; return j; } t -= 64;
  if (t < 96) { j = {p.mla_w_in, p.g_pre + 1024, W3 + (size_t)256 * 1024, 1408, 0, 384, 1024, t}; return j; } t -= 96;
  if (t < 256) { j = {p.mla_w_in, p.g_pre + 1024, W3 + (size_t)640 * 1024, 1408, 384, 1024, 1024, t}; return j; } t -= 256;
  if (t < 32) { j = {p.kv_w_down, p.kv_g_in, W3 + (size_t)1664 * 1024, 288, 256, 32, 1024, t}; return j; } t -= 32;
  if (t < 128) { j = {p.kv_w_up, p.kv_g_lat, W4, 2048, 0, 2048, 256, t}; return j; } t -= 128;
  if (t < 144) { j = {p.mla_w_uq, p.mla_g_q, W5, 1536, 0, 1536, 384, t}; return j; } t -= 144;
  j = {p.mla_w_out, nullptr, W6, 1024, 0, 1024, 1024, t}; return j;
}
DI void wprep_load(const WJob& j, int tid0, float4 (&v)[2], float (&gk)[2]) {
  const int nkt = j.K >> 6; const int tn = j.tile / nkt, tk = j.tile % nkt; const int n0 = tn * 64, k0 = tk * 64;
#pragma unroll
  for (int i = 0; i < 2; ++i) {
    const int e = tid0 + NTHREADS * i; const int kk = e >> 4, n4 = (e & 15) * 4;
    v[i] = make_float4(0.f, 0.f, 0.f, 0.f);
    if (n0 + n4 < j.ncols) v[i] = *(const float4*)(j.src + (size_t)(k0 + kk) * j.ld + j.col0 + n0 + n4);
    gk[i] = j.gain ? j.gain[k0 + kk] : 1.f;
  }
}
DI void phase_prep(const Params& p, unsigned char* smem, int ustart, int uend, int ustride) {
  float* sm = (float*)smem;
  const int tid0 = otid();
  int u = ustart;
  if (u >= uend) return;
  WJob j = wprep_job(p, u);
  float4 v[2]; float gk[2];
  wprep_load(j, tid0, v, gk);
  for (;;) {
#pragma unroll
    for (int i = 0; i < 2; ++i) {
      const int e = tid0 + NTHREADS * i; const int kk = e >> 4, n4 = (e & 15) * 4;
      float* d = sm + kk * 65 + n4;
      d[0] = v[i].x * gk[i]; d[1] = v[i].y * gk[i]; d[2] = v[i].z * gk[i]; d[3] = v[i].w * gk[i];
    }
    __syncthreads();
    const WJob jc = j;
    const int un = u + ustride; const bool more = (un < uend);
    if (more) { j = wprep_job(p, un); wprep_load(j, tid0, v, gk); }
    {
      const int nkt = jc.K >> 6; const int tn = jc.tile / nkt, tk = jc.tile % nkt; const int n0 = tn * 64, k0 = tk * 64;
      const int nn = tid0 >> 3, kc = (tid0 & 7) * 8;
      uint4 o;
      o.x = pk2(sm[(kc + 0) * 65 + nn], sm[(kc + 1) * 65 + nn]); o.y = pk2(sm[(kc + 2) * 65 + nn], sm[(kc + 3) * 65 + nn]);
      o.z = pk2(sm[(kc + 4) * 65 + nn], sm[(kc + 5) * 65 + nn]); o.w = pk2(sm[(kc + 6) * 65 + nn], sm[(kc + 7) * 65 + nn]);
      *(uint4*)(jc.dst + (size_t)(n0 + nn) * jc.K + k0 + kc) = o;
    }
    __syncthreads();
    if (!more) break;
    u = un;
  }
}

DI void phase_rope_tables(const Params& p, int blk, int nblk) {
  float* COS = (float*)(p.ws + OFF_COS); float* SIN = (float*)(p.ws + OFF_SIN);
  for (int e = blk * NTHREADS + otid(); e < T * 16; e += nblk * NTHREADS) {
    const int t = e >> 4, i = e & 15;
    const float ang = (float)p.pos[t] * powf(10000.f, -(float)(2 * i) / 32.f);
    COS[e] = cosf(ang); SIN[e] = sinf(ang);
  }
  float* SSQ = (float*)(p.ws + OFF_SSQ);
  for (int e = blk * NTHREADS + otid(); e < 3 * T; e += nblk * NTHREADS) SSQ[e] = 0.f;
}

DI void phase_rmsnorm_rows(const float* __restrict__ src, bf16_t* __restrict__ dst) {
  const int tid = otid(); const int lane = tid & 63, w = tid >> 6;
  for (int row = (blockIdx.x * 8 + w) * 2; row < T; row += gridDim.x * 16) {
    float4 v[2][4]; float ss[2] = {0.f, 0.f};
#pragma unroll
    for (int u = 0; u < 2; ++u)
#pragma unroll
      for (int i = 0; i < 4; ++i) v[u][i] = ((const float4*)(src + (size_t)(row + u) * DM))[lane + 64 * i];
#pragma unroll
    for (int u = 0; u < 2; ++u) {
#pragma unroll
      for (int i = 0; i < 4; ++i) ss[u] += v[u][i].x * v[u][i].x + v[u][i].y * v[u][i].y + v[u][i].z * v[u][i].z + v[u][i].w * v[u][i].w;
      ss[u] = wave_sum(ss[u]);
      const float r = rsqrtf(ss[u] * (1.f / 1024.f) + 1e-6f);
#pragma unroll
      for (int i = 0; i < 4; ++i) {
        uint2 o; o.x = pk2(v[u][i].x * r, v[u][i].y * r); o.y = pk2(v[u][i].z * r, v[u][i].w * r);
        *(uint2*)(dst + (size_t)(row + u) * DM + (lane + 64 * i) * 4) = o;
      }
    }
  }
}

enum { EPI_SSM_IN = 0, EPI_OUT1 = 1, EPI_MLA_IN = 2, EPI_KVUP = 3, EPI_QUP = 4, EPI_OUT2 = 5 };


typedef float f32x4 __attribute__((ext_vector_type(4)));
constexpr int EPI_WAVE_BYTES = 8704;
constexpr int TM_ROW = 72;
constexpr int CM_ROW = 40;
constexpr int F32_ROW = 68;

template <bool SILU>
DI void stage_tm(const f32x4 (&a)[4][2], bf16_t* wl, int fr, int fq) {
#pragma unroll
  for (int m = 0; m < 4; ++m)
#pragma unroll
    for (int n = 0; n < 2; ++n) {
      float v0 = a[m][n][0], v1 = a[m][n][1], v2 = a[m][n][2], v3 = a[m][n][3];
      if (SILU) { v0 = silu_f(v0); v1 = silu_f(v1); v2 = silu_f(v2); v3 = silu_f(v3); }
      uint2 o; o.x = pk2(v0, v1); o.y = pk2(v2, v3);
      *(uint2*)(wl + (n * 16 + fr) * TM_ROW + m * 16 + fq * 4) = o;
    }
}
DI void readout_tm(const bf16_t* wl, bf16_t* gdst, size_t ld, int lane) {
#pragma unroll
  for (int it = 0; it < 4; ++it) {
    const int idx = lane + 64 * it; const int row = idx >> 3, ch = idx & 7;
    *(uint4*)(gdst + (size_t)row * ld + ch * 8) = *(const uint4*)(wl + row * TM_ROW + ch * 8);
  }
}
DI void stage_cm(const f32x4 (&a)[4][2], bf16_t* wl, int fr, int fq) {
#pragma unroll
  for (int m = 0; m < 4; ++m)
#pragma unroll
    for (int n = 0; n < 2; ++n)
#pragma unroll
      for (int j = 0; j < 4; ++j) wl[(m * 16 + fq * 4 + j) * CM_ROW + n * 16 + fr] = f2bf(a[m][n][j]);
}
DI void readout_cm(const bf16_t* wl, bf16_t* gdst, int lane) {
#pragma unroll
  for (int it = 0; it < 4; ++it) {
    const int idx = lane + 64 * it; const int row = idx >> 2, ch = idx & 3;
    *(uint4*)(gdst + (size_t)row * SEQ + ch * 8) = *(const uint4*)(wl + row * CM_ROW + ch * 8);
  }
}
constexpr int CMP_ROW = 72;
DI void stage_cm_pair(const f32x4 (&a)[4][2], bf16_t* wlp, int par, int fr, int fq) {
#pragma unroll
  for (int m = 0; m < 4; ++m)
#pragma unroll
    for (int n = 0; n < 2; ++n)
#pragma unroll
      for (int j = 0; j < 4; ++j) wlp[(m * 16 + fq * 4 + j) * CMP_ROW + par * 32 + n * 16 + fr] = f2bf(a[m][n][j]);
}
DI void readout_cm_pair(const bf16_t* wlp, bf16_t* gdst, int par, int lane) {
#pragma unroll
  for (int it = 0; it < 4; ++it) {
    const int idx = lane + 64 * it; const int row = par * 32 + (idx >> 3), ch = idx & 7;
    *(uint4*)(gdst + (size_t)row * SEQ + ch * 8) = *(const uint4*)(wlp + row * CMP_ROW + ch * 8);
  }
}
DI void stage_f32(const f32x4 (&a)[4][2], float* wl, int fr, int fq) {
#pragma unroll
  for (int m = 0; m < 4; ++m)
#pragma unroll
    for (int n = 0; n < 2; ++n) *(f32x4*)(wl + (n * 16 + fr) * F32_ROW + m * 16 + fq * 4) = a[m][n];
}
DI void readout_f32_resid(const float* wl, const float* __restrict__ resid, float* __restrict__ gdst, int lane) {
#pragma unroll 4
  for (int it = 0; it < 8; ++it) {
    const int idx = lane + 64 * it; const int row = idx >> 4, ch = idx & 15;
    const float4 v = *(const float4*)(wl + row * F32_ROW + ch * 4);
    const float4 r = *(const float4*)(resid + (size_t)row * DM + ch * 4);
    *(float4*)(gdst + (size_t)row * DM + ch * 4) = make_float4(v.x + r.x, v.y + r.y, v.z + r.z, v.w + r.w);
  }
}

DI void readout_f32_resid_ssq(const float* wl, const float* __restrict__ resid, float* __restrict__ gdst, bf16_t* __restrict__ hs, float* __restrict__ ssq, int lane) {
#pragma unroll 4
  for (int it = 0; it < 8; ++it) {
    const int idx = lane + 64 * it; const int row = idx >> 4, ch = idx & 15;
    const float4 v = *(const float4*)(wl + row * F32_ROW + ch * 4);
    const float4 r = *(const float4*)(resid + (size_t)row * DM + ch * 4);
    const float4 h = make_float4(v.x + r.x, v.y + r.y, v.z + r.z, v.w + r.w);
    *(float4*)(gdst + (size_t)row * DM + ch * 4) = h;
    uint2 o; o.x = pk2(h.x, h.y); o.y = pk2(h.z, h.w);
    *(uint2*)(hs + (size_t)row * DM + ch * 4) = o;
    float q = h.x * h.x + h.y * h.y + h.z * h.z + h.w * h.w;
    q += swz_xor<1>(q); q += swz_xor<2>(q); q += swz_xor<4>(q); q += swz_xor<8>(q);
    if (ch == 0) atomicAdd(ssq + row, q);
  }
}

DI void wave_lds_sync() { asm volatile("s_waitcnt lgkmcnt(0)" ::: "memory"); }

template <int EPI>
DI void epilogue_block(const Params& p, const f32x4 (&a)[4][2], int c0, int mt, bf16_t* wl, bf16_t* wlp, int par, int lane, int fr, int fq) {
  unsigned char* ws = p.ws;
  const int b = mt >> 13, tok0 = mt & 8191;
  const int tok0p = tok0 - par * 32;
  if (EPI == EPI_SSM_IN) {
    if (c0 < 2048) {
      stage_tm<false>(a, wl, fr, fq); wave_lds_sync();
      readout_tm(wl, (bf16_t*)p.out + (size_t)mt * 2048 + c0, 2048, lane); wave_lds_sync();
    } else if (c0 < 4096) {
      stage_cm_pair(a, wlp, par, fr, fq); __syncthreads();
      readout_cm_pair(wlp, (bf16_t*)(ws + OFF_XT) + ((size_t)(b * 2048 + (c0 - 2048))) * SEQ + tok0p, par, lane); __syncthreads();
    } else if (c0 < 4608) {
      stage_tm<false>(a, wl, fr, fq); wave_lds_sync();
      readout_tm(wl, (bf16_t*)(ws + OFF_BR) + (size_t)mt * 512 + (c0 - 4096), 512, lane); __syncthreads();
      stage_cm_pair(a, wlp, par, fr, fq); __syncthreads();
      readout_cm_pair(wlp, (bf16_t*)(ws + OFF_BT) + ((size_t)(b * 512 + (c0 - 4096))) * SEQ + tok0p, par, lane); __syncthreads();
    } else if (c0 < 5120) {
      stage_tm<false>(a, wl, fr, fq); wave_lds_sync();
      readout_tm(wl, (bf16_t*)(ws + OFF_CR) + (size_t)mt * 512 + (c0 - 4608), 512, lane); wave_lds_sync();
    } else if (c0 == 5120) {
#pragma unroll
      for (int m = 0; m < 2; ++m)
#pragma unroll
        for (int n = 0; n < 2; ++n) {
          const int h = m * 16 + fq * 4;
          float4 o; float* op = (float*)&o;
#pragma unroll
          for (int j = 0; j < 4; ++j) { const float t = a[m][n][j] + p.dt_bias[h + j]; op[j] = (t > 20.f) ? t : log1pf(__expf(t)); }
          *(float4*)((float*)(ws + OFF_DT) + (size_t)(mt + n * 16 + fr) * 32 + h) = o;
        }
    }
  } else if (EPI == EPI_OUT1 || EPI == EPI_OUT2) {
    const float* resid = (EPI == EPI_OUT1) ? p.x : (const float*)(ws + OFF_XT);
    float* dst = (EPI == EPI_OUT1) ? (float*)(ws + OFF_XT) : p.out;
    stage_f32(a, (float*)wl, fr, fq); wave_lds_sync();
    if (EPI == EPI_OUT1) readout_f32_resid_ssq((const float*)wl, resid + (size_t)mt * DM + c0, dst + (size_t)mt * DM + c0, (bf16_t*)(ws + OFF_XN) + (size_t)mt * DM + c0, (float*)(ws + OFF_SSQ) + mt, lane);
    else readout_f32_resid((const float*)wl, resid + (size_t)mt * DM + c0, dst + (size_t)mt * DM + c0, lane);
    wave_lds_sync();
  } else if (EPI == EPI_MLA_IN) {
    const float* SSQ = (const float*)(ws + OFF_SSQ);
    f32x4 a2[4][2];
    float rs[2];
#pragma unroll
    for (int n = 0; n < 2; ++n) rs[n] = rsqrtf(SSQ[mt + n * 16 + fr] * (1.f / 1024.f) + 1e-6f);
#pragma unroll
    for (int m = 0; m < 4; ++m)
#pragma unroll
      for (int n = 0; n < 2; ++n) a2[m][n] = a[m][n] * rs[n];
    if (c0 < 640) {
      float* dstq = (float*)(ws + OFF_SSQ) + (c0 < 256 ? T : 2 * T);
#pragma unroll
      for (int n = 0; n < 2; ++n) {
        float q = 0.f;
#pragma unroll
        for (int m = 0; m < 4; ++m) q += a2[m][n][0] * a2[m][n][0] + a2[m][n][1] * a2[m][n][1] + a2[m][n][2] * a2[m][n][2] + a2[m][n][3] * a2[m][n][3];
        q += swz_xor<16>(q); q += __shfl_xor(q, 32);
        if (fq == 0) atomicAdd(dstq + mt + n * 16 + fr, q);
      }
    }
    const f32x4 (&a)[4][2] = a2;
    if (c0 < 640) stage_tm<false>(a, wl, fr, fq);
    else if (c0 < 1664) stage_tm<true>(a, wl, fr, fq);
    wave_lds_sync();
    if (c0 < 256) readout_tm(wl, (bf16_t*)(ws + OFF_ST + 32 * MiB) + (size_t)mt * 256 + c0, 256, lane);
    else if (c0 < 640) readout_tm(wl, (bf16_t*)(ws + OFF_ST + 40 * MiB) + (size_t)mt * 384 + (c0 - 256), 384, lane);
    else if (c0 < 1664) readout_tm(wl, (bf16_t*)(ws + OFF_ST) + (size_t)mt * 1024 + (c0 - 640), 1024, lane);
    else if (c0 == 1664) {
      const float* COS = (const float*)(ws + OFF_COS); const float* SIN = (const float*)(ws + OFF_SIN);
      bf16_t* KROPE = (bf16_t*)(ws + OFF_DEC);
#pragma unroll
      for (int n = 0; n < 2; ++n) {
        const int t = mt + n * 16 + fr;
        const f32x4 cs = *(const f32x4*)(COS + (size_t)t * 16 + fq * 4), sn = *(const f32x4*)(SIN + (size_t)t * 16 + fq * 4);
        const f32x4 x1 = a[0][n], x2 = a[1][n];
        const f32x4 r1 = x1 * cs - x2 * sn, r2 = x1 * sn + x2 * cs;
        uint2 o1, o2; o1.x = pk2(r1[0], r1[1]); o1.y = pk2(r1[2], r1[3]); o2.x = pk2(r2[0], r2[1]); o2.y = pk2(r2[2], r2[3]);
        *(uint2*)(KROPE + (size_t)t * 32 + fq * 4) = o1; *(uint2*)(KROPE + (size_t)t * 32 + 16 + fq * 4) = o2;
      }
    }
    wave_lds_sync();
  } else if (EPI == EPI_KVUP) {
    const int head = c0 >> 7; const bool isv = (c0 & 64) != 0;
    const float* SSQ = (const float*)(ws + OFF_SSQ) + T;
    f32x4 a2[4][2];
#pragma unroll
    for (int n = 0; n < 2; ++n) {
      const float rsn = rsqrtf(SSQ[mt + n * 16 + fr] * (1.f / 256.f) + 1e-6f);
#pragma unroll
      for (int m = 0; m < 4; ++m) a2[m][n] = a[m][n] * rsn;
    }
    const f32x4 (&a)[4][2] = a2;
    if (!isv) stage_tm<false>(a, wl, fr, fq); else stage_cm_pair(a, wlp, par, fr, fq);
    __syncthreads();
    if (!isv) readout_tm(wl, (bf16_t*)(ws + OFF_XN) + (size_t)mt * 1024 + head * 64, 1024, lane);
    else readout_cm_pair(wlp, (bf16_t*)(ws + OFF_BT) + ((size_t)((b * 16 + head) * 64)) * SEQ + tok0p, par, lane);
    __syncthreads();
  } else if (EPI == EPI_QUP) {
    const float SC = 0.10206207261596575f * 1.4426950408889634f;
    const float* SSQ = (const float*)(ws + OFF_SSQ) + 2 * T;
    f32x4 v[4][2];
#pragma unroll
    for (int n = 0; n < 2; ++n) {
      const float rsn = rsqrtf(SSQ[mt + n * 16 + fr] * (1.f / 384.f) + 1e-6f) * SC;
#pragma unroll
      for (int m = 0; m < 4; ++m) v[m][n] = a[m][n] * rsn;
    }
    const int ph = c0 % 96;
    if (ph != 0) {
      const float* COS = (const float*)(ws + OFF_COS); const float* SIN = (const float*)(ws + OFF_SIN);
#pragma unroll
      for (int n = 0; n < 2; ++n) {
        const int t = mt + n * 16 + fr;
        const f32x4 cs = *(const f32x4*)(COS + (size_t)t * 16 + fq * 4), sn = *(const f32x4*)(SIN + (size_t)t * 16 + fq * 4);
        if (ph == 64) { const f32x4 x1 = v[0][n], x2 = v[1][n]; v[0][n] = x1 * cs - x2 * sn; v[1][n] = x1 * sn + x2 * cs; }
        else          { const f32x4 x1 = v[2][n], x2 = v[3][n]; v[2][n] = x1 * cs - x2 * sn; v[3][n] = x1 * sn + x2 * cs; }
      }
    }
    stage_tm<false>(v, wl, fr, fq); wave_lds_sync();
    readout_tm(wl, (bf16_t*)p.out + (size_t)mt * 1536 + c0, 1536, lane);
    wave_lds_sync();
  }
}

constexpr int G8_BK = 64, G8_HALF = 128, G8_HT = G8_HALF * G8_BK;
constexpr int LDS_BYTES = 143360;
DI int g8_lds_byte(int r, int c) { const int st = (r >> 4) * 2 + (c >> 5), rr = r & 15, cc = c & 31, ob = rr * 64 + cc * 2; return st * 1024 + (ob ^ (((ob >> 9) & 1) << 5)); }
DI void g8_stage_rc(int b, int& R, int& C) { const int st = b / 1024, sb = b % 1024, swz = sb ^ (((sb >> 9) & 1) << 5); R = (st >> 1) * 16 + swz / 64; C = (st & 1) * 32 + (swz % 64) / 2; }

template <int EPI, int K>
DI void gemm_tile(const Params& p, const bf16_t* __restrict__ A, const bf16_t* __restrict__ Bt, int brow, int bcol, unsigned char* smem) {
  bf16_t* shm = (bf16_t*)smem;
#define SA(b, h) (shm + ((b) * 2 + (h)) * G8_HT)
#define SB(b, h) (shm + (4 + (b) * 2 + (h)) * G8_HT)
#define STAGE(P, BASE, br, kt) do { const long _g = (long)(br) * K + (long)(kt) * G8_BK; \
    _Pragma("unroll") for (int _i = 0; _i < 2; ++_i) { const int _b = tid * 16 + _i * 8192; int _r, _c; g8_stage_rc(_b, _r, _c); \
      __builtin_amdgcn_global_load_lds((const unsigned*)(BASE + _g + (long)_r * K + _c), (unsigned*)((char*)(P) + _b), 16, 0, 0); } } while (0)
#define LDA(dst, b, h) _Pragma("unroll") for (int m = 0; m < 4; ++m) _Pragma("unroll") for (int k = 0; k < 2; ++k) \
    dst[m][k] = *reinterpret_cast<const bf16x8*>((const char*)SA(b, h) + g8_lds_byte(wr * 64 + m * 16 + fr, k * 32 + fq * 8))
#define LDB(dst, b, h) _Pragma("unroll") for (int n = 0; n < 2; ++n) _Pragma("unroll") for (int k = 0; k < 2; ++k) \
    dst[n][k] = *reinterpret_cast<const bf16x8*>((const char*)SB(b, h) + g8_lds_byte(wc * 32 + n * 16 + fr, k * 32 + fq * 8))
#define MMA(ai, bj, At_, Bt_) do { __builtin_amdgcn_s_setprio(1); \
    _Pragma("unroll") for (int m = 0; m < 4; ++m) _Pragma("unroll") for (int n = 0; n < 2; ++n) _Pragma("unroll") for (int k = 0; k < 2; ++k) \
      acc[ai][bj][m][n] = __builtin_amdgcn_mfma_f32_16x16x32_bf16(At_[m][k], Bt_[n][k], acc[ai][bj][m][n], 0, 0, 0); \
    __builtin_amdgcn_s_setprio(0); } while (0)
#define WAIT_V(n) asm volatile("s_waitcnt vmcnt(" #n ")" ::: "memory")
#define WAIT_L(n) asm volatile("s_waitcnt lgkmcnt(" #n ")" ::: "memory")
#define BAR __builtin_amdgcn_s_barrier()
#define SCHED __builtin_amdgcn_sched_barrier(0)
  const int tid = otid();
  const int wid = tid >> 6, lane = tid & 63, wr = wid >> 2, wc = wid & 3, fr = lane & 15, fq = lane >> 4;
  f32x4 acc[2][2][4][2];
#pragma unroll
  for (int a_ = 0; a_ < 2; ++a_)
#pragma unroll
    for (int b_ = 0; b_ < 2; ++b_)
#pragma unroll
      for (int m = 0; m < 4; ++m)
#pragma unroll
        for (int n = 0; n < 2; ++n) acc[a_][b_][m][n] = (f32x4){0.f, 0.f, 0.f, 0.f};
  bf16x8 At[4][2], B0[2][2], B1[2][2];
  constexpr int nt = K / G8_BK;
  STAGE(SB(0, 0), Bt, bcol, 0); STAGE(SA(0, 0), A, brow, 0);
  STAGE(SB(0, 1), Bt, bcol + G8_HALF, 0); STAGE(SA(0, 1), A, brow + G8_HALF, 0);
  if (wr == 1) BAR;
  WAIT_V(4); BAR;
  STAGE(SB(1, 0), Bt, bcol, 1); STAGE(SA(1, 0), A, brow, 1); STAGE(SB(1, 1), Bt, bcol + G8_HALF, 1);
  WAIT_V(6); BAR;
  for (int t = 0; t < nt - 2; t += 2) {
    LDB(B0, 0, 0); SCHED; LDA(At, 0, 0); STAGE(SA(1, 1), A, brow + G8_HALF, t + 1);
    WAIT_L(8); BAR; WAIT_L(0); MMA(0, 0, At, B0); BAR; SCHED;
    LDB(B1, 0, 1); STAGE(SB(0, 0), Bt, bcol, t + 2);
    BAR; WAIT_L(0); MMA(0, 1, At, B1); BAR;
    LDA(At, 0, 1); STAGE(SA(0, 0), A, brow, t + 2);
    BAR; WAIT_L(0); MMA(1, 0, At, B0); BAR; SCHED;
    STAGE(SB(0, 1), Bt, bcol + G8_HALF, t + 2);
    WAIT_V(6); BAR; MMA(1, 1, At, B1); BAR;
    LDB(B0, 1, 0); SCHED; LDA(At, 1, 0); STAGE(SA(0, 1), A, brow + G8_HALF, t + 2);
    WAIT_L(8); BAR; WAIT_L(0); MMA(0, 0, At, B0); BAR; SCHED;
    LDB(B1, 1, 1); STAGE(SB(1, 0), Bt, bcol, t + 3);
    BAR; WAIT_L(0); MMA(0, 1, At, B1); BAR;
    LDA(At, 1, 1); STAGE(SA(1, 0), A, brow, t + 3);
    BAR; WAIT_L(0); MMA(1, 0, At, B0); BAR; SCHED;
    STAGE(SB(1, 1), Bt, bcol + G8_HALF, t + 3);
    WAIT_V(6); BAR; MMA(1, 1, At, B1); BAR;
  }
  { LDB(B0, 0, 0); LDA(At, 0, 0); STAGE(SA(1, 1), A, brow + G8_HALF, nt - 1);
    BAR; WAIT_L(0); MMA(0, 0, At, B0); BAR;
    LDB(B1, 0, 1); BAR; WAIT_L(0); MMA(0, 1, At, B1); BAR;
    LDA(At, 0, 1); WAIT_V(4); BAR; WAIT_L(0); MMA(1, 0, At, B0); MMA(1, 1, At, B1); BAR; }
  { LDB(B0, 1, 0); LDA(At, 1, 0); WAIT_V(2); BAR; WAIT_L(0); MMA(0, 0, At, B0); BAR;
    LDB(B1, 1, 1); WAIT_V(0); BAR; WAIT_L(0); MMA(0, 1, At, B1); BAR;
    LDA(At, 1, 1); BAR; WAIT_L(0); MMA(1, 0, At, B0); MMA(1, 1, At, B1); BAR; }
  if (wr == 0) BAR;
  __syncthreads();
  int t2 = tid; asm volatile("" : "+v"(t2));
  const int wid2 = t2 >> 6, lane2 = t2 & 63, wr2 = wid2 >> 2, wc2 = wid2 & 3, fr2 = lane2 & 15, fq2 = lane2 >> 4;
  bf16_t* wl = (bf16_t*)(smem + wid2 * EPI_WAVE_BYTES);
  bf16_t* wlp = (bf16_t*)(smem + (wid2 & ~1) * EPI_WAVE_BYTES);
#pragma unroll
  for (int ai = 0; ai < 2; ++ai)
#pragma unroll
    for (int bj = 0; bj < 2; ++bj)
      epilogue_block<EPI>(p, acc[ai][bj], brow + ai * 128 + wr2 * 64, bcol + bj * 128 + wc2 * 32, wl, wlp, wc2 & 1, lane2, fr2, fq2);
  __syncthreads();
#undef SA
#undef SB
#undef STAGE
#undef LDA
#undef LDB
#undef MMA
#undef WAIT_V
#undef WAIT_L
#undef BAR
#undef SCHED
}

template <int EPI, int K>
DI void gemm_phase(const Params& p, const bf16_t* Wt, const bf16_t* X, int ntn, unsigned char* smem) {
  const bool xa = (gridDim.x == 256);
  const int xcd = blockIdx.x & 7, li = blockIdx.x >> 3;
  const int per_half = 4 * ntn;
  const int start = xa ? li : (int)blockIdx.x, step = xa ? 32 : (int)gridDim.x, total = ntn * (xa ? 8 : 64);
  for (int t = start; t < total; t += step) {
    int tm, tn;
    if (xa) { const int h = t / per_half, tp = t - h * per_half; tn = tp >> 2; tm = xcd * 8 + h * 4 + (tp & 3); }
    else { tm = t / ntn; tn = t % ntn; }
    gemm_tile<EPI, K>(p, Wt, X, tn * 256, tm * 256, smem);
  }
}

DI void conv8_load(const bf16_t* rp, bool has_prev, uint4& cur, uint2& prv) {
  cur = *(const uint4*)rp; prv = make_uint2(0u, 0u);
  if (has_prev) prv = *(const uint2*)(rp - 4);
}
DI float fast_silu(float v) { return v * __builtin_amdgcn_rcpf(1.f + __expf(-v)); }
DI void conv8_compute(const uint4 cur, const uint2 prv, float w0, float w1, float w2, float w3, float bias, float (&out)[8]) {
  float r[11];
  r[0] = hi16(prv.x); r[1] = lo16(prv.y); r[2] = hi16(prv.y);
  r[3] = lo16(cur.x); r[4] = hi16(cur.x); r[5] = lo16(cur.y); r[6] = hi16(cur.y); r[7] = lo16(cur.z); r[8] = hi16(cur.z); r[9] = lo16(cur.w); r[10] = hi16(cur.w);
#pragma unroll
  for (int j = 0; j < 8; ++j) out[j] = fast_silu(bias + w0 * r[j] + w1 * r[j + 1] + w2 * r[j + 2] + w3 * r[j + 3]);
}
DI void conv8(const bf16_t* rp, bool has_prev, float w0, float w1, float w2, float w3, float bias, float (&out)[8]) {
  uint4 cur; uint2 prv; conv8_load(rp, has_prev, cur, prv); conv8_compute(cur, prv, w0, w1, w2, w3, bias, out);
}
DI bf16x8 pack8(const float (&v)[8]) {
  uint4 u; u.x = pk2(v[0], v[1]); u.y = pk2(v[2], v[3]); u.z = pk2(v[4], v[5]); u.w = pk2(v[6], v[7]);
  return __builtin_bit_cast(bf16x8, u);
}
DI void chunk_cumsum(const float* __restrict__ DTp, size_t tk0, int hd, float A, int lane, float (&d4)[4], float (&c4)[4], float& last) {
#pragma unroll
  for (int i = 0; i < 4; ++i) d4[i] = DTp[(tk0 + 4 * lane + i) * 32 + hd];
  c4[0] = d4[0] * A; c4[1] = c4[0] + d4[1] * A; c4[2] = c4[1] + d4[2] * A; c4[3] = c4[2] + d4[3] * A;
  const float tot = c4[3];
  float sum = tot, ex = 0.f, t;
  t = swz_xor<1>(sum);  if (lane & 1) ex += t;  sum += t;
  t = swz_xor<2>(sum);  if (lane & 2) ex += t;  sum += t;
  t = swz_xor<4>(sum);  if (lane & 4) ex += t;  sum += t;
  t = swz_xor<8>(sum);  if (lane & 8) ex += t;  sum += t;
  t = swz_xor<16>(sum); if (lane & 16) ex += t; sum += t;
  t = __shfl_xor(sum, 32); if (lane & 32) ex += t; sum += t;
#pragma unroll
  for (int i = 0; i < 4; ++i) c4[i] += ex;
  last = sum;
}

constexpr int BT_ROW = 264;
constexpr int CN_ROW = 136;

DI void phase_ssd_state(const Params& p, unsigned char* smem) {
  const bf16_t* XT = (const bf16_t*)(p.ws + OFF_XT); const bf16_t* BT = (const bf16_t*)(p.ws + OFF_BT); const float* DTp = (const float*)(p.ws + OFF_DT);
  float* ST = (float*)(p.ws + OFF_ST); float* DEC = (float*)(p.ws + OFF_DEC);
  bf16_t* BTs = (bf16_t*)smem; float* wgt = (float*)(smem + 128 * BT_ROW * 2);
  const int tid = otid(), lane = tid & 63, w = tid >> 6, l31 = lane & 31, lh = lane >> 5;
  for (int u = blockIdx.x; u < 256; u += gridDim.x) {
    const int b = u >> 7, c = (u >> 2) & 31, g = u & 3; const int hd = 8 * g + w;
    bf16_t* XTC = (bf16_t*)(p.ws + (b ? OFF_ST + 32 * MiB : OFF_XN));
    {
      float d4[4], c4[4], last; chunk_cumsum(DTp, (size_t)b * SEQ + c * 256, hd, -__expf(p.A_log[hd]), lane, d4, c4, last);
      float4 o = {__expf(last - c4[0]) * d4[0], __expf(last - c4[1]) * d4[1], __expf(last - c4[2]) * d4[2], __expf(last - c4[3]) * d4[3]};
      *(float4*)(wgt + w * 256 + 4 * lane) = o;
      if (lane == 0) DEC[(b * 32 + c) * 32 + hd] = __expf(last);
    }
#pragma unroll 2
    for (int i = 0; i < 8; ++i) {
      const int chunk = tid + 512 * i; const int s8 = (chunk & 31) * 8, n = chunk >> 5; const int ch = 2048 + g * 128 + n;
      float v[8];
      conv8(BT + ((size_t)(b * 512 + g * 128 + n)) * SEQ + c * 256 + s8, !(c == 0 && s8 == 0),
            p.conv_w[ch], p.conv_w[3072 + ch], p.conv_w[2 * 3072 + ch], p.conv_w[3 * 3072 + ch], p.conv_b[ch], v);
      *(bf16x8*)(BTs + n * BT_ROW + s8) = pack8(v);
    }
    __syncthreads();
    f32x16 acc[2][4];
#pragma unroll
    for (int a = 0; a < 2; ++a)
#pragma unroll
      for (int q = 0; q < 4; ++q)
#pragma unroll
        for (int i = 0; i < 16; ++i) acc[a][q][i] = 0.f;
    float xw[2][4], xb[2];
#pragma unroll
    for (int pt = 0; pt < 2; ++pt) {
      const int ch = hd * 64 + pt * 32 + l31;
#pragma unroll
      for (int k = 0; k < 4; ++k) xw[pt][k] = p.conv_w[k * 3072 + ch];
      xb[pt] = p.conv_b[ch];
    }
    for (int kb = 0; kb < 16; kb += 2) {
      uint4 rc[2][2]; uint2 rp[2][2];
#pragma unroll
      for (int i = 0; i < 2; ++i)
#pragma unroll
        for (int pt = 0; pt < 2; ++pt) {
          const int s0 = (kb + i) * 16 + 8 * lh;
          conv8_load(XT + ((size_t)(b * 2048 + hd * 64 + pt * 32 + l31)) * SEQ + c * 256 + s0, !(c == 0 && s0 == 0), rc[i][pt], rp[i][pt]);
        }
#pragma unroll
      for (int i = 0; i < 2; ++i) {
        const int ks = kb + i; const int s0 = ks * 16 + 8 * lh;
        const float4 g0 = *(const float4*)(wgt + w * 256 + s0), g1 = *(const float4*)(wgt + w * 256 + s0 + 4);
        const float wg[8] = {g0.x, g0.y, g0.z, g0.w, g1.x, g1.y, g1.z, g1.w};
        bf16x8 afr[2];
#pragma unroll
        for (int pt = 0; pt < 2; ++pt) {
          float v[8];
          conv8_compute(rc[i][pt], rp[i][pt], xw[pt][0], xw[pt][1], xw[pt][2], xw[pt][3], xb[pt], v);
          *(bf16x8*)(XTC + ((size_t)(hd * 64 + pt * 32 + l31)) * SEQ + c * 256 + s0) = pack8(v);
#pragma unroll
          for (int j = 0; j < 8; ++j) v[j] *= wg[j];
          afr[pt] = pack8(v);
        }
#pragma unroll
        for (int nt = 0; nt < 4; ++nt) {
          const bf16x8 bfr = *(const bf16x8*)(BTs + (nt * 32 + l31) * BT_ROW + ks * 16 + 8 * lh);
#pragma unroll
          for (int pt = 0; pt < 2; ++pt) acc[pt][nt] = MFMA32(afr[pt], bfr, acc[pt][nt]);
        }
      }
    }
    bf16_t* Sp = (bf16_t*)ST + (((size_t)(b * 32 + c) * 32 + hd) * 64) * 128;
#pragma unroll
    for (int pt = 0; pt < 2; ++pt)
#pragma unroll
      for (int nt = 0; nt < 4; ++nt)
#pragma unroll
        for (int r = 0; r < 16; ++r) Sp[(pt * 32 + (r & 3) + 8 * (r >> 2) + 4 * lh) * 128 + nt * 32 + l31] = f2bf(acc[pt][nt][r]);
    __syncthreads();
  }
}

DI void phase_ssd_scan(const Params& p) {
  bf16_t* ST = (bf16_t*)(p.ws + OFF_ST); const float* DEC = (const float*)(p.ws + OFF_DEC);
  for (int idx = blockIdx.x * NTHREADS + otid(); idx < 131072; idx += gridDim.x * NTHREADS) {
    const int n4 = idx & 31, pp = (idx >> 5) & 63, h = (idx >> 11) & 31, b = idx >> 16;
    float run[4] = {0.f, 0.f, 0.f, 0.f};
    bf16_t* base = ST + (((size_t)(b * 32) * 32 + h) * 64 + pp) * 128 + n4 * 4;
    const float* dbase = DEC + (b * 32) * 32 + h;
    for (int c0 = 0; c0 < 32; c0 += 16) {
      uint2 loc[16]; float d[16];
#pragma unroll
      for (int i = 0; i < 16; ++i) { loc[i] = *(const uint2*)(base + (size_t)(c0 + i) * (32 * 64 * 128)); d[i] = dbase[(c0 + i) * 32]; }
#pragma unroll
      for (int i = 0; i < 16; ++i) {
        uint2 o; o.x = pk2(run[0], run[1]); o.y = pk2(run[2], run[3]);
        *(uint2*)(base + (size_t)(c0 + i) * (32 * 64 * 128)) = o;
        run[0] = run[0] * d[i] + lo16(loc[i].x); run[1] = run[1] * d[i] + hi16(loc[i].x);
        run[2] = run[2] * d[i] + lo16(loc[i].y); run[3] = run[3] * d[i] + hi16(loc[i].y);
      }
    }
  }
}

DI void stage_tokmajor(const Params& p, const bf16_t* __restrict__ RAW, int b, int tok0, int nrows, int g, int cbase, bf16_t* dst, int tid_) {
  const int tid = otid(); (void)tid_;
  const int n8 = (tid & 15) * 8; const int ch = cbase + g * 128 + n8;
  float cw[4][8], cb[8];
#pragma unroll
  for (int k = 0; k < 4; ++k) {
    const float4 a = *(const float4*)(p.conv_w + k * 3072 + ch), bq = *(const float4*)(p.conv_w + k * 3072 + ch + 4);
    cw[k][0] = a.x; cw[k][1] = a.y; cw[k][2] = a.z; cw[k][3] = a.w; cw[k][4] = bq.x; cw[k][5] = bq.y; cw[k][6] = bq.z; cw[k][7] = bq.w;
  }
  { const float4 a = *(const float4*)(p.conv_b + ch), bq = *(const float4*)(p.conv_b + ch + 4);
    cb[0] = a.x; cb[1] = a.y; cb[2] = a.z; cb[3] = a.w; cb[4] = bq.x; cb[5] = bq.y; cb[6] = bq.z; cb[7] = bq.w; }
  for (int t = tid >> 4; t < nrows; t += 64) {
    uint4 r[2][4];
#pragma unroll
    for (int u = 0; u < 2; ++u)
#pragma unroll
      for (int k = 0; k < 4; ++k) {
        const int tk = tok0 + t + 32 * u - 3 + k;
        r[u][k] = make_uint4(0u, 0u, 0u, 0u);
        if (tk >= 0) r[u][k] = *(const uint4*)(RAW + ((size_t)b * SEQ + tk) * 512 + g * 128 + n8);
      }
#pragma unroll
    for (int u = 0; u < 2; ++u) {
      float acc[8];
#pragma unroll
      for (int j = 0; j < 8; ++j) acc[j] = cb[j];
#pragma unroll
      for (int k = 0; k < 4; ++k) {
        const uint4 q = r[u][k];
        acc[0] += cw[k][0] * lo16(q.x); acc[1] += cw[k][1] * hi16(q.x); acc[2] += cw[k][2] * lo16(q.y); acc[3] += cw[k][3] * hi16(q.y);
        acc[4] += cw[k][4] * lo16(q.z); acc[5] += cw[k][5] * hi16(q.z); acc[6] += cw[k][6] * lo16(q.w); acc[7] += cw[k][7] * hi16(q.w);
      }
#pragma unroll
      for (int j = 0; j < 8; ++j) acc[j] = fast_silu(acc[j]);
      *(bf16x8*)(dst + (t + 32 * u) * CN_ROW + n8) = pack8(acc);
    }
  }
}

constexpr int S3_CS = 0, S3_BS = 64 * CN_ROW * 2, S3_CB = S3_BS + 256 * CN_ROW * 2, S3_CUM = S3_CB + 64 * BT_ROW * 2, S3_DTS = S3_CUM + 8192,
              S3_PART = S3_DTS + 8192, S3_RSTD = S3_PART + 2048, S3_END = S3_RSTD + 256;

DI void phase_ssd_out(const Params& p, unsigned char* smem) {
  const bf16_t* XT = (const bf16_t*)(p.ws + OFF_XT); const bf16_t* BR = (const bf16_t*)(p.ws + OFF_BR); const bf16_t* CR = (const bf16_t*)(p.ws + OFF_CR);
  const float* DTp = (const float*)(p.ws + OFF_DT); const float* ST = (const float*)(p.ws + OFF_ST); bf16_t* Z = (bf16_t*)p.out;
  bf16_t* Cs = (bf16_t*)(smem + S3_CS); bf16_t* Bs = (bf16_t*)(smem + S3_BS); bf16_t* CBs = (bf16_t*)(smem + S3_CB);
  float* cumA = (float*)(smem + S3_CUM); float* dts = (float*)(smem + S3_DTS); float* part = (float*)(smem + S3_PART); float* rstd = (float*)(smem + S3_RSTD);
  const int tid = otid(), lane = tid & 63, w = tid >> 6, l31 = lane & 31, lh = lane >> 5;
  const bool persist = (gridDim.x == 256);
  for (int u = blockIdx.x; u < 1024; u += gridDim.x) {
    const int tq = u >> 8, rest = u & 255; const int b = rest >> 7, c = (rest >> 2) & 31, g = rest & 3; const int hd = 8 * g + w;
    const int ns = (tq + 1) * 64;
    if (!persist || tq == 0) {
      float d4[4], c4[4], last; chunk_cumsum(DTp, (size_t)b * SEQ + c * 256, hd, -__expf(p.A_log[hd]), lane, d4, c4, last);
      *(float4*)(cumA + w * 256 + 4 * lane) = make_float4(c4[0], c4[1], c4[2], c4[3]);
      *(float4*)(dts + w * 256 + 4 * lane) = make_float4(d4[0], d4[1], d4[2], d4[3]);
    }
    stage_tokmajor(p, CR, b, c * 256 + tq * 64, 64, g, 2560, Cs, tid);
    { const int r0 = persist ? tq * 64 : 0; stage_tokmajor(p, BR, b, c * 256 + r0, ns - r0, g, 2048, Bs + r0 * CN_ROW, tid); }
    __syncthreads();
    if (32 * w < ns) {
      f32x16 a2[2];
#pragma unroll
      for (int a = 0; a < 2; ++a)
#pragma unroll
        for (int i = 0; i < 16; ++i) a2[a][i] = 0.f;
#pragma unroll
      for (int ks = 0; ks < 8; ++ks) {
        const bf16x8 af = *(const bf16x8*)(Bs + (32 * w + l31) * CN_ROW + ks * 16 + 8 * lh);
#pragma unroll
        for (int tt = 0; tt < 2; ++tt) {
          const bf16x8 bq = *(const bf16x8*)(Cs + (tt * 32 + l31) * CN_ROW + ks * 16 + 8 * lh);
          a2[tt] = MFMA32(af, bq, a2[tt]);
        }
      }
#pragma unroll
      for (int tt = 0; tt < 2; ++tt)
#pragma unroll
        for (int rg = 0; rg < 4; ++rg) {
          uint2 o; o.x = pk2(a2[tt][4 * rg], a2[tt][4 * rg + 1]); o.y = pk2(a2[tt][4 * rg + 2], a2[tt][4 * rg + 3]);
          *(uint2*)(CBs + (tt * 32 + l31) * BT_ROW + 32 * w + 8 * rg + 4 * lh) = o;
        }
    }
    __syncthreads();
    f32x16 acc[2][2];
#pragma unroll
    for (int a = 0; a < 2; ++a)
#pragma unroll
      for (int q = 0; q < 2; ++q)
#pragma unroll
        for (int i = 0; i < 16; ++i) acc[a][q][i] = 0.f;
    {
      const bf16_t* Sp = (const bf16_t*)ST + (((size_t)(b * 32 + c) * 32 + hd) * 64) * 128;
      for (int kb = 0; kb < 8; kb += 4) {
        bf16x8 bfr[4][2];
#pragma unroll
        for (int i = 0; i < 4; ++i)
#pragma unroll
          for (int pt = 0; pt < 2; ++pt) bfr[i][pt] = *(const bf16x8*)(Sp + (pt * 32 + l31) * 128 + (kb + i) * 16 + 8 * lh);
#pragma unroll
        for (int i = 0; i < 4; ++i) {
          const int ks = kb + i;
#pragma unroll
          for (int tt = 0; tt < 2; ++tt) {
            const bf16x8 af = *(const bf16x8*)(Cs + (tt * 32 + l31) * CN_ROW + ks * 16 + 8 * lh);
#pragma unroll
            for (int pt = 0; pt < 2; ++pt) acc[tt][pt] = MFMA32(af, bfr[i][pt], acc[tt][pt]);
          }
        }
      }
#pragma unroll
      for (int tt = 0; tt < 2; ++tt)
#pragma unroll
        for (int r = 0; r < 16; ++r) {
          const float e = __expf(cumA[w * 256 + tq * 64 + tt * 32 + (r & 3) + 8 * (r >> 2) + 4 * lh]);
          acc[tt][0][r] *= e; acc[tt][1][r] *= e;
        }
    }
    {
      const float Dh = p.Dskip[hd];
      const int tl0 = tq * 64 + l31, tl1 = tq * 64 + 32 + l31;
      const float ct0 = cumA[w * 256 + tl0], ct1 = cumA[w * 256 + tl1];
      const bf16_t* XTC = (const bf16_t*)(p.ws + (b ? OFF_ST + 32 * MiB : OFF_XN)) + ((size_t)(hd * 64 + l31)) * SEQ + c * 256 + 8 * lh;
      const int nks = ns >> 4;
      for (int kb = 0; kb < nks; kb += 4) {
        bf16x8 xq[4][2];
#pragma unroll
        for (int i = 0; i < 4; ++i)
#pragma unroll
          for (int pt = 0; pt < 2; ++pt) xq[i][pt] = *(const bf16x8*)(XTC + (size_t)pt * 32 * SEQ + (kb + i) * 16);
#pragma unroll
        for (int i = 0; i < 4; ++i) {
          const int ks = kb + i; const int s0 = ks * 16 + 8 * lh;
          const float4 c0 = *(const float4*)(cumA + w * 256 + s0), c1 = *(const float4*)(cumA + w * 256 + s0 + 4);
          const float4 d0 = *(const float4*)(dts + w * 256 + s0), d1 = *(const float4*)(dts + w * 256 + s0 + 4);
          const float cs[8] = {c0.x, c0.y, c0.z, c0.w, c1.x, c1.y, c1.z, c1.w};
          const float ds[8] = {d0.x, d0.y, d0.z, d0.w, d1.x, d1.y, d1.z, d1.w};
          const float cref = cumA[w * 256 + ks * 16];
          const bool steep = (cref - cumA[w * 256 + ks * 16 + 15]) > 60.f;
          float Fs[8];
#pragma unroll
          for (int j = 0; j < 8; ++j) Fs[j] = __expf(fminf(cref - cs[j], 64.f)) * ds[j];
#pragma unroll
          for (int tt = 0; tt < 2; ++tt) {
            if (ks * 16 <= tq * 64 + tt * 32 + 31) {
              const int tl = tt ? tl1 : tl0; const float ct = tt ? ct1 : ct0;
              const float Et = __expf(fminf(ct - cref, 0.f));
              const uint4 cbv = *(const uint4*)(CBs + (tt * 32 + l31) * BT_ROW + s0);
              const float cb[8] = {lo16(cbv.x), hi16(cbv.x), lo16(cbv.y), hi16(cbv.y), lo16(cbv.z), hi16(cbv.z), lo16(cbv.w), hi16(cbv.w)};
              float mv[8];
              if (steep) {
#pragma unroll
                for (int j = 0; j < 8; ++j) {
                  const int sidx = s0 + j;
                  float v = cb[j] * __expf(fminf(ct - cs[j], 0.f)) * ds[j];
                  v = (sidx <= tl) ? v : 0.f;
                  if (sidx == tl) v += Dh;
                  mv[j] = v;
                }
              } else if (ks * 16 + 15 > tq * 64 + tt * 32) {
#pragma unroll
                for (int j = 0; j < 8; ++j) {
                  const int sidx = s0 + j;
                  float v = cb[j] * (Et * Fs[j]);
                  v = (sidx <= tl) ? v : 0.f;
                  if (sidx == tl) v += Dh;
                  mv[j] = v;
                }
              } else {
#pragma unroll
                for (int j = 0; j < 8; ++j) mv[j] = cb[j] * (Et * Fs[j]);
              }
              const bf16x8 af = pack8(mv);
#pragma unroll
              for (int pt = 0; pt < 2; ++pt) acc[tt][pt] = MFMA32(af, xq[i][pt], acc[tt][pt]);
            }
          }
        }
      }
    }
    const size_t tokb = (size_t)b * SEQ + c * 256 + tq * 64;
#pragma unroll
    for (int tt = 0; tt < 2; ++tt)
#pragma unroll
      for (int r = 0; r < 16; ++r) {
        const int tloc = tt * 32 + (r & 3) + 8 * (r >> 2) + 4 * lh;
        const bf16_t* zp = Z + (tokb + tloc) * 2048 + hd * 64 + l31;
        const float y0 = acc[tt][0][r] * silu_f(bf2f(zp[0])), y1 = acc[tt][1][r] * silu_f(bf2f(zp[32]));
        acc[tt][0][r] = y0; acc[tt][1][r] = y1;
        float v = y0 * y0 + y1 * y1;
        v += swz_xor<1>(v); v += swz_xor<2>(v); v += swz_xor<4>(v); v += swz_xor<8>(v); v += swz_xor<16>(v);
        if (l31 == 0) part[w * 64 + tloc] = v;
      }
    __syncthreads();
    if (tid < 64) {
      float sres = 0.f;
#pragma unroll
      for (int ww = 0; ww < 8; ++ww) sres += part[ww * 64 + tid];
      rstd[tid] = rsqrtf(sres * (1.f / 512.f) + 1e-6f);
    }
    __syncthreads();
#pragma unroll
    for (int tt = 0; tt < 2; ++tt)
#pragma unroll
      for (int r = 0; r < 16; ++r) {
        const int tloc = tt * 32 + (r & 3) + 8 * (r >> 2) + 4 * lh;
        const float rs = rstd[tloc];
        bf16_t* zp = Z + (tokb + tloc) * 2048 + hd * 64 + l31;
        zp[0] = f2bf(acc[tt][0][r] * rs); zp[32] = f2bf(acc[tt][1][r] * rs);
      }
    __syncthreads();
  }
}

constexpr int KROW = 104;
constexpr int VROW = 68;
constexpr int ATT_K_BYTES = 64 * KROW * 2;
constexpr int ATT_V_BYTES = 64 * VROW * 2;
constexpr int ATT_STAGE = ATT_K_BYTES + ATT_V_BYTES;

DI void attn_kload(const bf16_t* sK, bf16x8 (&kf)[2][6], int l31, int lh) {
#pragma unroll
  for (int sub = 0; sub < 2; ++sub)
#pragma unroll
    for (int ks = 0; ks < 6; ++ks) kf[sub][ks] = *(const bf16x8*)(sK + (sub * 32 + l31) * KROW + ks * 16 + lh * 8);
}
DI void attn_qkmma(const bf16x8 (&kf)[2][6], const bf16x8 (&qf)[6], f32x16 (&sc)[2]) {
#pragma unroll
  for (int sub = 0; sub < 2; ++sub)
#pragma unroll
    for (int i = 0; i < 16; ++i) sc[sub][i] = 0.f;
#pragma unroll
  for (int ks = 0; ks < 6; ++ks)
#pragma unroll
    for (int sub = 0; sub < 2; ++sub) sc[sub] = MFMA32(kf[sub][ks], qf[ks], sc[sub]);
}
DI void attn_qk(const bf16_t* sK, const bf16x8 (&qf)[6], f32x16 (&sc)[2], int l31, int lh) {
  bf16x8 kf[2][6]; attn_kload(sK, kf, l31, lh); attn_qkmma(kf, qf, sc);
}

template <bool MASK>
DI void attn_softmax(f32x16 (&sc)[2], f32x16 (&o)[2], float& m, float& l, int kt, int myq, int lh) {
  float tmax = -1e30f;
#pragma unroll
  for (int sub = 0; sub < 2; ++sub)
#pragma unroll
    for (int r = 0; r < 16; ++r) {
      if (MASK) { const int key = kt * 64 + sub * 32 + (r & 3) + 8 * (r >> 2) + 4 * lh; if (key > myq) sc[sub][r] = -1e30f; }
      tmax = fmaxf(tmax, sc[sub][r]);
    }
  tmax = fmaxf(tmax, __shfl_xor(tmax, 32));
  if (__builtin_amdgcn_ballot_w64(tmax - m > 8.f) != 0) {
    const float mn = fmaxf(m, tmax); const float al = __builtin_amdgcn_exp2f(m - mn); m = mn;
    l *= al;
#pragma unroll
    for (int a = 0; a < 2; ++a)
#pragma unroll
      for (int i = 0; i < 16; ++i) o[a][i] *= al;
  }
  f32x2 ps2 = {0.f, 0.f}; const f32x2 mn2 = {m, m};
#pragma unroll
  for (int sub = 0; sub < 2; ++sub)
#pragma unroll
    for (int r = 0; r < 16; r += 2) {
      f32x2 d = {sc[sub][r], sc[sub][r + 1]}; d = d - mn2;
      f32x2 pe; pe.x = __builtin_amdgcn_exp2f(d.x); pe.y = __builtin_amdgcn_exp2f(d.y);
      sc[sub][r] = pe.x; sc[sub][r + 1] = pe.y; ps2 = ps2 + pe;
    }
  l += ps2.x + ps2.y;
}
DI void attn_pv(const f32x16 (&sc)[2], f32x16 (&o)[2], const bf16_t* sV, int l31, int lh) {
#pragma unroll
  for (int sub = 0; sub < 2; ++sub)
#pragma unroll
    for (int s2 = 0; s2 < 2; ++s2) {
      uint4 pu; pu.x = pk2(sc[sub][8 * s2], sc[sub][8 * s2 + 1]); pu.y = pk2(sc[sub][8 * s2 + 2], sc[sub][8 * s2 + 3]);
      pu.z = pk2(sc[sub][8 * s2 + 4], sc[sub][8 * s2 + 5]); pu.w = pk2(sc[sub][8 * s2 + 6], sc[sub][8 * s2 + 7]);
      const bf16x8 pb = __builtin_bit_cast(bf16x8, pu);
#pragma unroll
      for (int dvt = 0; dvt < 2; ++dvt) {
        const bf16_t* vp = sV + (dvt * 32 + l31) * VROW + sub * 32 + 16 * s2 + 4 * lh;
        const uint2 lo = *(const uint2*)vp, hi = *(const uint2*)(vp + 8);
        uint4 vu = {lo.x, lo.y, hi.x, hi.y};
        o[dvt] = MFMA32(__builtin_bit_cast(bf16x8, vu), pb, o[dvt]);
      }
    }
}

DI void attn_unit(const Params& p, int b, int h, int qb, unsigned char* smem) {
  const bf16_t* Q = (const bf16_t*)p.out; const bf16_t* KN = (const bf16_t*)(p.ws + OFF_XN); const bf16_t* VT = (const bf16_t*)(p.ws + OFF_BT);
  const bf16_t* KROPE = (const bf16_t*)(p.ws + OFF_DEC); const bf16_t* GATE = (const bf16_t*)(p.ws + OFF_ST); bf16_t* O = (bf16_t*)(p.ws + OFF_ST + 32 * MiB);
  const int tid = otid(), lane = tid & 63, w = tid >> 6, l31 = lane & 31, lh = lane >> 5;
  const int q0 = qb * 256, qw0 = q0 + 32 * w, myq = qw0 + l31;
  const size_t tq = (size_t)b * SEQ + myq;
  bf16x8 qf[6];
#pragma unroll
  for (int ks = 0; ks < 6; ++ks) qf[ks] = *(const bf16x8*)(Q + tq * 1536 + h * 96 + ks * 16 + lh * 8);
  f32x16 o[2];
#pragma unroll
  for (int a = 0; a < 2; ++a)
#pragma unroll
    for (int i = 0; i < 16; ++i) o[a][i] = 0.f;
  float m = -1e30f, l = 0.f;
  const int ntiles = 4 * qb + 4;
  const int nact = (qw0 + 31) / 64 + 1;
  const int kr = tid >> 3, kc = (tid & 7) * 8;
  const int rr = (tid & 255) >> 2, rc = (tid & 3) * 8;
  const bf16_t* gK = KN + ((size_t)b * SEQ + kr) * 1024 + h * 64 + kc;
  const bf16_t* gR = KROPE + ((size_t)b * SEQ + rr) * 32 + rc;
  const bf16_t* gV = VT + ((size_t)((b * 16 + h) * 64 + kr)) * SEQ + kc;
  uint4 rk, rr4, rv;
#define ATT_LOAD(T) do { rk = *(const uint4*)(gK + (size_t)(T) * 64 * 1024); rr4 = *(const uint4*)(gR + (size_t)(T) * 64 * 32); rv = *(const uint4*)(gV + (T) * 64); } while (0)
#define ATT_STORE(ST_) do { bf16_t* dK_ = (bf16_t*)(smem + (ST_) * ATT_STAGE); bf16_t* dV_ = (bf16_t*)(smem + (ST_) * ATT_STAGE + ATT_K_BYTES); \
    *(uint4*)(dK_ + kr * KROW + kc) = rk; *(uint4*)(dK_ + rr * KROW + 64 + rc) = rr4; \
    *(uint2*)(dV_ + kr * VROW + kc) = make_uint2(rv.x, rv.y); *(uint2*)(dV_ + kr * VROW + kc + 4) = make_uint2(rv.z, rv.w); } while (0)
  ATT_LOAD(0); ATT_STORE(0);
  ATT_LOAD(1); ATT_STORE(1);
  ATT_LOAD(2);
  __syncthreads();
  f32x16 sc[2], sn[2];
  attn_qk((const bf16_t*)smem, qf, sc, l31, lh);
  int st = 0;
  int kt = 0;
  for (; kt < nact - 1; ++kt) {
    const int st1 = (st == 2) ? 0 : st + 1, st2 = (st1 == 2) ? 0 : st1 + 1;
    ATT_STORE(st2);
    { const int tl = (kt + 3 < ntiles) ? kt + 3 : ntiles - 1; ATT_LOAD(tl); }
    attn_qk((const bf16_t*)(smem + st1 * ATT_STAGE), qf, sn, l31, lh);
    attn_softmax<false>(sc, o, m, l, kt, myq, lh);
    attn_pv(sc, o, (const bf16_t*)(smem + st * ATT_STAGE + ATT_K_BYTES), l31, lh);
    __syncthreads();
#pragma unroll
    for (int sub = 0; sub < 2; ++sub) sc[sub] = sn[sub];
    st = st1;
  }
  {
    const int st1 = (st == 2) ? 0 : st + 1, st2 = (st1 == 2) ? 0 : st1 + 1;
    ATT_STORE(st2);
    { const int tl = (kt + 3 < ntiles) ? kt + 3 : ntiles - 1; ATT_LOAD(tl); }
    attn_softmax<true>(sc, o, m, l, kt, myq, lh);
    attn_pv(sc, o, (const bf16_t*)(smem + st * ATT_STAGE + ATT_K_BYTES), l31, lh);
    __syncthreads();
    st = st1; ++kt;
  }
  for (; kt < ntiles; ++kt) {
    const int st1 = (st == 2) ? 0 : st + 1, st2 = (st1 == 2) ? 0 : st1 + 1;
    ATT_STORE(st2);
    { const int tl = (kt + 3 < ntiles) ? kt + 3 : ntiles - 1; ATT_LOAD(tl); }
    __syncthreads();
    st = st1;
  }
#undef ATT_LOAD
#undef ATT_STORE
  l += __shfl_xor(l, 32);
  const float il = 1.f / l;
#pragma unroll
  for (int dvt = 0; dvt < 2; ++dvt)
#pragma unroll
    for (int rg = 0; rg < 4; ++rg) {
      const int dv = dvt * 32 + 8 * rg + 4 * lh;
      const uint2 gv = *(const uint2*)(GATE + tq * 1024 + h * 64 + dv);
      const float g0 = __uint_as_float(gv.x << 16), g1 = __uint_as_float(gv.x & 0xffff0000u), g2 = __uint_as_float(gv.y << 16), g3 = __uint_as_float(gv.y & 0xffff0000u);
      uint2 ov; ov.x = pk2(o[dvt][4 * rg] * il * g0, o[dvt][4 * rg + 1] * il * g1); ov.y = pk2(o[dvt][4 * rg + 2] * il * g2, o[dvt][4 * rg + 3] * il * g3);
      *(uint2*)(O + tq * 1024 + h * 64 + dv) = ov;
    }
}

DI void phase_attn(const Params& p, unsigned char* smem) {
  for (int u = blockIdx.x; u < 512; u += gridDim.x) {
    int pu = u;
    if (gridDim.x == 256) {
      const int xcd = blockIdx.x & 7, li = blockIdx.x >> 3, r = u >> 8;
      pu = (r * 16 + xcd * 2 + (li >> 4)) * 16 + (li & 15);
    }
    const int bh = pu >> 4, x = pu & 15;
    for (int half = 0; half < 2; ++half) attn_unit(p, bh >> 4, bh & 15, half ? x : 31 - x, smem);
  }
}

DI void phase_final_norm(const Params& p) {
  const int tid = otid(); const int lane = tid & 63, w = tid >> 6;
  float4 g[4];
#pragma unroll
  for (int i = 0; i < 4; ++i) g[i] = ((const float4*)p.g_final)[lane + 64 * i];
  for (int row = (blockIdx.x * 8 + w) * 2; row < T; row += gridDim.x * 16) {
    float4 v[2][4]; float ss[2] = {0.f, 0.f};
#pragma unroll
    for (int u = 0; u < 2; ++u)
#pragma unroll
      for (int i = 0; i < 4; ++i) v[u][i] = ((const float4*)(p.out + (size_t)(row + u) * DM))[lane + 64 * i];
#pragma unroll
    for (int u = 0; u < 2; ++u) {
#pragma unroll
      for (int i = 0; i < 4; ++i) ss[u] += v[u][i].x * v[u][i].x + v[u][i].y * v[u][i].y + v[u][i].z * v[u][i].z + v[u][i].w * v[u][i].w;
      ss[u] = wave_sum(ss[u]);
      const float r = rsqrtf(ss[u] * (1.f / 1024.f) + 1e-6f);
#pragma unroll
      for (int i = 0; i < 4; ++i)
        ((float4*)(p.out + (size_t)(row + u) * DM))[lane + 64 * i] = make_float4(v[u][i].x * r * g[i].x, v[u][i].y * r * g[i].y, v[u][i].z * r * g[i].z, v[u][i].w * r * g[i].w);
    }
  }
}

__global__ void __launch_bounds__(NTHREADS) mega(Params p) {
  cg::grid_group grid = cg::this_grid();
  extern __shared__ __attribute__((aligned(16))) unsigned char smem[];
  unsigned char* ws = p.ws;
  __shared__ unsigned bar_st[4];
  if (threadIdx.x < 4) bar_st[threadIdx.x] = 0u;
  __syncthreads();
  const XcdBarrier xb = xcd_barrier_post((unsigned*)(ws + OFF_BAR), bar_st);
  const bool tailfill = (gridDim.x == 256);
  phase_prep(p, smem, blockIdx.x, tailfill ? 1344 : 2832, gridDim.x);
  if (!tailfill) phase_rope_tables(p, blockIdx.x, gridDim.x);
  phase_rmsnorm_rows(p.x, (bf16_t*)(ws + OFF_XN));
  if (p.out == nullptr) grid.sync();
  xcd_barrier(xb);
  gemm_phase<EPI_SSM_IN, 1024>(p, (const bf16_t*)(ws + OFF_W1), (const bf16_t*)(ws + OFF_XN), 21, smem);
  if (tailfill && (blockIdx.x >> 3) >= 8) {
    const int tj = (blockIdx.x & 7) * 24 + ((blockIdx.x >> 3) - 8);
    phase_prep(p, smem, 1344 + tj, 2832, 192);
    phase_rope_tables(p, tj, 192);
  }
  xcd_barrier(xb);
  phase_ssd_state(p, smem);
  xcd_barrier(xb);
  phase_ssd_scan(p);
  xcd_barrier(xb);
  phase_ssd_out(p, smem);
  xcd_barrier(xb);
  gemm_phase<EPI_OUT1, 2048>(p, (const bf16_t*)(ws + OFF_W2), (const bf16_t*)p.out, 4, smem);
  xcd_barrier(xb);
  gemm_phase<EPI_MLA_IN, 1024>(p, (const bf16_t*)(ws + OFF_W3), (const bf16_t*)(ws + OFF_XN), 7, smem);
  xcd_barrier(xb);
  gemm_phase<EPI_KVUP, 256>(p, (const bf16_t*)(ws + OFF_W4), (const bf16_t*)(ws + OFF_ST + 32 * MiB), 8, smem);
  gemm_phase<EPI_QUP, 384>(p, (const bf16_t*)(ws + OFF_W5), (const bf16_t*)(ws + OFF_ST + 40 * MiB), 6, smem);
  xcd_barrier(xb);
  phase_attn(p, smem);
  xcd_barrier(xb);
  gemm_phase<EPI_OUT2, 1024>(p, (const bf16_t*)(ws + OFF_W6), (const bf16_t*)(ws + OFF_ST + 32 * MiB), 4, smem);
  xcd_barrier(xb);
  phase_final_norm(p);
}

extern "C" void kernel_launch(void* const* d_in, const int* in_sizes, int n_in, void* d_out, int out_size, void* d_ws, size_t ws_size, hipStream_t stream) {
  static int grid = 0;
  if (grid == 0) {
    if (n_in != 20 || ws_size < WS_NEED) { fprintf(stderr, "kernel_launch: unexpected n_in %d / ws_size %zu\n", n_in, ws_size); grid = -1; return; }
    int dev = 0, cus = 0, per_cu = 0;
    hipGetDevice(&dev);
    hipDeviceGetAttribute(&cus, hipDeviceAttributeMultiprocessorCount, dev);
    if (hipFuncSetAttribute((const void*)mega, hipFuncAttributeMaxDynamicSharedMemorySize, LDS_BYTES) != hipSuccess) { fprintf(stderr, "hipFuncSetAttribute failed\n"); grid = -1; return; }
    hipOccupancyMaxActiveBlocksPerMultiprocessor(&per_cu, (const void*)mega, NTHREADS, LDS_BYTES);
    if (per_cu < 1) per_cu = 1;
    (void)hipGetLastError();
    grid = cus;
  }
  if (grid < 0) return;
  Params p{};
  p.x = (const float*)d_in[0]; p.pos = (const int*)d_in[1]; p.g_pre = (const float*)d_in[2]; p.ssm_w_in = (const float*)d_in[3];
  p.conv_w = (const float*)d_in[4]; p.conv_b = (const float*)d_in[5]; p.dt_bias = (const float*)d_in[6]; p.A_log = (const float*)d_in[7];
  p.Dskip = (const float*)d_in[8]; p.g_out = (const float*)d_in[9]; p.ssm_w_out = (const float*)d_in[10]; p.kv_g_in = (const float*)d_in[11];
  p.kv_w_down = (const float*)d_in[12]; p.kv_g_lat = (const float*)d_in[13]; p.kv_w_up = (const float*)d_in[14]; p.mla_w_in = (const float*)d_in[15];
  p.mla_g_q = (const float*)d_in[16]; p.mla_w_uq = (const float*)d_in[17]; p.mla_w_out = (const float*)d_in[18]; p.g_final = (const float*)d_in[19];
  p.out = (float*)d_out; p.ws = (unsigned char*)d_ws;
  if (hipMemsetAsync((char*)d_ws + OFF_BAR, 0, XCD_BAR_WORDS * sizeof(unsigned), stream) != hipSuccess) { fprintf(stderr, "memset of barrier words failed\n"); return; }
  void* args[] = {&p};
  hipError_t e = hipLaunchCooperativeKernel((const void*)mega, dim3(grid), dim3(NTHREADS), args, LDS_BYTES, stream);
  if (e != hipSuccess) fprintf(stderr, "cooperative launch failed: %s (grid %d)\n", hipGetErrorString(e), grid);
}
```

```cpp
#include <hip/hip_runtime.h>
#include <hip/hip_cooperative_groups.h>
#include <cstdio>
#include <cstdint>
namespace cg = cooperative_groups;

typedef unsigned short bf16_t;
typedef short bf16x8 __attribute__((ext_vector_type(8)));
typedef float f32x16 __attribute__((ext_vector_type(16)));
#define DI __device__ __forceinline__
#define MFMA32(a, b, c) __builtin_amdgcn_mfma_f32_32x32x16_bf16((a), (b), (c), 0, 0, 0)

constexpr int T = 16384, SEQ = 8192, DM = 1024;
constexpr int NTHREADS = 512;
constexpr size_t MiB = 1024 * 1024;
constexpr size_t OFF_W1 = 0;
constexpr size_t OFF_W2 = OFF_W1 + (size_t)5376 * 1024 * 2;
constexpr size_t OFF_W3 = OFF_W2 + (size_t)1024 * 2048 * 2;
constexpr size_t OFF_W4 = OFF_W3 + (size_t)1792 * 1024 * 2;
constexpr size_t OFF_W5 = OFF_W4 + (size_t)2048 * 256 * 2;
constexpr size_t OFF_W6 = OFF_W5 + (size_t)1536 * 384 * 2;
constexpr size_t OFF_XN = 24 * MiB;
constexpr size_t OFF_XT = 56 * MiB;
constexpr size_t OFF_BT = 120 * MiB;
constexpr size_t OFF_BR = 136 * MiB;
constexpr size_t OFF_CR = 152 * MiB;
constexpr size_t OFF_DT = 168 * MiB;
constexpr size_t OFF_ST = 170 * MiB;
constexpr size_t OFF_DEC = 234 * MiB;
constexpr size_t OFF_BAR = 236 * MiB;
constexpr size_t OFF_COS = 238 * MiB;
constexpr size_t OFF_SIN = 239 * MiB;
constexpr size_t OFF_SSQ = 240 * MiB;
constexpr size_t WS_NEED = 241 * MiB;

struct Params {
  const float* x; const int* pos; const float* g_pre; const float* ssm_w_in; const float* conv_w; const float* conv_b;
  const float* dt_bias; const float* A_log; const float* Dskip; const float* g_out; const float* ssm_w_out;
  const float* kv_g_in; const float* kv_w_down; const float* kv_g_lat; const float* kv_w_up;
  const float* mla_w_in; const float* mla_g_q; const float* mla_w_uq; const float* mla_w_out; const float* g_final;
  float* out; unsigned char* ws;
};

DI bf16_t f2bf(float x) { unsigned u = __float_as_uint(x); u += 0x7fffu + ((u >> 16) & 1u); return (bf16_t)(u >> 16); }
DI float bf2f(bf16_t b) { return __uint_as_float(((unsigned)b) << 16); }
DI float lo16(unsigned u) { return __uint_as_float(u << 16); }
DI float hi16(unsigned u) { return __uint_as_float(u & 0xffff0000u); }
typedef float f32x2 __attribute__((ext_vector_type(2)));
typedef __bf16 bf16x2_t __attribute__((ext_vector_type(2)));
DI unsigned pk2(float a, float b) { f32x2 v = {a, b}; bf16x2_t r = __builtin_convertvector(v, bf16x2_t); return __builtin_bit_cast(unsigned, r); }
DI float wave_sum(float v) {
#pragma unroll
  for (int o = 32; o >= 1; o >>= 1) v += __shfl_xor(v, o);
  return v;
}
DI int otid() { int t = threadIdx.x; asm volatile("" : "+v"(t)); return t; }
template <int K> DI float swz_xor(float v) {
  return __int_as_float(__builtin_amdgcn_ds_swizzle(__float_as_int(v), (K << 10) | 0x1f));
}
DI float silu_f(float v) { return v * __builtin_amdgcn_rcpf(1.f + __expf(-v)); }


#define XB_TMO      128
#define XB_XCNT(j)  (256  + 64 * (j))
#define XB_XSUB(j)  (1280 + 64 * (j))
#define XB_XGEN(j)  (2304 + 64 * (j))
#define XB_TOP      3328
#define XB_TOPGEN   3392
#define XCD_BAR_WORDS 3456
#define XB_SPIN_CAP (1u << 18)
DI unsigned xb_ld(unsigned* p)              { return __hip_atomic_load(p, __ATOMIC_RELAXED, __HIP_MEMORY_SCOPE_AGENT); }
DI unsigned xb_add(unsigned* p, unsigned v) { return __hip_atomic_fetch_add(p, v, __ATOMIC_RELAXED, __HIP_MEMORY_SCOPE_AGENT); }
DI unsigned xb_xcc_id() { return (unsigned)__builtin_amdgcn_s_getreg((3 << 11) | 20) & 0xFu; }
#define XB_SPIN(cond, bar) do { unsigned _sp = 0; while (cond) { __builtin_amdgcn_s_sleep(1); \
    if ((++_sp & 255u) == 0u) { if (xb_ld(&(bar)[XB_TMO])) break; if (_sp > XB_SPIN_CAP) { atomicAdd(&(bar)[XB_TMO], 1u); break; } } } } while (0)
struct XcdBarrier { unsigned* bar; unsigned x; volatile unsigned* st; };
DI XcdBarrier xcd_barrier_post(unsigned* bar, volatile unsigned* st) {
  XcdBarrier b; b.bar = bar; b.x = xb_xcc_id(); b.st = st;
  if (threadIdx.x == 0) (void)xb_add(&bar[XB_XCNT(b.x)], 1u);
  return b;
}
DI void xcd_barrier_complete(unsigned* bar, unsigned x, unsigned& nloc, unsigned& nx) {
  const unsigned G = gridDim.x * gridDim.y * gridDim.z;
  unsigned sum, cnt, mine, sp = 0u;
  for (;;) {
    sum = 0u; cnt = 0u; mine = 0u;
#pragma unroll
    for (unsigned j = 0; j < 16; ++j) { const unsigned c = xb_ld(&bar[XB_XCNT(j)]); sum += c; cnt += (c > 0u) ? 1u : 0u; mine = (j == x) ? c : mine; }
    if (sum == G) break;
    __builtin_amdgcn_s_sleep(1);
    if ((++sp & 255u) == 0u) { if (xb_ld(&bar[XB_TMO])) break; if (sp > XB_SPIN_CAP) { atomicAdd(&bar[XB_TMO], 1u); break; } }
  }
  nloc = mine > 0u ? mine : 1u; nx = cnt > 0u ? cnt : 1u;
}
DI void xcd_barrier(const XcdBarrier& b) {
  asm volatile("s_waitcnt vmcnt(0)" ::: "memory");
  __syncthreads();
  if (threadIdx.x == 0) {
    unsigned* bar = b.bar;
    __builtin_amdgcn_s_waitcnt(0);
    unsigned nloc = b.st[0], nx = b.st[1];
    if (nloc == 0u) { xcd_barrier_complete(bar, b.x, nloc, nx); b.st[0] = nloc; b.st[1] = nx; }
    const unsigned old = xb_add(&bar[XB_XSUB(b.x)], 1u);
    const unsigned gen = old / nloc;
    if (old + 1u == (gen + 1u) * nloc) {
      __builtin_amdgcn_fence(__ATOMIC_RELEASE, "agent");
      asm volatile("s_waitcnt vmcnt(0)" ::: "memory");
      const unsigned og = xb_add(&bar[XB_TOP], 1u);
      const unsigned tg = og / nx;
      if (og + 1u == (tg + 1u) * nx) xb_add(&bar[XB_TOPGEN], 1u);
      else XB_SPIN(xb_ld(&bar[XB_TOPGEN]) == tg, bar);
      __builtin_amdgcn_fence(__ATOMIC_ACQUIRE, "agent");
      xb_add(&bar[XB_XGEN(b.x)], 1u);
      asm volatile("s_waitcnt vmcnt(0)" ::: "memory");
    } else {
      XB_SPIN(xb_ld(&bar[XB_XGEN(b.x)]) == gen, bar);
      __builtin_amdgcn_fence(__ATOMIC_ACQUIRE, "agent");
      asm volatile("s_waitcnt vmcnt(0)" ::: "memory");
    }
  }
  __syncthreads();
}

struct WJob { const float* src; const float* gain; bf16_t* dst; int ld, col0, ncols, K, tile; };
DI WJob wprep_job(const Params& p, int u) {
  bf16_t* W1 = (bf16_t*)(p.ws + OFF_W1); bf16_t* W2 = (bf16_t*)(p.ws + OFF_W2); bf16_t* W3 = (bf16_t*)(p.ws + OFF_W3);
  bf16_t* W4 = (bf16_t*)(p.ws + OFF_W4); bf16_t* W5 = (bf16_t*)(p.ws + OFF_W5); bf16_t* W6 = (bf16_t*)(p.ws + OFF_W6);
  int t = u; WJob j;
  if (t < 1344) { j = {p.ssm_w_in, p.g_pre, W1, 5152, 0, 5152, 1024, t}; return j; } t -= 1344;
  if (t < 512) { j = {p.ssm_w_out, p.g_out, W2, 1024, 0, 1024, 2048, t}; return j; } t -= 512;
  if (t < 64) { j = {p.kv_w_down, p.kv_g_in, W3, 288, 0, 256, 1024, t}; return j; } t -= 64;
  if (t < 96) { j = {p.mla_w_in, p.g_pre + 1024, W3 + (size_t)256 * 1024, 1408, 0, 384, 1024, t}; return j; } t -= 96;
  if (t < 256) { j = {p.mla_w_in, p.g_pre + 1024, W3 + (size_t)640 * 1024, 1408, 384, 1024, 1024, t}; return j; } t -= 256;
  if (t < 32) { j = {p.kv_w_down, p.kv_g_in, W3 + (size_t)1664 * 1024, 288, 256, 32, 1024, t}; return j; } t -= 32;
  if (t < 128) { j = {p.kv_w_up, p.kv_g_lat, W4, 2048, 0, 2048, 256, t}; return j; } t -= 128;
  if (t < 144) { j = {p.mla_w_uq, p.mla_g_q, W5, 1536, 0, 1536, 384, t}; return j; } t -= 144;
  j = {p.mla_w_out, nullptr, W6, 1024, 0, 1024, 1024, t}; return j;
}
DI void wprep_load(const WJob& j, int tid0, float4 (&v)[2], float (&gk)[2]) {
  const int nkt = j.K >> 6; const int tn = j.tile / nkt, tk = j.tile % nkt; const int n0 = tn * 64, k0 = tk * 64;
#pragma unroll
  for (int i = 0; i < 2; ++i) {
    const int e = tid0 + NTHREADS * i; const int kk = e >> 4, n4 = (e & 15) * 4;
    v[i] = make_float4(0.f, 0.f, 0.f, 0.f);
    if (n0 + n4 < j.ncols) v[i] = *(const float4*)(j.src + (size_t)(k0 + kk) * j.ld + j.col0 + n0 + n4);
    gk[i] = j.gain ? j.gain[k0 + kk] : 1.f;
  }
}
DI void phase_prep(const Params& p, unsigned char* smem, int ustart, int uend, int ustride) {
  float* sm = (float*)smem;
  const int tid0 = otid();
  int u = ustart;
  if (u >= uend) return;
  WJob j = wprep_job(p, u);
  float4 v[2]; float gk[2];
  wprep_load(j, tid0, v, gk);
  for (;;) {
#pragma unroll
    for (int i = 0; i < 2; ++i) {
      const int e = tid0 + NTHREADS * i; const int kk = e >> 4, n4 = (e & 15) * 4;
      float* d = sm + kk * 65 + n4;
      d[0] = v[i].x * gk[i]; d[1] = v[i].y * gk[i]; d[2] = v[i].z * gk[i]; d[3] = v[i].w * gk[i];
    }
    __syncthreads();
    const WJob jc = j;
    const int un = u + ustride; const bool more = (un < uend);
    if (more) { j = wprep_job(p, un); wprep_load(j, tid0, v, gk); }
    {
      const int nkt = jc.K >> 6; const int tn = jc.tile / nkt, tk = jc.tile % nkt; const int n0 = tn * 64, k0 = tk * 64;
      const int nn = tid0 >> 3, kc = (tid0 & 7) * 8;
      uint4 o;
      o.x = pk2(sm[(kc + 0) * 65 + nn], sm[(kc + 1) * 65 + nn]); o.y = pk2(sm[(kc + 2) * 65 + nn], sm[(kc + 3) * 65 + nn]);
      o.z = pk2(sm[(kc + 4) * 65 + nn], sm[(kc + 5) * 65 + nn]); o.w = pk2(sm[(kc + 6) * 65 + nn], sm[(kc + 7) * 65 + nn]);
      *(uint4*)(jc.dst + (size_t)(n0 + nn) * jc.K + k0 + kc) = o;
    }
    __syncthreads();
    if (!more) break;
    u = un;
  }
}

DI void phase_rope_tables(const Params& p, int blk, int nblk) {
  float* COS = (float*)(p.ws + OFF_COS); float* SIN = (float*)(p.ws + OFF_SIN);
  for (int e = blk * NTHREADS + otid(); e < T * 16; e += nblk * NTHREADS) {
    const int t = e >> 4, i = e & 15;
    const float ang = (float)p.pos[t] * powf(10000.f, -(float)(2 * i) / 32.f);
    COS[e] = cosf(ang); SIN[e] = sinf(ang);
  }
  float* SSQ = (float*)(p.ws + OFF_SSQ);
  for (int e = blk * NTHREADS + otid(); e < 3 * T; e += nblk * NTHREADS) SSQ[e] = 0.f;
}

DI void phase_rmsnorm_rows(const float* __restrict__ src, bf16_t* __restrict__ dst) {
  const int tid = otid(); const int lane = tid & 63, w = tid >> 6;
  for (int row = (blockIdx.x * 8 + w) * 2; row < T; row += gridDim.x * 16) {
    float4 v[2][4]; float ss[2] = {0.f, 0.f};
#pragma unroll
    for (int u = 0; u < 2; ++u)
#pragma unroll
      for (int i = 0; i < 4; ++i) v[u][i] = ((const float4*)(src + (size_t)(row + u) * DM))[lane + 64 * i];
#pragma unroll
    for (int u = 0; u < 2; ++u) {
#pragma unroll
      for (int i = 0; i < 4; ++i) ss[u] += v[u][i].x * v[u][i].x + v[u][i].y * v[u][i].y + v[u][i].z * v[u][i].z + v[u][i].w * v[u][i].w;
      ss[u] = wave_sum(ss[u]);
      const float r = rsqrtf(ss[u] * (1.f / 1024.f) + 1e-6f);
#pragma unroll
      for (int i = 0; i < 4; ++i) {
        uint2 o; o.x = pk2(v[u][i].x * r, v[u][i].y * r); o.y = pk2(v[u][i].z * r, v[u][i].w * r);
        *(uint2*)(dst + (size_t)(row + u) * DM + (lane + 64 * i) * 4) = o;
      }
    }
  }
}

enum { EPI_SSM_IN = 0, EPI_OUT1 = 1, EPI_MLA_IN = 2, EPI_KVUP = 3, EPI_QUP = 4, EPI_OUT2 = 5 };


typedef float f32x4 __attribute__((ext_vector_type(4)));
constexpr int EPI_WAVE_BYTES = 8704;
constexpr int TM_ROW = 72;
constexpr int CM_ROW = 40;
constexpr int F32_ROW = 68;

template <bool SILU>
DI void stage_tm(const f32x4 (&a)[4][2], bf16_t* wl, int fr, int fq) {
#pragma unroll
  for (int m = 0; m < 4; ++m)
#pragma unroll
    for (int n = 0; n < 2; ++n) {
      float v0 = a[m][n][0], v1 = a[m][n][1], v2 = a[m][n][2], v3 = a[m][n][3];
      if (SILU) { v0 = silu_f(v0); v1 = silu_f(v1); v2 = silu_f(v2); v3 = silu_f(v3); }
      uint2 o; o.x = pk2(v0, v1); o.y = pk2(v2, v3);
      *(uint2*)(wl + (n * 16 + fr) * TM_ROW + m * 16 + fq * 4) = o;
    }
}
DI void readout_tm(const bf16_t* wl, bf16_t* gdst, size_t ld, int lane) {
#pragma unroll
  for (int it = 0; it < 4; ++it) {
    const int idx = lane + 64 * it; const int row = idx >> 3, ch = idx & 7;
    *(uint4*)(gdst + (size_t)row * ld + ch * 8) = *(const uint4*)(wl + row * TM_ROW + ch * 8);
  }
}
DI void stage_cm(const f32x4 (&a)[4][2], bf16_t* wl, int fr, int fq) {
#pragma unroll
  for (int m = 0; m < 4; ++m)
#pragma unroll
    for (int n = 0; n < 2; ++n)
#pragma unroll
      for (int j = 0; j < 4; ++j) wl[(m * 16 + fq * 4 + j) * CM_ROW + n * 16 + fr] = f2bf(a[m][n][j]);
}
DI void readout_cm(const bf16_t* wl, bf16_t* gdst, int lane) {
#pragma unroll
  for (int it = 0; it < 4; ++it) {
    const int idx = lane + 64 * it; const int row = idx >> 2, ch = idx & 3;
    *(uint4*)(gdst + (size_t)row * SEQ + ch * 8) = *(const uint4*)(wl + row * CM_ROW + ch * 8);
  }
}
constexpr int CMP_ROW = 72;
DI void stage_cm_pair(const f32x4 (&a)[4][2], bf16_t* wlp, int par, int fr, int fq) {
#pragma unroll
  for (int m = 0; m < 4; ++m)
#pragma unroll
    for (int n = 0; n < 2; ++n)
#pragma unroll
      for (int j = 0; j < 4; ++j) wlp[(m * 16 + fq * 4 + j) * CMP_ROW + par * 32 + n * 16 + fr] = f2bf(a[m][n][j]);
}
DI void readout_cm_pair(const bf16_t* wlp, bf16_t* gdst, int par, int lane) {
#pragma unroll
  for (int it = 0; it < 4; ++it) {
    const int idx = lane + 64 * it; const int row = par * 32 + (idx >> 3), ch = idx & 7;
    *(uint4*)(gdst + (size_t)row * SEQ + ch * 8) = *(const uint4*)(wlp + row * CMP_ROW + ch * 8);
  }
}
DI void stage_f32(const f32x4 (&a)[4][2], float* wl, int fr, int fq) {
#pragma unroll
  for (int m = 0; m < 4; ++m)
#pragma unroll
    for (int n = 0; n < 2; ++n) *(f32x4*)(wl + (n * 16 + fr) * F32_ROW + m * 16 + fq * 4) = a[m][n];
}
DI void readout_f32_resid(const float* wl, const float* __restrict__ resid, float* __restrict__ gdst, int lane) {
#pragma unroll 4
  for (int it = 0; it < 8; ++it) {
    const int idx = lane + 64 * it; const int row = idx >> 4, ch = idx & 15;
    const float4 v = *(const float4*)(wl + row * F32_ROW + ch * 4);
    const float4 r = *(const float4*)(resid + (size_t)row * DM + ch * 4);
    *(float4*)(gdst + (size_t)row * DM + ch * 4) = make_float4(v.x + r.x, v.y + r.y, v.z + r.z, v.w + r.w);
  }
}

DI void readout_f32_resid_ssq(const float* wl, const float* __restrict__ resid, float* __restrict__ gdst, bf16_t* __restrict__ hs, float* __restrict__ ssq, int lane) {
#pragma unroll 4
  for (int it = 0; it < 8; ++it) {
    const int idx = lane + 64 * it; const int row = idx >> 4, ch = idx & 15;
    const float4 v = *(const float4*)(wl + row * F32_ROW + ch * 4);
    const float4 r = *(const float4*)(resid + (size_t)row * DM + ch * 4);
    const float4 h = make_float4(v.x + r.x, v.y + r.y, v.z + r.z, v.w + r.w);
    *(float4*)(gdst + (size_t)row * DM + ch * 4) = h;
    uint2 o; o.x = pk2(h.x, h.y); o.y = pk2(h.z, h.w);
    *(uint2*)(hs + (size_t)row * DM + ch * 4) = o;
    float q = h.x * h.x + h.y * h.y + h.z * h.z + h.w * h.w;
    q += swz_xor<1>(q); q += swz_xor<2>(q); q += swz_xor<4>(q); q += swz_xor<8>(q);
    if (ch == 0) atomicAdd(ssq + row, q);
  }
}

DI void resid_preload(const float* __restrict__ resid, int lane, float4 (&rr)[8]) {
#pragma unroll
  for (int it = 0; it < 8; ++it) { const int idx = lane + 64 * it; rr[it] = *(const float4*)(resid + (size_t)(idx >> 4) * DM + (idx & 15) * 4); }
}
DI void readout_f32_pre(const float* wl, const float4 (&rr)[8], float* __restrict__ gdst, int lane) {
#pragma unroll
  for (int it = 0; it < 8; ++it) {
    const int idx = lane + 64 * it; const int row = idx >> 4, ch = idx & 15;
    const float4 v = *(const float4*)(wl + row * F32_ROW + ch * 4);
    *(float4*)(gdst + (size_t)row * DM + ch * 4) = make_float4(v.x + rr[it].x, v.y + rr[it].y, v.z + rr[it].z, v.w + rr[it].w);
  }
}
DI void readout_f32_pre_ssq(const float* wl, const float4 (&rr)[8], float* __restrict__ gdst, bf16_t* __restrict__ hs, float* __restrict__ ssq, int lane) {
#pragma unroll
  for (int it = 0; it < 8; ++it) {
    const int idx = lane + 64 * it; const int row = idx >> 4, ch = idx & 15;
    const float4 v = *(const float4*)(wl + row * F32_ROW + ch * 4);
    const float4 h = make_float4(v.x + rr[it].x, v.y + rr[it].y, v.z + rr[it].z, v.w + rr[it].w);
    *(float4*)(gdst + (size_t)row * DM + ch * 4) = h;
    uint2 o; o.x = pk2(h.x, h.y); o.y = pk2(h.z, h.w);
    *(uint2*)(hs + (size_t)row * DM + ch * 4) = o;
    float q = h.x * h.x + h.y * h.y + h.z * h.z + h.w * h.w;
    q += swz_xor<1>(q); q += swz_xor<2>(q); q += swz_xor<4>(q); q += swz_xor<8>(q);
    if (ch == 0) atomicAdd(ssq + row, q);
  }
}

DI void wave_lds_sync() { asm volatile("s_waitcnt lgkmcnt(0)" ::: "memory"); }

template <int EPI>
DI void epilogue_block(const Params& p, const f32x4 (&a)[4][2], int c0, int mt, bf16_t* wl, bf16_t* wlp, int par, int lane, int fr, int fq) {
  unsigned char* ws = p.ws;
  const int b = mt >> 13, tok0 = mt & 8191;
  const int tok0p = tok0 - par * 32;
  if (EPI == EPI_SSM_IN) {
    if (c0 < 2048) {
      stage_tm<false>(a, wl, fr, fq); wave_lds_sync();
      readout_tm(wl, (bf16_t*)p.out + (size_t)mt * 2048 + c0, 2048, lane); wave_lds_sync();
    } else if (c0 < 4096) {
      stage_cm_pair(a, wlp, par, fr, fq); __syncthreads();
      readout_cm_pair(wlp, (bf16_t*)(ws + OFF_XT) + ((size_t)(b * 2048 + (c0 - 2048))) * SEQ + tok0p, par, lane); __syncthreads();
    } else if (c0 < 4608) {
      stage_tm<false>(a, wl, fr, fq); wave_lds_sync();
      readout_tm(wl, (bf16_t*)(ws + OFF_BR) + (size_t)mt * 512 + (c0 - 4096), 512, lane); __syncthreads();
      stage_cm_pair(a, wlp, par, fr, fq); __syncthreads();
      readout_cm_pair(wlp, (bf16_t*)(ws + OFF_BT) + ((size_t)(b * 512 + (c0 - 4096))) * SEQ + tok0p, par, lane); __syncthreads();
    } else if (c0 < 5120) {
      stage_tm<false>(a, wl, fr, fq); wave_lds_sync();
      readout_tm(wl, (bf16_t*)(ws + OFF_CR) + (size_t)mt * 512 + (c0 - 4608), 512, lane); wave_lds_sync();
    } else if (c0 == 5120) {
#pragma unroll
      for (int m = 0; m < 2; ++m)
#pragma unroll
        for (int n = 0; n < 2; ++n) {
          const int h = m * 16 + fq * 4;
          float4 o; float* op = (float*)&o;
#pragma unroll
          for (int j = 0; j < 4; ++j) { const float t = a[m][n][j] + p.dt_bias[h + j]; op[j] = (t > 20.f) ? t : log1pf(__expf(t)); }
          *(float4*)((float*)(ws + OFF_DT) + (size_t)(mt + n * 16 + fr) * 32 + h) = o;
        }
    }
  } else if (EPI == EPI_OUT1 || EPI == EPI_OUT2) {
    const float* resid = (EPI == EPI_OUT1) ? p.x : (const float*)(ws + OFF_XT);
    float* dst = (EPI == EPI_OUT1) ? (float*)(ws + OFF_XT) : p.out;
    float4 rr[8]; resid_preload(resid + (size_t)mt * DM + c0, lane, rr);
    stage_f32(a, (float*)wl, fr, fq); wave_lds_sync();
    if (EPI == EPI_OUT1) readout_f32_pre_ssq((const float*)wl, rr, dst + (size_t)mt * DM + c0, (bf16_t*)(ws + OFF_XN) + (size_t)mt * DM + c0, (float*)(ws + OFF_SSQ) + mt, lane);
    else readout_f32_pre((const float*)wl, rr, dst + (size_t)mt * DM + c0, lane);
    wave_lds_sync();
  } else if (EPI == EPI_MLA_IN) {
    const float* SSQ = (const float*)(ws + OFF_SSQ);
    f32x4 a2[4][2];
    float rs[2];
#pragma unroll
    for (int n = 0; n < 2; ++n) rs[n] = rsqrtf(SSQ[mt + n * 16 + fr] * (1.f / 1024.f) + 1e-6f);
#pragma unroll
    for (int m = 0; m < 4; ++m)
#pragma unroll
      for (int n = 0; n < 2; ++n) a2[m][n] = a[m][n] * rs[n];
    if (c0 < 640) {
      float* dstq = (float*)(ws + OFF_SSQ) + (c0 < 256 ? T : 2 * T);
#pragma unroll
      for (int n = 0; n < 2; ++n) {
        float q = 0.f;
#pragma unroll
        for (int m = 0; m < 4; ++m) q += a2[m][n][0] * a2[m][n][0] + a2[m][n][1] * a2[m][n][1] + a2[m][n][2] * a2[m][n][2] + a2[m][n][3] * a2[m][n][3];
        q += swz_xor<16>(q); q += __shfl_xor(q, 32);
        if (fq == 0) atomicAdd(dstq + mt + n * 16 + fr, q);
      }
    }
    const f32x4 (&a)[4][2] = a2;
    if (c0 < 640) stage_tm<false>(a, wl, fr, fq);
    else if (c0 < 1664) stage_tm<true>(a, wl, fr, fq);
    wave_lds_sync();
    if (c0 < 256) readout_tm(wl, (bf16_t*)(ws + OFF_ST + 32 * MiB) + (size_t)mt * 256 + c0, 256, lane);
    else if (c0 < 640) readout_tm(wl, (bf16_t*)(ws + OFF_ST + 40 * MiB) + (size_t)mt * 384 + (c0 - 256), 384, lane);
    else if (c0 < 1664) readout_tm(wl, (bf16_t*)(ws + OFF_ST) + (size_t)mt * 1024 + (c0 - 640), 1024, lane);
    else if (c0 == 1664) {
      const float* COS = (const float*)(ws + OFF_COS); const float* SIN = (const float*)(ws + OFF_SIN);
      bf16_t* KROPE = (bf16_t*)(ws + OFF_DEC);
#pragma unroll
      for (int n = 0; n < 2; ++n) {
        const int t = mt + n * 16 + fr;
        const f32x4 cs = *(const f32x4*)(COS + (size_t)t * 16 + fq * 4), sn = *(const f32x4*)(SIN + (size_t)t * 16 + fq * 4);
        const f32x4 x1 = a[0][n], x2 = a[1][n];
        const f32x4 r1 = x1 * cs - x2 * sn, r2 = x1 * sn + x2 * cs;
        uint2 o1, o2; o1.x = pk2(r1[0], r1[1]); o1.y = pk2(r1[2], r1[3]); o2.x = pk2(r2[0], r2[1]); o2.y = pk2(r2[2], r2[3]);
        *(uint2*)(KROPE + (size_t)t * 32 + fq * 4) = o1; *(uint2*)(KROPE + (size_t)t * 32 + 16 + fq * 4) = o2;
      }
    }
    wave_lds_sync();
  } else if (EPI == EPI_KVUP) {
    const int head = c0 >> 7; const bool isv = (c0 & 64) != 0;
    const float* SSQ = (const float*)(ws + OFF_SSQ) + T;
    f32x4 a2[4][2];
#pragma unroll
    for (int n = 0; n < 2; ++n) {
      const float rsn = rsqrtf(SSQ[mt + n * 16 + fr] * (1.f / 256.f) + 1e-6f);
#pragma unroll
      for (int m = 0; m < 4; ++m) a2[m][n] = a[m][n] * rsn;
    }
    const f32x4 (&a)[4][2] = a2;
    if (!isv) stage_tm<false>(a, wl, fr, fq); else stage_cm_pair(a, wlp, par, fr, fq);
    __syncthreads();
    if (!isv) readout_tm(wl, (bf16_t*)(ws + OFF_XN) + (size_t)mt * 1024 + head * 64, 1024, lane);
    else readout_cm_pair(wlp, (bf16_t*)(ws + OFF_BT) + ((size_t)((b * 16 + head) * 64)) * SEQ + tok0p, par, lane);
    __syncthreads();
  } else if (EPI == EPI_QUP) {
    const float SC = 0.10206207261596575f * 1.4426950408889634f;
    const float* SSQ = (const float*)(ws + OFF_SSQ) + 2 * T;
    f32x4 v[4][2];
#pragma unroll
    for (int n = 0; n < 2; ++n) {
      const float rsn = rsqrtf(SSQ[mt + n * 16 + fr] * (1.f / 384.f) + 1e-6f) * SC;
#pragma unroll
      for (int m = 0; m < 4; ++m) v[m][n] = a[m][n] * rsn;
    }
    const int ph = c0 % 96;
    if (ph != 0) {
      const float* COS = (const float*)(ws + OFF_COS); const float* SIN = (const float*)(ws + OFF_SIN);
#pragma unroll
      for (int n = 0; n < 2; ++n) {
        const int t = mt + n * 16 + fr;
        const f32x4 cs = *(const f32x4*)(COS + (size_t)t * 16 + fq * 4), sn = *(const f32x4*)(SIN + (size_t)t * 16 + fq * 4);
        if (ph == 64) { const f32x4 x1 = v[0][n], x2 = v[1][n]; v[0][n] = x1 * cs - x2 * sn; v[1][n] = x1 * sn + x2 * cs; }
        else          { const f32x4 x1 = v[2][n], x2 = v[3][n]; v[2][n] = x1 * cs - x2 * sn; v[3][n] = x1 * sn + x2 * cs; }
      }
    }
    stage_tm<false>(v, wl, fr, fq); wave_lds_sync();
    readout_tm(wl, (bf16_t*)p.out + (size_t)mt * 1536 + c0, 1536, lane);
    wave_lds_sync();
  }
}

constexpr int G8_BK = 64, G8_HALF = 128, G8_HT = G8_HALF * G8_BK;
constexpr int LDS_BYTES = 143360;
DI int g8_lds_byte(int r, int c) { const int st = (r >> 4) * 2 + (c >> 5), rr = r & 15, cc = c & 31, ob = rr * 64 + cc * 2; return st * 1024 + (ob ^ (((ob >> 9) & 1) << 5)); }
DI void g8_stage_rc(int b, int& R, int& C) { const int st = b / 1024, sb = b % 1024, swz = sb ^ (((sb >> 9) & 1) << 5); R = (st >> 1) * 16 + swz / 64; C = (st & 1) * 32 + (swz % 64) / 2; }

template <int EPI, int K>
DI void gemm_tile(const Params& p, const bf16_t* __restrict__ A, const bf16_t* __restrict__ Bt, int brow, int bcol, unsigned char* smem) {
  bf16_t* shm = (bf16_t*)smem;
#define SA(b, h) (shm + ((b) * 2 + (h)) * G8_HT)
#define SB(b, h) (shm + (4 + (b) * 2 + (h)) * G8_HT)
#define STAGE(P, BASE, br, kt) do { const long _g = (long)(br) * K + (long)(kt) * G8_BK; \
    _Pragma("unroll") for (int _i = 0; _i < 2; ++_i) { const int _b = tid * 16 + _i * 8192; int _r, _c; g8_stage_rc(_b, _r, _c); \
      __builtin_amdgcn_global_load_lds((const unsigned*)(BASE + _g + (long)_r * K + _c), (unsigned*)((char*)(P) + _b), 16, 0, 0); } } while (0)
#define LDA(dst, b, h) _Pragma("unroll") for (int m = 0; m < 4; ++m) _Pragma("unroll") for (int k = 0; k < 2; ++k) \
    dst[m][k] = *reinterpret_cast<const bf16x8*>((const char*)SA(b, h) + g8_lds_byte(wr * 64 + m * 16 + fr, k * 32 + fq * 8))
#define LDB(dst, b, h) _Pragma("unroll") for (int n = 0; n < 2; ++n) _Pragma("unroll") for (int k = 0; k < 2; ++k) \
    dst[n][k] = *reinterpret_cast<const bf16x8*>((const char*)SB(b, h) + g8_lds_byte(wc * 32 + n * 16 + fr, k * 32 + fq * 8))
#define MMA(ai, bj, At_, Bt_) do { __builtin_amdgcn_s_setprio(1); \
    _Pragma("unroll") for (int m = 0; m < 4; ++m) _Pragma("unroll") for (int n = 0; n < 2; ++n) _Pragma("unroll") for (int k = 0; k < 2; ++k) \
      acc[ai][bj][m][n] = __builtin_amdgcn_mfma_f32_16x16x32_bf16(At_[m][k], Bt_[n][k], acc[ai][bj][m][n], 0, 0, 0); \
    __builtin_amdgcn_s_setprio(0); } while (0)
#define WAIT_V(n) asm volatile("s_waitcnt vmcnt(" #n ")" ::: "memory")
#define WAIT_L(n) asm volatile("s_waitcnt lgkmcnt(" #n ")" ::: "memory")
#define BAR __builtin_amdgcn_s_barrier()
#define SCHED __builtin_amdgcn_sched_barrier(0)
  const int tid = otid();
  const int wid = tid >> 6, lane = tid & 63, wr = wid >> 2, wc = wid & 3, fr = lane & 15, fq = lane >> 4;
  f32x4 acc[2][2][4][2];
#pragma unroll
  for (int a_ = 0; a_ < 2; ++a_)
#pragma unroll
    for (int b_ = 0; b_ < 2; ++b_)
#pragma unroll
      for (int m = 0; m < 4; ++m)
#pragma unroll
        for (int n = 0; n < 2; ++n) acc[a_][b_][m][n] = (f32x4){0.f, 0.f, 0.f, 0.f};
  bf16x8 At[4][2], B0[2][2], B1[2][2];
  constexpr int nt = K / G8_BK;
  STAGE(SB(0, 0), Bt, bcol, 0); STAGE(SA(0, 0), A, brow, 0);
  STAGE(SB(0, 1), Bt, bcol + G8_HALF, 0); STAGE(SA(0, 1), A, brow + G8_HALF, 0);
  if (wr == 1) BAR;
  WAIT_V(4); BAR;
  STAGE(SB(1, 0), Bt, bcol, 1); STAGE(SA(1, 0), A, brow, 1); STAGE(SB(1, 1), Bt, bcol + G8_HALF, 1);
  WAIT_V(6); BAR;
  for (int t = 0; t < nt - 2; t += 2) {
    LDB(B0, 0, 0); SCHED; LDA(At, 0, 0); STAGE(SA(1, 1), A, brow + G8_HALF, t + 1);
    WAIT_L(8); BAR; WAIT_L(0); MMA(0, 0, At, B0); BAR; SCHED;
    LDB(B1, 0, 1); STAGE(SB(0, 0), Bt, bcol, t + 2);
    BAR; WAIT_L(0); MMA(0, 1, At, B1); BAR;
    LDA(At, 0, 1); STAGE(SA(0, 0), A, brow, t + 2);
    BAR; WAIT_L(0); MMA(1, 0, At, B0); BAR; SCHED;
    STAGE(SB(0, 1), Bt, bcol + G8_HALF, t + 2);
    WAIT_V(6); BAR; MMA(1, 1, At, B1); BAR;
    LDB(B0, 1, 0); SCHED; LDA(At, 1, 0); STAGE(SA(0, 1), A, brow + G8_HALF, t + 2);
    WAIT_L(8); BAR; WAIT_L(0); MMA(0, 0, At, B0); BAR; SCHED;
    LDB(B1, 1, 1); STAGE(SB(1, 0), Bt, bcol, t + 3);
    BAR; WAIT_L(0); MMA(0, 1, At, B1); BAR;
    LDA(At, 1, 1); STAGE(SA(1, 0), A, brow, t + 3);
    BAR; WAIT_L(0); MMA(1, 0, At, B0); BAR; SCHED;
    STAGE(SB(1, 1), Bt, bcol + G8_HALF, t + 3);
    WAIT_V(6); BAR; MMA(1, 1, At, B1); BAR;
  }
  { LDB(B0, 0, 0); LDA(At, 0, 0); STAGE(SA(1, 1), A, brow + G8_HALF, nt - 1);
    BAR; WAIT_L(0); MMA(0, 0, At, B0); BAR;
    LDB(B1, 0, 1); BAR; WAIT_L(0); MMA(0, 1, At, B1); BAR;
    LDA(At, 0, 1); WAIT_V(4); BAR; WAIT_L(0); MMA(1, 0, At, B0); MMA(1, 1, At, B1); BAR; }
  { LDB(B0, 1, 0); LDA(At, 1, 0); WAIT_V(2); BAR; WAIT_L(0); MMA(0, 0, At, B0); BAR;
    LDB(B1, 1, 1); WAIT_V(0); BAR; WAIT_L(0); MMA(0, 1, At, B1); BAR;
    LDA(At, 1, 1); BAR; WAIT_L(0); MMA(1, 0, At, B0); MMA(1, 1, At, B1); BAR; }
  if (wr == 0) BAR;
  __syncthreads();
  int t2 = tid; asm volatile("" : "+v"(t2));
  const int wid2 = t2 >> 6, lane2 = t2 & 63, wr2 = wid2 >> 2, wc2 = wid2 & 3, fr2 = lane2 & 15, fq2 = lane2 >> 4;
  bf16_t* wl = (bf16_t*)(smem + wid2 * EPI_WAVE_BYTES);
  bf16_t* wlp = (bf16_t*)(smem + (wid2 & ~1) * EPI_WAVE_BYTES);
#pragma unroll
  for (int ai = 0; ai < 2; ++ai)
#pragma unroll
    for (int bj = 0; bj < 2; ++bj)
      epilogue_block<EPI>(p, acc[ai][bj], brow + ai * 128 + wr2 * 64, bcol + bj * 128 + wc2 * 32, wl, wlp, wc2 & 1, lane2, fr2, fq2);
  __syncthreads();
#undef SA
#undef SB
#undef STAGE
#undef LDA
#undef LDB
#undef MMA
#undef WAIT_V
#undef WAIT_L
#undef BAR
#undef SCHED
}

template <int EPI, int K>
DI void gemm_phase(const Params& p, const bf16_t* Wt, const bf16_t* X, int ntn, unsigned char* smem) {
  const bool xa = (gridDim.x == 256);
  const int xcd = blockIdx.x & 7, li = blockIdx.x >> 3;
  const int per_half = 4 * ntn;
  const int start = xa ? li : (int)blockIdx.x, step = xa ? 32 : (int)gridDim.x, total = ntn * (xa ? 8 : 64);
  for (int t = start; t < total; t += step) {
    int tm, tn;
    if (xa) { const int h = t / per_half, tp = t - h * per_half; tn = tp >> 2; tm = xcd * 8 + h * 4 + (tp & 3); }
    else { tm = t / ntn; tn = t % ntn; }
    gemm_tile<EPI, K>(p, Wt, X, tn * 256, tm * 256, smem);
  }
}

DI void conv8_load(const bf16_t* rp, bool has_prev, uint4& cur, uint2& prv) {
  cur = *(const uint4*)rp; prv = make_uint2(0u, 0u);
  if (has_prev) prv = *(const uint2*)(rp - 4);
}
DI float fast_silu(float v) { return v * __builtin_amdgcn_rcpf(1.f + __expf(-v)); }
DI void conv8_compute(const uint4 cur, const uint2 prv, float w0, float w1, float w2, float w3, float bias, float (&out)[8]) {
  float r[11];
  r[0] = hi16(prv.x); r[1] = lo16(prv.y); r[2] = hi16(prv.y);
  r[3] = lo16(cur.x); r[4] = hi16(cur.x); r[5] = lo16(cur.y); r[6] = hi16(cur.y); r[7] = lo16(cur.z); r[8] = hi16(cur.z); r[9] = lo16(cur.w); r[10] = hi16(cur.w);
#pragma unroll
  for (int j = 0; j < 8; ++j) out[j] = fast_silu(bias + w0 * r[j] + w1 * r[j + 1] + w2 * r[j + 2] + w3 * r[j + 3]);
}
DI void conv8(const bf16_t* rp, bool has_prev, float w0, float w1, float w2, float w3, float bias, float (&out)[8]) {
  uint4 cur; uint2 prv; conv8_load(rp, has_prev, cur, prv); conv8_compute(cur, prv, w0, w1, w2, w3, bias, out);
}
DI bf16x8 pack8(const float (&v)[8]) {
  uint4 u; u.x = pk2(v[0], v[1]); u.y = pk2(v[2], v[3]); u.z = pk2(v[4], v[5]); u.w = pk2(v[6], v[7]);
  return __builtin_bit_cast(bf16x8, u);
}
DI void chunk_cumsum(const float* __restrict__ DTp, size_t tk0, int hd, float A, int lane, float (&d4)[4], float (&c4)[4], float& last) {
#pragma unroll
  for (int i = 0; i < 4; ++i) d4[i] = DTp[(tk0 + 4 * lane + i) * 32 + hd];
  c4[0] = d4[0] * A; c4[1] = c4[0] + d4[1] * A; c4[2] = c4[1] + d4[2] * A; c4[3] = c4[2] + d4[3] * A;
  const float tot = c4[3];
  float sum = tot, ex = 0.f, t;
  t = swz_xor<1>(sum);  if (lane & 1) ex += t;  sum += t;
  t = swz_xor<2>(sum);  if (lane & 2) ex += t;  sum += t;
  t = swz_xor<4>(sum);  if (lane & 4) ex += t;  sum += t;
  t = swz_xor<8>(sum);  if (lane & 8) ex += t;  sum += t;
  t = swz_xor<16>(sum); if (lane & 16) ex += t; sum += t;
  t = __shfl_xor(sum, 32); if (lane & 32) ex += t; sum += t;
#pragma unroll
  for (int i = 0; i < 4; ++i) c4[i] += ex;
  last = sum;
}

constexpr int BT_ROW = 264;
constexpr int CN_ROW = 136;

DI void phase_ssd_state(const Params& p, unsigned char* smem) {
  const bf16_t* XT = (const bf16_t*)(p.ws + OFF_XT); const bf16_t* BT = (const bf16_t*)(p.ws + OFF_BT); const float* DTp = (const float*)(p.ws + OFF_DT);
  float* ST = (float*)(p.ws + OFF_ST); float* DEC = (float*)(p.ws + OFF_DEC);
  bf16_t* BTs = (bf16_t*)smem; float* wgt = (float*)(smem + 128 * BT_ROW * 2);
  const int tid = otid(), lane = tid & 63, w = tid >> 6, l31 = lane & 31, lh = lane >> 5;
  for (int u = blockIdx.x; u < 256; u += gridDim.x) {
    const int b = u >> 7, c = (u >> 2) & 31, g = u & 3; const int hd = 8 * g + w;
    bf16_t* XTC = (bf16_t*)(p.ws + (b ? OFF_ST + 32 * MiB : OFF_XN));
    {
      float d4[4], c4[4], last; chunk_cumsum(DTp, (size_t)b * SEQ + c * 256, hd, -__expf(p.A_log[hd]), lane, d4, c4, last);
      float4 o = {__expf(last - c4[0]) * d4[0], __expf(last - c4[1]) * d4[1], __expf(last - c4[2]) * d4[2], __expf(last - c4[3]) * d4[3]};
      *(float4*)(wgt + w * 256 + 4 * lane) = o;
      if (lane == 0) DEC[(b * 32 + c) * 32 + hd] = __expf(last);
    }
#pragma unroll 2
    for (int i = 0; i < 8; ++i) {
      const int chunk = tid + 512 * i; const int s8 = (chunk & 31) * 8, n = chunk >> 5; const int ch = 2048 + g * 128 + n;
      float v[8];
      conv8(BT + ((size_t)(b * 512 + g * 128 + n)) * SEQ + c * 256 + s8, !(c == 0 && s8 == 0),
            p.conv_w[ch], p.conv_w[3072 + ch], p.conv_w[2 * 3072 + ch], p.conv_w[3 * 3072 + ch], p.conv_b[ch], v);
      *(bf16x8*)(BTs + n * BT_ROW + s8) = pack8(v);
    }
    __syncthreads();
    f32x16 acc[2][4];
#pragma unroll
    for (int a = 0; a < 2; ++a)
#pragma unroll
      for (int q = 0; q < 4; ++q)
#pragma unroll
        for (int i = 0; i < 16; ++i) acc[a][q][i] = 0.f;
    float xw[2][4], xb[2];
#pragma unroll
    for (int pt = 0; pt < 2; ++pt) {
      const int ch = hd * 64 + pt * 32 + l31;
#pragma unroll
      for (int k = 0; k < 4; ++k) xw[pt][k] = p.conv_w[k * 3072 + ch];
      xb[pt] = p.conv_b[ch];
    }
    for (int kb = 0; kb < 16; kb += 2) {
      uint4 rc[2][2]; uint2 rp[2][2];
#pragma unroll
      for (int i = 0; i < 2; ++i)
#pragma unroll
        for (int pt = 0; pt < 2; ++pt) {
          const int s0 = (kb + i) * 16 + 8 * lh;
          conv8_load(XT + ((size_t)(b * 2048 + hd * 64 + pt * 32 + l31)) * SEQ + c * 256 + s0, !(c == 0 && s0 == 0), rc[i][pt], rp[i][pt]);
        }
#pragma unroll
      for (int i = 0; i < 2; ++i) {
        const int ks = kb + i; const int s0 = ks * 16 + 8 * lh;
        const float4 g0 = *(const float4*)(wgt + w * 256 + s0), g1 = *(const float4*)(wgt + w * 256 + s0 + 4);
        const float wg[8] = {g0.x, g0.y, g0.z, g0.w, g1.x, g1.y, g1.z, g1.w};
        bf16x8 afr[2];
#pragma unroll
        for (int pt = 0; pt < 2; ++pt) {
          float v[8];
          conv8_compute(rc[i][pt], rp[i][pt], xw[pt][0], xw[pt][1], xw[pt][2], xw[pt][3], xb[pt], v);
          *(bf16x8*)(XTC + ((size_t)(hd * 64 + pt * 32 + l31)) * SEQ + c * 256 + s0) = pack8(v);
#pragma unroll
          for (int j = 0; j < 8; ++j) v[j] *= wg[j];
          afr[pt] = pack8(v);
        }
#pragma unroll
        for (int nt = 0; nt < 4; ++nt) {
          const bf16x8 bfr = *(const bf16x8*)(BTs + (nt * 32 + l31) * BT_ROW + ks * 16 + 8 * lh);
#pragma unroll
          for (int pt = 0; pt < 2; ++pt) acc[pt][nt] = MFMA32(afr[pt], bfr, acc[pt][nt]);
        }
      }
    }
    bf16_t* Sp = (bf16_t*)ST + (((size_t)(b * 32 + c) * 32 + hd) * 64) * 128;
#pragma unroll
    for (int pt = 0; pt < 2; ++pt)
#pragma unroll
      for (int nt = 0; nt < 4; ++nt)
#pragma unroll
        for (int r = 0; r < 16; ++r) Sp[(pt * 32 + (r & 3) + 8 * (r >> 2) + 4 * lh) * 128 + nt * 32 + l31] = f2bf(acc[pt][nt][r]);
    __syncthreads();
  }
}

DI void phase_ssd_scan(const Params& p) {
  bf16_t* ST = (bf16_t*)(p.ws + OFF_ST); const float* DEC = (const float*)(p.ws + OFF_DEC);
  for (int idx = blockIdx.x * NTHREADS + otid(); idx < 131072; idx += gridDim.x * NTHREADS) {
    const int n4 = idx & 31, pp = (idx >> 5) & 63, h = (idx >> 11) & 31, b = idx >> 16;
    float run[4] = {0.f, 0.f, 0.f, 0.f};
    bf16_t* base = ST + (((size_t)(b * 32) * 32 + h) * 64 + pp) * 128 + n4 * 4;
    const float* dbase = DEC + (b * 32) * 32 + h;
    for (int c0 = 0; c0 < 32; c0 += 16) {
      uint2 loc[16]; float d[16];
#pragma unroll
      for (int i = 0; i < 16; ++i) { loc[i] = *(const uint2*)(base + (size_t)(c0 + i) * (32 * 64 * 128)); d[i] = dbase[(c0 + i) * 32]; }
#pragma unroll
      for (int i = 0; i < 16; ++i) {
        uint2 o; o.x = pk2(run[0], run[1]); o.y = pk2(run[2], run[3]);
        *(uint2*)(base + (size_t)(c0 + i) * (32 * 64 * 128)) = o;
        run[0] = run[0] * d[i] + lo16(loc[i].x); run[1] = run[1] * d[i] + hi16(loc[i].x);
        run[2] = run[2] * d[i] + lo16(loc[i].y); run[3] = run[3] * d[i] + hi16(loc[i].y);
      }
    }
  }
}

DI void stage_tokmajor(const Params& p, const bf16_t* __restrict__ RAW, int b, int tok0, int nrows, int g, int cbase, bf16_t* dst, int tid_) {
  const int tid = otid(); (void)tid_;
  const int n8 = (tid & 15) * 8; const int ch = cbase + g * 128 + n8;
  float cw[4][8], cb[8];
#pragma unroll
  for (int k = 0; k < 4; ++k) {
    const float4 a = *(const float4*)(p.conv_w + k * 3072 + ch), bq = *(const float4*)(p.conv_w + k * 3072 + ch + 4);
    cw[k][0] = a.x; cw[k][1] = a.y; cw[k][2] = a.z; cw[k][3] = a.w; cw[k][4] = bq.x; cw[k][5] = bq.y; cw[k][6] = bq.z; cw[k][7] = bq.w;
  }
  { const float4 a = *(const float4*)(p.conv_b + ch), bq = *(const float4*)(p.conv_b + ch + 4);
    cb[0] = a.x; cb[1] = a.y; cb[2] = a.z; cb[3] = a.w; cb[4] = bq.x; cb[5] = bq.y; cb[6] = bq.z; cb[7] = bq.w; }
  for (int t = tid >> 4; t < nrows; t += 64) {
    uint4 r[2][4];
#pragma unroll
    for (int u = 0; u < 2; ++u)
#pragma unroll
      for (int k = 0; k < 4; ++k) {
        const int tk = tok0 + t + 32 * u - 3 + k;
        r[u][k] = make_uint4(0u, 0u, 0u, 0u);
        if (tk >= 0) r[u][k] = *(const uint4*)(RAW + ((size_t)b * SEQ + tk) * 512 + g * 128 + n8);
      }
#pragma unroll
    for (int u = 0; u < 2; ++u) {
      float acc[8];
#pragma unroll
      for (int j = 0; j < 8; ++j) acc[j] = cb[j];
#pragma unroll
      for (int k = 0; k < 4; ++k) {
        const uint4 q = r[u][k];
        acc[0] += cw[k][0] * lo16(q.x); acc[1] += cw[k][1] * hi16(q.x); acc[2] += cw[k][2] * lo16(q.y); acc[3] += cw[k][3] * hi16(q.y);
        acc[4] += cw[k][4] * lo16(q.z); acc[5] += cw[k][5] * hi16(q.z); acc[6] += cw[k][6] * lo16(q.w); acc[7] += cw[k][7] * hi16(q.w);
      }
#pragma unroll
      for (int j = 0; j < 8; ++j) acc[j] = fast_silu(acc[j]);
      *(bf16x8*)(dst + (t + 32 * u) * CN_ROW + n8) = pack8(acc);
    }
  }
}

constexpr int S3_CS = 0, S3_BS = 64 * CN_ROW * 2, S3_CB = S3_BS + 256 * CN_ROW * 2, S3_CUM = S3_CB + 64 * BT_ROW * 2, S3_DTS = S3_CUM + 8192,
              S3_PART = S3_DTS + 8192, S3_RSTD = S3_PART + 2048, S3_END = S3_RSTD + 256;

DI void phase_ssd_out(const Params& p, unsigned char* smem) {
  const bf16_t* XT = (const bf16_t*)(p.ws + OFF_XT); const bf16_t* BR = (const bf16_t*)(p.ws + OFF_BR); const bf16_t* CR = (const bf16_t*)(p.ws + OFF_CR);
  const float* DTp = (const float*)(p.ws + OFF_DT); const float* ST = (const float*)(p.ws + OFF_ST); bf16_t* Z = (bf16_t*)p.out;
  bf16_t* Cs = (bf16_t*)(smem + S3_CS); bf16_t* Bs = (bf16_t*)(smem + S3_BS); bf16_t* CBs = (bf16_t*)(smem + S3_CB);
  float* cumA = (float*)(smem + S3_CUM); float* dts = (float*)(smem + S3_DTS); float* part = (float*)(smem + S3_PART); float* rstd = (float*)(smem + S3_RSTD);
  const int tid = otid(), lane = tid & 63, w = tid >> 6, l31 = lane & 31, lh = lane >> 5;
  const bool persist = (gridDim.x == 256);
  for (int u = blockIdx.x; u < 1024; u += gridDim.x) {
    const int tq = u >> 8, rest = u & 255; const int b = rest >> 7, c = (rest >> 2) & 31, g = rest & 3; const int hd = 8 * g + w;
    const int ns = (tq + 1) * 64;
    if (!persist || tq == 0) {
      float d4[4], c4[4], last; chunk_cumsum(DTp, (size_t)b * SEQ + c * 256, hd, -__expf(p.A_log[hd]), lane, d4, c4, last);
      *(float4*)(cumA + w * 256 + 4 * lane) = make_float4(c4[0], c4[1], c4[2], c4[3]);
      *(float4*)(dts + w * 256 + 4 * lane) = make_float4(d4[0], d4[1], d4[2], d4[3]);
    }
    stage_tokmajor(p, CR, b, c * 256 + tq * 64, 64, g, 2560, Cs, tid);
    { const int r0 = persist ? tq * 64 : 0; stage_tokmajor(p, BR, b, c * 256 + r0, ns - r0, g, 2048, Bs + r0 * CN_ROW, tid); }
    __syncthreads();
    if (32 * w < ns) {
      f32x16 a2[2];
#pragma unroll
      for (int a = 0; a < 2; ++a)
#pragma unroll
        for (int i = 0; i < 16; ++i) a2[a][i] = 0.f;
#pragma unroll
      for (int ks = 0; ks < 8; ++ks) {
        const bf16x8 af = *(const bf16x8*)(Bs + (32 * w + l31) * CN_ROW + ks * 16 + 8 * lh);
#pragma unroll
        for (int tt = 0; tt < 2; ++tt) {
          const bf16x8 bq = *(const bf16x8*)(Cs + (tt * 32 + l31) * CN_ROW + ks * 16 + 8 * lh);
          a2[tt] = MFMA32(af, bq, a2[tt]);
        }
      }
#pragma unroll
      for (int tt = 0; tt < 2; ++tt)
#pragma unroll
        for (int rg = 0; rg < 4; ++rg) {
          uint2 o; o.x = pk2(a2[tt][4 * rg], a2[tt][4 * rg + 1]); o.y = pk2(a2[tt][4 * rg + 2], a2[tt][4 * rg + 3]);
          *(uint2*)(CBs + (tt * 32 + l31) * BT_ROW + 32 * w + 8 * rg + 4 * lh) = o;
        }
    }
    __syncthreads();
    f32x16 acc[2][2];
#pragma unroll
    for (int a = 0; a < 2; ++a)
#pragma unroll
      for (int q = 0; q < 2; ++q)
#pragma unroll
        for (int i = 0; i < 16; ++i) acc[a][q][i] = 0.f;
    {
      const bf16_t* Sp = (const bf16_t*)ST + (((size_t)(b * 32 + c) * 32 + hd) * 64) * 128;
      for (int kb = 0; kb < 8; kb += 4) {
        bf16x8 bfr[4][2];
#pragma unroll
        for (int i = 0; i < 4; ++i)
#pragma unroll
          for (int pt = 0; pt < 2; ++pt) bfr[i][pt] = *(const bf16x8*)(Sp + (pt * 32 + l31) * 128 + (kb + i) * 16 + 8 * lh);
#pragma unroll
        for (int i = 0; i < 4; ++i) {
          const int ks = kb + i;
#pragma unroll
          for (int tt = 0; tt < 2; ++tt) {
            const bf16x8 af = *(const bf16x8*)(Cs + (tt * 32 + l31) * CN_ROW + ks * 16 + 8 * lh);
#pragma unroll
            for (int pt = 0; pt < 2; ++pt) acc[tt][pt] = MFMA32(af, bfr[i][pt], acc[tt][pt]);
          }
        }
      }
#pragma unroll
      for (int tt = 0; tt < 2; ++tt)
#pragma unroll
        for (int r = 0; r < 16; ++r) {
          const float e = __expf(cumA[w * 256 + tq * 64 + tt * 32 + (r & 3) + 8 * (r >> 2) + 4 * lh]);
          acc[tt][0][r] *= e; acc[tt][1][r] *= e;
        }
    }
    {
      const float Dh = p.Dskip[hd];
      const int tl0 = tq * 64 + l31, tl1 = tq * 64 + 32 + l31;
      const float ct0 = cumA[w * 256 + tl0], ct1 = cumA[w * 256 + tl1];
      const bf16_t* XTC = (const bf16_t*)(p.ws + (b ? OFF_ST + 32 * MiB : OFF_XN)) + ((size_t)(hd * 64 + l31)) * SEQ + c * 256 + 8 * lh;
      const int nks = ns >> 4;
      for (int kb = 0; kb < nks; kb += 4) {
        bf16x8 xq[4][2];
#pragma unroll
        for (int i = 0; i < 4; ++i)
#pragma unroll
          for (int pt = 0; pt < 2; ++pt) xq[i][pt] = *(const bf16x8*)(XTC + (size_t)pt * 32 * SEQ + (kb + i) * 16);
#pragma unroll
        for (int i = 0; i < 4; ++i) {
          const int ks = kb + i; const int s0 = ks * 16 + 8 * lh;
          const float4 c0 = *(const float4*)(cumA + w * 256 + s0), c1 = *(const float4*)(cumA + w * 256 + s0 + 4);
          const float4 d0 = *(const float4*)(dts + w * 256 + s0), d1 = *(const float4*)(dts + w * 256 + s0 + 4);
          const float cs[8] = {c0.x, c0.y, c0.z, c0.w, c1.x, c1.y, c1.z, c1.w};
          const float ds[8] = {d0.x, d0.y, d0.z, d0.w, d1.x, d1.y, d1.z, d1.w};
          const float cref = cumA[w * 256 + ks * 16];
          const bool steep = (cref - cumA[w * 256 + ks * 16 + 15]) > 60.f;
          float Fs[8];
#pragma unroll
          for (int j = 0; j < 8; ++j) Fs[j] = __expf(fminf(cref - cs[j], 64.f)) * ds[j];
#pragma unroll
          for (int tt = 0; tt < 2; ++tt) {
            if (ks * 16 <= tq * 64 + tt * 32 + 31) {
              const int tl = tt ? tl1 : tl0; const float ct = tt ? ct1 : ct0;
              const float Et = __expf(fminf(ct - cref, 0.f));
              const uint4 cbv = *(const uint4*)(CBs + (tt * 32 + l31) * BT_ROW + s0);
              const float cb[8] = {lo16(cbv.x), hi16(cbv.x), lo16(cbv.y), hi16(cbv.y), lo16(cbv.z), hi16(cbv.z), lo16(cbv.w), hi16(cbv.w)};
              float mv[8];
              if (steep) {
#pragma unroll
                for (int j = 0; j < 8; ++j) {
                  const int sidx = s0 + j;
                  float v = cb[j] * __expf(fminf(ct - cs[j], 0.f)) * ds[j];
                  v = (sidx <= tl) ? v : 0.f;
                  if (sidx == tl) v += Dh;
                  mv[j] = v;
                }
              } else if (ks * 16 + 15 > tq * 64 + tt * 32) {
#pragma unroll
                for (int j = 0; j < 8; ++j) {
                  const int sidx = s0 + j;
                  float v = cb[j] * (Et * Fs[j]);
                  v = (sidx <= tl) ? v : 0.f;
                  if (sidx == tl) v += Dh;
                  mv[j] = v;
                }
              } else {
#pragma unroll
                for (int j = 0; j < 8; ++j) mv[j] = cb[j] * (Et * Fs[j]);
              }
              const bf16x8 af = pack8(mv);
#pragma unroll
              for (int pt = 0; pt < 2; ++pt) acc[tt][pt] = MFMA32(af, xq[i][pt], acc[tt][pt]);
            }
          }
        }
      }
    }
    const size_t tokb = (size_t)b * SEQ + c * 256 + tq * 64;
#pragma unroll
    for (int tt = 0; tt < 2; ++tt)
#pragma unroll
      for (int r = 0; r < 16; ++r) {
        const int tloc = tt * 32 + (r & 3) + 8 * (r >> 2) + 4 * lh;
        const bf16_t* zp = Z + (tokb + tloc) * 2048 + hd * 64 + l31;
        const float y0 = acc[tt][0][r] * silu_f(bf2f(zp[0])), y1 = acc[tt][1][r] * silu_f(bf2f(zp[32]));
        acc[tt][0][r] = y0; acc[tt][1][r] = y1;
        float v = y0 * y0 + y1 * y1;
        v += swz_xor<1>(v); v += swz_xor<2>(v); v += swz_xor<4>(v); v += swz_xor<8>(v); v += swz_xor<16>(v);
        if (l31 == 0) part[w * 64 + tloc] = v;
      }
    __syncthreads();
    if (tid < 64) {
      float sres = 0.f;
#pragma unroll
      for (int ww = 0; ww < 8; ++ww) sres += part[ww * 64 + tid];
      rstd[tid] = rsqrtf(sres * (1.f / 512.f) + 1e-6f);
    }
    __syncthreads();
#pragma unroll
    for (int tt = 0; tt < 2; ++tt)
#pragma unroll
      for (int r = 0; r < 16; ++r) {
        const int tloc = tt * 32 + (r & 3) + 8 * (r >> 2) + 4 * lh;
        const float rs = rstd[tloc];
        bf16_t* zp = Z + (tokb + tloc) * 2048 + hd * 64 + l31;
        zp[0] = f2bf(acc[tt][0][r] * rs); zp[32] = f2bf(acc[tt][1][r] * rs);
      }
    __syncthreads();
  }
}

constexpr int KROW = 104;
constexpr int VROW = 68;
constexpr int ATT_K_BYTES = 64 * KROW * 2;
constexpr int ATT_V_BYTES = 64 * VROW * 2;
constexpr int ATT_STAGE = ATT_K_BYTES + ATT_V_BYTES;

DI void attn_kload(const bf16_t* sK, bf16x8 (&kf)[2][6], int l31, int lh) {
#pragma unroll
  for (int sub = 0; sub < 2; ++sub)
#pragma unroll
    for (int ks = 0; ks < 6; ++ks) kf[sub][ks] = *(const bf16x8*)(sK + (sub * 32 + l31) * KROW + ks * 16 + lh * 8);
}
DI void attn_qkmma(const bf16x8 (&kf)[2][6], const bf16x8 (&qf)[6], f32x16 (&sc)[2]) {
#pragma unroll
  for (int sub = 0; sub < 2; ++sub)
#pragma unroll
    for (int i = 0; i < 16; ++i) sc[sub][i] = 0.f;
#pragma unroll
  for (int ks = 0; ks < 6; ++ks)
#pragma unroll
    for (int sub = 0; sub < 2; ++sub) sc[sub] = MFMA32(kf[sub][ks], qf[ks], sc[sub]);
}
DI void attn_qk(const bf16_t* sK, const bf16x8 (&qf)[6], f32x16 (&sc)[2], int l31, int lh) {
  bf16x8 kf[2][6]; attn_kload(sK, kf, l31, lh); attn_qkmma(kf, qf, sc);
}

template <bool MASK>
DI void attn_softmax(f32x16 (&sc)[2], f32x16 (&o)[2], float& m, float& l, int kt, int myq, int lh) {
  float tmax = -1e30f;
#pragma unroll
  for (int sub = 0; sub < 2; ++sub)
#pragma unroll
    for (int r = 0; r < 16; ++r) {
      if (MASK) { const int key = kt * 64 + sub * 32 + (r & 3) + 8 * (r >> 2) + 4 * lh; if (key > myq) sc[sub][r] = -1e30f; }
      tmax = fmaxf(tmax, sc[sub][r]);
    }
  tmax = fmaxf(tmax, __shfl_xor(tmax, 32));
  if (__builtin_amdgcn_ballot_w64(tmax - m > 8.f) != 0) {
    const float mn = fmaxf(m, tmax); const float al = __builtin_amdgcn_exp2f(m - mn); m = mn;
    l *= al;
#pragma unroll
    for (int a = 0; a < 2; ++a)
#pragma unroll
      for (int i = 0; i < 16; ++i) o[a][i] *= al;
  }
  f32x2 ps2 = {0.f, 0.f}; const f32x2 mn2 = {m, m};
#pragma unroll
  for (int sub = 0; sub < 2; ++sub)
#pragma unroll
    for (int r = 0; r < 16; r += 2) {
      f32x2 d = {sc[sub][r], sc[sub][r + 1]}; d = d - mn2;
      f32x2 pe; pe.x = __builtin_amdgcn_exp2f(d.x); pe.y = __builtin_amdgcn_exp2f(d.y);
      sc[sub][r] = pe.x; sc[sub][r + 1] = pe.y; ps2 = ps2 + pe;
    }
  l += ps2.x + ps2.y;
}
DI void attn_pv(const f32x16 (&sc)[2], f32x16 (&o)[2], const bf16_t* sV, int l31, int lh) {
#pragma unroll
  for (int sub = 0; sub < 2; ++sub)
#pragma unroll
    for (int s2 = 0; s2 < 2; ++s2) {
      uint4 pu; pu.x = pk2(sc[sub][8 * s2], sc[sub][8 * s2 + 1]); pu.y = pk2(sc[sub][8 * s2 + 2], sc[sub][8 * s2 + 3]);
      pu.z = pk2(sc[sub][8 * s2 + 4], sc[sub][8 * s2 + 5]); pu.w = pk2(sc[sub][8 * s2 + 6], sc[sub][8 * s2 + 7]);
      const bf16x8 pb = __builtin_bit_cast(bf16x8, pu);
#pragma unroll
      for (int dvt = 0; dvt < 2; ++dvt) {
        const bf16_t* vp = sV + (dvt * 32 + l31) * VROW + sub * 32 + 16 * s2 + 4 * lh;
        const uint2 lo = *(const uint2*)vp, hi = *(const uint2*)(vp + 8);
        uint4 vu = {lo.x, lo.y, hi.x, hi.y};
        o[dvt] = MFMA32(__builtin_bit_cast(bf16x8, vu), pb, o[dvt]);
      }
    }
}

DI void attn_unit(const Params& p, int b, int h, int qb, unsigned char* smem) {
  const bf16_t* Q = (const bf16_t*)p.out; const bf16_t* KN = (const bf16_t*)(p.ws + OFF_XN); const bf16_t* VT = (const bf16_t*)(p.ws + OFF_BT);
  const bf16_t* KROPE = (const bf16_t*)(p.ws + OFF_DEC); const bf16_t* GATE = (const bf16_t*)(p.ws + OFF_ST); bf16_t* O = (bf16_t*)(p.ws + OFF_ST + 32 * MiB);
  const int tid = otid(), lane = tid & 63, w = tid >> 6, l31 = lane & 31, lh = lane >> 5;
  const int q0 = qb * 256, qw0 = q0 + 32 * w, myq = qw0 + l31;
  const size_t tq = (size_t)b * SEQ + myq;
  bf16x8 qf[6];
#pragma unroll
  for (int ks = 0; ks < 6; ++ks) qf[ks] = *(const bf16x8*)(Q + tq * 1536 + h * 96 + ks * 16 + lh * 8);
  f32x16 o[2];
#pragma unroll
  for (int a = 0; a < 2; ++a)
#pragma unroll
    for (int i = 0; i < 16; ++i) o[a][i] = 0.f;
  float m = -1e30f, l = 0.f;
  const int ntiles = 4 * qb + 4;
  const int nact = (qw0 + 31) / 64 + 1;
  const int kr = tid >> 3, kc = (tid & 7) * 8;
  const int rr = (tid & 255) >> 2, rc = (tid & 3) * 8;
  const bf16_t* gK = KN + ((size_t)b * SEQ + kr) * 1024 + h * 64 + kc;
  const bf16_t* gR = KROPE + ((size_t)b * SEQ + rr) * 32 + rc;
  const bf16_t* gV = VT + ((size_t)((b * 16 + h) * 64 + kr)) * SEQ + kc;
  uint4 rk, rr4, rv;
#define ATT_LOAD(T) do { rk = *(const uint4*)(gK + (size_t)(T) * 64 * 1024); rr4 = *(const uint4*)(gR + (size_t)(T) * 64 * 32); rv = *(const uint4*)(gV + (T) * 64); } while (0)
#define ATT_STORE(ST_) do { bf16_t* dK_ = (bf16_t*)(smem + (ST_) * ATT_STAGE); bf16_t* dV_ = (bf16_t*)(smem + (ST_) * ATT_STAGE + ATT_K_BYTES); \
    *(uint4*)(dK_ + kr * KROW + kc) = rk; *(uint4*)(dK_ + rr * KROW + 64 + rc) = rr4; \
    *(uint2*)(dV_ + kr * VROW + kc) = make_uint2(rv.x, rv.y); *(uint2*)(dV_ + kr * VROW + kc + 4) = make_uint2(rv.z, rv.w); } while (0)
  ATT_LOAD(0); ATT_STORE(0);
  ATT_LOAD(1); ATT_STORE(1);
  ATT_LOAD(2);
  __syncthreads();
  f32x16 sc[2], sn[2];
  attn_qk((const bf16_t*)smem, qf, sc, l31, lh);
  int st = 0;
  int kt = 0;
  for (; kt < nact - 1; ++kt) {
    const int st1 = (st == 2) ? 0 : st + 1, st2 = (st1 == 2) ? 0 : st1 + 1;
    ATT_STORE(st2);
    { const int tl = (kt + 3 < ntiles) ? kt + 3 : ntiles - 1; ATT_LOAD(tl); }
    attn_qk((const bf16_t*)(smem + st1 * ATT_STAGE), qf, sn, l31, lh);
    attn_softmax<false>(sc, o, m, l, kt, myq, lh);
    attn_pv(sc, o, (const bf16_t*)(smem + st * ATT_STAGE + ATT_K_BYTES), l31, lh);
    __syncthreads();
#pragma unroll
    for (int sub = 0; sub < 2; ++sub) sc[sub] = sn[sub];
    st = st1;
  }
  {
    const int st1 = (st == 2) ? 0 : st + 1, st2 = (st1 == 2) ? 0 : st1 + 1;
    ATT_STORE(st2);
    { const int tl = (kt + 3 < ntiles) ? kt + 3 : ntiles - 1; ATT_LOAD(tl); }
    attn_softmax<true>(sc, o, m, l, kt, myq, lh);
    attn_pv(sc, o, (const bf16_t*)(smem + st * ATT_STAGE + ATT_K_BYTES), l31, lh);
    __syncthreads();
    st = st1; ++kt;
  }
  for (; kt < ntiles; ++kt) {
    const int st1 = (st == 2) ? 0 : st + 1, st2 = (st1 == 2) ? 0 : st1 + 1;
    ATT_STORE(st2);
    { const int tl = (kt + 3 < ntiles) ? kt + 3 : ntiles - 1; ATT_LOAD(tl); }
    __syncthreads();
    st = st1;
  }
#undef ATT_LOAD
#undef ATT_STORE
  l += __shfl_xor(l, 32);
  const float il = 1.f / l;
#pragma unroll
  for (int dvt = 0; dvt < 2; ++dvt)
#pragma unroll
    for (int rg = 0; rg < 4; ++rg) {
      const int dv = dvt * 32 + 8 * rg + 4 * lh;
      const uint2 gv = *(const uint2*)(GATE + tq * 1024 + h * 64 + dv);
      const float g0 = __uint_as_float(gv.x << 16), g1 = __uint_as_float(gv.x & 0xffff0000u), g2 = __uint_as_float(gv.y << 16), g3 = __uint_as_float(gv.y & 0xffff0000u);
      uint2 ov; ov.x = pk2(o[dvt][4 * rg] * il * g0, o[dvt][4 * rg + 1] * il * g1); ov.y = pk2(o[dvt][4 * rg + 2] * il * g2, o[dvt][4 * rg + 3] * il * g3);
      *(uint2*)(O + tq * 1024 + h * 64 + dv) = ov;
    }
}

DI void phase_attn(const Params& p, unsigned char* smem) {
  for (int u = blockIdx.x; u < 512; u += gridDim.x) {
    int pu = u;
    if (gridDim.x == 256) {
      const int xcd = blockIdx.x & 7, li = blockIdx.x >> 3, r = u >> 8;
      pu = (r * 16 + xcd * 2 + (li >> 4)) * 16 + (li & 15);
    }
    const int bh = pu >> 4, x = pu & 15;
    for (int half = 0; half < 2; ++half) attn_unit(p, bh >> 4, bh & 15, half ? x : 31 - x, smem);
  }
}

DI void phase_final_norm(const Params& p) {
  const int tid = otid(); const int lane = tid & 63, w = tid >> 6;
  float4 g[4];
#pragma unroll
  for (int i = 0; i < 4; ++i) g[i] = ((const float4*)p.g_final)[lane + 64 * i];
  for (int row = (blockIdx.x * 8 + w) * 2; row < T; row += gridDim.x * 16) {
    float4 v[2][4]; float ss[2] = {0.f, 0.f};
#pragma unroll
    for (int u = 0; u < 2; ++u)
#pragma unroll
      for (int i = 0; i < 4; ++i) v[u][i] = ((const float4*)(p.out + (size_t)(row + u) * DM))[lane + 64 * i];
#pragma unroll
    for (int u = 0; u < 2; ++u) {
#pragma unroll
      for (int i = 0; i < 4; ++i) ss[u] += v[u][i].x * v[u][i].x + v[u][i].y * v[u][i].y + v[u][i].z * v[u][i].z + v[u][i].w * v[u][i].w;
      ss[u] = wave_sum(ss[u]);
      const float r = rsqrtf(ss[u] * (1.f / 1024.f) + 1e-6f);
#pragma unroll
      for (int i = 0; i < 4; ++i)
        ((float4*)(p.out + (size_t)(row + u) * DM))[lane + 64 * i] = make_float4(v[u][i].x * r * g[i].x, v[u][i].y * r * g[i].y, v[u][i].z * r * g[i].z, v[u][i].w * r * g[i].w);
    }
  }
}

__global__ void __launch_bounds__(NTHREADS) mega(Params p) {
  cg::grid_group grid = cg::this_grid();
  extern __shared__ __attribute__((aligned(16))) unsigned char smem[];
  unsigned char* ws = p.ws;
  __shared__ unsigned bar_st[4];
  if (threadIdx.x < 4) bar_st[threadIdx.x] = 0u;
  __syncthreads();
  const XcdBarrier xb = xcd_barrier_post((unsigned*)(ws + OFF_BAR), bar_st);
  const bool tailfill = (gridDim.x == 256);
  phase_prep(p, smem, blockIdx.x, tailfill ? 1344 : 2832, gridDim.x);
  if (!tailfill) phase_rope_tables(p, blockIdx.x, gridDim.x);
  phase_rmsnorm_rows(p.x, (bf16_t*)(ws + OFF_XN));
  if (p.out == nullptr) grid.sync();
  xcd_barrier(xb);
  gemm_phase<EPI_SSM_IN, 1024>(p, (const bf16_t*)(ws + OFF_W1), (const bf16_t*)(ws + OFF_XN), 21, smem);
  if (tailfill && (blockIdx.x >> 3) >= 8) {
    const int tj = (blockIdx.x & 7) * 24 + ((blockIdx.x >> 3) - 8);
    phase_prep(p, smem, 1344 + tj, 2832, 192);
    phase_rope_tables(p, tj, 192);
  }
  xcd_barrier(xb);
  phase_ssd_state(p, smem);
  xcd_barrier(xb);
  phase_ssd_scan(p);
  xcd_barrier(xb);
  phase_ssd_out(p, smem);
  xcd_barrier(xb);
  gemm_phase<EPI_OUT1, 2048>(p, (const bf16_t*)(ws + OFF_W2), (const bf16_t*)p.out, 4, smem);
  xcd_barrier(xb);
  gemm_phase<EPI_MLA_IN, 1024>(p, (const bf16_t*)(ws + OFF_W3), (const bf16_t*)(ws + OFF_XN), 7, smem);
  xcd_barrier(xb);
  gemm_phase<EPI_KVUP, 256>(p, (const bf16_t*)(ws + OFF_W4), (const bf16_t*)(ws + OFF_ST + 32 * MiB), 8, smem);
  gemm_phase<EPI_QUP, 384>(p, (const bf16_t*)(ws + OFF_W5), (const bf16_t*)(ws + OFF_ST + 40 * MiB), 6, smem);
  xcd_barrier(xb);
  phase_attn(p, smem);
  xcd_barrier(xb);
  gemm_phase<EPI_OUT2, 1024>(p, (const bf16_t*)(ws + OFF_W6), (const bf16_t*)(ws + OFF_ST + 32 * MiB), 4, smem);
  xcd_barrier(xb);
  phase_final_norm(p);
}

extern "C" void kernel_launch(void* const* d_in, const int* in_sizes, int n_in, void* d_out, int out_size, void* d_ws, size_t ws_size, hipStream_t stream) {
  static int grid = 0;
  if (grid == 0) {
    if (n_in != 20 || ws_size < WS_NEED) { fprintf(stderr, "kernel_launch: unexpected n_in %d / ws_size %zu\n", n_in, ws_size); grid = -1; return; }
    int dev = 0, cus = 0, per_cu = 0;
    hipGetDevice(&dev);
    hipDeviceGetAttribute(&cus, hipDeviceAttributeMultiprocessorCount, dev);
    if (hipFuncSetAttribute((const void*)mega, hipFuncAttributeMaxDynamicSharedMemorySize, LDS_BYTES) != hipSuccess) { fprintf(stderr, "hipFuncSetAttribute failed\n"); grid = -1; return; }
    hipOccupancyMaxActiveBlocksPerMultiprocessor(&per_cu, (const void*)mega, NTHREADS, LDS_BYTES);
    if (per_cu < 1) per_cu = 1;
    (void)hipGetLastError();
    grid = cus;
  }
  if (grid < 0) return;
  Params p{};
  p.x = (const float*)d_in[0]; p.pos = (const int*)d_in[1]; p.g_pre = (const float*)d_in[2]; p.ssm_w_in = (const float*)d_in[3];
  p.conv_w = (const float*)d_in[4]; p.conv_b = (const float*)d_in[5]; p.dt_bias = (const float*)d_in[6]; p.A_log = (const float*)d_in[7];
  p.Dskip = (const float*)d_in[8]; p.g_out = (const float*)d_in[9]; p.ssm_w_out = (const float*)d_in[10]; p.kv_g_in = (const float*)d_in[11];
  p.kv_w_down = (const float*)d_in[12]; p.kv_g_lat = (const float*)d_in[13]; p.kv_w_up = (const float*)d_in[14]; p.mla_w_in = (const float*)d_in[15];
  p.mla_g_q = (const float*)d_in[16]; p.mla_w_uq = (const float*)d_in[17]; p.mla_w_out = (const float*)d_in[18]; p.g_final = (const float*)d_in[19];
  p.out = (float*)d_out; p.ws = (unsigned char*)d_ws;
  if (hipMemsetAsync((char*)d_ws + OFF_BAR, 0, XCD_BAR_WORDS * sizeof(unsigned), stream) != hipSuccess) { fprintf(stderr, "memset of barrier words failed\n"); return; }
  void* args[] = {&p};
  hipError_t e = hipLaunchCooperativeKernel((const void*)mega, dim3(grid), dim3(NTHREADS), args, LDS_BYTES, stream);
  if (e != hipSuccess) fprintf(stderr, "cooperative launch failed: %s (grid %d)\n", hipGetErrorString(e), grid);
}
```

```cpp
#include <hip/hip_runtime.h>
#include <hip/hip_cooperative_groups.h>
#include <cstdio>
#include <cstdint>
namespace cg = cooperative_groups;

typedef unsigned short bf16_t;
typedef short bf16x8 __attribute__((ext_vector_type(8)));
typedef float f32x16 __attribute__((ext_vector_type(16)));
#define DI __device__ __forceinline__
#define MFMA32(a, b, c) __builtin_amdgcn_mfma_f32_32x32x16_bf16((a), (b), (c), 0, 0, 0)

constexpr int T = 16384, SEQ = 8192, DM = 1024;
constexpr int NTHREADS = 512;
constexpr size_t MiB = 1024 * 1024;
constexpr size_t OFF_W1 = 0;
constexpr size_t OFF_W2 = OFF_W1 + (size_t)5376 * 1024 * 2;
constexpr size_t OFF_W3 = OFF_W2 + (size_t)1024 * 2048 * 2;
constexpr size_t OFF_W4 = OFF_W3 + (size_t)1792 * 1024 * 2;
constexpr size_t OFF_W5 = OFF_W4 + (size_t)2048 * 256 * 2;
constexpr size_t OFF_W6 = OFF_W5 + (size_t)1536 * 384 * 2;
constexpr size_t OFF_XN = 24 * MiB;
constexpr size_t OFF_XT = 56 * MiB;
constexpr size_t OFF_BT = 120 * MiB;
constexpr size_t OFF_BR = 136 * MiB;
constexpr size_t OFF_CR = 152 * MiB;
constexpr size_t OFF_DT = 168 * MiB;
constexpr size_t OFF_ST = 170 * MiB;
constexpr size_t OFF_DEC = 234 * MiB;
constexpr size_t OFF_BAR = 236 * MiB;
constexpr size_t OFF_COS = 238 * MiB;
constexpr size_t OFF_SIN = 239 * MiB;
constexpr size_t OFF_SSQ = 240 * MiB;
constexpr size_t WS_NEED = 241 * MiB;

struct Params {
  const float* x; const int* pos; const float* g_pre; const float* ssm_w_in; const float* conv_w; const float* conv_b;
  const float* dt_bias; const float* A_log; const float* Dskip; const float* g_out; const float* ssm_w_out;
  const float* kv_g_in; const float* kv_w_down; const float* kv_g_lat; const float* kv_w_up;
  const float* mla_w_in; const float* mla_g_q; const float* mla_w_uq; const float* mla_w_out; const float* g_final;
  float* out; unsigned char* ws;
};

DI bf16_t f2bf(float x) { unsigned u = __float_as_uint(x); u += 0x7fffu + ((u >> 16) & 1u); return (bf16_t)(u >> 16); }
DI float bf2f(bf16_t b) { return __uint_as_float(((unsigned)b) << 16); }
DI float lo16(unsigned u) { return __uint_as_float(u << 16); }
DI float hi16(unsigned u) { return __uint_as_float(u & 0xffff0000u); }
typedef float f32x2 __attribute__((ext_vector_type(2)));
typedef __bf16 bf16x2_t __attribute__((ext_vector_type(2)));
DI unsigned pk2(float a, float b) { f32x2 v = {a, b}; bf16x2_t r = __builtin_convertvector(v, bf16x2_t); return __builtin_bit_cast(unsigned, r); }
DI float wave_sum(float v) {
#pragma unroll
  for (int o = 32; o >= 1; o >>= 1) v += __shfl_xor(v, o);
  return v;
}
DI int otid() { int t = threadIdx.x; asm volatile("" : "+v"(t)); return t; }
template <int K> DI float swz_xor(float v) {
  return __int_as_float(__builtin_amdgcn_ds_swizzle(__float_as_int(v), (K << 10) | 0x1f));
}
DI float silu_f(float v) { return v * __builtin_amdgcn_rcpf(1.f + __expf(-v)); }


#define XB_TMO      128
#define XB_XCNT(j)  (256  + 64 * (j))
#define XB_XSUB(j)  (1280 + 64 * (j))
#define XB_XGEN(j)  (2304 + 64 * (j))
#define XB_TOP      3328
#define XB_TOPGEN   3392
#define XCD_BAR_WORDS 3456
#define XB_SPIN_CAP (1u << 18)
DI unsigned xb_ld(unsigned* p)              { return __hip_atomic_load(p, __ATOMIC_RELAXED, __HIP_MEMORY_SCOPE_AGENT); }
DI unsigned xb_add(unsigned* p, unsigned v) { return __hip_atomic_fetch_add(p, v, __ATOMIC_RELAXED, __HIP_MEMORY_SCOPE_AGENT); }
DI unsigned xb_xcc_id() { return (unsigned)__builtin_amdgcn_s_getreg((3 << 11) | 20) & 0xFu; }
#define XB_SPIN(cond, bar) do { unsigned _sp = 0; while (cond) { __builtin_amdgcn_s_sleep(1); \
    if ((++_sp & 255u) == 0u) { if (xb_ld(&(bar)[XB_TMO])) break; if (_sp > XB_SPIN_CAP) { atomicAdd(&(bar)[XB_TMO], 1u); break; } } } } while (0)
struct XcdBarrier { unsigned* bar; unsigned x; volatile unsigned* st; };
DI XcdBarrier xcd_barrier_post(unsigned* bar, volatile unsigned* st) {
  XcdBarrier b; b.bar = bar; b.x = xb_xcc_id(); b.st = st;
  if (threadIdx.x == 0) (void)xb_add(&bar[XB_XCNT(b.x)], 1u);
  return b;
}
DI void xcd_barrier_complete(unsigned* bar, unsigned x, unsigned& nloc, unsigned& nx) {
  const unsigned G = gridDim.x * gridDim.y * gridDim.z;
  unsigned sum, cnt, mine, sp = 0u;
  for (;;) {
    sum = 0u; cnt = 0u; mine = 0u;
#pragma unroll
    for (unsigned j = 0; j < 16; ++j) { const unsigned c = xb_ld(&bar[XB_XCNT(j)]); sum += c; cnt += (c > 0u) ? 1u : 0u; mine = (j == x) ? c : mine; }
    if (sum == G) break;
    __builtin_amdgcn_s_sleep(1);
    if ((++sp & 255u) == 0u) { if (xb_ld(&bar[XB_TMO])) break; if (sp > XB_SPIN_CAP) { atomicAdd(&bar[XB_TMO], 1u); break; } }
  }
  nloc = mine > 0u ? mine : 1u; nx = cnt > 0u ? cnt : 1u;
}
DI void xcd_barrier(const XcdBarrier& b) {
  asm volatile("s_waitcnt vmcnt(0)" ::: "memory");
  __syncthreads();
  if (threadIdx.x == 0) {
    unsigned* bar = b.bar;
    __builtin_amdgcn_s_waitcnt(0);
    unsigned nloc = b.st[0], nx = b.st[1];
    if (nloc == 0u) { xcd_barrier_complete(bar, b.x, nloc, nx); b.st[0] = nloc; b.st[1] = nx; }
    const unsigned old = xb_add(&bar[XB_XSUB(b.x)], 1u);
    const unsigned gen = old / nloc;
    if (old + 1u == (gen + 1u) * nloc) {
      __builtin_amdgcn_fence(__ATOMIC_RELEASE, "agent");
      asm volatile("s_waitcnt vmcnt(0)" ::: "memory");
      const unsigned og = xb_add(&bar[XB_TOP], 1u);
      const unsigned tg = og / nx;
      if (og + 1u == (tg + 1u) * nx) xb_add(&bar[XB_TOPGEN], 1u);
      else XB_SPIN(xb_ld(&bar[XB_TOPGEN]) == tg, bar);
      __builtin_amdgcn_fence(__ATOMIC_ACQUIRE, "agent");
      xb_add(&bar[XB_XGEN(b.x)], 1u);
      asm volatile("s_waitcnt vmcnt(0)" ::: "memory");
    } else {
      XB_SPIN(xb_ld(&bar[XB_XGEN(b.x)]) == gen, bar);
      __builtin_amdgcn_fence(__ATOMIC_ACQUIRE, "agent");
      asm volatile("s_waitcnt vmcnt(0)" ::: "memory");
    }
  }
  __syncthreads();
}

struct WJob { const float* src; const float* gain; bf16_t* dst; int ld, col0, ncols, K, tile; };
DI WJob wprep_job(const Params& p, int u) {
  bf16_t* W1 = (bf16_t*)(p.ws + OFF_W1); bf16_t* W2 = (bf16_t*)(p.ws + OFF_W2); bf16_t* W3 = (bf16_t*)(p.ws + OFF_W3);
  bf16_t* W4 = (bf16_t*)(p.ws + OFF_W4); bf16_t* W5 = (bf16_t*)(p.ws + OFF_W5); bf16_t* W6 = (bf16_t*)(p.ws + OFF_W6);
  int t = u; WJob j;
  if (t < 1344) { j = {p.ssm_w_in, p.g_pre, W1, 5152, 0, 5152, 1024, t}; return j; } t -= 1344;
  if (t < 512) { j = {p.ssm_w_out, p.g_out, W2, 1024, 0, 1024, 2048, t}; return j; } t -= 512;
  if (t < 64) { j = {p.kv_w_down, p.kv_g_in, W3, 288, 0, 256, 1024, t}; return j; } t -= 64;
  if (t < 96) { j = {p.mla_w_in, p.g_pre + 1024, W3 + (size_t)256 * 1024, 1408, 0, 384, 1024, t}; return j; } t -= 96;
  if (t < 256) { j = {p.mla_w_in, p.g_pre + 1024, W3 + (size_t)640 * 1024, 1408, 384, 1024, 1024, t}; return j; } t -= 256;
  if (t < 32) { j = {p.kv_w_down, p.kv_g_in, W3 + (size_t)1664 * 1024, 288, 256, 32, 1024, t}; return j; } t -= 32;
  if (t < 128) { j = {p.kv_w_up, p.kv_g_lat, W4, 2048, 0, 2048, 256, t}; return j; } t -= 128;
  if (t < 144) { j = {p.mla_w_uq, p.mla_g_q, W5, 1536, 0, 1536, 384, t}; return j; } t -= 144;
  j = {p.mla_w_out, nullptr, W6, 1024, 0, 1024, 1024, t}; return j;
}
DI void wprep_load(const WJob& j, int tid0, float4 (&v)[2], float (&gk)[2]) {
  const int nkt = j.K >> 6; const int tn = j.tile / nkt, tk = j.tile % nkt; const int n0 = tn * 64, k0 = tk * 64;
#pragma unroll
  for (int i = 0; i < 2; ++i) {
    const int e = tid0 + NTHREADS * i; const int kk = e >> 4, n4 = (e & 15) * 4;
    v[i] = make_float4(0.f, 0.f, 0.f, 0.f);
    if (n0 + n4 < j.ncols) v[i] = *(const float4*)(j.src + (size_t)(k0 + kk) * j.ld + j.col0 + n0 + n4);
    gk[i] = j.gain ? j.gain[k0 + kk] : 1.f;
  }
}
DI void phase_prep(const Params& p, unsigned char* smem, int ustart, int uend, int ustride) {
  float* sm = (float*)smem;
  const int tid0 = otid();
  int u = ustart;
  if (u >= uend) return;
  WJob j = wprep_job(p, u);
  float4 v[2]; float gk[2];
  wprep_load(j, tid0, v, gk);
  for (;;) {
#pragma unroll
    for (int i = 0; i < 2; ++i) {
      const int e = tid0 + NTHREADS * i; const int kk = e >> 4, n4 = (e & 15) * 4;
      float* d = sm + kk * 65 + n4;
      d[0] = v[i].x * gk[i]; d[1] = v[i].y * gk[i]; d[2] = v[i].z * gk[i]; d[3] = v[i].w * gk[i];
    }
    __syncthreads();
    const WJob jc = j;
    const int un = u + ustride; const bool more = (un < uend);
    if (more) { j = wprep_job(p, un); wprep_load(j, tid0, v, gk); }
    {
      const int nkt = jc.K >> 6; const int tn = jc.tile / nkt, tk = jc.tile % nkt; const int n0 = tn * 64, k0 = tk * 64;
      const int nn = tid0 >> 3, kc = (tid0 & 7) * 8;
      uint4 o;
      o.x = pk2(sm[(kc + 0) * 65 + nn], sm[(kc + 1) * 65 + nn]); o.y = pk2(sm[(kc + 2) * 65 + nn], sm[(kc + 3) * 65 + nn]);
      o.z = pk2(sm[(kc + 4) * 65 + nn], sm[(kc + 5) * 65 + nn]); o.w = pk2(sm[(kc + 6) * 65 + nn], sm[(kc + 7) * 65 + nn]);
      *(uint4*)(jc.dst + (size_t)(n0 + nn) * jc.K + k0 + kc) = o;
    }
    __syncthreads();
    if (!more) break;
    u = un;
  }
}

DI void phase_rope_tables(const Params& p, int blk, int nblk) {
  float* COS = (float*)(p.ws + OFF_COS); float* SIN = (float*)(p.ws + OFF_SIN);
  for (int e = blk * NTHREADS + otid(); e < T * 16; e += nblk * NTHREADS) {
    const int t = e >> 4, i = e & 15;
    const float ang = (float)p.pos[t] * powf(10000.f, -(float)(2 * i) / 32.f);
    COS[e] = cosf(ang); SIN[e] = sinf(ang);
  }
  float* SSQ = (float*)(p.ws + OFF_SSQ);
  for (int e = blk * NTHREADS + otid(); e < 3 * T; e += nblk * NTHREADS) SSQ[e] = 0.f;
}

DI void phase_rmsnorm_rows(const float* __restrict__ src, bf16_t* __restrict__ dst) {
  const int tid = otid(); const int lane = tid & 63, w = tid >> 6;
  for (int row = (blockIdx.x * 8 + w) * 2; row < T; row += gridDim.x * 16) {
    float4 v[2][4]; float ss[2] = {0.f, 0.f};
#pragma unroll
    for (int u = 0; u < 2; ++u)
#pragma unroll
      for (int i = 0; i < 4; ++i) v[u][i] = ((const float4*)(src + (size_t)(row + u) * DM))[lane + 64 * i];
#pragma unroll
    for (int u = 0; u < 2; ++u) {
#pragma unroll
      for (int i = 0; i < 4; ++i) ss[u] += v[u][i].x * v[u][i].x + v[u][i].y * v[u][i].y + v[u][i].z * v[u][i].z + v[u][i].w * v[u][i].w;
      ss[u] = wave_sum(ss[u]);
      const float r = rsqrtf(ss[u] * (1.f / 1024.f) + 1e-6f);
#pragma unroll
      for (int i = 0; i < 4; ++i) {
        uint2 o; o.x = pk2(v[u][i].x * r, v[u][i].y * r); o.y = pk2(v[u][i].z * r, v[u][i].w * r);
        *(uint2*)(dst + (size_t)(row + u) * DM + (lane + 64 * i) * 4) = o;
      }
    }
  }
}

enum { EPI_SSM_IN = 0, EPI_OUT1 = 1, EPI_MLA_IN = 2, EPI_KVUP = 3, EPI_QUP = 4, EPI_OUT2 = 5 };


typedef float f32x4 __attribute__((ext_vector_type(4)));
constexpr int EPI_WAVE_BYTES = 8704;
constexpr int TM_ROW = 72;
constexpr int CM_ROW = 40;
constexpr int F32_ROW = 68;

template <bool SILU>
DI void stage_tm(const f32x4 (&a)[4][2], bf16_t* wl, int fr, int fq) {
#pragma unroll
  for (int m = 0; m < 4; ++m)
#pragma unroll
    for (int n = 0; n < 2; ++n) {
      float v0 = a[m][n][0], v1 = a[m][n][1], v2 = a[m][n][2], v3 = a[m][n][3];
      if (SILU) { v0 = silu_f(v0); v1 = silu_f(v1); v2 = silu_f(v2); v3 = silu_f(v3); }
      uint2 o; o.x = pk2(v0, v1); o.y = pk2(v2, v3);
      *(uint2*)(wl + (n * 16 + fr) * TM_ROW + m * 16 + fq * 4) = o;
    }
}
DI void readout_tm(const bf16_t* wl, bf16_t* gdst, size_t ld, int lane) {
#pragma unroll
  for (int it = 0; it < 4; ++it) {
    const int idx = lane + 64 * it; const int row = idx >> 3, ch = idx & 7;
    *(uint4*)(gdst + (size_t)row * ld + ch * 8) = *(const uint4*)(wl + row * TM_ROW + ch * 8);
  }
}
DI void stage_cm(const f32x4 (&a)[4][2], bf16_t* wl, int fr, int fq) {
#pragma unroll
  for (int m = 0; m < 4; ++m)
#pragma unroll
    for (int n = 0; n < 2; ++n)
#pragma unroll
      for (int j = 0; j < 4; ++j) wl[(m * 16 + fq * 4 + j) * CM_ROW + n * 16 + fr] = f2bf(a[m][n][j]);
}
DI void readout_cm(const bf16_t* wl, bf16_t* gdst, int lane) {
#pragma unroll
  for (int it = 0; it < 4; ++it) {
    const int idx = lane + 64 * it; const int row = idx >> 2, ch = idx & 3;
    *(uint4*)(gdst + (size_t)row * SEQ + ch * 8) = *(const uint4*)(wl + row * CM_ROW + ch * 8);
  }
}
constexpr int CMP_ROW = 72;
DI void stage_cm_pair(const f32x4 (&a)[4][2], bf16_t* wlp, int par, int fr, int fq) {
#pragma unroll
  for (int m = 0; m < 4; ++m)
#pragma unroll
    for (int n = 0; n < 2; ++n)
#pragma unroll
      for (int j = 0; j < 4; ++j) wlp[(m * 16 + fq * 4 + j) * CMP_ROW + par * 32 + n * 16 + fr] = f2bf(a[m][n][j]);
}
DI void readout_cm_pair(const bf16_t* wlp, bf16_t* gdst, int par, int lane) {
#pragma unroll
  for (int it = 0; it < 4; ++it) {
    const int idx = lane + 64 * it; const int row = par * 32 + (idx >> 3), ch = idx & 7;
    *(uint4*)(gdst + (size_t)row * SEQ + ch * 8) = *(const uint4*)(wlp + row * CMP_ROW + ch * 8);
  }
}
DI void stage_f32(const f32x4 (&a)[4][2], float* wl, int fr, int fq) {
#pragma unroll
  for (int m = 0; m < 4; ++m)
#pragma unroll
    for (int n = 0; n < 2; ++n) *(f32x4*)(wl + (n * 16 + fr) * F32_ROW + m * 16 + fq * 4) = a[m][n];
}
DI void readout_f32_resid(const float* wl, const float* __restrict__ resid, float* __restrict__ gdst, int lane) {
#pragma unroll 4
  for (int it = 0; it < 8; ++it) {
    const int idx = lane + 64 * it; const int row = idx >> 4, ch = idx & 15;
    const float4 v = *(const float4*)(wl + row * F32_ROW + ch * 4);
    const float4 r = *(const float4*)(resid + (size_t)row * DM + ch * 4);
    *(float4*)(gdst + (size_t)row * DM + ch * 4) = make_float4(v.x + r.x, v.y + r.y, v.z + r.z, v.w + r.w);
  }
}

DI void readout_f32_resid_ssq(const float* wl, const float* __restrict__ resid, float* __restrict__ gdst, bf16_t* __restrict__ hs, float* __restrict__ ssq, int lane) {
#pragma unroll 4
  for (int it = 0; it < 8; ++it) {
    const int idx = lane + 64 * it; const int row = idx >> 4, ch = idx & 15;
    const float4 v = *(const float4*)(wl + row * F32_ROW + ch * 4);
    const float4 r = *(const float4*)(resid + (size_t)row * DM + ch * 4);
    const float4 h = make_float4(v.x + r.x, v.y + r.y, v.z + r.z, v.w + r.w);
    *(float4*)(gdst + (size_t)row * DM + ch * 4) = h;
    uint2 o; o.x = pk2(h.x, h.y); o.y = pk2(h.z, h.w);
    *(uint2*)(hs + (size_t)row * DM + ch * 4) = o;
    float q = h.x * h.x + h.y * h.y + h.z * h.z + h.w * h.w;
    q += swz_xor<1>(q); q += swz_xor<2>(q); q += swz_xor<4>(q); q += swz_xor<8>(q);
    if (ch == 0) atomicAdd(ssq + row, q);
  }
}

DI void resid_preload(const float* __restrict__ resid, int lane, float4 (&rr)[8]) {
#pragma unroll
  for (int it = 0; it < 8; ++it) { const int idx = lane + 64 * it; rr[it] = *(const float4*)(resid + (size_t)(idx >> 4) * DM + (idx & 15) * 4); }
}
DI void readout_f32_pre(const float* wl, const float4 (&rr)[8], float* __restrict__ gdst, int lane) {
#pragma unroll
  for (int it = 0; it < 8; ++it) {
    const int idx = lane + 64 * it; const int row = idx >> 4, ch = idx & 15;
    const float4 v = *(const float4*)(wl + row * F32_ROW + ch * 4);
    *(float4*)(gdst + (size_t)row * DM + ch * 4) = make_float4(v.x + rr[it].x, v.y + rr[it].y, v.z + rr[it].z, v.w + rr[it].w);
  }
}
DI void readout_f32_pre_ssq(const float* wl, const float4 (&rr)[8], float* __restrict__ gdst, bf16_t* __restrict__ hs, float* __restrict__ ssq, int lane) {
#pragma unroll
  for (int it = 0; it < 8; ++it) {
    const int idx = lane + 64 * it; const int row = idx >> 4, ch = idx & 15;
    const float4 v = *(const float4*)(wl + row * F32_ROW + ch * 4);
    const float4 h = make_float4(v.x + rr[it].x, v.y + rr[it].y, v.z + rr[it].z, v.w + rr[it].w);
    *(float4*)(gdst + (size_t)row * DM + ch * 4) = h;
    uint2 o; o.x = pk2(h.x, h.y); o.y = pk2(h.z, h.w);
    *(uint2*)(hs + (size_t)row * DM + ch * 4) = o;
    float q = h.x * h.x + h.y * h.y + h.z * h.z + h.w * h.w;
    q += swz_xor<1>(q); q += swz_xor<2>(q); q += swz_xor<4>(q); q += swz_xor<8>(q);
    if (ch == 0) atomicAdd(ssq + row, q);
  }
}

DI void wave_lds_sync() { asm volatile("s_waitcnt lgkmcnt(0)" ::: "memory"); }

template <int EPI>
DI void epilogue_block(const Params& p, const f32x4 (&a)[4][2], int c0, int mt, bf16_t* wl, bf16_t* wlp, int par, int lane, int fr, int fq, const float (&sq)[2]) {
  unsigned char* ws = p.ws;
  const int b = mt >> 13, tok0 = mt & 8191;
  const int tok0p = tok0 - par * 32;
  if (EPI == EPI_SSM_IN) {
    if (c0 < 2048) {
      stage_tm<false>(a, wl, fr, fq); wave_lds_sync();
      readout_tm(wl, (bf16_t*)p.out + (size_t)mt * 2048 + c0, 2048, lane); wave_lds_sync();
    } else if (c0 < 4096) {
      stage_cm_pair(a, wlp, par, fr, fq); __syncthreads();
      readout_cm_pair(wlp, (bf16_t*)(ws + OFF_XT) + ((size_t)(b * 2048 + (c0 - 2048))) * SEQ + tok0p, par, lane); __syncthreads();
    } else if (c0 < 4608) {
      stage_tm<false>(a, wl, fr, fq); wave_lds_sync();
      readout_tm(wl, (bf16_t*)(ws + OFF_BR) + (size_t)mt * 512 + (c0 - 4096), 512, lane); __syncthreads();
      stage_cm_pair(a, wlp, par, fr, fq); __syncthreads();
      readout_cm_pair(wlp, (bf16_t*)(ws + OFF_BT) + ((size_t)(b * 512 + (c0 - 4096))) * SEQ + tok0p, par, lane); __syncthreads();
    } else if (c0 < 5120) {
      stage_tm<false>(a, wl, fr, fq); wave_lds_sync();
      readout_tm(wl, (bf16_t*)(ws + OFF_CR) + (size_t)mt * 512 + (c0 - 4608), 512, lane); wave_lds_sync();
    } else if (c0 == 5120) {
#pragma unroll
      for (int m = 0; m < 2; ++m)
#pragma unroll
        for (int n = 0; n < 2; ++n) {
          const int h = m * 16 + fq * 4;
          float4 o; float* op = (float*)&o;
#pragma unroll
          for (int j = 0; j < 4; ++j) { const float t = a[m][n][j] + p.dt_bias[h + j]; op[j] = (t > 20.f) ? t : log1pf(__expf(t)); }
          *(float4*)((float*)(ws + OFF_DT) + (size_t)(mt + n * 16 + fr) * 32 + h) = o;
        }
    }
  } else if (EPI == EPI_OUT1 || EPI == EPI_OUT2) {
    const float* resid = (EPI == EPI_OUT1) ? p.x : (const float*)(ws + OFF_XT);
    float* dst = (EPI == EPI_OUT1) ? (float*)(ws + OFF_XT) : p.out;
    float4 rr[8]; resid_preload(resid + (size_t)mt * DM + c0, lane, rr);
    stage_f32(a, (float*)wl, fr, fq); wave_lds_sync();
    if (EPI == EPI_OUT1) readout_f32_pre_ssq((const float*)wl, rr, dst + (size_t)mt * DM + c0, (bf16_t*)(ws + OFF_XN) + (size_t)mt * DM + c0, (float*)(ws + OFF_SSQ) + mt, lane);
    else readout_f32_pre((const float*)wl, rr, dst + (size_t)mt * DM + c0, lane);
    wave_lds_sync();
  } else if (EPI == EPI_MLA_IN) {
    const float* SSQ = (const float*)(ws + OFF_SSQ);
    f32x4 a2[4][2];
    float rs[2];
#pragma unroll
    for (int n = 0; n < 2; ++n) rs[n] = rsqrtf(sq[n] * (1.f / 1024.f) + 1e-6f);
#pragma unroll
    for (int m = 0; m < 4; ++m)
#pragma unroll
      for (int n = 0; n < 2; ++n) a2[m][n] = a[m][n] * rs[n];
    if (c0 < 640) {
      float* dstq = (float*)(ws + OFF_SSQ) + (c0 < 256 ? T : 2 * T);
#pragma unroll
      for (int n = 0; n < 2; ++n) {
        float q = 0.f;
#pragma unroll
        for (int m = 0; m < 4; ++m) q += a2[m][n][0] * a2[m][n][0] + a2[m][n][1] * a2[m][n][1] + a2[m][n][2] * a2[m][n][2] + a2[m][n][3] * a2[m][n][3];
        q += swz_xor<16>(q); q += __shfl_xor(q, 32);
        if (fq == 0) atomicAdd(dstq + mt + n * 16 + fr, q);
      }
    }
    const f32x4 (&a)[4][2] = a2;
    if (c0 < 640) stage_tm<false>(a, wl, fr, fq);
    else if (c0 < 1664) stage_tm<true>(a, wl, fr, fq);
    wave_lds_sync();
    if (c0 < 256) readout_tm(wl, (bf16_t*)(ws + OFF_ST + 32 * MiB) + (size_t)mt * 256 + c0, 256, lane);
    else if (c0 < 640) readout_tm(wl, (bf16_t*)(ws + OFF_ST + 40 * MiB) + (size_t)mt * 384 + (c0 - 256), 384, lane);
    else if (c0 < 1664) readout_tm(wl, (bf16_t*)(ws + OFF_ST) + (size_t)mt * 1024 + (c0 - 640), 1024, lane);
    else if (c0 == 1664) {
      const float* COS = (const float*)(ws + OFF_COS); const float* SIN = (const float*)(ws + OFF_SIN);
      bf16_t* KROPE = (bf16_t*)(ws + OFF_DEC);
#pragma unroll
      for (int n = 0; n < 2; ++n) {
        const int t = mt + n * 16 + fr;
        const f32x4 cs = *(const f32x4*)(COS + (size_t)t * 16 + fq * 4), sn = *(const f32x4*)(SIN + (size_t)t * 16 + fq * 4);
        const f32x4 x1 = a[0][n], x2 = a[1][n];
        const f32x4 r1 = x1 * cs - x2 * sn, r2 = x1 * sn + x2 * cs;
        uint2 o1, o2; o1.x = pk2(r1[0], r1[1]); o1.y = pk2(r1[2], r1[3]); o2.x = pk2(r2[0], r2[1]); o2.y = pk2(r2[2], r2[3]);
        *(uint2*)(KROPE + (size_t)t * 32 + fq * 4) = o1; *(uint2*)(KROPE + (size_t)t * 32 + 16 + fq * 4) = o2;
      }
    }
    wave_lds_sync();
  } else if (EPI == EPI_KVUP) {
    const int head = c0 >> 7; const bool isv = (c0 & 64) != 0;
    const float* SSQ = (const float*)(ws + OFF_SSQ) + T;
    f32x4 a2[4][2];
#pragma unroll
    for (int n = 0; n < 2; ++n) {
      const float rsn = rsqrtf(sq[n] * (1.f / 256.f) + 1e-6f);
#pragma unroll
      for (int m = 0; m < 4; ++m) a2[m][n] = a[m][n] * rsn;
    }
    const f32x4 (&a)[4][2] = a2;
    if (!isv) stage_tm<false>(a, wl, fr, fq); else stage_cm_pair(a, wlp, par, fr, fq);
    __syncthreads();
    if (!isv) readout_tm(wl, (bf16_t*)(ws + OFF_XN) + (size_t)mt * 1024 + head * 64, 1024, lane);
    else readout_cm_pair(wlp, (bf16_t*)(ws + OFF_BT) + ((size_t)((b * 16 + head) * 64)) * SEQ + tok0p, par, lane);
    __syncthreads();
  } else if (EPI == EPI_QUP) {
    const float SC = 0.10206207261596575f * 1.4426950408889634f;
    const float* SSQ = (const float*)(ws + OFF_SSQ) + 2 * T;
    f32x4 v[4][2];
#pragma unroll
    for (int n = 0; n < 2; ++n) {
      const float rsn = rsqrtf(sq[n] * (1.f / 384.f) + 1e-6f) * SC;
#pragma unroll
      for (int m = 0; m < 4; ++m) v[m][n] = a[m][n] * rsn;
    }
    const int ph = c0 % 96;
    if (ph != 0) {
      const float* COS = (const float*)(ws + OFF_COS); const float* SIN = (const float*)(ws + OFF_SIN);
#pragma unroll
      for (int n = 0; n < 2; ++n) {
        const int t = mt + n * 16 + fr;
        const f32x4 cs = *(const f32x4*)(COS + (size_t)t * 16 + fq * 4), sn = *(const f32x4*)(SIN + (size_t)t * 16 + fq * 4);
        if (ph == 64) { const f32x4 x1 = v[0][n], x2 = v[1][n]; v[0][n] = x1 * cs - x2 * sn; v[1][n] = x1 * sn + x2 * cs; }
        else          { const f32x4 x1 = v[2][n], x2 = v[3][n]; v[2][n] = x1 * cs - x2 * sn; v[3][n] = x1 * sn + x2 * cs; }
      }
    }
    stage_tm<false>(v, wl, fr, fq); wave_lds_sync();
    readout_tm(wl, (bf16_t*)p.out + (size_t)mt * 1536 + c0, 1536, lane);
    wave_lds_sync();
  }
}

constexpr int G8_BK = 64, G8_HALF = 128, G8_HT = G8_HALF * G8_BK;
constexpr int LDS_BYTES = 143360;
DI int g8_lds_byte(int r, int c) { const int st = (r >> 4) * 2 + (c >> 5), rr = r & 15, cc = c & 31, ob = rr * 64 + cc * 2; return st * 1024 + (ob ^ (((ob >> 9) & 1) << 5)); }
DI void g8_stage_rc(int b, int& R, int& C) { const int st = b / 1024, sb = b % 1024, swz = sb ^ (((sb >> 9) & 1) << 5); R = (st >> 1) * 16 + swz / 64; C = (st & 1) * 32 + (swz % 64) / 2; }

template <int EPI, int K>
DI void gemm_tile(const Params& p, const bf16_t* __restrict__ A, const bf16_t* __restrict__ Bt, int brow, int bcol, unsigned char* smem) {
  bf16_t* shm = (bf16_t*)smem;
#define SA(b, h) (shm + ((b) * 2 + (h)) * G8_HT)
#define SB(b, h) (shm + (4 + (b) * 2 + (h)) * G8_HT)
#define STAGE(P, BASE, br, kt) do { const long _g = (long)(br) * K + (long)(kt) * G8_BK; \
    _Pragma("unroll") for (int _i = 0; _i < 2; ++_i) { const int _b = tid * 16 + _i * 8192; int _r, _c; g8_stage_rc(_b, _r, _c); \
      __builtin_amdgcn_global_load_lds((const unsigned*)(BASE + _g + (long)_r * K + _c), (unsigned*)((char*)(P) + _b), 16, 0, 0); } } while (0)
#define LDA(dst, b, h) _Pragma("unroll") for (int m = 0; m < 4; ++m) _Pragma("unroll") for (int k = 0; k < 2; ++k) \
    dst[m][k] = *reinterpret_cast<const bf16x8*>((const char*)SA(b, h) + g8_lds_byte(wr * 64 + m * 16 + fr, k * 32 + fq * 8))
#define LDB(dst, b, h) _Pragma("unroll") for (int n = 0; n < 2; ++n) _Pragma("unroll") for (int k = 0; k < 2; ++k) \
    dst[n][k] = *reinterpret_cast<const bf16x8*>((const char*)SB(b, h) + g8_lds_byte(wc * 32 + n * 16 + fr, k * 32 + fq * 8))
#define MMA(ai, bj, At_, Bt_) do { __builtin_amdgcn_s_setprio(1); \
    _Pragma("unroll") for (int m = 0; m < 4; ++m) _Pragma("unroll") for (int n = 0; n < 2; ++n) _Pragma("unroll") for (int k = 0; k < 2; ++k) \
      acc[ai][bj][m][n] = __builtin_amdgcn_mfma_f32_16x16x32_bf16(At_[m][k], Bt_[n][k], acc[ai][bj][m][n], 0, 0, 0); \
    __builtin_amdgcn_s_setprio(0); } while (0)
#define WAIT_V(n) asm volatile("s_waitcnt vmcnt(" #n ")" ::: "memory")
#define WAIT_L(n) asm volatile("s_waitcnt lgkmcnt(" #n ")" ::: "memory")
#define BAR __builtin_amdgcn_s_barrier()
#define SCHED __builtin_amdgcn_sched_barrier(0)
  const int tid = otid();
  const int wid = tid >> 6, lane = tid & 63, wr = wid >> 2, wc = wid & 3, fr = lane & 15, fq = lane >> 4;
  f32x4 acc[2][2][4][2];
#pragma unroll
  for (int a_ = 0; a_ < 2; ++a_)
#pragma unroll
    for (int b_ = 0; b_ < 2; ++b_)
#pragma unroll
      for (int m = 0; m < 4; ++m)
#pragma unroll
        for (int n = 0; n < 2; ++n) acc[a_][b_][m][n] = (f32x4){0.f, 0.f, 0.f, 0.f};
  bf16x8 At[4][2], B0[2][2], B1[2][2];
  constexpr int nt = K / G8_BK;
  STAGE(SB(0, 0), Bt, bcol, 0); STAGE(SA(0, 0), A, brow, 0);
  STAGE(SB(0, 1), Bt, bcol + G8_HALF, 0); STAGE(SA(0, 1), A, brow + G8_HALF, 0);
  if (wr == 1) BAR;
  WAIT_V(4); BAR;
  STAGE(SB(1, 0), Bt, bcol, 1); STAGE(SA(1, 0), A, brow, 1); STAGE(SB(1, 1), Bt, bcol + G8_HALF, 1);
  WAIT_V(6); BAR;
  for (int t = 0; t < nt - 2; t += 2) {
    LDB(B0, 0, 0); SCHED; LDA(At, 0, 0); STAGE(SA(1, 1), A, brow + G8_HALF, t + 1);
    WAIT_L(8); BAR; WAIT_L(0); MMA(0, 0, At, B0); BAR; SCHED;
    LDB(B1, 0, 1); STAGE(SB(0, 0), Bt, bcol, t + 2);
    BAR; WAIT_L(0); MMA(0, 1, At, B1); BAR;
    LDA(At, 0, 1); STAGE(SA(0, 0), A, brow, t + 2);
    BAR; WAIT_L(0); MMA(1, 0, At, B0); BAR; SCHED;
    STAGE(SB(0, 1), Bt, bcol + G8_HALF, t + 2);
    WAIT_V(6); BAR; MMA(1, 1, At, B1); BAR;
    LDB(B0, 1, 0); SCHED; LDA(At, 1, 0); STAGE(SA(0, 1), A, brow + G8_HALF, t + 2);
    WAIT_L(8); BAR; WAIT_L(0); MMA(0, 0, At, B0); BAR; SCHED;
    LDB(B1, 1, 1); STAGE(SB(1, 0), Bt, bcol, t + 3);
    BAR; WAIT_L(0); MMA(0, 1, At, B1); BAR;
    LDA(At, 1, 1); STAGE(SA(1, 0), A, brow, t + 3);
    BAR; WAIT_L(0); MMA(1, 0, At, B0); BAR; SCHED;
    STAGE(SB(1, 1), Bt, bcol + G8_HALF, t + 3);
    WAIT_V(6); BAR; MMA(1, 1, At, B1); BAR;
  }
  { LDB(B0, 0, 0); LDA(At, 0, 0); STAGE(SA(1, 1), A, brow + G8_HALF, nt - 1);
    BAR; WAIT_L(0); MMA(0, 0, At, B0); BAR;
    LDB(B1, 0, 1); BAR; WAIT_L(0); MMA(0, 1, At, B1); BAR;
    LDA(At, 0, 1); WAIT_V(4); BAR; WAIT_L(0); MMA(1, 0, At, B0); MMA(1, 1, At, B1); BAR; }
  { LDB(B0, 1, 0); LDA(At, 1, 0); WAIT_V(2); BAR; WAIT_L(0); MMA(0, 0, At, B0); BAR;
    LDB(B1, 1, 1); WAIT_V(0); BAR; WAIT_L(0); MMA(0, 1, At, B1); BAR;
    LDA(At, 1, 1); BAR; WAIT_L(0); MMA(1, 0, At, B0); MMA(1, 1, At, B1); BAR; }
  if (wr == 0) BAR;
  __syncthreads();
  int t2 = tid; asm volatile("" : "+v"(t2));
  const int wid2 = t2 >> 6, lane2 = t2 & 63, wr2 = wid2 >> 2, wc2 = wid2 & 3, fr2 = lane2 & 15, fq2 = lane2 >> 4;
  bf16_t* wl = (bf16_t*)(smem + wid2 * EPI_WAVE_BYTES);
  bf16_t* wlp = (bf16_t*)(smem + (wid2 & ~1) * EPI_WAVE_BYTES);
  float sqv[2][2] = {{0.f, 0.f}, {0.f, 0.f}};
  if (EPI == EPI_MLA_IN || EPI == EPI_KVUP || EPI == EPI_QUP) {
    const float* SQ = (const float*)(p.ws + OFF_SSQ) + (EPI == EPI_MLA_IN ? 0 : (EPI == EPI_KVUP ? T : 2 * T));
#pragma unroll
    for (int bj = 0; bj < 2; ++bj)
#pragma unroll
      for (int n = 0; n < 2; ++n) sqv[bj][n] = SQ[bcol + bj * 128 + wc2 * 32 + n * 16 + fr2];
  }
#pragma unroll
  for (int ai = 0; ai < 2; ++ai)
#pragma unroll
    for (int bj = 0; bj < 2; ++bj)
      epilogue_block<EPI>(p, acc[ai][bj], brow + ai * 128 + wr2 * 64, bcol + bj * 128 + wc2 * 32, wl, wlp, wc2 & 1, lane2, fr2, fq2, sqv[bj]);
  __syncthreads();
#undef SA
#undef SB
#undef STAGE
#undef LDA
#undef LDB
#undef MMA
#undef WAIT_V
#undef WAIT_L
#undef BAR
#undef SCHED
}

template <int EPI, int K>
DI void gemm_phase(const Params& p, const bf16_t* Wt, const bf16_t* X, int ntn, unsigned char* smem) {
  const bool xa = (gridDim.x == 256);
  const int xcd = blockIdx.x & 7, li = blockIdx.x >> 3;
  const int per_half = 4 * ntn;
  const int start = xa ? li : (int)blockIdx.x, step = xa ? 32 : (int)gridDim.x, total = ntn * (xa ? 8 : 64);
  for (int t = start; t < total; t += step) {
    int tm, tn;
    if (xa) { const int h = t / per_half, tp = t - h * per_half; tn = tp >> 2; tm = xcd * 8 + h * 4 + (tp & 3); }
    else { tm = t / ntn; tn = t % ntn; }
    gemm_tile<EPI, K>(p, Wt, X, tn * 256, tm * 256, smem);
  }
}

DI void conv8_load(const bf16_t* rp, bool has_prev, uint4& cur, uint2& prv) {
  cur = *(const uint4*)rp; prv = make_uint2(0u, 0u);
  if (has_prev) prv = *(const uint2*)(rp - 4);
}
DI float fast_silu(float v) { return v * __builtin_amdgcn_rcpf(1.f + __expf(-v)); }
DI void conv8_compute(const uint4 cur, const uint2 prv, float w0, float w1, float w2, float w3, float bias, float (&out)[8]) {
  float r[11];
  r[0] = hi16(prv.x); r[1] = lo16(prv.y); r[2] = hi16(prv.y);
  r[3] = lo16(cur.x); r[4] = hi16(cur.x); r[5] = lo16(cur.y); r[6] = hi16(cur.y); r[7] = lo16(cur.z); r[8] = hi16(cur.z); r[9] = lo16(cur.w); r[10] = hi16(cur.w);
#pragma unroll
  for (int j = 0; j < 8; ++j) out[j] = fast_silu(bias + w0 * r[j] + w1 * r[j + 1] + w2 * r[j + 2] + w3 * r[j + 3]);
}
DI void conv8(const bf16_t* rp, bool has_prev, float w0, float w1, float w2, float w3, float bias, float (&out)[8]) {
  uint4 cur; uint2 prv; conv8_load(rp, has_prev, cur, prv); conv8_compute(cur, prv, w0, w1, w2, w3, bias, out);
}
DI bf16x8 pack8(const float (&v)[8]) {
  uint4 u; u.x = pk2(v[0], v[1]); u.y = pk2(v[2], v[3]); u.z = pk2(v[4], v[5]); u.w = pk2(v[6], v[7]);
  return __builtin_bit_cast(bf16x8, u);
}
DI void chunk_cumsum(const float* __restrict__ DTp, size_t tk0, int hd, float A, int lane, float (&d4)[4], float (&c4)[4], float& last) {
#pragma unroll
  for (int i = 0; i < 4; ++i) d4[i] = DTp[(tk0 + 4 * lane + i) * 32 + hd];
  c4[0] = d4[0] * A; c4[1] = c4[0] + d4[1] * A; c4[2] = c4[1] + d4[2] * A; c4[3] = c4[2] + d4[3] * A;
  const float tot = c4[3];
  float sum = tot, ex = 0.f, t;
  t = swz_xor<1>(sum);  if (lane & 1) ex += t;  sum += t;
  t = swz_xor<2>(sum);  if (lane & 2) ex += t;  sum += t;
  t = swz_xor<4>(sum);  if (lane & 4) ex += t;  sum += t;
  t = swz_xor<8>(sum);  if (lane & 8) ex += t;  sum += t;
  t = swz_xor<16>(sum); if (lane & 16) ex += t; sum += t;
  t = __shfl_xor(sum, 32); if (lane & 32) ex += t; sum += t;
#pragma unroll
  for (int i = 0; i < 4; ++i) c4[i] += ex;
  last = sum;
}

constexpr int BT_ROW = 264;
constexpr int CN_ROW = 136;

DI void phase_ssd_state(const Params& p, unsigned char* smem) {
  const bf16_t* XT = (const bf16_t*)(p.ws + OFF_XT); const bf16_t* BT = (const bf16_t*)(p.ws + OFF_BT); const float* DTp = (const float*)(p.ws + OFF_DT);
  float* ST = (float*)(p.ws + OFF_ST); float* DEC = (float*)(p.ws + OFF_DEC);
  bf16_t* BTs = (bf16_t*)smem; float* wgt = (float*)(smem + 128 * BT_ROW * 2);
  const int tid = otid(), lane = tid & 63, w = tid >> 6, l31 = lane & 31, lh = lane >> 5;
  for (int u = blockIdx.x; u < 256; u += gridDim.x) {
    const int b = u >> 7, c = (u >> 2) & 31, g = u & 3; const int hd = 8 * g + w;
    bf16_t* XTC = (bf16_t*)(p.ws + (b ? OFF_ST + 32 * MiB : OFF_XN));
    {
      float d4[4], c4[4], last; chunk_cumsum(DTp, (size_t)b * SEQ + c * 256, hd, -__expf(p.A_log[hd]), lane, d4, c4, last);
      float4 o = {__expf(last - c4[0]) * d4[0], __expf(last - c4[1]) * d4[1], __expf(last - c4[2]) * d4[2], __expf(last - c4[3]) * d4[3]};
      *(float4*)(wgt + w * 256 + 4 * lane) = o;
      if (lane == 0) DEC[(b * 32 + c) * 32 + hd] = __expf(last);
    }
#pragma unroll 2
    for (int i = 0; i < 8; ++i) {
      const int chunk = tid + 512 * i; const int s8 = (chunk & 31) * 8, n = chunk >> 5; const int ch = 2048 + g * 128 + n;
      float v[8];
      conv8(BT + ((size_t)(b * 512 + g * 128 + n)) * SEQ + c * 256 + s8, !(c == 0 && s8 == 0),
            p.conv_w[ch], p.conv_w[3072 + ch], p.conv_w[2 * 3072 + ch], p.conv_w[3 * 3072 + ch], p.conv_b[ch], v);
      *(bf16x8*)(BTs + n * BT_ROW + s8) = pack8(v);
    }
    __syncthreads();
    f32x16 acc[2][4];
#pragma unroll
    for (int a = 0; a < 2; ++a)
#pragma unroll
      for (int q = 0; q < 4; ++q)
#pragma unroll
        for (int i = 0; i < 16; ++i) acc[a][q][i] = 0.f;
    float xw[2][4], xb[2];
#pragma unroll
    for (int pt = 0; pt < 2; ++pt) {
      const int ch = hd * 64 + pt * 32 + l31;
#pragma unroll
      for (int k = 0; k < 4; ++k) xw[pt][k] = p.conv_w[k * 3072 + ch];
      xb[pt] = p.conv_b[ch];
    }
    for (int kb = 0; kb < 16; kb += 2) {
      uint4 rc[2][2]; uint2 rp[2][2];
#pragma unroll
      for (int i = 0; i < 2; ++i)
#pragma unroll
        for (int pt = 0; pt < 2; ++pt) {
          const int s0 = (kb + i) * 16 + 8 * lh;
          conv8_load(XT + ((size_t)(b * 2048 + hd * 64 + pt * 32 + l31)) * SEQ + c * 256 + s0, !(c == 0 && s0 == 0), rc[i][pt], rp[i][pt]);
        }
#pragma unroll
      for (int i = 0; i < 2; ++i) {
        const int ks = kb + i; const int s0 = ks * 16 + 8 * lh;
        const float4 g0 = *(const float4*)(wgt + w * 256 + s0), g1 = *(const float4*)(wgt + w * 256 + s0 + 4);
        const float wg[8] = {g0.x, g0.y, g0.z, g0.w, g1.x, g1.y, g1.z, g1.w};
        bf16x8 afr[2];
#pragma unroll
        for (int pt = 0; pt < 2; ++pt) {
          float v[8];
          conv8_compute(rc[i][pt], rp[i][pt], xw[pt][0], xw[pt][1], xw[pt][2], xw[pt][3], xb[pt], v);
          *(bf16x8*)(XTC + ((size_t)(hd * 64 + pt * 32 + l31)) * SEQ + c * 256 + s0) = pack8(v);
#pragma unroll
          for (int j = 0; j < 8; ++j) v[j] *= wg[j];
          afr[pt] = pack8(v);
        }
#pragma unroll
        for (int nt = 0; nt < 4; ++nt) {
          const bf16x8 bfr = *(const bf16x8*)(BTs + (nt * 32 + l31) * BT_ROW + ks * 16 + 8 * lh);
#pragma unroll
          for (int pt = 0; pt < 2; ++pt) acc[pt][nt] = MFMA32(afr[pt], bfr, acc[pt][nt]);
        }
      }
    }
    bf16_t* Sp = (bf16_t*)ST + (((size_t)(b * 32 + c) * 32 + hd) * 64) * 128;
#pragma unroll
    for (int pt = 0; pt < 2; ++pt)
#pragma unroll
      for (int nt = 0; nt < 4; ++nt)
#pragma unroll
        for (int r = 0; r < 16; ++r) Sp[(pt * 32 + (r & 3) + 8 * (r >> 2) + 4 * lh) * 128 + nt * 32 + l31] = f2bf(acc[pt][nt][r]);
    __syncthreads();
  }
}

DI void phase_ssd_scan(const Params& p) {
  bf16_t* ST = (bf16_t*)(p.ws + OFF_ST); const float* DEC = (const float*)(p.ws + OFF_DEC);
  for (int idx = blockIdx.x * NTHREADS + otid(); idx < 131072; idx += gridDim.x * NTHREADS) {
    const int n4 = idx & 31, pp = (idx >> 5) & 63, h = (idx >> 11) & 31, b = idx >> 16;
    float run[4] = {0.f, 0.f, 0.f, 0.f};
    bf16_t* base = ST + (((size_t)(b * 32) * 32 + h) * 64 + pp) * 128 + n4 * 4;
    const float* dbase = DEC + (b * 32) * 32 + h;
    for (int c0 = 0; c0 < 32; c0 += 16) {
      uint2 loc[16]; float d[16];
#pragma unroll
      for (int i = 0; i < 16; ++i) { loc[i] = *(const uint2*)(base + (size_t)(c0 + i) * (32 * 64 * 128)); d[i] = dbase[(c0 + i) * 32]; }
#pragma unroll
      for (int i = 0; i < 16; ++i) {
        uint2 o; o.x = pk2(run[0], run[1]); o.y = pk2(run[2], run[3]);
        *(uint2*)(base + (size_t)(c0 + i) * (32 * 64 * 128)) = o;
        run[0] = run[0] * d[i] + lo16(loc[i].x); run[1] = run[1] * d[i] + hi16(loc[i].x);
        run[2] = run[2] * d[i] + lo16(loc[i].y); run[3] = run[3] * d[i] + hi16(loc[i].y);
      }
    }
  }
}

DI void stage_tokmajor(const Params& p, const bf16_t* __restrict__ RAW, int b, int tok0, int nrows, int g, int cbase, bf16_t* dst, int tid_) {
  const int tid = otid(); (void)tid_;
  const int n8 = (tid & 15) * 8; const int ch = cbase + g * 128 + n8;
  float cw[4][8], cb[8];
#pragma unroll
  for (int k = 0; k < 4; ++k) {
    const float4 a = *(const float4*)(p.conv_w + k * 3072 + ch), bq = *(const float4*)(p.conv_w + k * 3072 + ch + 4);
    cw[k][0] = a.x; cw[k][1] = a.y; cw[k][2] = a.z; cw[k][3] = a.w; cw[k][4] = bq.x; cw[k][5] = bq.y; cw[k][6] = bq.z; cw[k][7] = bq.w;
  }
  { const float4 a = *(const float4*)(p.conv_b + ch), bq = *(const float4*)(p.conv_b + ch + 4);
    cb[0] = a.x; cb[1] = a.y; cb[2] = a.z; cb[3] = a.w; cb[4] = bq.x; cb[5] = bq.y; cb[6] = bq.z; cb[7] = bq.w; }
  for (int t = tid >> 4; t < nrows; t += 64) {
    uint4 r[2][4];
#pragma unroll
    for (int u = 0; u < 2; ++u)
#pragma unroll
      for (int k = 0; k < 4; ++k) {
        const int tk = tok0 + t + 32 * u - 3 + k;
        r[u][k] = make_uint4(0u, 0u, 0u, 0u);
        if (tk >= 0) r[u][k] = *(const uint4*)(RAW + ((size_t)b * SEQ + tk) * 512 + g * 128 + n8);
      }
#pragma unroll
    for (int u = 0; u < 2; ++u) {
      float acc[8];
#pragma unroll
      for (int j = 0; j < 8; ++j) acc[j] = cb[j];
#pragma unroll
      for (int k = 0; k < 4; ++k) {
        const uint4 q = r[u][k];
        acc[0] += cw[k][0] * lo16(q.x); acc[1] += cw[k][1] * hi16(q.x); acc[2] += cw[k][2] * lo16(q.y); acc[3] += cw[k][3] * hi16(q.y);
        acc[4] += cw[k][4] * lo16(q.z); acc[5] += cw[k][5] * hi16(q.z); acc[6] += cw[k][6] * lo16(q.w); acc[7] += cw[k][7] * hi16(q.w);
      }
#pragma unroll
      for (int j = 0; j < 8; ++j) acc[j] = fast_silu(acc[j]);
      *(bf16x8*)(dst + (t + 32 * u) * CN_ROW + n8) = pack8(acc);
    }
  }
}

constexpr int S3_CS = 0, S3_BS = 64 * CN_ROW * 2, S3_CB = S3_BS + 256 * CN_ROW * 2, S3_CUM = S3_CB + 64 * BT_ROW * 2, S3_DTS = S3_CUM + 8192,
              S3_PART = S3_DTS + 8192, S3_RSTD = S3_PART + 2048, S3_END = S3_RSTD + 256;

DI void phase_ssd_out(const Params& p, unsigned char* smem) {
  const bf16_t* XT = (const bf16_t*)(p.ws + OFF_XT); const bf16_t* BR = (const bf16_t*)(p.ws + OFF_BR); const bf16_t* CR = (const bf16_t*)(p.ws + OFF_CR);
  const float* DTp = (const float*)(p.ws + OFF_DT); const float* ST = (const float*)(p.ws + OFF_ST); bf16_t* Z = (bf16_t*)p.out;
  bf16_t* Cs = (bf16_t*)(smem + S3_CS); bf16_t* Bs = (bf16_t*)(smem + S3_BS); bf16_t* CBs = (bf16_t*)(smem + S3_CB);
  float* cumA = (float*)(smem + S3_CUM); float* dts = (float*)(smem + S3_DTS); float* part = (float*)(smem + S3_PART); float* rstd = (float*)(smem + S3_RSTD);
  const int tid = otid(), lane = tid & 63, w = tid >> 6, l31 = lane & 31, lh = lane >> 5;
  const bool persist = (gridDim.x == 256);
  for (int u = blockIdx.x; u < 1024; u += gridDim.x) {
    const int tq = u >> 8, rest = u & 255; const int b = rest >> 7, c = (rest >> 2) & 31, g = rest & 3; const int hd = 8 * g + w;
    const int ns = (tq + 1) * 64;
    if (!persist || tq == 0) {
      float d4[4], c4[4], last; chunk_cumsum(DTp, (size_t)b * SEQ + c * 256, hd, -__expf(p.A_log[hd]), lane, d4, c4, last);
      *(float4*)(cumA + w * 256 + 4 * lane) = make_float4(c4[0], c4[1], c4[2], c4[3]);
      *(float4*)(dts + w * 256 + 4 * lane) = make_float4(d4[0], d4[1], d4[2], d4[3]);
    }
    stage_tokmajor(p, CR, b, c * 256 + tq * 64, 64, g, 2560, Cs, tid);
    { const int r0 = persist ? tq * 64 : 0; stage_tokmajor(p, BR, b, c * 256 + r0, ns - r0, g, 2048, Bs + r0 * CN_ROW, tid); }
    __syncthreads();
    if (32 * w < ns) {
      f32x16 a2[2];
#pragma unroll
      for (int a = 0; a < 2; ++a)
#pragma unroll
        for (int i = 0; i < 16; ++i) a2[a][i] = 0.f;
#pragma unroll
      for (int ks = 0; ks < 8; ++ks) {
        const bf16x8 af = *(const bf16x8*)(Bs + (32 * w + l31) * CN_ROW + ks * 16 + 8 * lh);
#pragma unroll
        for (int tt = 0; tt < 2; ++tt) {
          const bf16x8 bq = *(const bf16x8*)(Cs + (tt * 32 + l31) * CN_ROW + ks * 16 + 8 * lh);
          a2[tt] = MFMA32(af, bq, a2[tt]);
        }
      }
#pragma unroll
      for (int tt = 0; tt < 2; ++tt)
#pragma unroll
        for (int rg = 0; rg < 4; ++rg) {
          uint2 o; o.x = pk2(a2[tt][4 * rg], a2[tt][4 * rg + 1]); o.y = pk2(a2[tt][4 * rg + 2], a2[tt][4 * rg + 3]);
          *(uint2*)(CBs + (tt * 32 + l31) * BT_ROW + 32 * w + 8 * rg + 4 * lh) = o;
        }
    }
    __syncthreads();
    f32x16 acc[2][2];
#pragma unroll
    for (int a = 0; a < 2; ++a)
#pragma unroll
      for (int q = 0; q < 2; ++q)
#pragma unroll
        for (int i = 0; i < 16; ++i) acc[a][q][i] = 0.f;
    {
      const bf16_t* Sp = (const bf16_t*)ST + (((size_t)(b * 32 + c) * 32 + hd) * 64) * 128;
      for (int kb = 0; kb < 8; kb += 4) {
        bf16x8 bfr[4][2];
#pragma unroll
        for (int i = 0; i < 4; ++i)
#pragma unroll
          for (int pt = 0; pt < 2; ++pt) bfr[i][pt] = *(const bf16x8*)(Sp + (pt * 32 + l31) * 128 + (kb + i) * 16 + 8 * lh);
#pragma unroll
        for (int i = 0; i < 4; ++i) {
          const int ks = kb + i;
#pragma unroll
          for (int tt = 0; tt < 2; ++tt) {
            const bf16x8 af = *(const bf16x8*)(Cs + (tt * 32 + l31) * CN_ROW + ks * 16 + 8 * lh);
#pragma unroll
            for (int pt = 0; pt < 2; ++pt) acc[tt][pt] = MFMA32(af, bfr[i][pt], acc[tt][pt]);
          }
        }
      }
#pragma unroll
      for (int tt = 0; tt < 2; ++tt)
#pragma unroll
        for (int r = 0; r < 16; ++r) {
          const float e = __expf(cumA[w * 256 + tq * 64 + tt * 32 + (r & 3) + 8 * (r >> 2) + 4 * lh]);
          acc[tt][0][r] *= e; acc[tt][1][r] *= e;
        }
    }
    {
      const float Dh = p.Dskip[hd];
      const int tl0 = tq * 64 + l31, tl1 = tq * 64 + 32 + l31;
      const float ct0 = cumA[w * 256 + tl0], ct1 = cumA[w * 256 + tl1];
      const bf16_t* XTC = (const bf16_t*)(p.ws + (b ? OFF_ST + 32 * MiB : OFF_XN)) + ((size_t)(hd * 64 + l31)) * SEQ + c * 256 + 8 * lh;
      const int nks = ns >> 4;
      for (int kb = 0; kb < nks; kb += 4) {
        bf16x8 xq[4][2];
#pragma unroll
        for (int i = 0; i < 4; ++i)
#pragma unroll
          for (int pt = 0; pt < 2; ++pt) xq[i][pt] = *(const bf16x8*)(XTC + (size_t)pt * 32 * SEQ + (kb + i) * 16);
#pragma unroll
        for (int i = 0; i < 4; ++i) {
          const int ks = kb + i; const int s0 = ks * 16 + 8 * lh;
          const float4 c0 = *(const float4*)(cumA + w * 256 + s0), c1 = *(const float4*)(cumA + w * 256 + s0 + 4);
          const float4 d0 = *(const float4*)(dts + w * 256 + s0), d1 = *(const float4*)(dts + w * 256 + s0 + 4);
          const float cs[8] = {c0.x, c0.y, c0.z, c0.w, c1.x, c1.y, c1.z, c1.w};
          const float ds[8] = {d0.x, d0.y, d0.z, d0.w, d1.x, d1.y, d1.z, d1.w};
          const float cref = cumA[w * 256 + ks * 16];
          const bool steep = (cref - cumA[w * 256 + ks * 16 + 15]) > 60.f;
          float Fs[8];
#pragma unroll
          for (int j = 0; j < 8; ++j) Fs[j] = __expf(fminf(cref - cs[j], 64.f)) * ds[j];
#pragma unroll
          for (int tt = 0; tt < 2; ++tt) {
            if (ks * 16 <= tq * 64 + tt * 32 + 31) {
              const int tl = tt ? tl1 : tl0; const float ct = tt ? ct1 : ct0;
              const float Et = __expf(fminf(ct - cref, 0.f));
              const uint4 cbv = *(const uint4*)(CBs + (tt * 32 + l31) * BT_ROW + s0);
              const float cb[8] = {lo16(cbv.x), hi16(cbv.x), lo16(cbv.y), hi16(cbv.y), lo16(cbv.z), hi16(cbv.z), lo16(cbv.w), hi16(cbv.w)};
              float mv[8];
              if (steep) {
#pragma unroll
                for (int j = 0; j < 8; ++j) {
                  const int sidx = s0 + j;
                  float v = cb[j] * __expf(fminf(ct - cs[j], 0.f)) * ds[j];
                  v = (sidx <= tl) ? v : 0.f;
                  if (sidx == tl) v += Dh;
                  mv[j] = v;
                }
              } else if (ks * 16 + 15 > tq * 64 + tt * 32) {
#pragma unroll
                for (int j = 0; j < 8; ++j) {
                  const int sidx = s0 + j;
                  float v = cb[j] * (Et * Fs[j]);
                  v = (sidx <= tl) ? v : 0.f;
                  if (sidx == tl) v += Dh;
                  mv[j] = v;
                }
              } else {
#pragma unroll
                for (int j = 0; j < 8; ++j) mv[j] = cb[j] * (Et * Fs[j]);
              }
              const bf16x8 af = pack8(mv);
#pragma unroll
              for (int pt = 0; pt < 2; ++pt) acc[tt][pt] = MFMA32(af, xq[i][pt], acc[tt][pt]);
            }
          }
        }
      }
    }
    const size_t tokb = (size_t)b * SEQ + c * 256 + tq * 64;
#pragma unroll
    for (int tt = 0; tt < 2; ++tt)
#pragma unroll
      for (int r = 0; r < 16; ++r) {
        const int tloc = tt * 32 + (r & 3) + 8 * (r >> 2) + 4 * lh;
        const bf16_t* zp = Z + (tokb + tloc) * 2048 + hd * 64 + l31;
        const float y0 = acc[tt][0][r] * silu_f(bf2f(zp[0])), y1 = acc[tt][1][r] * silu_f(bf2f(zp[32]));
        acc[tt][0][r] = y0; acc[tt][1][r] = y1;
        float v = y0 * y0 + y1 * y1;
        v += swz_xor<1>(v); v += swz_xor<2>(v); v += swz_xor<4>(v); v += swz_xor<8>(v); v += swz_xor<16>(v);
        if (l31 == 0) part[w * 64 + tloc] = v;
      }
    __syncthreads();
    if (tid < 64) {
      float sres = 0.f;
#pragma unroll
      for (int ww = 0; ww < 8; ++ww) sres += part[ww * 64 + tid];
      rstd[tid] = rsqrtf(sres * (1.f / 512.f) + 1e-6f);
    }
    __syncthreads();
#pragma unroll
    for (int tt = 0; tt < 2; ++tt)
#pragma unroll
      for (int r = 0; r < 16; ++r) {
        const int tloc = tt * 32 + (r & 3) + 8 * (r >> 2) + 4 * lh;
        const float rs = rstd[tloc];
        bf16_t* zp = Z + (tokb + tloc) * 2048 + hd * 64 + l31;
        zp[0] = f2bf(acc[tt][0][r] * rs); zp[32] = f2bf(acc[tt][1][r] * rs);
      }
    __syncthreads();
  }
}

constexpr int KROW = 104;
constexpr int VROW = 68;
constexpr int ATT_K_BYTES = 64 * KROW * 2;
constexpr int ATT_V_BYTES = 64 * VROW * 2;
constexpr int ATT_STAGE = ATT_K_BYTES + ATT_V_BYTES;

DI void attn_kload(const bf16_t* sK, bf16x8 (&kf)[2][6], int l31, int lh) {
#pragma unroll
  for (int sub = 0; sub < 2; ++sub)
#pragma unroll
    for (int ks = 0; ks < 6; ++ks) kf[sub][ks] = *(const bf16x8*)(sK + (sub * 32 + l31) * KROW + ks * 16 + lh * 8);
}
DI void attn_qkmma(const bf16x8 (&kf)[2][6], const bf16x8 (&qf)[6], f32x16 (&sc)[2]) {
#pragma unroll
  for (int sub = 0; sub < 2; ++sub)
#pragma unroll
    for (int i = 0; i < 16; ++i) sc[sub][i] = 0.f;
#pragma unroll
  for (int ks = 0; ks < 6; ++ks)
#pragma unroll
    for (int sub = 0; sub < 2; ++sub) sc[sub] = MFMA32(kf[sub][ks], qf[ks], sc[sub]);
}
DI void attn_qk(const bf16_t* sK, const bf16x8 (&qf)[6], f32x16 (&sc)[2], int l31, int lh) {
  bf16x8 kf[2][6]; attn_kload(sK, kf, l31, lh); attn_qkmma(kf, qf, sc);
}

template <bool MASK>
DI void attn_softmax(f32x16 (&sc)[2], f32x16 (&o)[2], float& m, float& l, int kt, int myq, int lh) {
  float tmax = -1e30f;
#pragma unroll
  for (int sub = 0; sub < 2; ++sub)
#pragma unroll
    for (int r = 0; r < 16; ++r) {
      if (MASK) { const int key = kt * 64 + sub * 32 + (r & 3) + 8 * (r >> 2) + 4 * lh; if (key > myq) sc[sub][r] = -1e30f; }
      tmax = fmaxf(tmax, sc[sub][r]);
    }
  tmax = fmaxf(tmax, __shfl_xor(tmax, 32));
  if (__builtin_amdgcn_ballot_w64(tmax - m > 8.f) != 0) {
    const float mn = fmaxf(m, tmax); const float al = __builtin_amdgcn_exp2f(m - mn); m = mn;
    l *= al;
#pragma unroll
    for (int a = 0; a < 2; ++a)
#pragma unroll
      for (int i = 0; i < 16; ++i) o[a][i] *= al;
  }
  f32x2 ps2 = {0.f, 0.f}; const f32x2 mn2 = {m, m};
#pragma unroll
  for (int sub = 0; sub < 2; ++sub)
#pragma unroll
    for (int r = 0; r < 16; r += 2) {
      f32x2 d = {sc[sub][r], sc[sub][r + 1]}; d = d - mn2;
      f32x2 pe; pe.x = __builtin_amdgcn_exp2f(d.x); pe.y = __builtin_amdgcn_exp2f(d.y);
      sc[sub][r] = pe.x; sc[sub][r + 1] = pe.y; ps2 = ps2 + pe;
    }
  l += ps2.x + ps2.y;
}
DI void attn_pv(const f32x16 (&sc)[2], f32x16 (&o)[2], const bf16_t* sV, int l31, int lh) {
#pragma unroll
  for (int sub = 0; sub < 2; ++sub)
#pragma unroll
    for (int s2 = 0; s2 < 2; ++s2) {
      uint4 pu; pu.x = pk2(sc[sub][8 * s2], sc[sub][8 * s2 + 1]); pu.y = pk2(sc[sub][8 * s2 + 2], sc[sub][8 * s2 + 3]);
      pu.z = pk2(sc[sub][8 * s2 + 4], sc[sub][8 * s2 + 5]); pu.w = pk2(sc[sub][8 * s2 + 6], sc[sub][8 * s2 + 7]);
      const bf16x8 pb = __builtin_bit_cast(bf16x8, pu);
#pragma unroll
      for (int dvt = 0; dvt < 2; ++dvt) {
        const bf16_t* vp = sV + (dvt * 32 + l31) * VROW + sub * 32 + 16 * s2 + 4 * lh;
        const uint2 lo = *(const uint2*)vp, hi = *(const uint2*)(vp + 8);
        uint4 vu = {lo.x, lo.y, hi.x, hi.y};
        o[dvt] = MFMA32(__builtin_bit_cast(bf16x8, vu), pb, o[dvt]);
      }
    }
}

DI void attn_unit(const Params& p, int b, int h, int qb, unsigned char* smem) {
  const bf16_t* Q = (const bf16_t*)p.out; const bf16_t* KN = (const bf16_t*)(p.ws + OFF_XN); const bf16_t* VT = (const bf16_t*)(p.ws + OFF_BT);
  const bf16_t* KROPE = (const bf16_t*)(p.ws + OFF_DEC); const bf16_t* GATE = (const bf16_t*)(p.ws + OFF_ST); bf16_t* O = (bf16_t*)(p.ws + OFF_ST + 32 * MiB);
  const int tid = otid(), lane = tid & 63, w = tid >> 6, l31 = lane & 31, lh = lane >> 5;
  const int q0 = qb * 256, qw0 = q0 + 32 * w, myq = qw0 + l31;
  const size_t tq = (size_t)b * SEQ + myq;
  bf16x8 qf[6];
#pragma unroll
  for (int ks = 0; ks < 6; ++ks) qf[ks] = *(const bf16x8*)(Q + tq * 1536 + h * 96 + ks * 16 + lh * 8);
  f32x16 o[2];
#pragma unroll
  for (int a = 0; a < 2; ++a)
#pragma unroll
    for (int i = 0; i < 16; ++i) o[a][i] = 0.f;
  float m = -1e30f, l = 0.f;
  const int ntiles = 4 * qb + 4;
  const int nact = (qw0 + 31) / 64 + 1;
  const int kr = tid >> 3, kc = (tid & 7) * 8;
  const int rr = (tid & 255) >> 2, rc = (tid & 3) * 8;
  const bf16_t* gK = KN + ((size_t)b * SEQ + kr) * 1024 + h * 64 + kc;
  const bf16_t* gR = KROPE + ((size_t)b * SEQ + rr) * 32 + rc;
  const bf16_t* gV = VT + ((size_t)((b * 16 + h) * 64 + kr)) * SEQ + kc;
  uint4 rk, rr4, rv;
#define ATT_LOAD(T) do { rk = *(const uint4*)(gK + (size_t)(T) * 64 * 1024); rr4 = *(const uint4*)(gR + (size_t)(T) * 64 * 32); rv = *(const uint4*)(gV + (T) * 64); } while (0)
#define ATT_STORE(ST_) do { bf16_t* dK_ = (bf16_t*)(smem + (ST_) * ATT_STAGE); bf16_t* dV_ = (bf16_t*)(smem + (ST_) * ATT_STAGE + ATT_K_BYTES); \
    *(uint4*)(dK_ + kr * KROW + kc) = rk; *(uint4*)(dK_ + rr * KROW + 64 + rc) = rr4; \
    *(uint2*)(dV_ + kr * VROW + kc) = make_uint2(rv.x, rv.y); *(uint2*)(dV_ + kr * VROW + kc + 4) = make_uint2(rv.z, rv.w); } while (0)
  ATT_LOAD(0); ATT_STORE(0);
  ATT_LOAD(1); ATT_STORE(1);
  ATT_LOAD(2);
  __syncthreads();
  f32x16 sc[2], sn[2];
  attn_qk((const bf16_t*)smem, qf, sc, l31, lh);
  int st = 0;
  int kt = 0;
  for (; kt < nact - 1; ++kt) {
    const int st1 = (st == 2) ? 0 : st + 1, st2 = (st1 == 2) ? 0 : st1 + 1;
    ATT_STORE(st2);
    { const int tl = (kt + 3 < ntiles) ? kt + 3 : ntiles - 1; ATT_LOAD(tl); }
    attn_qk((const bf16_t*)(smem + st1 * ATT_STAGE), qf, sn, l31, lh);
    attn_softmax<false>(sc, o, m, l, kt, myq, lh);
    attn_pv(sc, o, (const bf16_t*)(smem + st * ATT_STAGE + ATT_K_BYTES), l31, lh);
    __syncthreads();
#pragma unroll
    for (int sub = 0; sub < 2; ++sub) sc[sub] = sn[sub];
    st = st1;
  }
  {
    const int st1 = (st == 2) ? 0 : st + 1, st2 = (st1 == 2) ? 0 : st1 + 1;
    ATT_STORE(st2);
    { const int tl = (kt + 3 < ntiles) ? kt + 3 : ntiles - 1; ATT_LOAD(tl); }
    attn_softmax<true>(sc, o, m, l, kt, myq, lh);
    attn_pv(sc, o, (const bf16_t*)(smem + st * ATT_STAGE + ATT_K_BYTES), l31, lh);
    __syncthreads();
    st = st1; ++kt;
  }
  for (; kt < ntiles; ++kt) {
    const int st1 = (st == 2) ? 0 : st + 1, st2 = (st1 == 2) ? 0 : st1 + 1;
    ATT_STORE(st2);
    { const int tl = (kt + 3 < ntiles) ? kt + 3 : ntiles - 1; ATT_LOAD(tl); }
    __syncthreads();
    st = st1;
  }
#undef ATT_LOAD
#undef ATT_STORE
  l += __shfl_xor(l, 32);
  const float il = 1.f / l;
#pragma unroll
  for (int dvt = 0; dvt < 2; ++dvt)
#pragma unroll
    for (int rg = 0; rg < 4; ++rg) {
      const int dv = dvt * 32 + 8 * rg + 4 * lh;
      const uint2 gv = *(const uint2*)(GATE + tq * 1024 + h * 64 + dv);
      const float g0 = __uint_as_float(gv.x << 16), g1 = __uint_as_float(gv.x & 0xffff0000u), g2 = __uint_as_float(gv.y << 16), g3 = __uint_as_float(gv.y & 0xffff0000u);
      uint2 ov; ov.x = pk2(o[dvt][4 * rg] * il * g0, o[dvt][4 * rg + 1] * il * g1); ov.y = pk2(o[dvt][4 * rg + 2] * il * g2, o[dvt][4 * rg + 3] * il * g3);
      *(uint2*)(O + tq * 1024 + h * 64 + dv) = ov;
    }
}

DI void phase_attn(const Params& p, unsigned char* smem) {
  for (int u = blockIdx.x; u < 512; u += gridDim.x) {
    int pu = u;
    if (gridDim.x == 256) {
      const int xcd = blockIdx.x & 7, li = blockIdx.x >> 3, r = u >> 8;
      pu = (r * 16 + xcd * 2 + (li >> 4)) * 16 + (li & 15);
    }
    const int bh = pu >> 4, x = pu & 15;
    for (int half = 0; half < 2; ++half) attn_unit(p, bh >> 4, bh & 15, half ? x : 31 - x, smem);
  }
}

DI void phase_final_norm(const Params& p) {
  const int tid = otid(); const int lane = tid & 63, w = tid >> 6;
  float4 g[4];
#pragma unroll
  for (int i = 0; i < 4; ++i) g[i] = ((const float4*)p.g_final)[lane + 64 * i];
  for (int row = (blockIdx.x * 8 + w) * 2; row < T; row += gridDim.x * 16) {
    float4 v[2][4]; float ss[2] = {0.f, 0.f};
#pragma unroll
    for (int u = 0; u < 2; ++u)
#pragma unroll
      for (int i = 0; i < 4; ++i) v[u][i] = ((const float4*)(p.out + (size_t)(row + u) * DM))[lane + 64 * i];
#pragma unroll
    for (int u = 0; u < 2; ++u) {
#pragma unroll
      for (int i = 0; i < 4; ++i) ss[u] += v[u][i].x * v[u][i].x + v[u][i].y * v[u][i].y + v[u][i].z * v[u][i].z + v[u][i].w * v[u][i].w;
      ss[u] = wave_sum(ss[u]);
      const float r = rsqrtf(ss[u] * (1.f / 1024.f) + 1e-6f);
#pragma unroll
      for (int i = 0; i < 4; ++i)
        ((float4*)(p.out + (size_t)(row + u) * DM))[lane + 64 * i] = make_float4(v[u][i].x * r * g[i].x, v[u][i].y * r * g[i].y, v[u][i].z * r * g[i].z, v[u][i].w * r * g[i].w);
    }
  }
}

__global__ void __launch_bounds__(NTHREADS) mega(Params p) {
  cg::grid_group grid = cg::this_grid();
  extern __shared__ __attribute__((aligned(16))) unsigned char smem[];
  unsigned char* ws = p.ws;
  __shared__ unsigned bar_st[4];
  if (threadIdx.x < 4) bar_st[threadIdx.x] = 0u;
  __syncthreads();
  const XcdBarrier xb = xcd_barrier_post((unsigned*)(ws + OFF_BAR), bar_st);
  const bool tailfill = (gridDim.x == 256);
  phase_prep(p, smem, blockIdx.x, tailfill ? 1344 : 2832, gridDim.x);
  if (!tailfill) phase_rope_tables(p, blockIdx.x, gridDim.x);
  phase_rmsnorm_rows(p.x, (bf16_t*)(ws + OFF_XN));
  if (p.out == nullptr) grid.sync();
  xcd_barrier(xb);
  gemm_phase<EPI_SSM_IN, 1024>(p, (const bf16_t*)(ws + OFF_W1), (const bf16_t*)(ws + OFF_XN), 21, smem);
  if (tailfill && (blockIdx.x >> 3) >= 8) {
    const int tj = (blockIdx.x & 7) * 24 + ((blockIdx.x >> 3) - 8);
    phase_prep(p, smem, 1344 + tj, 2832, 192);
    phase_rope_tables(p, tj, 192);
  }
  xcd_barrier(xb);
  phase_ssd_state(p, smem);
  xcd_barrier(xb);
  phase_ssd_scan(p);
  xcd_barrier(xb);
  phase_ssd_out(p, smem);
  xcd_barrier(xb);
  gemm_phase<EPI_OUT1, 2048>(p, (const bf16_t*)(ws + OFF_W2), (const bf16_t*)p.out, 4, smem);
  xcd_barrier(xb);
  gemm_phase<EPI_MLA_IN, 1024>(p, (const bf16_t*)(ws + OFF_W3), (const bf16_t*)(ws + OFF_XN), 7, smem);
  xcd_barrier(xb);
  gemm_phase<EPI_KVUP, 256>(p, (const bf16_t*)(ws + OFF_W4), (const bf16_t*)(ws + OFF_ST + 32 * MiB), 8, smem);
  gemm_phase<EPI_QUP, 384>(p, (const bf16_t*)(ws + OFF_W5), (const bf16_t*)(ws + OFF_ST + 40 * MiB), 6, smem);
  xcd_barrier(xb);
  phase_attn(p, smem);
  xcd_barrier(xb);
  gemm_phase<EPI_OUT2, 1024>(p, (const bf16_t*)(ws + OFF_W6), (const bf16_t*)(ws + OFF_ST + 32 * MiB), 4, smem);
  xcd_barrier(xb);
  phase_final_norm(p);
}

extern "C" void kernel_launch(void* const* d_in, const int* in_sizes, int n_in, void* d_out, int out_size, void* d_ws, size_t ws_size, hipStream_t stream) {
  static int grid = 0;
  if (grid == 0) {
    if (n_in != 20 || ws_size < WS_NEED) { fprintf(stderr, "kernel_launch: unexpected n_in %d / ws_size %zu\n", n_in, ws_size); grid = -1; return; }
    int dev = 0, cus = 0, per_cu = 0;
    hipGetDevice(&dev);
    hipDeviceGetAttribute(&cus, hipDeviceAttributeMultiprocessorCount, dev);
    if (hipFuncSetAttribute((const void*)mega, hipFuncAttributeMaxDynamicSharedMemorySize, LDS_BYTES) != hipSuccess) { fprintf(stderr, "hipFuncSetAttribute failed\n"); grid = -1; return; }
    hipOccupancyMaxActiveBlocksPerMultiprocessor(&per_cu, (const void*)mega, NTHREADS, LDS_BYTES);
    if (per_cu < 1) per_cu = 1;
    (void)hipGetLastError();
    grid = cus;
  }
  if (grid < 0) return;
  Params p{};
  p.x = (const float*)d_in[0]; p.pos = (const int*)d_in[1]; p.g_pre = (const float*)d_in[2]; p.ssm_w_in = (const float*)d_in[3];
  p.conv_w = (const float*)d_in[4]; p.conv_b = (const float*)d_in[5]; p.dt_bias = (const float*)d_in[6]; p.A_log = (const float*)d_in[7];
  p.Dskip = (const float*)d_in[8]; p.g_out = (const float*)d_in[9]; p.ssm_w_out = (const float*)d_in[10]; p.kv_g_in = (const float*)d_in[11];
  p.kv_w_down = (const float*)d_in[12]; p.kv_g_lat = (const float*)d_in[13]; p.kv_w_up = (const float*)d_in[14]; p.mla_w_in = (const float*)d_in[15];
  p.mla_g_q = (const float*)d_in[16]; p.mla_w_uq = (const float*)d_in[17]; p.mla_w_out = (const float*)d_in[18]; p.g_final = (const float*)d_in[19];
  p.out = (float*)d_out; p.ws = (unsigned char*)d_ws;
  if (hipMemsetAsync((char*)d_ws + OFF_BAR, 0, XCD_BAR_WORDS * sizeof(unsigned), stream) != hipSuccess) { fprintf(stderr, "memset of barrier words failed\n"); return; }
  void* args[] = {&p};
  hipError_t e = hipLaunchCooperativeKernel((const void*)mega, dim3(grid), dim3(NTHREADS), args, LDS_BYTES, stream);
  if (e != hipSuccess) fprintf(stderr, "cooperative launch failed: %s (grid %d)\n", hipGetErrorString(e), grid);
}
```

```cpp
#include <hip/hip_runtime.h>
#include <hip/hip_cooperative_groups.h>
#include <cstdio>
#include <cstdint>
namespace cg = cooperative_groups;

typedef unsigned short bf16_t;
typedef short bf16x8 __attribute__((ext_vector_type(8)));
typedef float f32x16 __attribute__((ext_vector_type(16)));
#define DI __device__ __forceinline__
#define MFMA32(a, b, c) __builtin_amdgcn_mfma_f32_32x32x16_bf16((a), (b), (c), 0, 0, 0)

constexpr int T = 16384, SEQ = 8192, DM = 1024;
constexpr int NTHREADS = 512;
constexpr size_t MiB = 1024 * 1024;
constexpr size_t OFF_W1 = 0;
constexpr size_t OFF_W2 = OFF_W1 + (size_t)5376 * 1024 * 2;
constexpr size_t OFF_W3 = OFF_W2 + (size_t)1024 * 2048 * 2;
constexpr size_t OFF_W4 = OFF_W3 + (size_t)1792 * 1024 * 2;
constexpr size_t OFF_W5 = OFF_W4 + (size_t)2048 * 256 * 2;
constexpr size_t OFF_W6 = OFF_W5 + (size_t)1536 * 384 * 2;
constexpr size_t OFF_XN = 24 * MiB;
constexpr size_t OFF_XT = 56 * MiB;
constexpr size_t OFF_BT = 120 * MiB;
constexpr size_t OFF_BR = 136 * MiB;
constexpr size_t OFF_CR = 152 * MiB;
constexpr size_t OFF_DT = 168 * MiB;
constexpr size_t OFF_ST = 170 * MiB;
constexpr size_t OFF_DEC = 234 * MiB;
constexpr size_t OFF_BAR = 236 * MiB;
constexpr size_t OFF_COS = 238 * MiB;
constexpr size_t OFF_SIN = 239 * MiB;
constexpr size_t OFF_SSQ = 240 * MiB;
constexpr size_t WS_NEED = 241 * MiB;

struct Params {
  const float* x; const int* pos; const float* g_pre; const float* ssm_w_in; const float* conv_w; const float* conv_b;
  const float* dt_bias; const float* A_log; const float* Dskip; const float* g_out; const float* ssm_w_out;
  const float* kv_g_in; const float* kv_w_down; const float* kv_g_lat; const float* kv_w_up;
  const float* mla_w_in; const float* mla_g_q; const float* mla_w_uq; const float* mla_w_out; const float* g_final;
  float* out; unsigned char* ws;
};

DI bf16_t f2bf(float x) { unsigned u = __float_as_uint(x); u += 0x7fffu + ((u >> 16) & 1u); return (bf16_t)(u >> 16); }
DI float bf2f(bf16_t b) { return __uint_as_float(((unsigned)b) << 16); }
DI float lo16(unsigned u) { return __uint_as_float(u << 16); }
DI float hi16(unsigned u) { return __uint_as_float(u & 0xffff0000u); }
typedef float f32x2 __attribute__((ext_vector_type(2)));
typedef __bf16 bf16x2_t __attribute__((ext_vector_type(2)));
DI unsigned pk2(float a, float b) { f32x2 v = {a, b}; bf16x2_t r = __builtin_convertvector(v, bf16x2_t); return __builtin_bit_cast(unsigned, r); }
DI float wave_sum(float v) {
#pragma unroll
  for (int o = 32; o >= 1; o >>= 1) v += __shfl_xor(v, o);
  return v;
}
DI int otid() { int t = threadIdx.x; asm volatile("" : "+v"(t)); return t; }
template <int K> DI float swz_xor(float v) {
  return __int_as_float(__builtin_amdgcn_ds_swizzle(__float_as_int(v), (K << 10) | 0x1f));
}
DI float silu_f(float v) { return v * __builtin_amdgcn_rcpf(1.f + __expf(-v)); }


#define XB_TMO      128
#define XB_XCNT(j)  (256  + 64 * (j))
#define XB_XSUB(j)  (1280 + 64 * (j))
#define XB_XGEN(j)  (2304 + 64 * (j))
#define XB_TOP      3328
#define XB_TOPGEN   3392
#define XCD_BAR_WORDS 3456
#define XB_SPIN_CAP (1u << 18)
DI unsigned xb_ld(unsigned* p)              { return __hip_atomic_load(p, __ATOMIC_RELAXED, __HIP_MEMORY_SCOPE_AGENT); }
DI unsigned xb_add(unsigned* p, unsigned v) { return __hip_atomic_fetch_add(p, v, __ATOMIC_RELAXED, __HIP_MEMORY_SCOPE_AGENT); }
DI unsigned xb_xcc_id() { return (unsigned)__builtin_amdgcn_s_getreg((3 << 11) | 20) & 0xFu; }
#define XB_SPIN(cond, bar) do { unsigned _sp = 0; while (cond) { __builtin_amdgcn_s_sleep(1); \
    if ((++_sp & 255u) == 0u) { if (xb_ld(&(bar)[XB_TMO])) break; if (_sp > XB_SPIN_CAP) { atomicAdd(&(bar)[XB_TMO], 1u); break; } } } } while (0)
struct XcdBarrier { unsigned* bar; unsigned x; volatile unsigned* st; };
DI XcdBarrier xcd_barrier_post(unsigned* bar, volatile unsigned* st) {
  XcdBarrier b; b.bar = bar; b.x = xb_xcc_id(); b.st = st;
  if (threadIdx.x == 0) (void)xb_add(&bar[XB_XCNT(b.x)], 1u);
  return b;
}
DI void xcd_barrier_complete(unsigned* bar, unsigned x, unsigned& nloc, unsigned& nx) {
  const unsigned G = gridDim.x * gridDim.y * gridDim.z;
  unsigned sum, cnt, mine, sp = 0u;
  for (;;) {
    sum = 0u; cnt = 0u; mine = 0u;
#pragma unroll
    for (unsigned j = 0; j < 16; ++j) { const unsigned c = xb_ld(&bar[XB_XCNT(j)]); sum += c; cnt += (c > 0u) ? 1u : 0u; mine = (j == x) ? c : mine; }
    if (sum == G) break;
    __builtin_amdgcn_s_sleep(1);
    if ((++sp & 255u) == 0u) { if (xb_ld(&bar[XB_TMO])) break; if (sp > XB_SPIN_CAP) { atomicAdd(&bar[XB_TMO], 1u); break; } }
  }
  nloc = mine > 0u ? mine : 1u; nx = cnt > 0u ? cnt : 1u;
}
DI void xcd_barrier(const XcdBarrier& b) {
  asm volatile("s_waitcnt vmcnt(0)" ::: "memory");
  __syncthreads();
  if (threadIdx.x == 0) {
    unsigned* bar = b.bar;
    __builtin_amdgcn_s_waitcnt(0);
    unsigned nloc = b.st[0], nx = b.st[1];
    if (nloc == 0u) { xcd_barrier_complete(bar, b.x, nloc, nx); b.st[0] = nloc; b.st[1] = nx; }
    const unsigned old = xb_add(&bar[XB_XSUB(b.x)], 1u);
    const unsigned gen = old / nloc;
    if (old + 1u == (gen + 1u) * nloc) {
      __builtin_amdgcn_fence(__ATOMIC_RELEASE, "agent");
      asm volatile("s_waitcnt vmcnt(0)" ::: "memory");
      const unsigned og = xb_add(&bar[XB_TOP], 1u);
      const unsigned tg = og / nx;
      if (og + 1u == (tg + 1u) * nx) xb_add(&bar[XB_TOPGEN], 1u);
      else XB_SPIN(xb_ld(&bar[XB_TOPGEN]) == tg, bar);
      __builtin_amdgcn_fence(__ATOMIC_ACQUIRE, "agent");
      xb_add(&bar[XB_XGEN(b.x)], 1u);
      asm volatile("s_waitcnt vmcnt(0)" ::: "memory");
    } else {
      XB_SPIN(xb_ld(&bar[XB_XGEN(b.x)]) == gen, bar);
      __builtin_amdgcn_fence(__ATOMIC_ACQUIRE, "agent");
      asm volatile("s_waitcnt vmcnt(0)" ::: "memory");
    }
  }
  __syncthreads();
}

struct WJob { const float* src; const float* gain; bf16_t* dst; int ld, col0, ncols, K, tile; };
DI WJob wprep_job(const Params& p, int u) {
  bf16_t* W1 = (bf16_t*)(p.ws + OFF_W1); bf16_t* W2 = (bf16_t*)(p.ws + OFF_W2); bf16_t* W3 = (bf16_t*)(p.ws + OFF_W3);
  bf16_t* W4 = (bf16_t*)(p.ws + OFF_W4); bf16_t* W5 = (bf16_t*)(p.ws + OFF_W5); bf16_t* W6 = (bf16_t*)(p.ws + OFF_W6);
  int t = u; WJob j;
  if (t < 1344) { j = {p.ssm_w_in, p.g_pre, W1, 5152, 0, 5152, 1024, t}; return j; } t -= 1344;
  if (t < 512) { j = {p.ssm_w_out, p.g_out, W2, 1024, 0, 1024, 2048, t}; return j; } t -= 512;
  if (t < 64) { j = {p.kv_w_down, p.kv_g_in, W3, 288, 0, 256, 1024, t}; return j; } t -= 64;
  if (t < 96) { j = {p.mla_w_in, p.g_pre + 1024, W3 + (size_t)256 * 1024, 1408, 0, 384, 1024, t}; return j; } t -= 96;
  if (t < 256) { j = {p.mla_w_in, p.g_pre + 1024, W3 + (size_t)640 * 1024, 1408, 384, 1024, 1024, t}; return j; } t -= 256;
  if (t < 32) { j = {p.kv_w_down, p.kv_g_in, W3 + (size_t)1664 * 1024, 288, 256, 32, 1024, t}; return j; } t -= 32;
  if (t < 128) { j = {p.kv_w_up, p.kv_g_lat, W4, 2048, 0, 2048, 256, t}; return j; } t -= 128;
  if (t < 144) { j = {p.mla_w_uq, p.mla_g_q, W5, 1536, 0, 1536, 384, t}; return j; } t -= 144;
  j = {p.mla_w_out, nullptr, W6, 1024, 0, 1024, 1024, t}; return j;
}
DI void wprep_load(const WJob& j, int tid0, float4 (&v)[2], float (&gk)[2]) {
  const int nkt = j.K >> 6; const int tn = j.tile / nkt, tk = j.tile % nkt; const int n0 = tn * 64, k0 = tk * 64;
#pragma unroll
  for (int i = 0; i < 2; ++i) {
    const int e = tid0 + NTHREADS * i; const int kk = e >> 4, n4 = (e & 15) * 4;
    v[i] = make_float4(0.f, 0.f, 0.f, 0.f);
    if (n0 + n4 < j.ncols) v[i] = *(const float4*)(j.src + (size_t)(k0 + kk) * j.ld + j.col0 + n0 + n4);
    gk[i] = j.gain ? j.gain[k0 + kk] : 1.f;
  }
}
DI void phase_prep(const Params& p, unsigned char* smem, int ustart, int uend, int ustride) {
  float* sm = (float*)smem;
  const int tid0 = otid();
  int u = ustart;
  if (u >= uend) return;
  WJob j = wprep_job(p, u);
  float4 v[2]; float gk[2];
  wprep_load(j, tid0, v, gk);
  for (;;) {
#pragma unroll
    for (int i = 0; i < 2; ++i) {
      const int e = tid0 + NTHREADS * i; const int kk = e >> 4, n4 = (e & 15) * 4;
      float* d = sm + kk * 65 + n4;
      d[0] = v[i].x * gk[i]; d[1] = v[i].y * gk[i]; d[2] = v[i].z * gk[i]; d[3] = v[i].w * gk[i];
    }
    __syncthreads();
    const WJob jc = j;
    const int un = u + ustride; const bool more = (un < uend);
    if (more) { j = wprep_job(p, un); wprep_load(j, tid0, v, gk); }
    {
      const int nkt = jc.K >> 6; const int tn = jc.tile / nkt, tk = jc.tile % nkt; const int n0 = tn * 64, k0 = tk * 64;
      const int nn = tid0 >> 3, kc = (tid0 & 7) * 8;
      uint4 o;
      o.x = pk2(sm[(kc + 0) * 65 + nn], sm[(kc + 1) * 65 + nn]); o.y = pk2(sm[(kc + 2) * 65 + nn], sm[(kc + 3) * 65 + nn]);
      o.z = pk2(sm[(kc + 4) * 65 + nn], sm[(kc + 5) * 65 + nn]); o.w = pk2(sm[(kc + 6) * 65 + nn], sm[(kc + 7) * 65 + nn]);
      *(uint4*)(jc.dst + (size_t)(n0 + nn) * jc.K + k0 + kc) = o;
    }
    __syncthreads();
    if (!more) break;
    u = un;
  }
}

DI void phase_rope_tables(const Params& p, int blk, int nblk) {
  float* COS = (float*)(p.ws + OFF_COS); float* SIN = (float*)(p.ws + OFF_SIN);
  for (int e = blk * NTHREADS + otid(); e < T * 16; e += nblk * NTHREADS) {
    const int t = e >> 4, i = e & 15;
    const float ang = (float)p.pos[t] * powf(10000.f, -(float)(2 * i) / 32.f);
    COS[e] = cosf(ang); SIN[e] = sinf(ang);
  }
  float* SSQ = (float*)(p.ws + OFF_SSQ);
  for (int e = blk * NTHREADS + otid(); e < 3 * T; e += nblk * NTHREADS) SSQ[e] = 0.f;
}

DI void phase_rmsnorm_rows(const float* __restrict__ src, bf16_t* __restrict__ dst) {
  const int tid = otid(); const int lane = tid & 63, w = tid >> 6;
  for (int row = (blockIdx.x * 8 + w) * 2; row < T; row += gridDim.x * 16) {
    float4 v[2][4]; float ss[2] = {0.f, 0.f};
#pragma unroll
    for (int u = 0; u < 2; ++u)
#pragma unroll
      for (int i = 0; i < 4; ++i) v[u][i] = ((const float4*)(src + (size_t)(row + u) * DM))[lane + 64 * i];
#pragma unroll
    for (int u = 0; u < 2; ++u) {
#pragma unroll
      for (int i = 0; i < 4; ++i) ss[u] += v[u][i].x * v[u][i].x + v[u][i].y * v[u][i].y + v[u][i].z * v[u][i].z + v[u][i].w * v[u][i].w;
      ss[u] = wave_sum(ss[u]);
      const float r = rsqrtf(ss[u] * (1.f / 1024.f) + 1e-6f);
#pragma unroll
      for (int i = 0; i < 4; ++i) {
        uint2 o; o.x = pk2(v[u][i].x * r, v[u][i].y * r); o.y = pk2(v[u][i].z * r, v[u][i].w * r);
        *(uint2*)(dst + (size_t)(row + u) * DM + (lane + 64 * i) * 4) = o;
      }
    }
  }
}

enum { EPI_SSM_IN = 0, EPI_OUT1 = 1, EPI_MLA_IN = 2, EPI_KVUP = 3, EPI_QUP = 4, EPI_OUT2 = 5 };


typedef float f32x4 __attribute__((ext_vector_type(4)));
constexpr int EPI_WAVE_BYTES = 8704;
constexpr int TM_ROW = 72;
constexpr int CM_ROW = 40;
constexpr int F32_ROW = 68;

template <bool SILU>
DI void stage_tm(const f32x4 (&a)[4][2], bf16_t* wl, int fr, int fq) {
#pragma unroll
  for (int m = 0; m < 4; ++m)
#pragma unroll
    for (int n = 0; n < 2; ++n) {
      float v0 = a[m][n][0], v1 = a[m][n][1], v2 = a[m][n][2], v3 = a[m][n][3];
      if (SILU) { v0 = silu_f(v0); v1 = silu_f(v1); v2 = silu_f(v2); v3 = silu_f(v3); }
      uint2 o; o.x = pk2(v0, v1); o.y = pk2(v2, v3);
      *(uint2*)(wl + (n * 16 + fr) * TM_ROW + m * 16 + fq * 4) = o;
    }
}
DI void readout_tm(const bf16_t* wl, bf16_t* gdst, size_t ld, int lane) {
#pragma unroll
  for (int it = 0; it < 4; ++it) {
    const int idx = lane + 64 * it; const int row = idx >> 3, ch = idx & 7;
    *(uint4*)(gdst + (size_t)row * ld + ch * 8) = *(const uint4*)(wl + row * TM_ROW + ch * 8);
  }
}
DI void stage_cm(const f32x4 (&a)[4][2], bf16_t* wl, int fr, int fq) {
#pragma unroll
  for (int m = 0; m < 4; ++m)
#pragma unroll
    for (int n = 0; n < 2; ++n)
#pragma unroll
      for (int j = 0; j < 4; ++j) wl[(m * 16 + fq * 4 + j) * CM_ROW + n * 16 + fr] = f2bf(a[m][n][j]);
}
DI void readout_cm(const bf16_t* wl, bf16_t* gdst, int lane) {
#pragma unroll
  for (int it = 0; it < 4; ++it) {
    const int idx = lane + 64 * it; const int row = idx >> 2, ch = idx & 3;
    *(uint4*)(gdst + (size_t)row * SEQ + ch * 8) = *(const uint4*)(wl + row * CM_ROW + ch * 8);
  }
}
constexpr int CMP_ROW = 72;
DI void stage_cm_pair(const f32x4 (&a)[4][2], bf16_t* wlp, int par, int fr, int fq) {
#pragma unroll
  for (int m = 0; m < 4; ++m)
#pragma unroll
    for (int n = 0; n < 2; ++n)
#pragma unroll
      for (int j = 0; j < 4; ++j) wlp[(m * 16 + fq * 4 + j) * CMP_ROW + par * 32 + n * 16 + fr] = f2bf(a[m][n][j]);
}
DI void readout_cm_pair(const bf16_t* wlp, bf16_t* gdst, int par, int lane) {
#pragma unroll
  for (int it = 0; it < 4; ++it) {
    const int idx = lane + 64 * it; const int row = par * 32 + (idx >> 3), ch = idx & 7;
    *(uint4*)(gdst + (size_t)row * SEQ + ch * 8) = *(const uint4*)(wlp + row * CMP_ROW + ch * 8);
  }
}
DI void stage_f32(const f32x4 (&a)[4][2], float* wl, int fr, int fq) {
#pragma unroll
  for (int m = 0; m < 4; ++m)
#pragma unroll
    for (int n = 0; n < 2; ++n) *(f32x4*)(wl + (n * 16 + fr) * F32_ROW + m * 16 + fq * 4) = a[m][n];
}
DI void readout_f32_resid(const float* wl, const float* __restrict__ resid, float* __restrict__ gdst, int lane) {
#pragma unroll 4
  for (int it = 0; it < 8; ++it) {
    const int idx = lane + 64 * it; const int row = idx >> 4, ch = idx & 15;
    const float4 v = *(const float4*)(wl + row * F32_ROW + ch * 4);
    const float4 r = *(const float4*)(resid + (size_t)row * DM + ch * 4);
    *(float4*)(gdst + (size_t)row * DM + ch * 4) = make_float4(v.x + r.x, v.y + r.y, v.z + r.z, v.w + r.w);
  }
}

DI void readout_f32_resid_ssq(const float* wl, const float* __restrict__ resid, float* __restrict__ gdst, bf16_t* __restrict__ hs, float* __restrict__ ssq, int lane) {
#pragma unroll 4
  for (int it = 0; it < 8; ++it) {
    const int idx = lane + 64 * it; const int row = idx >> 4, ch = idx & 15;
    const float4 v = *(const float4*)(wl + row * F32_ROW + ch * 4);
    const float4 r = *(const float4*)(resid + (size_t)row * DM + ch * 4);
    const float4 h = make_float4(v.x + r.x, v.y + r.y, v.z + r.z, v.w + r.w);
    *(float4*)(gdst + (size_t)row * DM + ch * 4) = h;
    uint2 o; o.x = pk2(h.x, h.y); o.y = pk2(h.z, h.w);
    *(uint2*)(hs + (size_t)row * DM + ch * 4) = o;
    float q = h.x * h.x + h.y * h.y + h.z * h.z + h.w * h.w;
    q += swz_xor<1>(q); q += swz_xor<2>(q); q += swz_xor<4>(q); q += swz_xor<8>(q);
    if (ch == 0) atomicAdd(ssq + row, q);
  }
}

DI void resid_preload(const float* __restrict__ resid, int lane, float4 (&rr)[8]) {
#pragma unroll
  for (int it = 0; it < 8; ++it) { const int idx = lane + 64 * it; rr[it] = *(const float4*)(resid + (size_t)(idx >> 4) * DM + (idx & 15) * 4); }
}
DI void readout_f32_pre(const float* wl, const float4 (&rr)[8], float* __restrict__ gdst, int lane) {
#pragma unroll
  for (int it = 0; it < 8; ++it) {
    const int idx = lane + 64 * it; const int row = idx >> 4, ch = idx & 15;
    const float4 v = *(const float4*)(wl + row * F32_ROW + ch * 4);
    *(float4*)(gdst + (size_t)row * DM + ch * 4) = make_float4(v.x + rr[it].x, v.y + rr[it].y, v.z + rr[it].z, v.w + rr[it].w);
  }
}
DI void readout_f32_pre_ssq(const float* wl, const float4 (&rr)[8], float* __restrict__ gdst, bf16_t* __restrict__ hs, float* __restrict__ ssq, int lane) {
#pragma unroll
  for (int it = 0; it < 8; ++it) {
    const int idx = lane + 64 * it; const int row = idx >> 4, ch = idx & 15;
    const float4 v = *(const float4*)(wl + row * F32_ROW + ch * 4);
    const float4 h = make_float4(v.x + rr[it].x, v.y + rr[it].y, v.z + rr[it].z, v.w + rr[it].w);
    *(float4*)(gdst + (size_t)row * DM + ch * 4) = h;
    uint2 o; o.x = pk2(h.x, h.y); o.y = pk2(h.z, h.w);
    *(uint2*)(hs + (size_t)row * DM + ch * 4) = o;
    float q = h.x * h.x + h.y * h.y + h.z * h.z + h.w * h.w;
    q += swz_xor<1>(q); q += swz_xor<2>(q); q += swz_xor<4>(q); q += swz_xor<8>(q);
    if (ch == 0) atomicAdd(ssq + row, q);
  }
}

DI void wave_lds_sync() { asm volatile("s_waitcnt lgkmcnt(0)" ::: "memory"); }

template <int EPI>
DI void epilogue_block(const Params& p, const f32x4 (&a)[4][2], int c0, int mt, bf16_t* wl, bf16_t* wlp, int par, int lane, int fr, int fq, const float (&sq)[2], const f32x4 (&csv)[2], const f32x4 (&snv)[2]) {
  unsigned char* ws = p.ws;
  const int b = mt >> 13, tok0 = mt & 8191;
  const int tok0p = tok0 - par * 32;
  if (EPI == EPI_SSM_IN) {
    if (c0 < 2048) {
      stage_tm<false>(a, wl, fr, fq); wave_lds_sync();
      readout_tm(wl, (bf16_t*)p.out + (size_t)mt * 2048 + c0, 2048, lane); wave_lds_sync();
    } else if (c0 < 4096) {
      stage_cm_pair(a, wlp, par, fr, fq); __syncthreads();
      readout_cm_pair(wlp, (bf16_t*)(ws + OFF_XT) + ((size_t)(b * 2048 + (c0 - 2048))) * SEQ + tok0p, par, lane); __syncthreads();
    } else if (c0 < 4608) {
      stage_tm<false>(a, wl, fr, fq); wave_lds_sync();
      readout_tm(wl, (bf16_t*)(ws + OFF_BR) + (size_t)mt * 512 + (c0 - 4096), 512, lane); __syncthreads();
      stage_cm_pair(a, wlp, par, fr, fq); __syncthreads();
      readout_cm_pair(wlp, (bf16_t*)(ws + OFF_BT) + ((size_t)(b * 512 + (c0 - 4096))) * SEQ + tok0p, par, lane); __syncthreads();
    } else if (c0 < 5120) {
      stage_tm<false>(a, wl, fr, fq); wave_lds_sync();
      readout_tm(wl, (bf16_t*)(ws + OFF_CR) + (size_t)mt * 512 + (c0 - 4608), 512, lane); wave_lds_sync();
    } else if (c0 == 5120) {
#pragma unroll
      for (int m = 0; m < 2; ++m)
#pragma unroll
        for (int n = 0; n < 2; ++n) {
          const int h = m * 16 + fq * 4;
          float4 o; float* op = (float*)&o;
#pragma unroll
          for (int j = 0; j < 4; ++j) { const float t = a[m][n][j] + p.dt_bias[h + j]; op[j] = (t > 20.f) ? t : log1pf(__expf(t)); }
          *(float4*)((float*)(ws + OFF_DT) + (size_t)(mt + n * 16 + fr) * 32 + h) = o;
        }
    }
  } else if (EPI == EPI_OUT1 || EPI == EPI_OUT2) {
    const float* resid = (EPI == EPI_OUT1) ? p.x : (const float*)(ws + OFF_XT);
    float* dst = (EPI == EPI_OUT1) ? (float*)(ws + OFF_XT) : p.out;
    float4 rr[8]; resid_preload(resid + (size_t)mt * DM + c0, lane, rr);
    stage_f32(a, (float*)wl, fr, fq); wave_lds_sync();
    if (EPI == EPI_OUT1) readout_f32_pre_ssq((const float*)wl, rr, dst + (size_t)mt * DM + c0, (bf16_t*)(ws + OFF_XN) + (size_t)mt * DM + c0, (float*)(ws + OFF_SSQ) + mt, lane);
    else readout_f32_pre((const float*)wl, rr, dst + (size_t)mt * DM + c0, lane);
    wave_lds_sync();
  } else if (EPI == EPI_MLA_IN) {
    const float* SSQ = (const float*)(ws + OFF_SSQ);
    f32x4 a2[4][2];
    float rs[2];
#pragma unroll
    for (int n = 0; n < 2; ++n) rs[n] = rsqrtf(sq[n] * (1.f / 1024.f) + 1e-6f);
#pragma unroll
    for (int m = 0; m < 4; ++m)
#pragma unroll
      for (int n = 0; n < 2; ++n) a2[m][n] = a[m][n] * rs[n];
    if (c0 < 640) {
      float* dstq = (float*)(ws + OFF_SSQ) + (c0 < 256 ? T : 2 * T);
#pragma unroll
      for (int n = 0; n < 2; ++n) {
        float q = 0.f;
#pragma unroll
        for (int m = 0; m < 4; ++m) q += a2[m][n][0] * a2[m][n][0] + a2[m][n][1] * a2[m][n][1] + a2[m][n][2] * a2[m][n][2] + a2[m][n][3] * a2[m][n][3];
        q += swz_xor<16>(q); q += __shfl_xor(q, 32);
        if (fq == 0) atomicAdd(dstq + mt + n * 16 + fr, q);
      }
    }
    const f32x4 (&a)[4][2] = a2;
    if (c0 < 640) stage_tm<false>(a, wl, fr, fq);
    else if (c0 < 1664) stage_tm<true>(a, wl, fr, fq);
    wave_lds_sync();
    if (c0 < 256) readout_tm(wl, (bf16_t*)(ws + OFF_ST + 32 * MiB) + (size_t)mt * 256 + c0, 256, lane);
    else if (c0 < 640) readout_tm(wl, (bf16_t*)(ws + OFF_ST + 40 * MiB) + (size_t)mt * 384 + (c0 - 256), 384, lane);
    else if (c0 < 1664) readout_tm(wl, (bf16_t*)(ws + OFF_ST) + (size_t)mt * 1024 + (c0 - 640), 1024, lane);
    else if (c0 == 1664) {
      const float* COS = (const float*)(ws + OFF_COS); const float* SIN = (const float*)(ws + OFF_SIN);
      bf16_t* KROPE = (bf16_t*)(ws + OFF_DEC);
#pragma unroll
      for (int n = 0; n < 2; ++n) {
        const int t = mt + n * 16 + fr;
        const f32x4 cs = *(const f32x4*)(COS + (size_t)t * 16 + fq * 4), sn = *(const f32x4*)(SIN + (size_t)t * 16 + fq * 4);
        const f32x4 x1 = a[0][n], x2 = a[1][n];
        const f32x4 r1 = x1 * cs - x2 * sn, r2 = x1 * sn + x2 * cs;
        uint2 o1, o2; o1.x = pk2(r1[0], r1[1]); o1.y = pk2(r1[2], r1[3]); o2.x = pk2(r2[0], r2[1]); o2.y = pk2(r2[2], r2[3]);
        *(uint2*)(KROPE + (size_t)t * 32 + fq * 4) = o1; *(uint2*)(KROPE + (size_t)t * 32 + 16 + fq * 4) = o2;
      }
    }
    wave_lds_sync();
  } else if (EPI == EPI_KVUP) {
    const int head = c0 >> 7; const bool isv = (c0 & 64) != 0;
    const float* SSQ = (const float*)(ws + OFF_SSQ) + T;
    f32x4 a2[4][2];
#pragma unroll
    for (int n = 0; n < 2; ++n) {
      const float rsn = rsqrtf(sq[n] * (1.f / 256.f) + 1e-6f);
#pragma unroll
      for (int m = 0; m < 4; ++m) a2[m][n] = a[m][n] * rsn;
    }
    const f32x4 (&a)[4][2] = a2;
    if (!isv) stage_tm<false>(a, wl, fr, fq); else stage_cm_pair(a, wlp, par, fr, fq);
    __syncthreads();
    if (!isv) readout_tm(wl, (bf16_t*)(ws + OFF_XN) + (size_t)mt * 1024 + head * 64, 1024, lane);
    else readout_cm_pair(wlp, (bf16_t*)(ws + OFF_BT) + ((size_t)((b * 16 + head) * 64)) * SEQ + tok0p, par, lane);
    __syncthreads();
  } else if (EPI == EPI_QUP) {
    const float SC = 0.10206207261596575f * 1.4426950408889634f;
    const float* SSQ = (const float*)(ws + OFF_SSQ) + 2 * T;
    f32x4 v[4][2];
#pragma unroll
    for (int n = 0; n < 2; ++n) {
      const float rsn = rsqrtf(sq[n] * (1.f / 384.f) + 1e-6f) * SC;
#pragma unroll
      for (int m = 0; m < 4; ++m) v[m][n] = a[m][n] * rsn;
    }
    const int ph = c0 % 96;
    if (ph != 0) {
      const float* COS = (const float*)(ws + OFF_COS); const float* SIN = (const float*)(ws + OFF_SIN);
#pragma unroll
      for (int n = 0; n < 2; ++n) {
        const f32x4 cs = csv[n], sn = snv[n];
        if (ph == 64) { const f32x4 x1 = v[0][n], x2 = v[1][n]; v[0][n] = x1 * cs - x2 * sn; v[1][n] = x1 * sn + x2 * cs; }
        else          { const f32x4 x1 = v[2][n], x2 = v[3][n]; v[2][n] = x1 * cs - x2 * sn; v[3][n] = x1 * sn + x2 * cs; }
      }
    }
    stage_tm<false>(v, wl, fr, fq); wave_lds_sync();
    readout_tm(wl, (bf16_t*)p.out + (size_t)mt * 1536 + c0, 1536, lane);
    wave_lds_sync();
  }
}

constexpr int G8_BK = 64, G8_HALF = 128, G8_HT = G8_HALF * G8_BK;
constexpr int LDS_BYTES = 143360;
DI int g8_lds_byte(int r, int c) { const int st = (r >> 4) * 2 + (c >> 5), rr = r & 15, cc = c & 31, ob = rr * 64 + cc * 2; return st * 1024 + (ob ^ (((ob >> 9) & 1) << 5)); }
DI void g8_stage_rc(int b, int& R, int& C) { const int st = b / 1024, sb = b % 1024, swz = sb ^ (((sb >> 9) & 1) << 5); R = (st >> 1) * 16 + swz / 64; C = (st & 1) * 32 + (swz % 64) / 2; }

template <int EPI, int K>
DI void gemm_tile(const Params& p, const bf16_t* __restrict__ A, const bf16_t* __restrict__ Bt, int brow, int bcol, unsigned char* smem) {
  bf16_t* shm = (bf16_t*)smem;
#define SA(b, h) (shm + ((b) * 2 + (h)) * G8_HT)
#define SB(b, h) (shm + (4 + (b) * 2 + (h)) * G8_HT)
#define STAGE(P, BASE, br, kt) do { const long _g = (long)(br) * K + (long)(kt) * G8_BK; \
    _Pragma("unroll") for (int _i = 0; _i < 2; ++_i) { const int _b = tid * 16 + _i * 8192; int _r, _c; g8_stage_rc(_b, _r, _c); \
      __builtin_amdgcn_global_load_lds((const unsigned*)(BASE + _g + (long)_r * K + _c), (unsigned*)((char*)(P) + _b), 16, 0, 0); } } while (0)
#define LDA(dst, b, h) _Pragma("unroll") for (int m = 0; m < 4; ++m) _Pragma("unroll") for (int k = 0; k < 2; ++k) \
    dst[m][k] = *reinterpret_cast<const bf16x8*>((const char*)SA(b, h) + g8_lds_byte(wr * 64 + m * 16 + fr, k * 32 + fq * 8))
#define LDB(dst, b, h) _Pragma("unroll") for (int n = 0; n < 2; ++n) _Pragma("unroll") for (int k = 0; k < 2; ++k) \
    dst[n][k] = *reinterpret_cast<const bf16x8*>((const char*)SB(b, h) + g8_lds_byte(wc * 32 + n * 16 + fr, k * 32 + fq * 8))
#define MMA(ai, bj, At_, Bt_) do { __builtin_amdgcn_s_setprio(1); \
    _Pragma("unroll") for (int m = 0; m < 4; ++m) _Pragma("unroll") for (int n = 0; n < 2; ++n) _Pragma("unroll") for (int k = 0; k < 2; ++k) \
      acc[ai][bj][m][n] = __builtin_amdgcn_mfma_f32_16x16x32_bf16(At_[m][k], Bt_[n][k], acc[ai][bj][m][n], 0, 0, 0); \
    __builtin_amdgcn_s_setprio(0); } while (0)
#define WAIT_V(n) asm volatile("s_waitcnt vmcnt(" #n ")" ::: "memory")
#define WAIT_L(n) asm volatile("s_waitcnt lgkmcnt(" #n ")" ::: "memory")
#define BAR __builtin_amdgcn_s_barrier()
#define SCHED __builtin_amdgcn_sched_barrier(0)
  const int tid = otid();
  const int wid = tid >> 6, lane = tid & 63, wr = wid >> 2, wc = wid & 3, fr = lane & 15, fq = lane >> 4;
  f32x4 acc[2][2][4][2];
#pragma unroll
  for (int a_ = 0; a_ < 2; ++a_)
#pragma unroll
    for (int b_ = 0; b_ < 2; ++b_)
#pragma unroll
      for (int m = 0; m < 4; ++m)
#pragma unroll
        for (int n = 0; n < 2; ++n) acc[a_][b_][m][n] = (f32x4){0.f, 0.f, 0.f, 0.f};
  bf16x8 At[4][2], B0[2][2], B1[2][2];
  constexpr int nt = K / G8_BK;
  STAGE(SB(0, 0), Bt, bcol, 0); STAGE(SA(0, 0), A, brow, 0);
  STAGE(SB(0, 1), Bt, bcol + G8_HALF, 0); STAGE(SA(0, 1), A, brow + G8_HALF, 0);
  if (wr == 1) BAR;
  WAIT_V(4); BAR;
  STAGE(SB(1, 0), Bt, bcol, 1); STAGE(SA(1, 0), A, brow, 1); STAGE(SB(1, 1), Bt, bcol + G8_HALF, 1);
  WAIT_V(6); BAR;
  for (int t = 0; t < nt - 2; t += 2) {
    LDB(B0, 0, 0); SCHED; LDA(At, 0, 0); STAGE(SA(1, 1), A, brow + G8_HALF, t + 1);
    WAIT_L(8); BAR; WAIT_L(0); MMA(0, 0, At, B0); BAR; SCHED;
    LDB(B1, 0, 1); STAGE(SB(0, 0), Bt, bcol, t + 2);
    BAR; WAIT_L(0); MMA(0, 1, At, B1); BAR;
    LDA(At, 0, 1); STAGE(SA(0, 0), A, brow, t + 2);
    BAR; WAIT_L(0); MMA(1, 0, At, B0); BAR; SCHED;
    STAGE(SB(0, 1), Bt, bcol + G8_HALF, t + 2);
    WAIT_V(6); BAR; MMA(1, 1, At, B1); BAR;
    LDB(B0, 1, 0); SCHED; LDA(At, 1, 0); STAGE(SA(0, 1), A, brow + G8_HALF, t + 2);
    WAIT_L(8); BAR; WAIT_L(0); MMA(0, 0, At, B0); BAR; SCHED;
    LDB(B1, 1, 1); STAGE(SB(1, 0), Bt, bcol, t + 3);
    BAR; WAIT_L(0); MMA(0, 1, At, B1); BAR;
    LDA(At, 1, 1); STAGE(SA(1, 0), A, brow, t + 3);
    BAR; WAIT_L(0); MMA(1, 0, At, B0); BAR; SCHED;
    STAGE(SB(1, 1), Bt, bcol + G8_HALF, t + 3);
    WAIT_V(6); BAR; MMA(1, 1, At, B1); BAR;
  }
  { LDB(B0, 0, 0); LDA(At, 0, 0); STAGE(SA(1, 1), A, brow + G8_HALF, nt - 1);
    BAR; WAIT_L(0); MMA(0, 0, At, B0); BAR;
    LDB(B1, 0, 1); BAR; WAIT_L(0); MMA(0, 1, At, B1); BAR;
    LDA(At, 0, 1); WAIT_V(4); BAR; WAIT_L(0); MMA(1, 0, At, B0); MMA(1, 1, At, B1); BAR; }
  { LDB(B0, 1, 0); LDA(At, 1, 0); WAIT_V(2); BAR; WAIT_L(0); MMA(0, 0, At, B0); BAR;
    LDB(B1, 1, 1); WAIT_V(0); BAR; WAIT_L(0); MMA(0, 1, At, B1); BAR;
    LDA(At, 1, 1); BAR; WAIT_L(0); MMA(1, 0, At, B0); MMA(1, 1, At, B1); BAR; }
  if (wr == 0) BAR;
  __syncthreads();
  int t2 = tid; asm volatile("" : "+v"(t2));
  const int wid2 = t2 >> 6, lane2 = t2 & 63, wr2 = wid2 >> 2, wc2 = wid2 & 3, fr2 = lane2 & 15, fq2 = lane2 >> 4;
  bf16_t* wl = (bf16_t*)(smem + wid2 * EPI_WAVE_BYTES);
  bf16_t* wlp = (bf16_t*)(smem + (wid2 & ~1) * EPI_WAVE_BYTES);
  float sqv[2][2] = {{0.f, 0.f}, {0.f, 0.f}};
  if (EPI == EPI_MLA_IN || EPI == EPI_KVUP || EPI == EPI_QUP) {
    const float* SQ = (const float*)(p.ws + OFF_SSQ) + (EPI == EPI_MLA_IN ? 0 : (EPI == EPI_KVUP ? T : 2 * T));
#pragma unroll
    for (int bj = 0; bj < 2; ++bj)
#pragma unroll
      for (int n = 0; n < 2; ++n) sqv[bj][n] = SQ[bcol + bj * 128 + wc2 * 32 + n * 16 + fr2];
  }
  f32x4 csv[2][2], snv[2][2];
#pragma unroll
  for (int bj = 0; bj < 2; ++bj)
#pragma unroll
    for (int n = 0; n < 2; ++n) { csv[bj][n] = (f32x4){0.f, 0.f, 0.f, 0.f}; snv[bj][n] = (f32x4){0.f, 0.f, 0.f, 0.f}; }
  if (EPI == EPI_QUP) {
    const float* COS = (const float*)(p.ws + OFF_COS); const float* SIN = (const float*)(p.ws + OFF_SIN);
#pragma unroll
    for (int bj = 0; bj < 2; ++bj)
#pragma unroll
      for (int n = 0; n < 2; ++n) {
        const size_t t = (size_t)(bcol + bj * 128 + wc2 * 32 + n * 16 + fr2);
        csv[bj][n] = *(const f32x4*)(COS + t * 16 + fq2 * 4); snv[bj][n] = *(const f32x4*)(SIN + t * 16 + fq2 * 4);
      }
  }
#pragma unroll
  for (int ai = 0; ai < 2; ++ai)
#pragma unroll
    for (int bj = 0; bj < 2; ++bj)
      epilogue_block<EPI>(p, acc[ai][bj], brow + ai * 128 + wr2 * 64, bcol + bj * 128 + wc2 * 32, wl, wlp, wc2 & 1, lane2, fr2, fq2, sqv[bj], csv[bj], snv[bj]);
  __syncthreads();
#undef SA
#undef SB
#undef STAGE
#undef LDA
#undef LDB
#undef MMA
#undef WAIT_V
#undef WAIT_L
#undef BAR
#undef SCHED
}

template <int EPI, int K>
DI void gemm_phase(const Params& p, const bf16_t* Wt, const bf16_t* X, int ntn, unsigned char* smem) {
  const bool xa = (gridDim.x == 256);
  const int xcd = blockIdx.x & 7, li = blockIdx.x >> 3;
  const int per_half = 4 * ntn;
  const int start = xa ? li : (int)blockIdx.x, step = xa ? 32 : (int)gridDim.x, total = ntn * (xa ? 8 : 64);
  for (int t = start; t < total; t += step) {
    int tm, tn;
    if (xa) { const int h = t / per_half, tp = t - h * per_half; tn = tp >> 2; tm = xcd * 8 + h * 4 + (tp & 3); }
    else { tm = t / ntn; tn = t % ntn; }
    gemm_tile<EPI, K>(p, Wt, X, tn * 256, tm * 256, smem);
  }
}

DI void conv8_load(const bf16_t* rp, bool has_prev, uint4& cur, uint2& prv) {
  cur = *(const uint4*)rp; prv = make_uint2(0u, 0u);
  if (has_prev) prv = *(const uint2*)(rp - 4);
}
DI float fast_silu(float v) { return v * __builtin_amdgcn_rcpf(1.f + __expf(-v)); }
DI void conv8_compute(const uint4 cur, const uint2 prv, float w0, float w1, float w2, float w3, float bias, float (&out)[8]) {
  float r[11];
  r[0] = hi16(prv.x); r[1] = lo16(prv.y); r[2] = hi16(prv.y);
  r[3] = lo16(cur.x); r[4] = hi16(cur.x); r[5] = lo16(cur.y); r[6] = hi16(cur.y); r[7] = lo16(cur.z); r[8] = hi16(cur.z); r[9] = lo16(cur.w); r[10] = hi16(cur.w);
#pragma unroll
  for (int j = 0; j < 8; ++j) out[j] = fast_silu(bias + w0 * r[j] + w1 * r[j + 1] + w2 * r[j + 2] + w3 * r[j + 3]);
}
DI void conv8(const bf16_t* rp, bool has_prev, float w0, float w1, float w2, float w3, float bias, float (&out)[8]) {
  uint4 cur; uint2 prv; conv8_load(rp, has_prev, cur, prv); conv8_compute(cur, prv, w0, w1, w2, w3, bias, out);
}
DI bf16x8 pack8(const float (&v)[8]) {
  uint4 u; u.x = pk2(v[0], v[1]); u.y = pk2(v[2], v[3]); u.z = pk2(v[4], v[5]); u.w = pk2(v[6], v[7]);
  return __builtin_bit_cast(bf16x8, u);
}
DI void chunk_cumsum(const float* __restrict__ DTp, size_t tk0, int hd, float A, int lane, float (&d4)[4], float (&c4)[4], float& last) {
#pragma unroll
  for (int i = 0; i < 4; ++i) d4[i] = DTp[(tk0 + 4 * lane + i) * 32 + hd];
  c4[0] = d4[0] * A; c4[1] = c4[0] + d4[1] * A; c4[2] = c4[1] + d4[2] * A; c4[3] = c4[2] + d4[3] * A;
  const float tot = c4[3];
  float sum = tot, ex = 0.f, t;
  t = swz_xor<1>(sum);  if (lane & 1) ex += t;  sum += t;
  t = swz_xor<2>(sum);  if (lane & 2) ex += t;  sum += t;
  t = swz_xor<4>(sum);  if (lane & 4) ex += t;  sum += t;
  t = swz_xor<8>(sum);  if (lane & 8) ex += t;  sum += t;
  t = swz_xor<16>(sum); if (lane & 16) ex += t; sum += t;
  t = __shfl_xor(sum, 32); if (lane & 32) ex += t; sum += t;
#pragma unroll
  for (int i = 0; i < 4; ++i) c4[i] += ex;
  last = sum;
}

constexpr int BT_ROW = 264;
constexpr int CN_ROW = 136;

DI void phase_ssd_state(const Params& p, unsigned char* smem) {
  const bf16_t* XT = (const bf16_t*)(p.ws + OFF_XT); const bf16_t* BT = (const bf16_t*)(p.ws + OFF_BT); const float* DTp = (const float*)(p.ws + OFF_DT);
  float* ST = (float*)(p.ws + OFF_ST); float* DEC = (float*)(p.ws + OFF_DEC);
  bf16_t* BTs = (bf16_t*)smem; float* wgt = (float*)(smem + 128 * BT_ROW * 2);
  const int tid = otid(), lane = tid & 63, w = tid >> 6, l31 = lane & 31, lh = lane >> 5;
  for (int u = blockIdx.x; u < 256; u += gridDim.x) {
    const int b = u >> 7, c = (u >> 2) & 31, g = u & 3; const int hd = 8 * g + w;
    bf16_t* XTC = (bf16_t*)(p.ws + (b ? OFF_ST + 32 * MiB : OFF_XN));
    {
      float d4[4], c4[4], last; chunk_cumsum(DTp, (size_t)b * SEQ + c * 256, hd, -__expf(p.A_log[hd]), lane, d4, c4, last);
      float4 o = {__expf(last - c4[0]) * d4[0], __expf(last - c4[1]) * d4[1], __expf(last - c4[2]) * d4[2], __expf(last - c4[3]) * d4[3]};
      *(float4*)(wgt + w * 256 + 4 * lane) = o;
      if (lane == 0) DEC[(b * 32 + c) * 32 + hd] = __expf(last);
    }
#pragma unroll 2
    for (int i = 0; i < 8; ++i) {
      const int chunk = tid + 512 * i; const int s8 = (chunk & 31) * 8, n = chunk >> 5; const int ch = 2048 + g * 128 + n;
      float v[8];
      conv8(BT + ((size_t)(b * 512 + g * 128 + n)) * SEQ + c * 256 + s8, !(c == 0 && s8 == 0),
            p.conv_w[ch], p.conv_w[3072 + ch], p.conv_w[2 * 3072 + ch], p.conv_w[3 * 3072 + ch], p.conv_b[ch], v);
      *(bf16x8*)(BTs + n * BT_ROW + s8) = pack8(v);
    }
    __syncthreads();
    f32x16 acc[2][4];
#pragma unroll
    for (int a = 0; a < 2; ++a)
#pragma unroll
      for (int q = 0; q < 4; ++q)
#pragma unroll
        for (int i = 0; i < 16; ++i) acc[a][q][i] = 0.f;
    float xw[2][4], xb[2];
#pragma unroll
    for (int pt = 0; pt < 2; ++pt) {
      const int ch = hd * 64 + pt * 32 + l31;
#pragma unroll
      for (int k = 0; k < 4; ++k) xw[pt][k] = p.conv_w[k * 3072 + ch];
      xb[pt] = p.conv_b[ch];
    }
    for (int kb = 0; kb < 16; kb += 2) {
      uint4 rc[2][2]; uint2 rp[2][2];
#pragma unroll
      for (int i = 0; i < 2; ++i)
#pragma unroll
        for (int pt = 0; pt < 2; ++pt) {
          const int s0 = (kb + i) * 16 + 8 * lh;
          conv8_load(XT + ((size_t)(b * 2048 + hd * 64 + pt * 32 + l31)) * SEQ + c * 256 + s0, !(c == 0 && s0 == 0), rc[i][pt], rp[i][pt]);
        }
#pragma unroll
      for (int i = 0; i < 2; ++i) {
        const int ks = kb + i; const int s0 = ks * 16 + 8 * lh;
        const float4 g0 = *(const float4*)(wgt + w * 256 + s0), g1 = *(const float4*)(wgt + w * 256 + s0 + 4);
        const float wg[8] = {g0.x, g0.y, g0.z, g0.w, g1.x, g1.y, g1.z, g1.w};
        bf16x8 afr[2];
#pragma unroll
        for (int pt = 0; pt < 2; ++pt) {
          float v[8];
          conv8_compute(rc[i][pt], rp[i][pt], xw[pt][0], xw[pt][1], xw[pt][2], xw[pt][3], xb[pt], v);
          *(bf16x8*)(XTC + ((size_t)(hd * 64 + pt * 32 + l31)) * SEQ + c * 256 + s0) = pack8(v);
#pragma unroll
          for (int j = 0; j < 8; ++j) v[j] *= wg[j];
          afr[pt] = pack8(v);
        }
#pragma unroll
        for (int nt = 0; nt < 4; ++nt) {
          const bf16x8 bfr = *(const bf16x8*)(BTs + (nt * 32 + l31) * BT_ROW + ks * 16 + 8 * lh);
#pragma unroll
          for (int pt = 0; pt < 2; ++pt) acc[pt][nt] = MFMA32(afr[pt], bfr, acc[pt][nt]);
        }
      }
    }
    bf16_t* Sp = (bf16_t*)ST + (((size_t)(b * 32 + c) * 32 + hd) * 64) * 128;
#pragma unroll
    for (int pt = 0; pt < 2; ++pt)
#pragma unroll
      for (int nt = 0; nt < 4; ++nt)
#pragma unroll
        for (int r = 0; r < 16; ++r) Sp[(pt * 32 + (r & 3) + 8 * (r >> 2) + 4 * lh) * 128 + nt * 32 + l31] = f2bf(acc[pt][nt][r]);
    __syncthreads();
  }
}

DI void phase_ssd_scan(const Params& p) {
  bf16_t* ST = (bf16_t*)(p.ws + OFF_ST); const float* DEC = (const float*)(p.ws + OFF_DEC);
  for (int idx = blockIdx.x * NTHREADS + otid(); idx < 131072; idx += gridDim.x * NTHREADS) {
    const int n4 = idx & 31, pp = (idx >> 5) & 63, h = (idx >> 11) & 31, b = idx >> 16;
    float run[4] = {0.f, 0.f, 0.f, 0.f};
    bf16_t* base = ST + (((size_t)(b * 32) * 32 + h) * 64 + pp) * 128 + n4 * 4;
    const float* dbase = DEC + (b * 32) * 32 + h;
    for (int c0 = 0; c0 < 32; c0 += 16) {
      uint2 loc[16]; float d[16];
#pragma unroll
      for (int i = 0; i < 16; ++i) { loc[i] = *(const uint2*)(base + (size_t)(c0 + i) * (32 * 64 * 128)); d[i] = dbase[(c0 + i) * 32]; }
#pragma unroll
      for (int i = 0; i < 16; ++i) {
        uint2 o; o.x = pk2(run[0], run[1]); o.y = pk2(run[2], run[3]);
        *(uint2*)(base + (size_t)(c0 + i) * (32 * 64 * 128)) = o;
        run[0] = run[0] * d[i] + lo16(loc[i].x); run[1] = run[1] * d[i] + hi16(loc[i].x);
        run[2] = run[2] * d[i] + lo16(loc[i].y); run[3] = run[3] * d[i] + hi16(loc[i].y);
      }
    }
  }
}

DI void stage_tokmajor(const Params& p, const bf16_t* __restrict__ RAW, int b, int tok0, int nrows, int g, int cbase, bf16_t* dst, int tid_) {
  const int tid = otid(); (void)tid_;
  const int n8 = (tid & 15) * 8; const int ch = cbase + g * 128 + n8;
  float cw[4][8], cb[8];
#pragma unroll
  for (int k = 0; k < 4; ++k) {
    const float4 a = *(const float4*)(p.conv_w + k * 3072 + ch), bq = *(const float4*)(p.conv_w + k * 3072 + ch + 4);
    cw[k][0] = a.x; cw[k][1] = a.y; cw[k][2] = a.z; cw[k][3] = a.w; cw[k][4] = bq.x; cw[k][5] = bq.y; cw[k][6] = bq.z; cw[k][7] = bq.w;
  }
  { const float4 a = *(const float4*)(p.conv_b + ch), bq = *(const float4*)(p.conv_b + ch + 4);
    cb[0] = a.x; cb[1] = a.y; cb[2] = a.z; cb[3] = a.w; cb[4] = bq.x; cb[5] = bq.y; cb[6] = bq.z; cb[7] = bq.w; }
  for (int t = tid >> 4; t < nrows; t += 64) {
    uint4 r[2][4];
#pragma unroll
    for (int u = 0; u < 2; ++u)
#pragma unroll
      for (int k = 0; k < 4; ++k) {
        const int tk = tok0 + t + 32 * u - 3 + k;
        r[u][k] = make_uint4(0u, 0u, 0u, 0u);
        if (tk >= 0) r[u][k] = *(const uint4*)(RAW + ((size_t)b * SEQ + tk) * 512 + g * 128 + n8);
      }
#pragma unroll
    for (int u = 0; u < 2; ++u) {
      float acc[8];
#pragma unroll
      for (int j = 0; j < 8; ++j) acc[j] = cb[j];
#pragma unroll
      for (int k = 0; k < 4; ++k) {
        const uint4 q = r[u][k];
        acc[0] += cw[k][0] * lo16(q.x); acc[1] += cw[k][1] * hi16(q.x); acc[2] += cw[k][2] * lo16(q.y); acc[3] += cw[k][3] * hi16(q.y);
        acc[4] += cw[k][4] * lo16(q.z); acc[5] += cw[k][5] * hi16(q.z); acc[6] += cw[k][6] * lo16(q.w); acc[7] += cw[k][7] * hi16(q.w);
      }
#pragma unroll
      for (int j = 0; j < 8; ++j) acc[j] = fast_silu(acc[j]);
      *(bf16x8*)(dst + (t + 32 * u) * CN_ROW + n8) = pack8(acc);
    }
  }
}

constexpr int S3_CS = 0, S3_BS = 64 * CN_ROW * 2, S3_CB = S3_BS + 256 * CN_ROW * 2, S3_CUM = S3_CB + 64 * BT_ROW * 2, S3_DTS = S3_CUM + 8192,
              S3_PART = S3_DTS + 8192, S3_RSTD = S3_PART + 2048, S3_END = S3_RSTD + 256;

DI void phase_ssd_out(const Params& p, unsigned char* smem) {
  const bf16_t* XT = (const bf16_t*)(p.ws + OFF_XT); const bf16_t* BR = (const bf16_t*)(p.ws + OFF_BR); const bf16_t* CR = (const bf16_t*)(p.ws + OFF_CR);
  const float* DTp = (const float*)(p.ws + OFF_DT); const float* ST = (const float*)(p.ws + OFF_ST); bf16_t* Z = (bf16_t*)p.out;
  bf16_t* Cs = (bf16_t*)(smem + S3_CS); bf16_t* Bs = (bf16_t*)(smem + S3_BS); bf16_t* CBs = (bf16_t*)(smem + S3_CB);
  float* cumA = (float*)(smem + S3_CUM); float* dts = (float*)(smem + S3_DTS); float* part = (float*)(smem + S3_PART); float* rstd = (float*)(smem + S3_RSTD);
  const int tid = otid(), lane = tid & 63, w = tid >> 6, l31 = lane & 31, lh = lane >> 5;
  const bool persist = (gridDim.x == 256);
  for (int u = blockIdx.x; u < 1024; u += gridDim.x) {
    const int tq = u >> 8, rest = u & 255; const int b = rest >> 7, c = (rest >> 2) & 31, g = rest & 3; const int hd = 8 * g + w;
    const int ns = (tq + 1) * 64;
    if (!persist || tq == 0) {
      float d4[4], c4[4], last; chunk_cumsum(DTp, (size_t)b * SEQ + c * 256, hd, -__expf(p.A_log[hd]), lane, d4, c4, last);
      *(float4*)(cumA + w * 256 + 4 * lane) = make_float4(c4[0], c4[1], c4[2], c4[3]);
      *(float4*)(dts + w * 256 + 4 * lane) = make_float4(d4[0], d4[1], d4[2], d4[3]);
    }
    stage_tokmajor(p, CR, b, c * 256 + tq * 64, 64, g, 2560, Cs, tid);
    { const int r0 = persist ? tq * 64 : 0; stage_tokmajor(p, BR, b, c * 256 + r0, ns - r0, g, 2048, Bs + r0 * CN_ROW, tid); }
    __syncthreads();
    if (32 * w < ns) {
      f32x16 a2[2];
#pragma unroll
      for (int a = 0; a < 2; ++a)
#pragma unroll
        for (int i = 0; i < 16; ++i) a2[a][i] = 0.f;
#pragma unroll
      for (int ks = 0; ks < 8; ++ks) {
        const bf16x8 af = *(const bf16x8*)(Bs + (32 * w + l31) * CN_ROW + ks * 16 + 8 * lh);
#pragma unroll
        for (int tt = 0; tt < 2; ++tt) {
          const bf16x8 bq = *(const bf16x8*)(Cs + (tt * 32 + l31) * CN_ROW + ks * 16 + 8 * lh);
          a2[tt] = MFMA32(af, bq, a2[tt]);
        }
      }
#pragma unroll
      for (int tt = 0; tt < 2; ++tt)
#pragma unroll
        for (int rg = 0; rg < 4; ++rg) {
          uint2 o; o.x = pk2(a2[tt][4 * rg], a2[tt][4 * rg + 1]); o.y = pk2(a2[tt][4 * rg + 2], a2[tt][4 * rg + 3]);
          *(uint2*)(CBs + (tt * 32 + l31) * BT_ROW + 32 * w + 8 * rg + 4 * lh) = o;
        }
    }
    __syncthreads();
    f32x16 acc[2][2];
#pragma unroll
    for (int a = 0; a < 2; ++a)
#pragma unroll
      for (int q = 0; q < 2; ++q)
#pragma unroll
        for (int i = 0; i < 16; ++i) acc[a][q][i] = 0.f;
    {
      const bf16_t* Sp = (const bf16_t*)ST + (((size_t)(b * 32 + c) * 32 + hd) * 64) * 128;
      for (int kb = 0; kb < 8; kb += 4) {
        bf16x8 bfr[4][2];
#pragma unroll
        for (int i = 0; i < 4; ++i)
#pragma unroll
          for (int pt = 0; pt < 2; ++pt) bfr[i][pt] = *(const bf16x8*)(Sp + (pt * 32 + l31) * 128 + (kb + i) * 16 + 8 * lh);
#pragma unroll
        for (int i = 0; i < 4; ++i) {
          const int ks = kb + i;
#pragma unroll
          for (int tt = 0; tt < 2; ++tt) {
            const bf16x8 af = *(const bf16x8*)(Cs + (tt * 32 + l31) * CN_ROW + ks * 16 + 8 * lh);
#pragma unroll
            for (int pt = 0; pt < 2; ++pt) acc[tt][pt] = MFMA32(af, bfr[i][pt], acc[tt][pt]);
          }
        }
      }
#pragma unroll
      for (int tt = 0; tt < 2; ++tt)
#pragma unroll
        for (int r = 0; r < 16; ++r) {
          const float e = __expf(cumA[w * 256 + tq * 64 + tt * 32 + (r & 3) + 8 * (r >> 2) + 4 * lh]);
          acc[tt][0][r] *= e; acc[tt][1][r] *= e;
        }
    }
    {
      const float Dh = p.Dskip[hd];
      const int tl0 = tq * 64 + l31, tl1 = tq * 64 + 32 + l31;
      const float ct0 = cumA[w * 256 + tl0], ct1 = cumA[w * 256 + tl1];
      const bf16_t* XTC = (const bf16_t*)(p.ws + (b ? OFF_ST + 32 * MiB : OFF_XN)) + ((size_t)(hd * 64 + l31)) * SEQ + c * 256 + 8 * lh;
      const int nks = ns >> 4;
      for (int kb = 0; kb < nks; kb += 4) {
        bf16x8 xq[4][2];
#pragma unroll
        for (int i = 0; i < 4; ++i)
#pragma unroll
          for (int pt = 0; pt < 2; ++pt) xq[i][pt] = *(const bf16x8*)(XTC + (size_t)pt * 32 * SEQ + (kb + i) * 16);
#pragma unroll
        for (int i = 0; i < 4; ++i) {
          const int ks = kb + i; const int s0 = ks * 16 + 8 * lh;
          const float4 c0 = *(const float4*)(cumA + w * 256 + s0), c1 = *(const float4*)(cumA + w * 256 + s0 + 4);
          const float4 d0 = *(const float4*)(dts + w * 256 + s0), d1 = *(const float4*)(dts + w * 256 + s0 + 4);
          const float cs[8] = {c0.x, c0.y, c0.z, c0.w, c1.x, c1.y, c1.z, c1.w};
          const float ds[8] = {d0.x, d0.y, d0.z, d0.w, d1.x, d1.y, d1.z, d1.w};
          const float cref = cumA[w * 256 + ks * 16];
          const bool steep = (cref - cumA[w * 256 + ks * 16 + 15]) > 60.f;
          float Fs[8];
#pragma unroll
          for (int j = 0; j < 8; ++j) Fs[j] = __expf(fminf(cref - cs[j], 64.f)) * ds[j];
#pragma unroll
          for (int tt = 0; tt < 2; ++tt) {
            if (ks * 16 <= tq * 64 + tt * 32 + 31) {
              const int tl = tt ? tl1 : tl0; const float ct = tt ? ct1 : ct0;
              const float Et = __expf(fminf(ct - cref, 0.f));
              const uint4 cbv = *(const uint4*)(CBs + (tt * 32 + l31) * BT_ROW + s0);
              const float cb[8] = {lo16(cbv.x), hi16(cbv.x), lo16(cbv.y), hi16(cbv.y), lo16(cbv.z), hi16(cbv.z), lo16(cbv.w), hi16(cbv.w)};
              float mv[8];
              if (steep) {
#pragma unroll
                for (int j = 0; j < 8; ++j) {
                  const int sidx = s0 + j;
                  float v = cb[j] * __expf(fminf(ct - cs[j], 0.f)) * ds[j];
                  v = (sidx <= tl) ? v : 0.f;
                  if (sidx == tl) v += Dh;
                  mv[j] = v;
                }
              } else if (ks * 16 + 15 > tq * 64 + tt * 32) {
#pragma unroll
                for (int j = 0; j < 8; ++j) {
                  const int sidx = s0 + j;
                  float v = cb[j] * (Et * Fs[j]);
                  v = (sidx <= tl) ? v : 0.f;
                  if (sidx == tl) v += Dh;
                  mv[j] = v;
                }
              } else {
#pragma unroll
                for (int j = 0; j < 8; ++j) mv[j] = cb[j] * (Et * Fs[j]);
              }
              const bf16x8 af = pack8(mv);
#pragma unroll
              for (int pt = 0; pt < 2; ++pt) acc[tt][pt] = MFMA32(af, xq[i][pt], acc[tt][pt]);
            }
          }
        }
      }
    }
    const size_t tokb = (size_t)b * SEQ + c * 256 + tq * 64;
#pragma unroll
    for (int tt = 0; tt < 2; ++tt)
#pragma unroll
      for (int r = 0; r < 16; ++r) {
        const int tloc = tt * 32 + (r & 3) + 8 * (r >> 2) + 4 * lh;
        const bf16_t* zp = Z + (tokb + tloc) * 2048 + hd * 64 + l31;
        const float y0 = acc[tt][0][r] * silu_f(bf2f(zp[0])), y1 = acc[tt][1][r] * silu_f(bf2f(zp[32]));
        acc[tt][0][r] = y0; acc[tt][1][r] = y1;
        float v = y0 * y0 + y1 * y1;
        v += swz_xor<1>(v); v += swz_xor<2>(v); v += swz_xor<4>(v); v += swz_xor<8>(v); v += swz_xor<16>(v);
        if (l31 == 0) part[w * 64 + tloc] = v;
      }
    __syncthreads();
    if (tid < 64) {
      float sres = 0.f;
#pragma unroll
      for (int ww = 0; ww < 8; ++ww) sres += part[ww * 64 + tid];
      rstd[tid] = rsqrtf(sres * (1.f / 512.f) + 1e-6f);
    }
    __syncthreads();
#pragma unroll
    for (int tt = 0; tt < 2; ++tt)
#pragma unroll
      for (int r = 0; r < 16; ++r) {
        const int tloc = tt * 32 + (r & 3) + 8 * (r >> 2) + 4 * lh;
        const float rs = rstd[tloc];
        bf16_t* zp = Z + (tokb + tloc) * 2048 + hd * 64 + l31;
        zp[0] = f2bf(acc[tt][0][r] * rs); zp[32] = f2bf(acc[tt][1][r] * rs);
      }
    __syncthreads();
  }
}

constexpr int KROW = 104;
constexpr int VROW = 68;
constexpr int ATT_K_BYTES = 64 * KROW * 2;
constexpr int ATT_V_BYTES = 64 * VROW * 2;
constexpr int ATT_STAGE = ATT_K_BYTES + ATT_V_BYTES;

DI void attn_kload(const bf16_t* sK, bf16x8 (&kf)[2][6], int l31, int lh) {
#pragma unroll
  for (int sub = 0; sub < 2; ++sub)
#pragma unroll
    for (int ks = 0; ks < 6; ++ks) kf[sub][ks] = *(const bf16x8*)(sK + (sub * 32 + l31) * KROW + ks * 16 + lh * 8);
}
DI void attn_qkmma(const bf16x8 (&kf)[2][6], const bf16x8 (&qf)[6], f32x16 (&sc)[2]) {
#pragma unroll
  for (int sub = 0; sub < 2; ++sub)
#pragma unroll
    for (int i = 0; i < 16; ++i) sc[sub][i] = 0.f;
#pragma unroll
  for (int ks = 0; ks < 6; ++ks)
#pragma unroll
    for (int sub = 0; sub < 2; ++sub) sc[sub] = MFMA32(kf[sub][ks], qf[ks], sc[sub]);
}
DI void attn_qk(const bf16_t* sK, const bf16x8 (&qf)[6], f32x16 (&sc)[2], int l31, int lh) {
  bf16x8 kf[2][6]; attn_kload(sK, kf, l31, lh); attn_qkmma(kf, qf, sc);
}

template <bool MASK>
DI void attn_softmax(f32x16 (&sc)[2], f32x16 (&o)[2], float& m, float& l, int kt, int myq, int lh) {
  float tmax = -1e30f;
#pragma unroll
  for (int sub = 0; sub < 2; ++sub)
#pragma unroll
    for (int r = 0; r < 16; ++r) {
      if (MASK) { const int key = kt * 64 + sub * 32 + (r & 3) + 8 * (r >> 2) + 4 * lh; if (key > myq) sc[sub][r] = -1e30f; }
      tmax = fmaxf(tmax, sc[sub][r]);
    }
  tmax = fmaxf(tmax, __shfl_xor(tmax, 32));
  if (__builtin_amdgcn_ballot_w64(tmax - m > 8.f) != 0) {
    const float mn = fmaxf(m, tmax); const float al = __builtin_amdgcn_exp2f(m - mn); m = mn;
    l *= al;
#pragma unroll
    for (int a = 0; a < 2; ++a)
#pragma unroll
      for (int i = 0; i < 16; ++i) o[a][i] *= al;
  }
  f32x2 ps2 = {0.f, 0.f}; const f32x2 mn2 = {m, m};
#pragma unroll
  for (int sub = 0; sub < 2; ++sub)
#pragma unroll
    for (int r = 0; r < 16; r += 2) {
      f32x2 d = {sc[sub][r], sc[sub][r + 1]}; d = d - mn2;
      f32x2 pe; pe.x = __builtin_amdgcn_exp2f(d.x); pe.y = __builtin_amdgcn_exp2f(d.y);
      sc[sub][r] = pe.x; sc[sub][r + 1] = pe.y; ps2 = ps2 + pe;
    }
  l += ps2.x + ps2.y;
}
DI void attn_pv(const f32x16 (&sc)[2], f32x16 (&o)[2], const bf16_t* sV, int l31, int lh) {
#pragma unroll
  for (int sub = 0; sub < 2; ++sub)
#pragma unroll
    for (int s2 = 0; s2 < 2; ++s2) {
      uint4 pu; pu.x = pk2(sc[sub][8 * s2], sc[sub][8 * s2 + 1]); pu.y = pk2(sc[sub][8 * s2 + 2], sc[sub][8 * s2 + 3]);
      pu.z = pk2(sc[sub][8 * s2 + 4], sc[sub][8 * s2 + 5]); pu.w = pk2(sc[sub][8 * s2 + 6], sc[sub][8 * s2 + 7]);
      const bf16x8 pb = __builtin_bit_cast(bf16x8, pu);
#pragma unroll
      for (int dvt = 0; dvt < 2; ++dvt) {
        const bf16_t* vp = sV + (dvt * 32 + l31) * VROW + sub * 32 + 16 * s2 + 4 * lh;
        const uint2 lo = *(const uint2*)vp, hi = *(const uint2*)(vp + 8);
        uint4 vu = {lo.x, lo.y, hi.x, hi.y};
        o[dvt] = MFMA32(__builtin_bit_cast(bf16x8, vu), pb, o[dvt]);
      }
    }
}

DI void attn_unit(const Params& p, int b, int h, int qb, unsigned char* smem) {
  const bf16_t* Q = (const bf16_t*)p.out; const bf16_t* KN = (const bf16_t*)(p.ws + OFF_XN); const bf16_t* VT = (const bf16_t*)(p.ws + OFF_BT);
  const bf16_t* KROPE = (const bf16_t*)(p.ws + OFF_DEC); const bf16_t* GATE = (const bf16_t*)(p.ws + OFF_ST); bf16_t* O = (bf16_t*)(p.ws + OFF_ST + 32 * MiB);
  const int tid = otid(), lane = tid & 63, w = tid >> 6, l31 = lane & 31, lh = lane >> 5;
  const int q0 = qb * 256, qw0 = q0 + 32 * w, myq = qw0 + l31;
  const size_t tq = (size_t)b * SEQ + myq;
  bf16x8 qf[6];
#pragma unroll
  for (int ks = 0; ks < 6; ++ks) qf[ks] = *(const bf16x8*)(Q + tq * 1536 + h * 96 + ks * 16 + lh * 8);
  f32x16 o[2];
#pragma unroll
  for (int a = 0; a < 2; ++a)
#pragma unroll
    for (int i = 0; i < 16; ++i) o[a][i] = 0.f;
  float m = -1e30f, l = 0.f;
  const int ntiles = 4 * qb + 4;
  const int nact = (qw0 + 31) / 64 + 1;
  const int kr = tid >> 3, kc = (tid & 7) * 8;
  const int rr = (tid & 255) >> 2, rc = (tid & 3) * 8;
  const bf16_t* gK = KN + ((size_t)b * SEQ + kr) * 1024 + h * 64 + kc;
  const bf16_t* gR = KROPE + ((size_t)b * SEQ + rr) * 32 + rc;
  const bf16_t* gV = VT + ((size_t)((b * 16 + h) * 64 + kr)) * SEQ + kc;
  uint4 rk, rr4, rv;
#define ATT_LOAD(T) do { rk = *(const uint4*)(gK + (size_t)(T) * 64 * 1024); rr4 = *(const uint4*)(gR + (size_t)(T) * 64 * 32); rv = *(const uint4*)(gV + (T) * 64); } while (0)
#define ATT_STORE(ST_) do { bf16_t* dK_ = (bf16_t*)(smem + (ST_) * ATT_STAGE); bf16_t* dV_ = (bf16_t*)(smem + (ST_) * ATT_STAGE + ATT_K_BYTES); \
    *(uint4*)(dK_ + kr * KROW + kc) = rk; *(uint4*)(dK_ + rr * KROW + 64 + rc) = rr4; \
    *(uint2*)(dV_ + kr * VROW + kc) = make_uint2(rv.x, rv.y); *(uint2*)(dV_ + kr * VROW + kc + 4) = make_uint2(rv.z, rv.w); } while (0)
  ATT_LOAD(0); ATT_STORE(0);
  ATT_LOAD(1); ATT_STORE(1);
  ATT_LOAD(2);
  __syncthreads();
  f32x16 sc[2], sn[2];
  attn_qk((const bf16_t*)smem, qf, sc, l31, lh);
  int st = 0;
  int kt = 0;
  for (; kt < nact - 1; ++kt) {
    const int st1 = (st == 2) ? 0 : st + 1, st2 = (st1 == 2) ? 0 : st1 + 1;
    ATT_STORE(st2);
    { const int tl = (kt + 3 < ntiles) ? kt + 3 : ntiles - 1; ATT_LOAD(tl); }
    attn_qk((const bf16_t*)(smem + st1 * ATT_STAGE), qf, sn, l31, lh);
    attn_softmax<false>(sc, o, m, l, kt, myq, lh);
    attn_pv(sc, o, (const bf16_t*)(smem + st * ATT_STAGE + ATT_K_BYTES), l31, lh);
    __syncthreads();
#pragma unroll
    for (int sub = 0; sub < 2; ++sub) sc[sub] = sn[sub];
    st = st1;
  }
  uint2 gpre[2][4];
#pragma unroll
  for (int dvt = 0; dvt < 2; ++dvt)
#pragma unroll
    for (int rg = 0; rg < 4; ++rg) gpre[dvt][rg] = *(const uint2*)(GATE + tq * 1024 + h * 64 + dvt * 32 + 8 * rg + 4 * lh);
  {
    const int st1 = (st == 2) ? 0 : st + 1, st2 = (st1 == 2) ? 0 : st1 + 1;
    ATT_STORE(st2);
    { const int tl = (kt + 3 < ntiles) ? kt + 3 : ntiles - 1; ATT_LOAD(tl); }
    attn_softmax<true>(sc, o, m, l, kt, myq, lh);
    attn_pv(sc, o, (const bf16_t*)(smem + st * ATT_STAGE + ATT_K_BYTES), l31, lh);
    __syncthreads();
    st = st1; ++kt;
  }
  for (; kt < ntiles; ++kt) {
    const int st1 = (st == 2) ? 0 : st + 1, st2 = (st1 == 2) ? 0 : st1 + 1;
    ATT_STORE(st2);
    { const int tl = (kt + 3 < ntiles) ? kt + 3 : ntiles - 1; ATT_LOAD(tl); }
    __syncthreads();
    st = st1;
  }
#undef ATT_LOAD
#undef ATT_STORE
  l += __shfl_xor(l, 32);
  const float il = 1.f / l;
#pragma unroll
  for (int dvt = 0; dvt < 2; ++dvt)
#pragma unroll
    for (int rg = 0; rg < 4; ++rg) {
      const int dv = dvt * 32 + 8 * rg + 4 * lh;
      const uint2 gv = gpre[dvt][rg];
      const float g0 = __uint_as_float(gv.x << 16), g1 = __uint_as_float(gv.x & 0xffff0000u), g2 = __uint_as_float(gv.y << 16), g3 = __uint_as_float(gv.y & 0xffff0000u);
      uint2 ov; ov.x = pk2(o[dvt][4 * rg] * il * g0, o[dvt][4 * rg + 1] * il * g1); ov.y = pk2(o[dvt][4 * rg + 2] * il * g2, o[dvt][4 * rg + 3] * il * g3);
      *(uint2*)(O + tq * 1024 + h * 64 + dv) = ov;
    }
}

DI void phase_attn(const Params& p, unsigned char* smem) {
  for (int u = blockIdx.x; u < 512; u += gridDim.x) {
    int pu = u;
    if (gridDim.x == 256) {
      const int xcd = blockIdx.x & 7, li = blockIdx.x >> 3, r = u >> 8;
      pu = (r * 16 + xcd * 2 + (li >> 4)) * 16 + (li & 15);
    }
    const int bh = pu >> 4, x = pu & 15;
    for (int half = 0; half < 2; ++half) attn_unit(p, bh >> 4, bh & 15, half ? x : 31 - x, smem);
  }
}

DI void phase_final_norm(const Params& p) {
  const int tid = otid(); const int lane = tid & 63, w = tid >> 6;
  float4 g[4];
#pragma unroll
  for (int i = 0; i < 4; ++i) g[i] = ((const float4*)p.g_final)[lane + 64 * i];
  for (int row = (blockIdx.x * 8 + w) * 2; row < T; row += gridDim.x * 16) {
    float4 v[2][4]; float ss[2] = {0.f, 0.f};
#pragma unroll
    for (int u = 0; u < 2; ++u)
#pragma unroll
      for (int i = 0; i < 4; ++i) v[u][i] = ((const float4*)(p.out + (size_t)(row + u) * DM))[lane + 64 * i];
#pragma unroll
    for (int u = 0; u < 2; ++u) {
#pragma unroll
      for (int i = 0; i < 4; ++i) ss[u] += v[u][i].x * v[u][i].x + v[u][i].y * v[u][i].y + v[u][i].z * v[u][i].z + v[u][i].w * v[u][i].w;
      ss[u] = wave_sum(ss[u]);
      const float r = rsqrtf(ss[u] * (1.f / 1024.f) + 1e-6f);
#pragma unroll
      for (int i = 0; i < 4; ++i)
        ((float4*)(p.out + (size_t)(row + u) * DM))[lane + 64 * i] = make_float4(v[u][i].x * r * g[i].x, v[u][i].y * r * g[i].y, v[u][i].z * r * g[i].z, v[u][i].w * r * g[i].w);
    }
  }
}

__global__ void __launch_bounds__(NTHREADS) mega(Params p) {
  cg::grid_group grid = cg::this_grid();
  extern __shared__ __attribute__((aligned(16))) unsigned char smem[];
  unsigned char* ws = p.ws;
  __shared__ unsigned bar_st[4];
  if (threadIdx.x < 4) bar_st[threadIdx.x] = 0u;
  __syncthreads();
  const XcdBarrier xb = xcd_barrier_post((unsigned*)(ws + OFF_BAR), bar_st);
  const bool tailfill = (gridDim.x == 256);
  phase_prep(p, smem, blockIdx.x, tailfill ? 1344 : 2832, gridDim.x);
  if (!tailfill) phase_rope_tables(p, blockIdx.x, gridDim.x);
  phase_rmsnorm_rows(p.x, (bf16_t*)(ws + OFF_XN));
  if (p.out == nullptr) grid.sync();
  xcd_barrier(xb);
  gemm_phase<EPI_SSM_IN, 1024>(p, (const bf16_t*)(ws + OFF_W1), (const bf16_t*)(ws + OFF_XN), 21, smem);
  if (tailfill && (blockIdx.x >> 3) >= 8) {
    const int tj = (blockIdx.x & 7) * 24 + ((blockIdx.x >> 3) - 8);
    phase_prep(p, smem, 1344 + tj, 2832, 192);
    phase_rope_tables(p, tj, 192);
  }
  xcd_barrier(xb);
  phase_ssd_state(p, smem);
  xcd_barrier(xb);
  phase_ssd_scan(p);
  xcd_barrier(xb);
  phase_ssd_out(p, smem);
  xcd_barrier(xb);
  gemm_phase<EPI_OUT1, 2048>(p, (const bf16_t*)(ws + OFF_W2), (const bf16_t*)p.out, 4, smem);
  xcd_barrier(xb);
  gemm_phase<EPI_MLA_IN, 1024>(p, (const bf16_t*)(ws + OFF_W3), (const bf16_t*)(ws + OFF_XN), 7, smem);
  xcd_barrier(xb);
  gemm_phase<EPI_KVUP, 256>(p, (const bf16_t*)(ws + OFF_W4), (const bf16_t*)(ws + OFF_ST + 32 * MiB), 8, smem);
  gemm_phase<EPI_QUP, 384>(p, (const bf16_t*)(ws + OFF_W5), (const bf16_t*)(ws + OFF_ST + 40 * MiB), 6, smem);
  xcd_barrier(xb);
  phase_attn(p, smem);
  xcd_barrier(xb);
  gemm_phase<EPI_OUT2, 1024>(p, (const bf16_t*)(ws + OFF_W6), (const bf16_t*)(ws + OFF_ST + 32 * MiB), 4, smem);
  xcd_barrier(xb);
  phase_final_norm(p);
}

extern "C" void kernel_launch(void* const* d_in, const int* in_sizes, int n_in, void* d_out, int out_size, void* d_ws, size_t ws_size, hipStream_t stream) {
  static int grid = 0;
  if (grid == 0) {
    if (n_in != 20 || ws_size < WS_NEED) { fprintf(stderr, "kernel_launch: unexpected n_in %d / ws_size %zu\n", n_in, ws_size); grid = -1; return; }
    int dev = 0, cus = 0, per_cu = 0;
    hipGetDevice(&dev);
    hipDeviceGetAttribute(&cus, hipDeviceAttributeMultiprocessorCount, dev);
    if (hipFuncSetAttribute((const void*)mega, hipFuncAttributeMaxDynamicSharedMemorySize, LDS_BYTES) != hipSuccess) { fprintf(stderr, "hipFuncSetAttribute failed\n"); grid = -1; return; }
    hipOccupancyMaxActiveBlocksPerMultiprocessor(&per_cu, (const void*)mega, NTHREADS, LDS_BYTES);
    if (per_cu < 1) per_cu = 1;
    (void)hipGetLastError();
    grid = cus;
  }
  if (grid < 0) return;
  Params p{};
  p.x = (const float*)d_in[0]; p.pos = (const int*)d_in[1]; p.g_pre = (const float*)d_in[2]; p.ssm_w_in = (const float*)d_in[3];
  p.conv_w = (const float*)d_in[4]; p.conv_b = (const float*)d_in[5]; p.dt_bias = (const float*)d_in[6]; p.A_log = (const float*)d_in[7];
  p.Dskip = (const float*)d_in[8]; p.g_out = (const float*)d_in[9]; p.ssm_w_out = (const float*)d_in[10]; p.kv_g_in = (const float*)d_in[11];
  p.kv_w_down = (const float*)d_in[12]; p.kv_g_lat = (const float*)d_in[13]; p.kv_w_up = (const float*)d_in[14]; p.mla_w_in = (const float*)d_in[15];
  p.mla_g_q = (const float*)d_in[16]; p.mla_w_uq = (const float*)d_in[17]; p.mla_w_out = (const float*)d_in[18]; p.g_final = (const float*)d_in[19];
  p.out = (float*)d_out; p.ws = (unsigned char*)d_ws;
  if (hipMemsetAsync((char*)d_ws + OFF_BAR, 0, XCD_BAR_WORDS * sizeof(unsigned), stream) != hipSuccess) { fprintf(stderr, "memset of barrier words failed\n"); return; }
  void* args[] = {&p};
  hipError_t e = hipLaunchCooperativeKernel((const void*)mega, dim3(grid), dim3(NTHREADS), args, LDS_BYTES, stream);
  if (e != hipSuccess) fprintf(stderr, "cooperative launch failed: %s (grid %d)\n", hipGetErrorString(e), grid);
}
```

```cpp
#include <hip/hip_runtime.h>
#include <hip/hip_cooperative_groups.h>
#include <cstdio>
#include <cstdint>
namespace cg = cooperative_groups;

typedef unsigned short bf16_t;
typedef short bf16x8 __attribute__((ext_vector_type(8)));
typedef float f32x16 __attribute__((ext_vector_type(16)));
#define DI __device__ __forceinline__
#define MFMA32(a, b, c) __builtin_amdgcn_mfma_f32_32x32x16_bf16((a), (b), (c), 0, 0, 0)

constexpr int T = 16384, SEQ = 8192, DM = 1024;
constexpr int NTHREADS = 512;
constexpr size_t MiB = 1024 * 1024;
constexpr size_t OFF_W1 = 0;
constexpr size_t OFF_W2 = OFF_W1 + (size_t)5376 * 1024 * 2;
constexpr size_t OFF_W3 = OFF_W2 + (size_t)1024 * 2048 * 2;
constexpr size_t OFF_W4 = OFF_W3 + (size_t)1792 * 1024 * 2;
constexpr size_t OFF_W5 = OFF_W4 + (size_t)2048 * 256 * 2;
constexpr size_t OFF_W6 = OFF_W5 + (size_t)1536 * 384 * 2;
constexpr size_t OFF_XN = 24 * MiB;
constexpr size_t OFF_XT = 56 * MiB;
constexpr size_t OFF_BT = 120 * MiB;
constexpr size_t OFF_BR = 136 * MiB;
constexpr size_t OFF_CR = 152 * MiB;
constexpr size_t OFF_DT = 168 * MiB;
constexpr size_t OFF_ST = 170 * MiB;
constexpr size_t OFF_DEC = 234 * MiB;
constexpr size_t OFF_BAR = 236 * MiB;
constexpr size_t OFF_COS = 238 * MiB;
constexpr size_t OFF_SIN = 239 * MiB;
constexpr size_t OFF_SSQ = 240 * MiB;
constexpr size_t WS_NEED = 241 * MiB;

struct Params {
  const float* x; const int* pos; const float* g_pre; const float* ssm_w_in; const float* conv_w; const float* conv_b;
  const float* dt_bias; const float* A_log; const float* Dskip; const float* g_out; const float* ssm_w_out;
  const float* kv_g_in; const float* kv_w_down; const float* kv_g_lat; const float* kv_w_up;
  const float* mla_w_in; const float* mla_g_q; const float* mla_w_uq; const float* mla_w_out; const float* g_final;
  float* out; unsigned char* ws;
};

DI bf16_t f2bf(float x) { unsigned u = __float_as_uint(x); u += 0x7fffu + ((u >> 16) & 1u); return (bf16_t)(u >> 16); }
DI float bf2f(bf16_t b) { return __uint_as_float(((unsigned)b) << 16); }
DI float lo16(unsigned u) { return __uint_as_float(u << 16); }
DI float hi16(unsigned u) { return __uint_as_float(u & 0xffff0000u); }
typedef float f32x2 __attribute__((ext_vector_type(2)));
typedef __bf16 bf16x2_t __attribute__((ext_vector_type(2)));
DI unsigned pk2(float a, float b) { f32x2 v = {a, b}; bf16x2_t r = __builtin_convertvector(v, bf16x2_t); return __builtin_bit_cast(unsigned, r); }
DI float wave_sum(float v) {
#pragma unroll
  for (int o = 32; o >= 1; o >>= 1) v += __shfl_xor(v, o);
  return v;
}
DI int otid() { int t = threadIdx.x; asm volatile("" : "+v"(t)); return t; }
template <int K> DI float swz_xor(float v) {
  return __int_as_float(__builtin_amdgcn_ds_swizzle(__float_as_int(v), (K << 10) | 0x1f));
}
DI float silu_f(float v) { return v * __builtin_amdgcn_rcpf(1.f + __expf(-v)); }


#define XB_TMO      128
#define XB_XCNT(j)  (256  + 64 * (j))
#define XB_XSUB(j)  (1280 + 64 * (j))
#define XB_XGEN(j)  (2304 + 64 * (j))
#define XB_TOP      3328
#define XB_TOPGEN   3392
#define XCD_BAR_WORDS 3456
#define XB_SPIN_CAP (1u << 18)
DI unsigned xb_ld(unsigned* p)              { return __hip_atomic_load(p, __ATOMIC_RELAXED, __HIP_MEMORY_SCOPE_AGENT); }
DI unsigned xb_add(unsigned* p, unsigned v) { return __hip_atomic_fetch_add(p, v, __ATOMIC_RELAXED, __HIP_MEMORY_SCOPE_AGENT); }
DI unsigned xb_xcc_id() { return (unsigned)__builtin_amdgcn_s_getreg((3 << 11) | 20) & 0xFu; }
#define XB_SPIN(cond, bar) do { unsigned _sp = 0; while (cond) { __builtin_amdgcn_s_sleep(1); \
    if ((++_sp & 255u) == 0u) { if (xb_ld(&(bar)[XB_TMO])) break; if (_sp > XB_SPIN_CAP) { atomicAdd(&(bar)[XB_TMO], 1u); break; } } } } while (0)
struct XcdBarrier { unsigned* bar; unsigned x; volatile unsigned* st; };
DI XcdBarrier xcd_barrier_post(unsigned* bar, volatile unsigned* st) {
  XcdBarrier b; b.bar = bar; b.x = xb_xcc_id(); b.st = st;
  if (threadIdx.x == 0) (void)xb_add(&bar[XB_XCNT(b.x)], 1u);
  return b;
}
DI void xcd_barrier_complete(unsigned* bar, unsigned x, unsigned& nloc, unsigned& nx) {
  const unsigned G = gridDim.x * gridDim.y * gridDim.z;
  unsigned sum, cnt, mine, sp = 0u;
  for (;;) {
    sum = 0u; cnt = 0u; mine = 0u;
#pragma unroll
    for (unsigned j = 0; j < 16; ++j) { const unsigned c = xb_ld(&bar[XB_XCNT(j)]); sum += c; cnt += (c > 0u) ? 1u : 0u; mine = (j == x) ? c : mine; }
    if (sum == G) break;
    __builtin_amdgcn_s_sleep(1);
    if ((++sp & 255u) == 0u) { if (xb_ld(&bar[XB_TMO])) break; if (sp > XB_SPIN_CAP) { atomicAdd(&bar[XB_TMO], 1u); break; } }
  }
  nloc = mine > 0u ? mine : 1u; nx = cnt > 0u ? cnt : 1u;
}
DI void xcd_barrier(const XcdBarrier& b) {
  asm volatile("s_waitcnt vmcnt(0)" ::: "memory");
  __syncthreads();
  if (threadIdx.x == 0) {
    unsigned* bar = b.bar;
    __builtin_amdgcn_s_waitcnt(0);
    unsigned nloc = b.st[0], nx = b.st[1];
    if (nloc == 0u) { xcd_barrier_complete(bar, b.x, nloc, nx); b.st[0] = nloc; b.st[1] = nx; }
    const unsigned old = xb_add(&bar[XB_XSUB(b.x)], 1u);
    const unsigned gen = old / nloc;
    if (old + 1u == (gen + 1u) * nloc) {
      __builtin_amdgcn_fence(__ATOMIC_RELEASE, "agent");
      asm volatile("s_waitcnt vmcnt(0)" ::: "memory");
      const unsigned og = xb_add(&bar[XB_TOP], 1u);
      const unsigned tg = og / nx;
      if (og + 1u == (tg + 1u) * nx) xb_add(&bar[XB_TOPGEN], 1u);
      else XB_SPIN(xb_ld(&bar[XB_TOPGEN]) == tg, bar);
      __builtin_amdgcn_fence(__ATOMIC_ACQUIRE, "agent");
      xb_add(&bar[XB_XGEN(b.x)], 1u);
      asm volatile("s_waitcnt vmcnt(0)" ::: "memory");
    } else {
      XB_SPIN(xb_ld(&bar[XB_XGEN(b.x)]) == gen, bar);
      __builtin_amdgcn_fence(__ATOMIC_ACQUIRE, "agent");
      asm volatile("s_waitcnt vmcnt(0)" ::: "memory");
    }
  }
  __syncthreads();
}

struct WJob { const float* src; const float* gain; bf16_t* dst; int ld, col0, ncols, K, tile; };
DI WJob wprep_job(const Params& p, int u) {
  bf16_t* W1 = (bf16_t*)(p.ws + OFF_W1); bf16_t* W2 = (bf16_t*)(p.ws + OFF_W2); bf16_t* W3 = (bf16_t*)(p.ws + OFF_W3);
  bf16_t* W4 = (bf16_t*)(p.ws + OFF_W4); bf16_t* W5 = (bf16_t*)(p.ws + OFF_W5); bf16_t* W6 = (bf16_t*)(p.ws + OFF_W6);
  int t = u; WJob j;
  if (t < 1344) { j = {p.ssm_w_in, p.g_pre, W1, 5152, 0, 5152, 1024, t}; return j; } t -= 1344;
  if (t < 512) { j = {p.ssm_w_out, p.g_out, W2, 1024, 0, 1024, 2048, t}; return j; } t -= 512;
  if (t < 64) { j = {p.kv_w_down, p.kv_g_in, W3, 288, 0, 256, 1024, t}; return j; } t -= 64;
  if (t < 96) { j = {p.mla_w_in, p.g_pre + 1024, W3 + (size_t)256 * 1024, 1408, 0, 384, 1024, t}; return j; } t -= 96;
  if (t < 256) { j = {p.mla_w_in, p.g_pre + 1024, W3 + (size_t)640 * 1024, 1408, 384, 1024, 1024, t}; return j; } t -= 256;
  if (t < 32) { j = {p.kv_w_down, p.kv_g_in, W3 + (size_t)1664 * 1024, 288, 256, 32, 1024, t}; return j; } t -= 32;
  if (t < 128) { j = {p.kv_w_up, p.kv_g_lat, W4, 2048, 0, 2048, 256, t}; return j; } t -= 128;
  if (t < 144) { j = {p.mla_w_uq, p.mla_g_q, W5, 1536, 0, 1536, 384, t}; return j; } t -= 144;
  j = {p.mla_w_out, nullptr, W6, 1024, 0, 1024, 1024, t}; return j;
}
DI void wprep_load(const WJob& j, int tid0, float4 (&v)[2], float (&gk)[2]) {
  const int nkt = j.K >> 6; const int tn = j.tile / nkt, tk = j.tile % nkt; const int n0 = tn * 64, k0 = tk * 64;
#pragma unroll
  for (int i = 0; i < 2; ++i) {
    const int e = tid0 + NTHREADS * i; const int kk = e >> 4, n4 = (e & 15) * 4;
    v[i] = make_float4(0.f, 0.f, 0.f, 0.f);
    if (n0 + n4 < j.ncols) v[i] = *(const float4*)(j.src + (size_t)(k0 + kk) * j.ld + j.col0 + n0 + n4);
    gk[i] = j.gain ? j.gain[k0 + kk] : 1.f;
  }
}
DI void phase_prep(const Params& p, unsigned char* smem, int ustart, int uend, int ustride) {
  float* sm = (float*)smem;
  const int tid0 = otid();
  int u = ustart;
  if (u >= uend) return;
  WJob j = wprep_job(p, u);
  float4 v[2]; float gk[2];
  wprep_load(j, tid0, v, gk);
  for (;;) {
#pragma unroll
    for (int i = 0; i < 2; ++i) {
      const int e = tid0 + NTHREADS * i; const int kk = e >> 4, n4 = (e & 15) * 4;
      float* d = sm + kk * 65 + n4;
      d[0] = v[i].x * gk[i]; d[1] = v[i].y * gk[i]; d[2] = v[i].z * gk[i]; d[3] = v[i].w * gk[i];
    }
    __syncthreads();
    const WJob jc = j;
    const int un = u + ustride; const bool more = (un < uend);
    if (more) { j = wprep_job(p, un); wprep_load(j, tid0, v, gk); }
    {
      const int nkt = jc.K >> 6; const int tn = jc.tile / nkt, tk = jc.tile % nkt; const int n0 = tn * 64, k0 = tk * 64;
      const int nn = tid0 >> 3, kc = (tid0 & 7) * 8;
      uint4 o;
      o.x = pk2(sm[(kc + 0) * 65 + nn], sm[(kc + 1) * 65 + nn]); o.y = pk2(sm[(kc + 2) * 65 + nn], sm[(kc + 3) * 65 + nn]);
      o.z = pk2(sm[(kc + 4) * 65 + nn], sm[(kc + 5) * 65 + nn]); o.w = pk2(sm[(kc + 6) * 65 + nn], sm[(kc + 7) * 65 + nn]);
      *(uint4*)(jc.dst + (size_t)(n0 + nn) * jc.K + k0 + kc) = o;
    }
    __syncthreads();
    if (!more) break;
    u = un;
  }
}

DI void phase_rope_tables(const Params& p, int blk, int nblk) {
  float* COS = (float*)(p.ws + OFF_COS); float* SIN = (float*)(p.ws + OFF_SIN);
  for (int e = blk * NTHREADS + otid(); e < T * 16; e += nblk * NTHREADS) {
    const int t = e >> 4, i = e & 15;
    const float ang = (float)p.pos[t] * powf(10000.f, -(float)(2 * i) / 32.f);
    COS[e] = cosf(ang); SIN[e] = sinf(ang);
  }
  float* SSQ = (float*)(p.ws + OFF_SSQ);
  for (int e = blk * NTHREADS + otid(); e < 3 * T; e += nblk * NTHREADS) SSQ[e] = 0.f;
}

DI void phase_rmsnorm_rows(const float* __restrict__ src, bf16_t* __restrict__ dst) {
  const int tid = otid(); const int lane = tid & 63, w = tid >> 6;
  for (int row = (blockIdx.x * 8 + w) * 2; row < T; row += gridDim.x * 16) {
    float4 v[2][4]; float ss[2] = {0.f, 0.f};
#pragma unroll
    for (int u = 0; u < 2; ++u)
#pragma unroll
      for (int i = 0; i < 4; ++i) v[u][i] = ((const float4*)(src + (size_t)(row + u) * DM))[lane + 64 * i];
#pragma unroll
    for (int u = 0; u < 2; ++u) {
#pragma unroll
      for (int i = 0; i < 4; ++i) ss[u] += v[u][i].x * v[u][i].x + v[u][i].y * v[u][i].y + v[u][i].z * v[u][i].z + v[u][i].w * v[u][i].w;
      ss[u] = wave_sum(ss[u]);
      const float r = rsqrtf(ss[u] * (1.f / 1024.f) + 1e-6f);
#pragma unroll
      for (int i = 0; i < 4; ++i) {
        uint2 o; o.x = pk2(v[u][i].x * r, v[u][i].y * r); o.y = pk2(v[u][i].z * r, v[u][i].w * r);
        *(uint2*)(dst + (size_t)(row + u) * DM + (lane + 64 * i) * 4) = o;
      }
    }
  }
}

enum { EPI_SSM_IN = 0, EPI_OUT1 = 1, EPI_MLA_IN = 2, EPI_KVUP = 3, EPI_QUP = 4, EPI_OUT2 = 5 };


typedef float f32x4 __attribute__((ext_vector_type(4)));
constexpr int EPI_WAVE_BYTES = 8704;
constexpr int TM_ROW = 72;
constexpr int CM_ROW = 40;
constexpr int F32_ROW = 68;

template <bool SILU>
DI void stage_tm(const f32x4 (&a)[4][2], bf16_t* wl, int fr, int fq) {
#pragma unroll
  for (int m = 0; m < 4; ++m)
#pragma unroll
    for (int n = 0; n < 2; ++n) {
      float v0 = a[m][n][0], v1 = a[m][n][1], v2 = a[m][n][2], v3 = a[m][n][3];
      if (SILU) { v0 = silu_f(v0); v1 = silu_f(v1); v2 = silu_f(v2); v3 = silu_f(v3); }
      uint2 o; o.x = pk2(v0, v1); o.y = pk2(v2, v3);
      *(uint2*)(wl + (n * 16 + fr) * TM_ROW + m * 16 + fq * 4) = o;
    }
}
DI void readout_tm(const bf16_t* wl, bf16_t* gdst, size_t ld, int lane) {
#pragma unroll
  for (int it = 0; it < 4; ++it) {
    const int idx = lane + 64 * it; const int row = idx >> 3, ch = idx & 7;
    *(uint4*)(gdst + (size_t)row * ld + ch * 8) = *(const uint4*)(wl + row * TM_ROW + ch * 8);
  }
}
DI void stage_cm(const f32x4 (&a)[4][2], bf16_t* wl, int fr, int fq) {
#pragma unroll
  for (int m = 0; m < 4; ++m)
#pragma unroll
    for (int n = 0; n < 2; ++n)
#pragma unroll
      for (int j = 0; j < 4; ++j) wl[(m * 16 + fq * 4 + j) * CM_ROW + n * 16 + fr] = f2bf(a[m][n][j]);
}
DI void readout_cm(const bf16_t* wl, bf16_t* gdst, int lane) {
#pragma unroll
  for (int it = 0; it < 4; ++it) {
    const int idx = lane + 64 * it; const int row = idx >> 2, ch = idx & 3;
    *(uint4*)(gdst + (size_t)row * SEQ + ch * 8) = *(const uint4*)(wl + row * CM_ROW + ch * 8);
  }
}
constexpr int CMP_ROW = 72;
DI void stage_cm_pair(const f32x4 (&a)[4][2], bf16_t* wlp, int par, int fr, int fq) {
#pragma unroll
  for (int m = 0; m < 4; ++m)
#pragma unroll
    for (int n = 0; n < 2; ++n)
#pragma unroll
      for (int j = 0; j < 4; ++j) wlp[(m * 16 + fq * 4 + j) * CMP_ROW + par * 32 + n * 16 + fr] = f2bf(a[m][n][j]);
}
DI void readout_cm_pair(const bf16_t* wlp, bf16_t* gdst, int par, int lane) {
#pragma unroll
  for (int it = 0; it < 4; ++it) {
    const int idx = lane + 64 * it; const int row = par * 32 + (idx >> 3), ch = idx & 7;
    *(uint4*)(gdst + (size_t)row * SEQ + ch * 8) = *(const uint4*)(wlp + row * CMP_ROW + ch * 8);
  }
}
DI void stage_f32(const f32x4 (&a)[4][2], float* wl, int fr, int fq) {
#pragma unroll
  for (int m = 0; m < 4; ++m)
#pragma unroll
    for (int n = 0; n < 2; ++n) *(f32x4*)(wl + (n * 16 + fr) * F32_ROW + m * 16 + fq * 4) = a[m][n];
}
DI void readout_f32_resid(const float* wl, const float* __restrict__ resid, float* __restrict__ gdst, int lane) {
#pragma unroll 4
  for (int it = 0; it < 8; ++it) {
    const int idx = lane + 64 * it; const int row = idx >> 4, ch = idx & 15;
    const float4 v = *(const float4*)(wl + row * F32_ROW + ch * 4);
    const float4 r = *(const float4*)(resid + (size_t)row * DM + ch * 4);
    *(float4*)(gdst + (size_t)row * DM + ch * 4) = make_float4(v.x + r.x, v.y + r.y, v.z + r.z, v.w + r.w);
  }
}

DI void readout_f32_resid_ssq(const float* wl, const float* __restrict__ resid, float* __restrict__ gdst, bf16_t* __restrict__ hs, float* __restrict__ ssq, int lane) {
#pragma unroll 4
  for (int it = 0; it < 8; ++it) {
    const int idx = lane + 64 * it; const int row = idx >> 4, ch = idx & 15;
    const float4 v = *(const float4*)(wl + row * F32_ROW + ch * 4);
    const float4 r = *(const float4*)(resid + (size_t)row * DM + ch * 4);
    const float4 h = make_float4(v.x + r.x, v.y + r.y, v.z + r.z, v.w + r.w);
    *(float4*)(gdst + (size_t)row * DM + ch * 4) = h;
    uint2 o; o.x = pk2(h.x, h.y); o.y = pk2(h.z, h.w);
    *(uint2*)(hs + (size_t)row * DM + ch * 4) = o;
    float q = h.x * h.x + h.y * h.y + h.z * h.z + h.w * h.w;
    q += swz_xor<1>(q); q += swz_xor<2>(q); q += swz_xor<4>(q); q += swz_xor<8>(q);
    if (ch == 0) atomicAdd(ssq + row, q);
  }
}

DI void resid_preload(const float* __restrict__ resid, int lane, float4 (&rr)[8]) {
#pragma unroll
  for (int it = 0; it < 8; ++it) { const int idx = lane + 64 * it; rr[it] = *(const float4*)(resid + (size_t)(idx >> 4) * DM + (idx & 15) * 4); }
}
DI void readout_f32_pre(const float* wl, const float4 (&rr)[8], float* __restrict__ gdst, int lane) {
#pragma unroll
  for (int it = 0; it < 8; ++it) {
    const int idx = lane + 64 * it; const int row = idx >> 4, ch = idx & 15;
    const float4 v = *(const float4*)(wl + row * F32_ROW + ch * 4);
    *(float4*)(gdst + (size_t)row * DM + ch * 4) = make_float4(v.x + rr[it].x, v.y + rr[it].y, v.z + rr[it].z, v.w + rr[it].w);
  }
}
DI void readout_f32_pre_ssq(const float* wl, const float4 (&rr)[8], float* __restrict__ gdst, bf16_t* __restrict__ hs, float* __restrict__ ssq, int lane) {
#pragma unroll
  for (int it = 0; it < 8; ++it) {
    const int idx = lane + 64 * it; const int row = idx >> 4, ch = idx & 15;
    const float4 v = *(const float4*)(wl + row * F32_ROW + ch * 4);
    const float4 h = make_float4(v.x + rr[it].x, v.y + rr[it].y, v.z + rr[it].z, v.w + rr[it].w);
    *(float4*)(gdst + (size_t)row * DM + ch * 4) = h;
    uint2 o; o.x = pk2(h.x, h.y); o.y = pk2(h.z, h.w);
    *(uint2*)(hs + (size_t)row * DM + ch * 4) = o;
    float q = h.x * h.x + h.y * h.y + h.z * h.z + h.w * h.w;
    q += swz_xor<1>(q); q += swz_xor<2>(q); q += swz_xor<4>(q); q += swz_xor<8>(q);
    if (ch == 0) atomicAdd(ssq + row, q);
  }
}

DI void wave_lds_sync() { asm volatile("s_waitcnt lgkmcnt(0)" ::: "memory"); }

template <int EPI>
DI void epilogue_block(const Params& p, const f32x4 (&a)[4][2], int c0, int mt, bf16_t* wl, bf16_t* wlp, int par, int lane, int fr, int fq, const float (&sq)[2], const f32x4 (&csv)[2], const f32x4 (&snv)[2], const float4 (&rr)[8]) {
  unsigned char* ws = p.ws;
  const int b = mt >> 13, tok0 = mt & 8191;
  const int tok0p = tok0 - par * 32;
  if (EPI == EPI_SSM_IN) {
    if (c0 < 2048) {
      stage_tm<false>(a, wl, fr, fq); wave_lds_sync();
      readout_tm(wl, (bf16_t*)p.out + (size_t)mt * 2048 + c0, 2048, lane); wave_lds_sync();
    } else if (c0 < 4096) {
      stage_cm_pair(a, wlp, par, fr, fq); __syncthreads();
      readout_cm_pair(wlp, (bf16_t*)(ws + OFF_XT) + ((size_t)(b * 2048 + (c0 - 2048))) * SEQ + tok0p, par, lane); __syncthreads();
    } else if (c0 < 4608) {
      stage_tm<false>(a, wl, fr, fq); wave_lds_sync();
      readout_tm(wl, (bf16_t*)(ws + OFF_BR) + (size_t)mt * 512 + (c0 - 4096), 512, lane); __syncthreads();
      stage_cm_pair(a, wlp, par, fr, fq); __syncthreads();
      readout_cm_pair(wlp, (bf16_t*)(ws + OFF_BT) + ((size_t)(b * 512 + (c0 - 4096))) * SEQ + tok0p, par, lane); __syncthreads();
    } else if (c0 < 5120) {
      stage_tm<false>(a, wl, fr, fq); wave_lds_sync();
      readout_tm(wl, (bf16_t*)(ws + OFF_CR) + (size_t)mt * 512 + (c0 - 4608), 512, lane); wave_lds_sync();
    } else if (c0 == 5120) {
#pragma unroll
      for (int m = 0; m < 2; ++m)
#pragma unroll
        for (int n = 0; n < 2; ++n) {
          const int h = m * 16 + fq * 4;
          float4 o; float* op = (float*)&o;
#pragma unroll
          for (int j = 0; j < 4; ++j) { const float t = a[m][n][j] + p.dt_bias[h + j]; op[j] = (t > 20.f) ? t : log1pf(__expf(t)); }
          *(float4*)((float*)(ws + OFF_DT) + (size_t)(mt + n * 16 + fr) * 32 + h) = o;
        }
    }
  } else if (EPI == EPI_OUT1 || EPI == EPI_OUT2) {
    const float* resid = (EPI == EPI_OUT1) ? p.x : (const float*)(ws + OFF_XT);
    float* dst = (EPI == EPI_OUT1) ? (float*)(ws + OFF_XT) : p.out;
    stage_f32(a, (float*)wl, fr, fq); wave_lds_sync();
    if (EPI == EPI_OUT1) readout_f32_pre_ssq((const float*)wl, rr, dst + (size_t)mt * DM + c0, (bf16_t*)(ws + OFF_XN) + (size_t)mt * DM + c0, (float*)(ws + OFF_SSQ) + mt, lane);
    else readout_f32_pre((const float*)wl, rr, dst + (size_t)mt * DM + c0, lane);
    wave_lds_sync();
  } else if (EPI == EPI_MLA_IN) {
    const float* SSQ = (const float*)(ws + OFF_SSQ);
    f32x4 a2[4][2];
    float rs[2];
#pragma unroll
    for (int n = 0; n < 2; ++n) rs[n] = rsqrtf(sq[n] * (1.f / 1024.f) + 1e-6f);
#pragma unroll
    for (int m = 0; m < 4; ++m)
#pragma unroll
      for (int n = 0; n < 2; ++n) a2[m][n] = a[m][n] * rs[n];
    if (c0 < 640) {
      float* dstq = (float*)(ws + OFF_SSQ) + (c0 < 256 ? T : 2 * T);
#pragma unroll
      for (int n = 0; n < 2; ++n) {
        float q = 0.f;
#pragma unroll
        for (int m = 0; m < 4; ++m) q += a2[m][n][0] * a2[m][n][0] + a2[m][n][1] * a2[m][n][1] + a2[m][n][2] * a2[m][n][2] + a2[m][n][3] * a2[m][n][3];
        q += swz_xor<16>(q); q += __shfl_xor(q, 32);
        if (fq == 0) atomicAdd(dstq + mt + n * 16 + fr, q);
      }
    }
    const f32x4 (&a)[4][2] = a2;
    if (c0 < 640) stage_tm<false>(a, wl, fr, fq);
    else if (c0 < 1664) stage_tm<true>(a, wl, fr, fq);
    wave_lds_sync();
    if (c0 < 256) readout_tm(wl, (bf16_t*)(ws + OFF_ST + 32 * MiB) + (size_t)mt * 256 + c0, 256, lane);
    else if (c0 < 640) readout_tm(wl, (bf16_t*)(ws + OFF_ST + 40 * MiB) + (size_t)mt * 384 + (c0 - 256), 384, lane);
    else if (c0 < 1664) readout_tm(wl, (bf16_t*)(ws + OFF_ST) + (size_t)mt * 1024 + (c0 - 640), 1024, lane);
    else if (c0 == 1664) {
      const float* COS = (const float*)(ws + OFF_COS); const float* SIN = (const float*)(ws + OFF_SIN);
      bf16_t* KROPE = (bf16_t*)(ws + OFF_DEC);
#pragma unroll
      for (int n = 0; n < 2; ++n) {
        const int t = mt + n * 16 + fr;
        const f32x4 cs = *(const f32x4*)(COS + (size_t)t * 16 + fq * 4), sn = *(const f32x4*)(SIN + (size_t)t * 16 + fq * 4);
        const f32x4 x1 = a[0][n], x2 = a[1][n];
        const f32x4 r1 = x1 * cs - x2 * sn, r2 = x1 * sn + x2 * cs;
        uint2 o1, o2; o1.x = pk2(r1[0], r1[1]); o1.y = pk2(r1[2], r1[3]); o2.x = pk2(r2[0], r2[1]); o2.y = pk2(r2[2], r2[3]);
        *(uint2*)(KROPE + (size_t)t * 32 + fq * 4) = o1; *(uint2*)(KROPE + (size_t)t * 32 + 16 + fq * 4) = o2;
      }
    }
    wave_lds_sync();
  } else if (EPI == EPI_KVUP) {
    const int head = c0 >> 7; const bool isv = (c0 & 64) != 0;
    const float* SSQ = (const float*)(ws + OFF_SSQ) + T;
    f32x4 a2[4][2];
#pragma unroll
    for (int n = 0; n < 2; ++n) {
      const float rsn = rsqrtf(sq[n] * (1.f / 256.f) + 1e-6f);
#pragma unroll
      for (int m = 0; m < 4; ++m) a2[m][n] = a[m][n] * rsn;
    }
    const f32x4 (&a)[4][2] = a2;
    if (!isv) stage_tm<false>(a, wl, fr, fq); else stage_cm_pair(a, wlp, par, fr, fq);
    __syncthreads();
    if (!isv) readout_tm(wl, (bf16_t*)(ws + OFF_XN) + (size_t)mt * 1024 + head * 64, 1024, lane);
    else readout_cm_pair(wlp, (bf16_t*)(ws + OFF_BT) + ((size_t)((b * 16 + head) * 64)) * SEQ + tok0p, par, lane);
    __syncthreads();
  } else if (EPI == EPI_QUP) {
    const float SC = 0.10206207261596575f * 1.4426950408889634f;
    const float* SSQ = (const float*)(ws + OFF_SSQ) + 2 * T;
    f32x4 v[4][2];
#pragma unroll
    for (int n = 0; n < 2; ++n) {
      const float rsn = rsqrtf(sq[n] * (1.f / 384.f) + 1e-6f) * SC;
#pragma unroll
      for (int m = 0; m < 4; ++m) v[m][n] = a[m][n] * rsn;
    }
    const int ph = c0 % 96;
    if (ph != 0) {
      const float* COS = (const float*)(ws + OFF_COS); const float* SIN = (const float*)(ws + OFF_SIN);
#pragma unroll
      for (int n = 0; n < 2; ++n) {
        const f32x4 cs = csv[n], sn = snv[n];
        if (ph == 64) { const f32x4 x1 = v[0][n], x2 = v[1][n]; v[0][n] = x1 * cs - x2 * sn; v[1][n] = x1 * sn + x2 * cs; }
        else          { const f32x4 x1 = v[2][n], x2 = v[3][n]; v[2][n] = x1 * cs - x2 * sn; v[3][n] = x1 * sn + x2 * cs; }
      }
    }
    stage_tm<false>(v, wl, fr, fq); wave_lds_sync();
    readout_tm(wl, (bf16_t*)p.out + (size_t)mt * 1536 + c0, 1536, lane);
    wave_lds_sync();
  }
}

constexpr int G8_BK = 64, G8_HALF = 128, G8_HT = G8_HALF * G8_BK;
constexpr int LDS_BYTES = 143360;
DI int g8_lds_byte(int r, int c) { const int st = (r >> 4) * 2 + (c >> 5), rr = r & 15, cc = c & 31, ob = rr * 64 + cc * 2; return st * 1024 + (ob ^ (((ob >> 9) & 1) << 5)); }
DI void g8_stage_rc(int b, int& R, int& C) { const int st = b / 1024, sb = b % 1024, swz = sb ^ (((sb >> 9) & 1) << 5); R = (st >> 1) * 16 + swz / 64; C = (st & 1) * 32 + (swz % 64) / 2; }

template <int EPI, int K>
DI void gemm_tile(const Params& p, const bf16_t* __restrict__ A, const bf16_t* __restrict__ Bt, int brow, int bcol, unsigned char* smem) {
  bf16_t* shm = (bf16_t*)smem;
#define SA(b, h) (shm + ((b) * 2 + (h)) * G8_HT)
#define SB(b, h) (shm + (4 + (b) * 2 + (h)) * G8_HT)
#define STAGE(P, BASE, br, kt) do { const long _g = (long)(br) * K + (long)(kt) * G8_BK; \
    _Pragma("unroll") for (int _i = 0; _i < 2; ++_i) { const int _b = tid * 16 + _i * 8192; int _r, _c; g8_stage_rc(_b, _r, _c); \
      __builtin_amdgcn_global_load_lds((const unsigned*)(BASE + _g + (long)_r * K + _c), (unsigned*)((char*)(P) + _b), 16, 0, 0); } } while (0)
#define LDA(dst, b, h) _Pragma("unroll") for (int m = 0; m < 4; ++m) _Pragma("unroll") for (int k = 0; k < 2; ++k) \
    dst[m][k] = *reinterpret_cast<const bf16x8*>((const char*)SA(b, h) + g8_lds_byte(wr * 64 + m * 16 + fr, k * 32 + fq * 8))
#define LDB(dst, b, h) _Pragma("unroll") for (int n = 0; n < 2; ++n) _Pragma("unroll") for (int k = 0; k < 2; ++k) \
    dst[n][k] = *reinterpret_cast<const bf16x8*>((const char*)SB(b, h) + g8_lds_byte(wc * 32 + n * 16 + fr, k * 32 + fq * 8))
#define MMA(ai, bj, At_, Bt_) do { __builtin_amdgcn_s_setprio(1); \
    _Pragma("unroll") for (int m = 0; m < 4; ++m) _Pragma("unroll") for (int n = 0; n < 2; ++n) _Pragma("unroll") for (int k = 0; k < 2; ++k) \
      acc[ai][bj][m][n] = __builtin_amdgcn_mfma_f32_16x16x32_bf16(At_[m][k], Bt_[n][k], acc[ai][bj][m][n], 0, 0, 0); \
    __builtin_amdgcn_s_setprio(0); } while (0)
#define WAIT_V(n) asm volatile("s_waitcnt vmcnt(" #n ")" ::: "memory")
#define WAIT_L(n) asm volatile("s_waitcnt lgkmcnt(" #n ")" ::: "memory")
#define BAR __builtin_amdgcn_s_barrier()
#define SCHED __builtin_amdgcn_sched_barrier(0)
  const int tid = otid();
  const int wid = tid >> 6, lane = tid & 63, wr = wid >> 2, wc = wid & 3, fr = lane & 15, fq = lane >> 4;
  f32x4 acc[2][2][4][2];
#pragma unroll
  for (int a_ = 0; a_ < 2; ++a_)
#pragma unroll
    for (int b_ = 0; b_ < 2; ++b_)
#pragma unroll
      for (int m = 0; m < 4; ++m)
#pragma unroll
        for (int n = 0; n < 2; ++n) acc[a_][b_][m][n] = (f32x4){0.f, 0.f, 0.f, 0.f};
  bf16x8 At[4][2], B0[2][2], B1[2][2];
  constexpr int nt = K / G8_BK;
  STAGE(SB(0, 0), Bt, bcol, 0); STAGE(SA(0, 0), A, brow, 0);
  STAGE(SB(0, 1), Bt, bcol + G8_HALF, 0); STAGE(SA(0, 1), A, brow + G8_HALF, 0);
  if (wr == 1) BAR;
  WAIT_V(4); BAR;
  STAGE(SB(1, 0), Bt, bcol, 1); STAGE(SA(1, 0), A, brow, 1); STAGE(SB(1, 1), Bt, bcol + G8_HALF, 1);
  WAIT_V(6); BAR;
  for (int t = 0; t < nt - 2; t += 2) {
    LDB(B0, 0, 0); SCHED; LDA(At, 0, 0); STAGE(SA(1, 1), A, brow + G8_HALF, t + 1);
    WAIT_L(8); BAR; WAIT_L(0); MMA(0, 0, At, B0); BAR; SCHED;
    LDB(B1, 0, 1); STAGE(SB(0, 0), Bt, bcol, t + 2);
    BAR; WAIT_L(0); MMA(0, 1, At, B1); BAR;
    LDA(At, 0, 1); STAGE(SA(0, 0), A, brow, t + 2);
    BAR; WAIT_L(0); MMA(1, 0, At, B0); BAR; SCHED;
    STAGE(SB(0, 1), Bt, bcol + G8_HALF, t + 2);
    WAIT_V(6); BAR; MMA(1, 1, At, B1); BAR;
    LDB(B0, 1, 0); SCHED; LDA(At, 1, 0); STAGE(SA(0, 1), A, brow + G8_HALF, t + 2);
    WAIT_L(8); BAR; WAIT_L(0); MMA(0, 0, At, B0); BAR; SCHED;
    LDB(B1, 1, 1); STAGE(SB(1, 0), Bt, bcol, t + 3);
    BAR; WAIT_L(0); MMA(0, 1, At, B1); BAR;
    LDA(At, 1, 1); STAGE(SA(1, 0), A, brow, t + 3);
    BAR; WAIT_L(0); MMA(1, 0, At, B0); BAR; SCHED;
    STAGE(SB(1, 1), Bt, bcol + G8_HALF, t + 3);
    WAIT_V(6); BAR; MMA(1, 1, At, B1); BAR;
  }
  { LDB(B0, 0, 0); LDA(At, 0, 0); STAGE(SA(1, 1), A, brow + G8_HALF, nt - 1);
    BAR; WAIT_L(0); MMA(0, 0, At, B0); BAR;
    LDB(B1, 0, 1); BAR; WAIT_L(0); MMA(0, 1, At, B1); BAR;
    LDA(At, 0, 1); WAIT_V(4); BAR; WAIT_L(0); MMA(1, 0, At, B0); MMA(1, 1, At, B1); BAR; }
  { LDB(B0, 1, 0); LDA(At, 1, 0); WAIT_V(2); BAR; WAIT_L(0); MMA(0, 0, At, B0); BAR;
    LDB(B1, 1, 1); WAIT_V(0); BAR; WAIT_L(0); MMA(0, 1, At, B1); BAR;
    LDA(At, 1, 1); BAR; WAIT_L(0); MMA(1, 0, At, B0); MMA(1, 1, At, B1); BAR; }
  if (wr == 0) BAR;
  __syncthreads();
  int t2 = tid; asm volatile("" : "+v"(t2));
  const int wid2 = t2 >> 6, lane2 = t2 & 63, wr2 = wid2 >> 2, wc2 = wid2 & 3, fr2 = lane2 & 15, fq2 = lane2 >> 4;
  bf16_t* wl = (bf16_t*)(smem + wid2 * EPI_WAVE_BYTES);
  bf16_t* wlp = (bf16_t*)(smem + (wid2 & ~1) * EPI_WAVE_BYTES);
  float sqv[2][2] = {{0.f, 0.f}, {0.f, 0.f}};
  if (EPI == EPI_MLA_IN || EPI == EPI_KVUP || EPI == EPI_QUP) {
    const float* SQ = (const float*)(p.ws + OFF_SSQ) + (EPI == EPI_MLA_IN ? 0 : (EPI == EPI_KVUP ? T : 2 * T));
#pragma unroll
    for (int bj = 0; bj < 2; ++bj)
#pragma unroll
      for (int n = 0; n < 2; ++n) sqv[bj][n] = SQ[bcol + bj * 128 + wc2 * 32 + n * 16 + fr2];
  }
  f32x4 csv[2][2], snv[2][2];
#pragma unroll
  for (int bj = 0; bj < 2; ++bj)
#pragma unroll
    for (int n = 0; n < 2; ++n) { csv[bj][n] = (f32x4){0.f, 0.f, 0.f, 0.f}; snv[bj][n] = (f32x4){0.f, 0.f, 0.f, 0.f}; }
  if (EPI == EPI_QUP) {
    const float* COS = (const float*)(p.ws + OFF_COS); const float* SIN = (const float*)(p.ws + OFF_SIN);
#pragma unroll
    for (int bj = 0; bj < 2; ++bj)
#pragma unroll
      for (int n = 0; n < 2; ++n) {
        const size_t t = (size_t)(bcol + bj * 128 + wc2 * 32 + n * 16 + fr2);
        csv[bj][n] = *(const f32x4*)(COS + t * 16 + fq2 * 4); snv[bj][n] = *(const f32x4*)(SIN + t * 16 + fq2 * 4);
      }
  }
  float4 rrb[2][8];
  const float* residp = (EPI == EPI_OUT1) ? p.x : (const float*)(p.ws + OFF_XT);
  if (EPI == EPI_OUT1 || EPI == EPI_OUT2) resid_preload(residp + (size_t)(bcol + wc2 * 32) * DM + brow + wr2 * 64, lane2, rrb[0]);
#pragma unroll
  for (int ai = 0; ai < 2; ++ai)
#pragma unroll
    for (int bj = 0; bj < 2; ++bj) {
      const int k = ai * 2 + bj;
      if ((EPI == EPI_OUT1 || EPI == EPI_OUT2) && k < 3) {
        const int ai1 = (k + 1) >> 1, bj1 = (k + 1) & 1;
        resid_preload(residp + (size_t)(bcol + bj1 * 128 + wc2 * 32) * DM + brow + ai1 * 128 + wr2 * 64, lane2, rrb[(k + 1) & 1]);
      }
      epilogue_block<EPI>(p, acc[ai][bj], brow + ai * 128 + wr2 * 64, bcol + bj * 128 + wc2 * 32, wl, wlp, wc2 & 1, lane2, fr2, fq2, sqv[bj], csv[bj], snv[bj], rrb[k & 1]);
    }
  __syncthreads();
#undef SA
#undef SB
#undef STAGE
#undef LDA
#undef LDB
#undef MMA
#undef WAIT_V
#undef WAIT_L
#undef BAR
#undef SCHED
}

template <int EPI, int K>
DI void gemm_phase(const Params& p, const bf16_t* Wt, const bf16_t* X, int ntn, unsigned char* smem) {
  const bool xa = (gridDim.x == 256);
  const int xcd = blockIdx.x & 7, li = blockIdx.x >> 3;
  const int per_half = 4 * ntn;
  const int start = xa ? li : (int)blockIdx.x, step = xa ? 32 : (int)gridDim.x, total = ntn * (xa ? 8 : 64);
  for (int t = start; t < total; t += step) {
    int tm, tn;
    if (xa) { const int h = t / per_half, tp = t - h * per_half; tn = tp >> 2; tm = xcd * 8 + h * 4 + (tp & 3); }
    else { tm = t / ntn; tn = t % ntn; }
    gemm_tile<EPI, K>(p, Wt, X, tn * 256, tm * 256, smem);
  }
}

DI void conv8_load(const bf16_t* rp, bool has_prev, uint4& cur, uint2& prv) {
  cur = *(const uint4*)rp; prv = make_uint2(0u, 0u);
  if (has_prev) prv = *(const uint2*)(rp - 4);
}
DI float fast_silu(float v) { return v * __builtin_amdgcn_rcpf(1.f + __expf(-v)); }
DI void conv8_compute(const uint4 cur, const uint2 prv, float w0, float w1, float w2, float w3, float bias, float (&out)[8]) {
  float r[11];
  r[0] = hi16(prv.x); r[1] = lo16(prv.y); r[2] = hi16(prv.y);
  r[3] = lo16(cur.x); r[4] = hi16(cur.x); r[5] = lo16(cur.y); r[6] = hi16(cur.y); r[7] = lo16(cur.z); r[8] = hi16(cur.z); r[9] = lo16(cur.w); r[10] = hi16(cur.w);
#pragma unroll
  for (int j = 0; j < 8; ++j) out[j] = fast_silu(bias + w0 * r[j] + w1 * r[j + 1] + w2 * r[j + 2] + w3 * r[j + 3]);
}
DI void conv8(const bf16_t* rp, bool has_prev, float w0, float w1, float w2, float w3, float bias, float (&out)[8]) {
  uint4 cur; uint2 prv; conv8_load(rp, has_prev, cur, prv); conv8_compute(cur, prv, w0, w1, w2, w3, bias, out);
}
DI bf16x8 pack8(const float (&v)[8]) {
  uint4 u; u.x = pk2(v[0], v[1]); u.y = pk2(v[2], v[3]); u.z = pk2(v[4], v[5]); u.w = pk2(v[6], v[7]);
  return __builtin_bit_cast(bf16x8, u);
}
DI void chunk_cumsum(const float* __restrict__ DTp, size_t tk0, int hd, float A, int lane, float (&d4)[4], float (&c4)[4], float& last) {
#pragma unroll
  for (int i = 0; i < 4; ++i) d4[i] = DTp[(tk0 + 4 * lane + i) * 32 + hd];
  c4[0] = d4[0] * A; c4[1] = c4[0] + d4[1] * A; c4[2] = c4[1] + d4[2] * A; c4[3] = c4[2] + d4[3] * A;
  const float tot = c4[3];
  float sum = tot, ex = 0.f, t;
  t = swz_xor<1>(sum);  if (lane & 1) ex += t;  sum += t;
  t = swz_xor<2>(sum);  if (lane & 2) ex += t;  sum += t;
  t = swz_xor<4>(sum);  if (lane & 4) ex += t;  sum += t;
  t = swz_xor<8>(sum);  if (lane & 8) ex += t;  sum += t;
  t = swz_xor<16>(sum); if (lane & 16) ex += t; sum += t;
  t = __shfl_xor(sum, 32); if (lane & 32) ex += t; sum += t;
#pragma unroll
  for (int i = 0; i < 4; ++i) c4[i] += ex;
  last = sum;
}

constexpr int BT_ROW = 264;
constexpr int CN_ROW = 136;

DI void phase_ssd_state(const Params& p, unsigned char* smem) {
  const bf16_t* XT = (const bf16_t*)(p.ws + OFF_XT); const bf16_t* BT = (const bf16_t*)(p.ws + OFF_BT); const float* DTp = (const float*)(p.ws + OFF_DT);
  float* ST = (float*)(p.ws + OFF_ST); float* DEC = (float*)(p.ws + OFF_DEC);
  bf16_t* BTs = (bf16_t*)smem; float* wgt = (float*)(smem + 128 * BT_ROW * 2);
  const int tid = otid(), lane = tid & 63, w = tid >> 6, l31 = lane & 31, lh = lane >> 5;
  for (int u = blockIdx.x; u < 256; u += gridDim.x) {
    const int b = u >> 7, c = (u >> 2) & 31, g = u & 3; const int hd = 8 * g + w;
    bf16_t* XTC = (bf16_t*)(p.ws + (b ? OFF_ST + 32 * MiB : OFF_XN));
    {
      float d4[4], c4[4], last; chunk_cumsum(DTp, (size_t)b * SEQ + c * 256, hd, -__expf(p.A_log[hd]), lane, d4, c4, last);
      float4 o = {__expf(last - c4[0]) * d4[0], __expf(last - c4[1]) * d4[1], __expf(last - c4[2]) * d4[2], __expf(last - c4[3]) * d4[3]};
      *(float4*)(wgt + w * 256 + 4 * lane) = o;
      if (lane == 0) DEC[(b * 32 + c) * 32 + hd] = __expf(last);
    }
#pragma unroll 2
    for (int i = 0; i < 8; ++i) {
      const int chunk = tid + 512 * i; const int s8 = (chunk & 31) * 8, n = chunk >> 5; const int ch = 2048 + g * 128 + n;
      float v[8];
      conv8(BT + ((size_t)(b * 512 + g * 128 + n)) * SEQ + c * 256 + s8, !(c == 0 && s8 == 0),
            p.conv_w[ch], p.conv_w[3072 + ch], p.conv_w[2 * 3072 + ch], p.conv_w[3 * 3072 + ch], p.conv_b[ch], v);
      *(bf16x8*)(BTs + n * BT_ROW + s8) = pack8(v);
    }
    __syncthreads();
    f32x16 acc[2][4];
#pragma unroll
    for (int a = 0; a < 2; ++a)
#pragma unroll
      for (int q = 0; q < 4; ++q)
#pragma unroll
        for (int i = 0; i < 16; ++i) acc[a][q][i] = 0.f;
    float xw[2][4], xb[2];
#pragma unroll
    for (int pt = 0; pt < 2; ++pt) {
      const int ch = hd * 64 + pt * 32 + l31;
#pragma unroll
      for (int k = 0; k < 4; ++k) xw[pt][k] = p.conv_w[k * 3072 + ch];
      xb[pt] = p.conv_b[ch];
    }
    for (int kb = 0; kb < 16; kb += 2) {
      uint4 rc[2][2]; uint2 rp[2][2];
#pragma unroll
      for (int i = 0; i < 2; ++i)
#pragma unroll
        for (int pt = 0; pt < 2; ++pt) {
          const int s0 = (kb + i) * 16 + 8 * lh;
          conv8_load(XT + ((size_t)(b * 2048 + hd * 64 + pt * 32 + l31)) * SEQ + c * 256 + s0, !(c == 0 && s0 == 0), rc[i][pt], rp[i][pt]);
        }
#pragma unroll
      for (int i = 0; i < 2; ++i) {
        const int ks = kb + i; const int s0 = ks * 16 + 8 * lh;
        const float4 g0 = *(const float4*)(wgt + w * 256 + s0), g1 = *(const float4*)(wgt + w * 256 + s0 + 4);
        const float wg[8] = {g0.x, g0.y, g0.z, g0.w, g1.x, g1.y, g1.z, g1.w};
        bf16x8 afr[2];
#pragma unroll
        for (int pt = 0; pt < 2; ++pt) {
          float v[8];
          conv8_compute(rc[i][pt], rp[i][pt], xw[pt][0], xw[pt][1], xw[pt][2], xw[pt][3], xb[pt], v);
          *(bf16x8*)(XTC + ((size_t)(hd * 64 + pt * 32 + l31)) * SEQ + c * 256 + s0) = pack8(v);
#pragma unroll
          for (int j = 0; j < 8; ++j) v[j] *= wg[j];
          afr[pt] = pack8(v);
        }
#pragma unroll
        for (int nt = 0; nt < 4; ++nt) {
          const bf16x8 bfr = *(const bf16x8*)(BTs + (nt * 32 + l31) * BT_ROW + ks * 16 + 8 * lh);
#pragma unroll
          for (int pt = 0; pt < 2; ++pt) acc[pt][nt] = MFMA32(afr[pt], bfr, acc[pt][nt]);
        }
      }
    }
    bf16_t* Sp = (bf16_t*)ST + (((size_t)(b * 32 + c) * 32 + hd) * 64) * 128;
#pragma unroll
    for (int pt = 0; pt < 2; ++pt)
#pragma unroll
      for (int nt = 0; nt < 4; ++nt)
#pragma unroll
        for (int r = 0; r < 16; ++r) Sp[(pt * 32 + (r & 3) + 8 * (r >> 2) + 4 * lh) * 128 + nt * 32 + l31] = f2bf(acc[pt][nt][r]);
    __syncthreads();
  }
}

DI void phase_ssd_scan(const Params& p) {
  bf16_t* ST = (bf16_t*)(p.ws + OFF_ST); const float* DEC = (const float*)(p.ws + OFF_DEC);
  for (int idx = blockIdx.x * NTHREADS + otid(); idx < 131072; idx += gridDim.x * NTHREADS) {
    const int n4 = idx & 31, pp = (idx >> 5) & 63, h = (idx >> 11) & 31, b = idx >> 16;
    float run[4] = {0.f, 0.f, 0.f, 0.f};
    bf16_t* base = ST + (((size_t)(b * 32) * 32 + h) * 64 + pp) * 128 + n4 * 4;
    const float* dbase = DEC + (b * 32) * 32 + h;
    for (int c0 = 0; c0 < 32; c0 += 16) {
      uint2 loc[16]; float d[16];
#pragma unroll
      for (int i = 0; i < 16; ++i) { loc[i] = *(const uint2*)(base + (size_t)(c0 + i) * (32 * 64 * 128)); d[i] = dbase[(c0 + i) * 32]; }
#pragma unroll
      for (int i = 0; i < 16; ++i) {
        uint2 o; o.x = pk2(run[0], run[1]); o.y = pk2(run[2], run[3]);
        *(uint2*)(base + (size_t)(c0 + i) * (32 * 64 * 128)) = o;
        run[0] = run[0] * d[i] + lo16(loc[i].x); run[1] = run[1] * d[i] + hi16(loc[i].x);
        run[2] = run[2] * d[i] + lo16(loc[i].y); run[3] = run[3] * d[i] + hi16(loc[i].y);
      }
    }
  }
}

DI void stage_tokmajor(const Params& p, const bf16_t* __restrict__ RAW, int b, int tok0, int nrows, int g, int cbase, bf16_t* dst, int tid_) {
  const int tid = otid(); (void)tid_;
  const int n8 = (tid & 15) * 8; const int ch = cbase + g * 128 + n8;
  float cw[4][8], cb[8];
#pragma unroll
  for (int k = 0; k < 4; ++k) {
    const float4 a = *(const float4*)(p.conv_w + k * 3072 + ch), bq = *(const float4*)(p.conv_w + k * 3072 + ch + 4);
    cw[k][0] = a.x; cw[k][1] = a.y; cw[k][2] = a.z; cw[k][3] = a.w; cw[k][4] = bq.x; cw[k][5] = bq.y; cw[k][6] = bq.z; cw[k][7] = bq.w;
  }
  { const float4 a = *(const float4*)(p.conv_b + ch), bq = *(const float4*)(p.conv_b + ch + 4);
    cb[0] = a.x; cb[1] = a.y; cb[2] = a.z; cb[3] = a.w; cb[4] = bq.x; cb[5] = bq.y; cb[6] = bq.z; cb[7] = bq.w; }
  for (int t = tid >> 4; t < nrows; t += 64) {
    uint4 r[2][4];
#pragma unroll
    for (int u = 0; u < 2; ++u)
#pragma unroll
      for (int k = 0; k < 4; ++k) {
        const int tk = tok0 + t + 32 * u - 3 + k;
        r[u][k] = make_uint4(0u, 0u, 0u, 0u);
        if (tk >= 0) r[u][k] = *(const uint4*)(RAW + ((size_t)b * SEQ + tk) * 512 + g * 128 + n8);
      }
#pragma unroll
    for (int u = 0; u < 2; ++u) {
      float acc[8];
#pragma unroll
      for (int j = 0; j < 8; ++j) acc[j] = cb[j];
#pragma unroll
      for (int k = 0; k < 4; ++k) {
        const uint4 q = r[u][k];
        acc[0] += cw[k][0] * lo16(q.x); acc[1] += cw[k][1] * hi16(q.x); acc[2] += cw[k][2] * lo16(q.y); acc[3] += cw[k][3] * hi16(q.y);
        acc[4] += cw[k][4] * lo16(q.z); acc[5] += cw[k][5] * hi16(q.z); acc[6] += cw[k][6] * lo16(q.w); acc[7] += cw[k][7] * hi16(q.w);
      }
#pragma unroll
      for (int j = 0; j < 8; ++j) acc[j] = fast_silu(acc[j]);
      *(bf16x8*)(dst + (t + 32 * u) * CN_ROW + n8) = pack8(acc);
    }
  }
}

constexpr int S3_CS = 0, S3_BS = 64 * CN_ROW * 2, S3_CB = S3_BS + 256 * CN_ROW * 2, S3_CUM = S3_CB + 64 * BT_ROW * 2, S3_DTS = S3_CUM + 8192,
              S3_PART = S3_DTS + 8192, S3_RSTD = S3_PART + 2048, S3_END = S3_RSTD + 256;

DI void phase_ssd_out(const Params& p, unsigned char* smem) {
  const bf16_t* XT = (const bf16_t*)(p.ws + OFF_XT); const bf16_t* BR = (const bf16_t*)(p.ws + OFF_BR); const bf16_t* CR = (const bf16_t*)(p.ws + OFF_CR);
  const float* DTp = (const float*)(p.ws + OFF_DT); const float* ST = (const float*)(p.ws + OFF_ST); bf16_t* Z = (bf16_t*)p.out;
  bf16_t* Cs = (bf16_t*)(smem + S3_CS); bf16_t* Bs = (bf16_t*)(smem + S3_BS); bf16_t* CBs = (bf16_t*)(smem + S3_CB);
  float* cumA = (float*)(smem + S3_CUM); float* dts = (float*)(smem + S3_DTS); float* part = (float*)(smem + S3_PART); float* rstd = (float*)(smem + S3_RSTD);
  const int tid = otid(), lane = tid & 63, w = tid >> 6, l31 = lane & 31, lh = lane >> 5;
  const bool persist = (gridDim.x == 256);
  for (int u = blockIdx.x; u < 1024; u += gridDim.x) {
    const int tq = u >> 8, rest = u & 255; const int b = rest >> 7, c = (rest >> 2) & 31, g = rest & 3; const int hd = 8 * g + w;
    const int ns = (tq + 1) * 64;
    if (!persist || tq == 0) {
      float d4[4], c4[4], last; chunk_cumsum(DTp, (size_t)b * SEQ + c * 256, hd, -__expf(p.A_log[hd]), lane, d4, c4, last);
      *(float4*)(cumA + w * 256 + 4 * lane) = make_float4(c4[0], c4[1], c4[2], c4[3]);
      *(float4*)(dts + w * 256 + 4 * lane) = make_float4(d4[0], d4[1], d4[2], d4[3]);
    }
    stage_tokmajor(p, CR, b, c * 256 + tq * 64, 64, g, 2560, Cs, tid);
    { const int r0 = persist ? tq * 64 : 0; stage_tokmajor(p, BR, b, c * 256 + r0, ns - r0, g, 2048, Bs + r0 * CN_ROW, tid); }
    __syncthreads();
    if (32 * w < ns) {
      f32x16 a2[2];
#pragma unroll
      for (int a = 0; a < 2; ++a)
#pragma unroll
        for (int i = 0; i < 16; ++i) a2[a][i] = 0.f;
#pragma unroll
      for (int ks = 0; ks < 8; ++ks) {
        const bf16x8 af = *(const bf16x8*)(Bs + (32 * w + l31) * CN_ROW + ks * 16 + 8 * lh);
#pragma unroll
        for (int tt = 0; tt < 2; ++tt) {
          const bf16x8 bq = *(const bf16x8*)(Cs + (tt * 32 + l31) * CN_ROW + ks * 16 + 8 * lh);
          a2[tt] = MFMA32(af, bq, a2[tt]);
        }
      }
#pragma unroll
      for (int tt = 0; tt < 2; ++tt)
#pragma unroll
        for (int rg = 0; rg < 4; ++rg) {
          uint2 o; o.x = pk2(a2[tt][4 * rg], a2[tt][4 * rg + 1]); o.y = pk2(a2[tt][4 * rg + 2], a2[tt][4 * rg + 3]);
          *(uint2*)(CBs + (tt * 32 + l31) * BT_ROW + 32 * w + 8 * rg + 4 * lh) = o;
        }
    }
    __syncthreads();
    f32x16 acc[2][2];
#pragma unroll
    for (int a = 0; a < 2; ++a)
#pragma unroll
      for (int q = 0; q < 2; ++q)
#pragma unroll
        for (int i = 0; i < 16; ++i) acc[a][q][i] = 0.f;
    {
      const bf16_t* Sp = (const bf16_t*)ST + (((size_t)(b * 32 + c) * 32 + hd) * 64) * 128;
      for (int kb = 0; kb < 8; kb += 4) {
        bf16x8 bfr[4][2];
#pragma unroll
        for (int i = 0; i < 4; ++i)
#pragma unroll
          for (int pt = 0; pt < 2; ++pt) bfr[i][pt] = *(const bf16x8*)(Sp + (pt * 32 + l31) * 128 + (kb + i) * 16 + 8 * lh);
#pragma unroll
        for (int i = 0; i < 4; ++i) {
          const int ks = kb + i;
#pragma unroll
          for (int tt = 0; tt < 2; ++tt) {
            const bf16x8 af = *(const bf16x8*)(Cs + (tt * 32 + l31) * CN_ROW + ks * 16 + 8 * lh);
#pragma unroll
            for (int pt = 0; pt < 2; ++pt) acc[tt][pt] = MFMA32(af, bfr[i][pt], acc[tt][pt]);
          }
        }
      }
#pragma unroll
      for (int tt = 0; tt < 2; ++tt)
#pragma unroll
        for (int r = 0; r < 16; ++r) {
          const float e = __expf(cumA[w * 256 + tq * 64 + tt * 32 + (r & 3) + 8 * (r >> 2) + 4 * lh]);
          acc[tt][0][r] *= e; acc[tt][1][r] *= e;
        }
    }
    {
      const float Dh = p.Dskip[hd];
      const int tl0 = tq * 64 + l31, tl1 = tq * 64 + 32 + l31;
      const float ct0 = cumA[w * 256 + tl0], ct1 = cumA[w * 256 + tl1];
      const bf16_t* XTC = (const bf16_t*)(p.ws + (b ? OFF_ST + 32 * MiB : OFF_XN)) + ((size_t)(hd * 64 + l31)) * SEQ + c * 256 + 8 * lh;
      const int nks = ns >> 4;
      for (int kb = 0; kb < nks; kb += 4) {
        bf16x8 xq[4][2];
#pragma unroll
        for (int i = 0; i < 4; ++i)
#pragma unroll
          for (int pt = 0; pt < 2; ++pt) xq[i][pt] = *(const bf16x8*)(XTC + (size_t)pt * 32 * SEQ + (kb + i) * 16);
#pragma unroll
        for (int i = 0; i < 4; ++i) {
          const int ks = kb + i; const int s0 = ks * 16 + 8 * lh;
          const float4 c0 = *(const float4*)(cumA + w * 256 + s0), c1 = *(const float4*)(cumA + w * 256 + s0 + 4);
          const float4 d0 = *(const float4*)(dts + w * 256 + s0), d1 = *(const float4*)(dts + w * 256 + s0 + 4);
          const float cs[8] = {c0.x, c0.y, c0.z, c0.w, c1.x, c1.y, c1.z, c1.w};
          const float ds[8] = {d0.x, d0.y, d0.z, d0.w, d1.x, d1.y, d1.z, d1.w};
          const float cref = cumA[w * 256 + ks * 16];
          const bool steep = (cref - cumA[w * 256 + ks * 16 + 15]) > 60.f;
          float Fs[8];
#pragma unroll
          for (int j = 0; j < 8; ++j) Fs[j] = __expf(fminf(cref - cs[j], 64.f)) * ds[j];
#pragma unroll
          for (int tt = 0; tt < 2; ++tt) {
            if (ks * 16 <= tq * 64 + tt * 32 + 31) {
              const int tl = tt ? tl1 : tl0; const float ct = tt ? ct1 : ct0;
              const float Et = __expf(fminf(ct - cref, 0.f));
              const uint4 cbv = *(const uint4*)(CBs + (tt * 32 + l31) * BT_ROW + s0);
              const float cb[8] = {lo16(cbv.x), hi16(cbv.x), lo16(cbv.y), hi16(cbv.y), lo16(cbv.z), hi16(cbv.z), lo16(cbv.w), hi16(cbv.w)};
              float mv[8];
              if (steep) {
#pragma unroll
                for (int j = 0; j < 8; ++j) {
                  const int sidx = s0 + j;
                  float v = cb[j] * __expf(fminf(ct - cs[j], 0.f)) * ds[j];
                  v = (sidx <= tl) ? v : 0.f;
                  if (sidx == tl) v += Dh;
                  mv[j] = v;
                }
              } else if (ks * 16 + 15 > tq * 64 + tt * 32) {
#pragma unroll
                for (int j = 0; j < 8; ++j) {
                  const int sidx = s0 + j;
                  float v = cb[j] * (Et * Fs[j]);
                  v = (sidx <= tl) ? v : 0.f;
                  if (sidx == tl) v += Dh;
                  mv[j] = v;
                }
              } else {
#pragma unroll
                for (int j = 0; j < 8; ++j) mv[j] = cb[j] * (Et * Fs[j]);
              }
              const bf16x8 af = pack8(mv);
#pragma unroll
              for (int pt = 0; pt < 2; ++pt) acc[tt][pt] = MFMA32(af, xq[i][pt], acc[tt][pt]);
            }
          }
        }
      }
    }
    const size_t tokb = (size_t)b * SEQ + c * 256 + tq * 64;
#pragma unroll
    for (int tt = 0; tt < 2; ++tt)
#pragma unroll
      for (int r = 0; r < 16; ++r) {
        const int tloc = tt * 32 + (r & 3) + 8 * (r >> 2) + 4 * lh;
        const bf16_t* zp = Z + (tokb + tloc) * 2048 + hd * 64 + l31;
        const float y0 = acc[tt][0][r] * silu_f(bf2f(zp[0])), y1 = acc[tt][1][r] * silu_f(bf2f(zp[32]));
        acc[tt][0][r] = y0; acc[tt][1][r] = y1;
        float v = y0 * y0 + y1 * y1;
        v += swz_xor<1>(v); v += swz_xor<2>(v); v += swz_xor<4>(v); v += swz_xor<8>(v); v += swz_xor<16>(v);
        if (l31 == 0) part[w * 64 + tloc] = v;
      }
    __syncthreads();
    if (tid < 64) {
      float sres = 0.f;
#pragma unroll
      for (int ww = 0; ww < 8; ++ww) sres += part[ww * 64 + tid];
      rstd[tid] = rsqrtf(sres * (1.f / 512.f) + 1e-6f);
    }
    __syncthreads();
#pragma unroll
    for (int tt = 0; tt < 2; ++tt)
#pragma unroll
      for (int r = 0; r < 16; ++r) {
        const int tloc = tt * 32 + (r & 3) + 8 * (r >> 2) + 4 * lh;
        const float rs = rstd[tloc];
        bf16_t* zp = Z + (tokb + tloc) * 2048 + hd * 64 + l31;
        zp[0] = f2bf(acc[tt][0][r] * rs); zp[32] = f2bf(acc[tt][1][r] * rs);
      }
    __syncthreads();
  }
}

constexpr int KROW = 104;
constexpr int VROW = 68;
constexpr int ATT_K_BYTES = 64 * KROW * 2;
constexpr int ATT_V_BYTES = 64 * VROW * 2;
constexpr int ATT_STAGE = ATT_K_BYTES + ATT_V_BYTES;

DI void attn_kload(const bf16_t* sK, bf16x8 (&kf)[2][6], int l31, int lh) {
#pragma unroll
  for (int sub = 0; sub < 2; ++sub)
#pragma unroll
    for (int ks = 0; ks < 6; ++ks) kf[sub][ks] = *(const bf16x8*)(sK + (sub * 32 + l31) * KROW + ks * 16 + lh * 8);
}
DI void attn_qkmma(const bf16x8 (&kf)[2][6], const bf16x8 (&qf)[6], f32x16 (&sc)[2]) {
#pragma unroll
  for (int sub = 0; sub < 2; ++sub)
#pragma unroll
    for (int i = 0; i < 16; ++i) sc[sub][i] = 0.f;
#pragma unroll
  for (int ks = 0; ks < 6; ++ks)
#pragma unroll
    for (int sub = 0; sub < 2; ++sub) sc[sub] = MFMA32(kf[sub][ks], qf[ks], sc[sub]);
}
DI void attn_qk(const bf16_t* sK, const bf16x8 (&qf)[6], f32x16 (&sc)[2], int l31, int lh) {
  bf16x8 kf[2][6]; attn_kload(sK, kf, l31, lh); attn_qkmma(kf, qf, sc);
}

template <bool MASK>
DI void attn_softmax(f32x16 (&sc)[2], f32x16 (&o)[2], float& m, float& l, int kt, int myq, int lh) {
  float tmax = -1e30f;
#pragma unroll
  for (int sub = 0; sub < 2; ++sub)
#pragma unroll
    for (int r = 0; r < 16; ++r) {
      if (MASK) { const int key = kt * 64 + sub * 32 + (r & 3) + 8 * (r >> 2) + 4 * lh; if (key > myq) sc[sub][r] = -1e30f; }
      tmax = fmaxf(tmax, sc[sub][r]);
    }
  tmax = fmaxf(tmax, __shfl_xor(tmax, 32));
  if (__builtin_amdgcn_ballot_w64(tmax - m > 8.f) != 0) {
    const float mn = fmaxf(m, tmax); const float al = __builtin_amdgcn_exp2f(m - mn); m = mn;
    l *= al;
#pragma unroll
    for (int a = 0; a < 2; ++a)
#pragma unroll
      for (int i = 0; i < 16; ++i) o[a][i] *= al;
  }
  f32x2 ps2 = {0.f, 0.f}; const f32x2 mn2 = {m, m};
#pragma unroll
  for (int sub = 0; sub < 2; ++sub)
#pragma unroll
    for (int r = 0; r < 16; r += 2) {
      f32x2 d = {sc[sub][r], sc[sub][r + 1]}; d = d - mn2;
      f32x2 pe; pe.x = __builtin_amdgcn_exp2f(d.x); pe.y = __builtin_amdgcn_exp2f(d.y);
      sc[sub][r] = pe.x; sc[sub][r + 1] = pe.y; ps2 = ps2 + pe;
    }
  l += ps2.x + ps2.y;
}
DI void attn_pv(const f32x16 (&sc)[2], f32x16 (&o)[2], const bf16_t* sV, int l31, int lh) {
#pragma unroll
  for (int sub = 0; sub < 2; ++sub)
#pragma unroll
    for (int s2 = 0; s2 < 2; ++s2) {
      uint4 pu; pu.x = pk2(sc[sub][8 * s2], sc[sub][8 * s2 + 1]); pu.y = pk2(sc[sub][8 * s2 + 2], sc[sub][8 * s2 + 3]);
      pu.z = pk2(sc[sub][8 * s2 + 4], sc[sub][8 * s2 + 5]); pu.w = pk2(sc[sub][8 * s2 + 6], sc[sub][8 * s2 + 7]);
      const bf16x8 pb = __builtin_bit_cast(bf16x8, pu);
#pragma unroll
      for (int dvt = 0; dvt < 2; ++dvt) {
        const bf16_t* vp = sV + (dvt * 32 + l31) * VROW + sub * 32 + 16 * s2 + 4 * lh;
        const uint2 lo = *(const uint2*)vp, hi = *(const uint2*)(vp + 8);
        uint4 vu = {lo.x, lo.y, hi.x, hi.y};
        o[dvt] = MFMA32(__builtin_bit_cast(bf16x8, vu), pb, o[dvt]);
      }
    }
}

DI void attn_unit(const Params& p, int b, int h, int qb, unsigned char* smem) {
  const bf16_t* Q = (const bf16_t*)p.out; const bf16_t* KN = (const bf16_t*)(p.ws + OFF_XN); const bf16_t* VT = (const bf16_t*)(p.ws + OFF_BT);
  const bf16_t* KROPE = (const bf16_t*)(p.ws + OFF_DEC); const bf16_t* GATE = (const bf16_t*)(p.ws + OFF_ST); bf16_t* O = (bf16_t*)(p.ws + OFF_ST + 32 * MiB);
  const int tid = otid(), lane = tid & 63, w = tid >> 6, l31 = lane & 31, lh = lane >> 5;
  const int q0 = qb * 256, qw0 = q0 + 32 * w, myq = qw0 + l31;
  const size_t tq = (size_t)b * SEQ + myq;
  bf16x8 qf[6];
#pragma unroll
  for (int ks = 0; ks < 6; ++ks) qf[ks] = *(const bf16x8*)(Q + tq * 1536 + h * 96 + ks * 16 + lh * 8);
  f32x16 o[2];
#pragma unroll
  for (int a = 0; a < 2; ++a)
#pragma unroll
    for (int i = 0; i < 16; ++i) o[a][i] = 0.f;
  float m = -1e30f, l = 0.f;
  const int ntiles = 4 * qb + 4;
  const int nact = (qw0 + 31) / 64 + 1;
  const int kr = tid >> 3, kc = (tid & 7) * 8;
  const int rr = (tid & 255) >> 2, rc = (tid & 3) * 8;
  const bf16_t* gK = KN + ((size_t)b * SEQ + kr) * 1024 + h * 64 + kc;
  const bf16_t* gR = KROPE + ((size_t)b * SEQ + rr) * 32 + rc;
  const bf16_t* gV = VT + ((size_t)((b * 16 + h) * 64 + kr)) * SEQ + kc;
  uint4 rk, rr4, rv;
#define ATT_LOAD(T) do { rk = *(const uint4*)(gK + (size_t)(T) * 64 * 1024); rr4 = *(const uint4*)(gR + (size_t)(T) * 64 * 32); rv = *(const uint4*)(gV + (T) * 64); } while (0)
#define ATT_STORE(ST_) do { bf16_t* dK_ = (bf16_t*)(smem + (ST_) * ATT_STAGE); bf16_t* dV_ = (bf16_t*)(smem + (ST_) * ATT_STAGE + ATT_K_BYTES); \
    *(uint4*)(dK_ + kr * KROW + kc) = rk; *(uint4*)(dK_ + rr * KROW + 64 + rc) = rr4; \
    *(uint2*)(dV_ + kr * VROW + kc) = make_uint2(rv.x, rv.y); *(uint2*)(dV_ + kr * VROW + kc + 4) = make_uint2(rv.z, rv.w); } while (0)
  ATT_LOAD(0); ATT_STORE(0);
  ATT_LOAD(1); ATT_STORE(1);
  ATT_LOAD(2);
  __syncthreads();
  f32x16 sc[2], sn[2];
  attn_qk((const bf16_t*)smem, qf, sc, l31, lh);
  int st = 0;
  int kt = 0;
  for (; kt < nact - 1; ++kt) {
    const int st1 = (st == 2) ? 0 : st + 1, st2 = (st1 == 2) ? 0 : st1 + 1;
    ATT_STORE(st2);
    { const int tl = (kt + 3 < ntiles) ? kt + 3 : ntiles - 1; ATT_LOAD(tl); }
    attn_qk((const bf16_t*)(smem + st1 * ATT_STAGE), qf, sn, l31, lh);
    attn_softmax<false>(sc, o, m, l, kt, myq, lh);
    attn_pv(sc, o, (const bf16_t*)(smem + st * ATT_STAGE + ATT_K_BYTES), l31, lh);
    __syncthreads();
#pragma unroll
    for (int sub = 0; sub < 2; ++sub) sc[sub] = sn[sub];
    st = st1;
  }
  uint2 gpre[2][4];
#pragma unroll
  for (int dvt = 0; dvt < 2; ++dvt)
#pragma unroll
    for (int rg = 0; rg < 4; ++rg) gpre[dvt][rg] = *(const uint2*)(GATE + tq * 1024 + h * 64 + dvt * 32 + 8 * rg + 4 * lh);
  {
    const int st1 = (st == 2) ? 0 : st + 1, st2 = (st1 == 2) ? 0 : st1 + 1;
    ATT_STORE(st2);
    { const int tl = (kt + 3 < ntiles) ? kt + 3 : ntiles - 1; ATT_LOAD(tl); }
    attn_softmax<true>(sc, o, m, l, kt, myq, lh);
    attn_pv(sc, o, (const bf16_t*)(smem + st * ATT_STAGE + ATT_K_BYTES), l31, lh);
    __syncthreads();
    st = st1; ++kt;
  }
  for (; kt < ntiles; ++kt) {
    const int st1 = (st == 2) ? 0 : st + 1, st2 = (st1 == 2) ? 0 : st1 + 1;
    ATT_STORE(st2);
    { const int tl = (kt + 3 < ntiles) ? kt + 3 : ntiles - 1; ATT_LOAD(tl); }
    __syncthreads();
    st = st1;
  }
#undef ATT_LOAD
#undef ATT_STORE
  l += __shfl_xor(l, 32);
  const float il = 1.f / l;
#pragma unroll
  for (int dvt = 0; dvt < 2; ++dvt)
#pragma unroll
    for (int rg = 0; rg < 4; ++rg) {
      const int dv = dvt * 32 + 8 * rg + 4 * lh;
      const uint2 gv = gpre[dvt][rg];
      const float g0 = __uint_as_float(gv.x << 16), g1 = __uint_as_float(gv.x & 0xffff0000u), g2 = __uint_as_float(gv.y << 16), g3 = __uint_as_float(gv.y & 0xffff0000u);
      uint2 ov; ov.x = pk2(o[dvt][4 * rg] * il * g0, o[dvt][4 * rg + 1] * il * g1); ov.y = pk2(o[dvt][4 * rg + 2] * il * g2, o[dvt][4 * rg + 3] * il * g3);
      *(uint2*)(O + tq * 1024 + h * 64 + dv) = ov;
    }
}

DI void phase_attn(const Params& p, unsigned char* smem) {
  for (int u = blockIdx.x; u < 512; u += gridDim.x) {
    int pu = u;
    if (gridDim.x == 256) {
      const int xcd = blockIdx.x & 7, li = blockIdx.x >> 3, r = u >> 8;
      pu = (r * 16 + xcd * 2 + (li >> 4)) * 16 + (li & 15);
    }
    const int bh = pu >> 4, x = pu & 15;
    for (int half = 0; half < 2; ++half) attn_unit(p, bh >> 4, bh & 15, half ? x : 31 - x, smem);
  }
}

DI void phase_final_norm(const Params& p) {
  const int tid = otid(); const int lane = tid & 63, w = tid >> 6;
  float4 g[4];
#pragma unroll
  for (int i = 0; i < 4; ++i) g[i] = ((const float4*)p.g_final)[lane + 64 * i];
  for (int row = (blockIdx.x * 8 + w) * 2; row < T; row += gridDim.x * 16) {
    float4 v[2][4]; float ss[2] = {0.f, 0.f};
#pragma unroll
    for (int u = 0; u < 2; ++u)
#pragma unroll
      for (int i = 0; i < 4; ++i) v[u][i] = ((const float4*)(p.out + (size_t)(row + u) * DM))[lane + 64 * i];
#pragma unroll
    for (int u = 0; u < 2; ++u) {
#pragma unroll
      for (int i = 0; i < 4; ++i) ss[u] += v[u][i].x * v[u][i].x + v[u][i].y * v[u][i].y + v[u][i].z * v[u][i].z + v[u][i].w * v[u][i].w;
      ss[u] = wave_sum(ss[u]);
      const float r = rsqrtf(ss[u] * (1.f / 1024.f) + 1e-6f);
#pragma unroll
      for (int i = 0; i < 4; ++i)
        ((float4*)(p.out + (size_t)(row + u) * DM))[lane + 64 * i] = make_float4(v[u][i].x * r * g[i].x, v[u][i].y * r * g[i].y, v[u][i].z * r * g[i].z, v[u][i].w * r * g[i].w);
    }
  }
}

__global__ void __launch_bounds__(NTHREADS) mega(Params p) {
  cg::grid_group grid = cg::this_grid();
  extern __shared__ __attribute__((aligned(16))) unsigned char smem[];
  unsigned char* ws = p.ws;
  __shared__ unsigned bar_st[4];
  if (threadIdx.x < 4) bar_st[threadIdx.x] = 0u;
  __syncthreads();
  const XcdBarrier xb = xcd_barrier_post((unsigned*)(ws + OFF_BAR), bar_st);
  const bool tailfill = (gridDim.x == 256);
  phase_prep(p, smem, blockIdx.x, tailfill ? 1344 : 2832, gridDim.x);
  if (!tailfill) phase_rope_tables(p, blockIdx.x, gridDim.x);
  phase_rmsnorm_rows(p.x, (bf16_t*)(ws + OFF_XN));
  if (p.out == nullptr) grid.sync();
  xcd_barrier(xb);
  gemm_phase<EPI_SSM_IN, 1024>(p, (const bf16_t*)(ws + OFF_W1), (const bf16_t*)(ws + OFF_XN), 21, smem);
  if (tailfill && (blockIdx.x >> 3) >= 8) {
    const int tj = (blockIdx.x & 7) * 24 + ((blockIdx.x >> 3) - 8);
    phase_prep(p, smem, 1344 + tj, 2832, 192);
    phase_rope_tables(p, tj, 192);
  }
  xcd_barrier(xb);
  phase_ssd_state(p, smem);
  xcd_barrier(xb);
  phase_ssd_scan(p);
  xcd_barrier(xb);
  phase_ssd_out(p, smem);
  xcd_barrier(xb);
  gemm_phase<EPI_OUT1, 2048>(p, (const bf16_t*)(ws + OFF_W2), (const bf16_t*)p.out, 4, smem);
  xcd_barrier(xb);
  gemm_phase<EPI_MLA_IN, 1024>(p, (const bf16_t*)(ws + OFF_W3), (const bf16_t*)(ws + OFF_XN), 7, smem);
  xcd_barrier(xb);
  gemm_phase<EPI_KVUP, 256>(p, (const bf16_t*)(ws + OFF_W4), (const bf16_t*)(ws + OFF_ST + 32 * MiB), 8, smem);
  gemm_phase<EPI_QUP, 384>(p, (const bf16_t*)(ws + OFF_W5), (const bf16_t*)(ws + OFF_ST + 40 * MiB), 6, smem);
  xcd_barrier(xb);
  phase_attn(p, smem);
  xcd_barrier(xb);
  gemm_phase<EPI_OUT2, 1024>(p, (const bf16_t*)(ws + OFF_W6), (const bf16_t*)(ws + OFF_ST + 32 * MiB), 4, smem);
  xcd_barrier(xb);
  phase_final_norm(p);
}

extern "C" void kernel_launch(void* const* d_in, const int* in_sizes, int n_in, void* d_out, int out_size, void* d_ws, size_t ws_size, hipStream_t stream) {
  static int grid = 0;
  if (grid == 0) {
    if (n_in != 20 || ws_size < WS_NEED) { fprintf(stderr, "kernel_launch: unexpected n_in %d / ws_size %zu\n", n_in, ws_size); grid = -1; return; }
    int dev = 0, cus = 0, per_cu = 0;
    hipGetDevice(&dev);
    hipDeviceGetAttribute(&cus, hipDeviceAttributeMultiprocessorCount, dev);
    if (hipFuncSetAttribute((const void*)mega, hipFuncAttributeMaxDynamicSharedMemorySize, LDS_BYTES) != hipSuccess) { fprintf(stderr, "hipFuncSetAttribute failed\n"); grid = -1; return; }
    hipOccupancyMaxActiveBlocksPerMultiprocessor(&per_cu, (const void*)mega, NTHREADS, LDS_BYTES);
    if (per_cu < 1) per_cu = 1;
    (void)hipGetLastError();
    grid = cus;
  }
  if (grid < 0) return;
  Params p{};
  p.x = (const float*)d_in[0]; p.pos = (const int*)d_in[1]; p.g_pre = (const float*)d_in[2]; p.ssm_w_in = (const float*)d_in[3];
  p.conv_w = (const float*)d_in[4]; p.conv_b = (const float*)d_in[5]; p.dt_bias = (const float*)d_in[6]; p.A_log = (const float*)d_in[7];
  p.Dskip = (const float*)d_in[8]; p.g_out = (const float*)d_in[9]; p.ssm_w_out = (const float*)d_in[10]; p.kv_g_in = (const float*)d_in[11];
  p.kv_w_down = (const float*)d_in[12]; p.kv_g_lat = (const float*)d_in[13]; p.kv_w_up = (const float*)d_in[14]; p.mla_w_in = (const float*)d_in[15];
  p.mla_g_q = (const float*)d_in[16]; p.mla_w_uq = (const float*)d_in[17]; p.mla_w_out = (const float*)d_in[18]; p.g_final = (const float*)d_in[19];
  p.out = (float*)d_out; p.ws = (unsigned char*)d_ws;
  if (hipMemsetAsync((char*)d_ws + OFF_BAR, 0, XCD_BAR_WORDS * sizeof(unsigned), stream) != hipSuccess) { fprintf(stderr, "memset of barrier words failed\n"); return; }
  void* args[] = {&p};
  hipError_t e = hipLaunchCooperativeKernel((const void*)mega, dim3(grid), dim3(NTHREADS), args, LDS_BYTES, stream);
  if (e != hipSuccess) fprintf(stderr, "cooperative launch failed: %s (grid %d)\n", hipGetErrorString(e), grid);
}
```

```cpp
#include <hip/hip_runtime.h>
#include <hip/hip_cooperative_groups.h>
#include <cstdio>
#include <cstdint>
namespace cg = cooperative_groups;

typedef unsigned short bf16_t;
typedef short bf16x8 __attribute__((ext_vector_type(8)));
typedef float f32x16 __attribute__((ext_vector_type(16)));
#define DI __device__ __forceinline__
#define MFMA32(a, b, c) __builtin_amdgcn_mfma_f32_32x32x16_bf16((a), (b), (c), 0, 0, 0)

constexpr int T = 16384, SEQ = 8192, DM = 1024;
constexpr int NTHREADS = 512;
constexpr size_t MiB = 1024 * 1024;
constexpr size_t OFF_W1 = 0;
constexpr size_t OFF_W2 = OFF_W1 + (size_t)5376 * 1024 * 2;
constexpr size_t OFF_W3 = OFF_W2 + (size_t)1024 * 2048 * 2;
constexpr size_t OFF_W4 = OFF_W3 + (size_t)1792 * 1024 * 2;
constexpr size_t OFF_W5 = OFF_W4 + (size_t)2048 * 256 * 2;
constexpr size_t OFF_W6 = OFF_W5 + (size_t)1536 * 384 * 2;
constexpr size_t OFF_XN = 24 * MiB;
constexpr size_t OFF_XT = 56 * MiB;
constexpr size_t OFF_BT = 120 * MiB;
constexpr size_t OFF_BR = 136 * MiB;
constexpr size_t OFF_CR = 152 * MiB;
constexpr size_t OFF_DT = 168 * MiB;
constexpr size_t OFF_ST = 170 * MiB;
constexpr size_t OFF_DEC = 234 * MiB;
constexpr size_t OFF_BAR = 236 * MiB;
constexpr size_t OFF_COS = 238 * MiB;
constexpr size_t OFF_SIN = 239 * MiB;
constexpr size_t OFF_SSQ = 240 * MiB;
constexpr size_t WS_NEED = 241 * MiB;

struct Params {
  const float* x; const int* pos; const float* g_pre; const float* ssm_w_in; const float* conv_w; const float* conv_b;
  const float* dt_bias; const float* A_log; const float* Dskip; const float* g_out; const float* ssm_w_out;
  const float* kv_g_in; const float* kv_w_down; const float* kv_g_lat; const float* kv_w_up;
  const float* mla_w_in; const float* mla_g_q; const float* mla_w_uq; const float* mla_w_out; const float* g_final;
  float* out; unsigned char* ws;
};

DI bf16_t f2bf(float x) { unsigned u = __float_as_uint(x); u += 0x7fffu + ((u >> 16) & 1u); return (bf16_t)(u >> 16); }
DI float bf2f(bf16_t b) { return __uint_as_float(((unsigned)b) << 16); }
DI float lo16(unsigned u) { return __uint_as_float(u << 16); }
DI float hi16(unsigned u) { return __uint_as_float(u & 0xffff0000u); }
typedef float f32x2 __attribute__((ext_vector_type(2)));
typedef __bf16 bf16x2_t __attribute__((ext_vector_type(2)));
DI unsigned pk2(float a, float b) { f32x2 v = {a, b}; bf16x2_t r = __builtin_convertvector(v, bf16x2_t); return __builtin_bit_cast(unsigned, r); }
DI float wave_sum(float v) {
#pragma unroll
  for (int o = 32; o >= 1; o >>= 1) v += __shfl_xor(v, o);
  return v;
}
DI int otid() { int t = threadIdx.x; asm volatile("" : "+v"(t)); return t; }
template <int K> DI float swz_xor(float v) {
  return __int_as_float(__builtin_amdgcn_ds_swizzle(__float_as_int(v), (K << 10) | 0x1f));
}
DI float silu_f(float v) { return v * __builtin_amdgcn_rcpf(1.f + __expf(-v)); }


#define XB_TMO      128
#define XB_XCNT(j)  (256  + 64 * (j))
#define XB_XSUB(j)  (1280 + 64 * (j))
#define XB_XGEN(j)  (2304 + 64 * (j))
#define XB_TOP      3328
#define XB_TOPGEN   3392
#define XCD_BAR_WORDS 3456
#define XB_SPIN_CAP (1u << 18)
DI unsigned xb_ld(unsigned* p)              { return __hip_atomic_load(p, __ATOMIC_RELAXED, __HIP_MEMORY_SCOPE_AGENT); }
DI unsigned xb_add(unsigned* p, unsigned v) { return __hip_atomic_fetch_add(p, v, __ATOMIC_RELAXED, __HIP_MEMORY_SCOPE_AGENT); }
DI unsigned xb_xcc_id() { return (unsigned)__builtin_amdgcn_s_getreg((3 << 11) | 20) & 0xFu; }
#define XB_SPIN(cond, bar) do { unsigned _sp = 0; while (cond) { __builtin_amdgcn_s_sleep(1); \
    if ((++_sp & 255u) == 0u) { if (xb_ld(&(bar)[XB_TMO])) break; if (_sp > XB_SPIN_CAP) { atomicAdd(&(bar)[XB_TMO], 1u); break; } } } } while (0)
struct XcdBarrier { unsigned* bar; unsigned x; volatile unsigned* st; };
DI XcdBarrier xcd_barrier_post(unsigned* bar, volatile unsigned* st) {
  XcdBarrier b; b.bar = bar; b.x = xb_xcc_id(); b.st = st;
  if (threadIdx.x == 0) (void)xb_add(&bar[XB_XCNT(b.x)], 1u);
  return b;
}
DI void xcd_barrier_complete(unsigned* bar, unsigned x, unsigned& nloc, unsigned& nx) {
  const unsigned G = gridDim.x * gridDim.y * gridDim.z;
  unsigned sum, cnt, mine, sp = 0u;
  for (;;) {
    sum = 0u; cnt = 0u; mine = 0u;
#pragma unroll
    for (unsigned j = 0; j < 16; ++j) { const unsigned c = xb_ld(&bar[XB_XCNT(j)]); sum += c; cnt += (c > 0u) ? 1u : 0u; mine = (j == x) ? c : mine; }
    if (sum == G) break;
    __builtin_amdgcn_s_sleep(1);
    if ((++sp & 255u) == 0u) { if (xb_ld(&bar[XB_TMO])) break; if (sp > XB_SPIN_CAP) { atomicAdd(&bar[XB_TMO], 1u); break; } }
  }
  nloc = mine > 0u ? mine : 1u; nx = cnt > 0u ? cnt : 1u;
}
DI void xcd_barrier(const XcdBarrier& b) {
  asm volatile("s_waitcnt vmcnt(0)" ::: "memory");
  __syncthreads();
  if (threadIdx.x == 0) {
    unsigned* bar = b.bar;
    __builtin_amdgcn_s_waitcnt(0);
    unsigned nloc = b.st[0], nx = b.st[1];
    if (nloc == 0u) { xcd_barrier_complete(bar, b.x, nloc, nx); b.st[0] = nloc; b.st[1] = nx; }
    const unsigned old = xb_add(&bar[XB_XSUB(b.x)], 1u);
    const unsigned gen = old / nloc;
    if (old + 1u == (gen + 1u) * nloc) {
      __builtin_amdgcn_fence(__ATOMIC_RELEASE, "agent");
      asm volatile("s_waitcnt vmcnt(0)" ::: "memory");
      const unsigned og = xb_add(&bar[XB_TOP], 1u);
      const unsigned tg = og / nx;
      if (og + 1u == (tg + 1u) * nx) xb_add(&bar[XB_TOPGEN], 1u);
      else XB_SPIN(xb_ld(&bar[XB_TOPGEN]) == tg, bar);
      __builtin_amdgcn_fence(__ATOMIC_ACQUIRE, "agent");
      xb_add(&bar[XB_XGEN(b.x)], 1u);
      asm volatile("s_waitcnt vmcnt(0)" ::: "memory");
    } else {
      XB_SPIN(xb_ld(&bar[XB_XGEN(b.x)]) == gen, bar);
      __builtin_amdgcn_fence(__ATOMIC_ACQUIRE, "agent");
      asm volatile("s_waitcnt vmcnt(0)" ::: "memory");
    }
  }
  __syncthreads();
}

struct WJob { const float* src; const float* gain; bf16_t* dst; int ld, col0, ncols, K, tile; };
DI WJob wprep_job(const Params& p, int u) {
  bf16_t* W1 = (bf16_t*)(p.ws + OFF_W1); bf16_t* W2 = (bf16_t*)(p.ws + OFF_W2); bf16_t* W3 = (bf16_t*)(p.ws + OFF_W3);
  bf16_t* W4 = (bf16_t*)(p.ws + OFF_W4); bf16_t* W5 = (bf16_t*)(p.ws + OFF_W5); bf16_t* W6 = (bf16_t*)(p.ws + OFF_W6);
  int t = u; WJob j;
  if (t < 1344) { j = {p.ssm_w_in, p.g_pre, W1, 5152, 0, 5152, 1024, t}; return j; } t -= 1344;
  if (t < 512) { j = {p.ssm_w_out, p.g_out, W2, 1024, 0, 1024, 2048, t}; return j; } t -= 512;
  if (t < 64) { j = {p.kv_w_down, p.kv_g_in, W3, 288, 0, 256, 1024, t}; return j; } t -= 64;
  if (t < 96) { j = {p.mla_w_in, p.g_pre + 1024, W3 + (size_t)256 * 1024, 1408, 0, 384, 1024, t}; return j; } t -= 96;
  if (t < 256) { j = {p.mla_w_in, p.g_pre + 1024, W3 + (size_t)640 * 1024, 1408, 384, 1024, 1024, t}; return j; } t -= 256;
  if (t < 32) { j = {p.kv_w_down, p.kv_g_in, W3 + (size_t)1664 * 1024, 288, 256, 32, 1024, t}; return j; } t -= 32;
  if (t < 128) { j = {p.kv_w_up, p.kv_g_lat, W4, 2048, 0, 2048, 256, t}; return j; } t -= 128;
  if (t < 144) { j = {p.mla_w_uq, p.mla_g_q, W5, 1536, 0, 1536, 384, t}; return j; } t -= 144;
  j = {p.mla_w_out, nullptr, W6, 1024, 0, 1024, 1024, t}; return j;
}
DI void wprep_load(const WJob& j, int tid0, float4 (&v)[2], float (&gk)[2]) {
  const int nkt = j.K >> 6; const int tn = j.tile / nkt, tk = j.tile % nkt; const int n0 = tn * 64, k0 = tk * 64;
#pragma unroll
  for (int i = 0; i < 2; ++i) {
    const int e = tid0 + NTHREADS * i; const int kk = e >> 4, n4 = (e & 15) * 4;
    v[i] = make_float4(0.f, 0.f, 0.f, 0.f);
    if (n0 + n4 < j.ncols) v[i] = *(const float4*)(j.src + (size_t)(k0 + kk) * j.ld + j.col0 + n0 + n4);
    gk[i] = j.gain ? j.gain[k0 + kk] : 1.f;
  }
}
DI void phase_prep(const Params& p, unsigned char* smem, int ustart, int uend, int ustride) {
  float* sm = (float*)smem;
  const int tid0 = otid();
  int u = ustart;
  if (u >= uend) return;
  WJob j = wprep_job(p, u);
  float4 v[2]; float gk[2];
  wprep_load(j, tid0, v, gk);
  for (;;) {
#pragma unroll
    for (int i = 0; i < 2; ++i) {
      const int e = tid0 + NTHREADS * i; const int kk = e >> 4, n4 = (e & 15) * 4;
      float* d = sm + kk * 65 + n4;
      d[0] = v[i].x * gk[i]; d[1] = v[i].y * gk[i]; d[2] = v[i].z * gk[i]; d[3] = v[i].w * gk[i];
    }
    __syncthreads();
    const WJob jc = j;
    const int un = u + ustride; const bool more = (un < uend);
    if (more) { j = wprep_job(p, un); wprep_load(j, tid0, v, gk); }
    {
      const int nkt = jc.K >> 6; const int tn = jc.tile / nkt, tk = jc.tile % nkt; const int n0 = tn * 64, k0 = tk * 64;
      const int nn = tid0 >> 3, kc = (tid0 & 7) * 8;
      uint4 o;
      o.x = pk2(sm[(kc + 0) * 65 + nn], sm[(kc + 1) * 65 + nn]); o.y = pk2(sm[(kc + 2) * 65 + nn], sm[(kc + 3) * 65 + nn]);
      o.z = pk2(sm[(kc + 4) * 65 + nn], sm[(kc + 5) * 65 + nn]); o.w = pk2(sm[(kc + 6) * 65 + nn], sm[(kc + 7) * 65 + nn]);
      *(uint4*)(jc.dst + (size_t)(n0 + nn) * jc.K + k0 + kc) = o;
    }
    __syncthreads();
    if (!more) break;
    u = un;
  }
}

DI void phase_rope_tables(const Params& p, int blk, int nblk) {
  float* COS = (float*)(p.ws + OFF_COS); float* SIN = (float*)(p.ws + OFF_SIN);
  for (int e = blk * NTHREADS + otid(); e < T * 16; e += nblk * NTHREADS) {
    const int t = e >> 4, i = e & 15;
    const float ang = (float)p.pos[t] * powf(10000.f, -(float)(2 * i) / 32.f);
    COS[e] = cosf(ang); SIN[e] = sinf(ang);
  }
  float* SSQ = (float*)(p.ws + OFF_SSQ);
  for (int e = blk * NTHREADS + otid(); e < 3 * T; e += nblk * NTHREADS) SSQ[e] = 0.f;
}

DI void phase_rmsnorm_rows(const float* __restrict__ src, bf16_t* __restrict__ dst) {
  const int tid = otid(); const int lane = tid & 63, w = tid >> 6;
  for (int row = (blockIdx.x * 8 + w) * 4; row < T; row += gridDim.x * 32) {
    float4 v[4][4]; float ss[4] = {0.f, 0.f, 0.f, 0.f};
#pragma unroll
    for (int u = 0; u < 4; ++u)
#pragma unroll
      for (int i = 0; i < 4; ++i) v[u][i] = ((const float4*)(src + (size_t)(row + u) * DM))[lane + 64 * i];
#pragma unroll
    for (int u = 0; u < 4; ++u) {
#pragma unroll
      for (int i = 0; i < 4; ++i) ss[u] += v[u][i].x * v[u][i].x + v[u][i].y * v[u][i].y + v[u][i].z * v[u][i].z + v[u][i].w * v[u][i].w;
      ss[u] = wave_sum(ss[u]);
      const float r = rsqrtf(ss[u] * (1.f / 1024.f) + 1e-6f);
#pragma unroll
      for (int i = 0; i < 4; ++i) {
        uint2 o; o.x = pk2(v[u][i].x * r, v[u][i].y * r); o.y = pk2(v[u][i].z * r, v[u][i].w * r);
        *(uint2*)(dst + (size_t)(row + u) * DM + (lane + 64 * i) * 4) = o;
      }
    }
  }
}

enum { EPI_SSM_IN = 0, EPI_OUT1 = 1, EPI_MLA_IN = 2, EPI_KVUP = 3, EPI_QUP = 4, EPI_OUT2 = 5 };


typedef float f32x4 __attribute__((ext_vector_type(4)));
constexpr int EPI_WAVE_BYTES = 8704;
constexpr int TM_ROW = 72;
constexpr int CM_ROW = 40;
constexpr int F32_ROW = 68;

template <bool SILU>
DI void stage_tm(const f32x4 (&a)[4][2], bf16_t* wl, int fr, int fq) {
#pragma unroll
  for (int m = 0; m < 4; ++m)
#pragma unroll
    for (int n = 0; n < 2; ++n) {
      float v0 = a[m][n][0], v1 = a[m][n][1], v2 = a[m][n][2], v3 = a[m][n][3];
      if (SILU) { v0 = silu_f(v0); v1 = silu_f(v1); v2 = silu_f(v2); v3 = silu_f(v3); }
      uint2 o; o.x = pk2(v0, v1); o.y = pk2(v2, v3);
      *(uint2*)(wl + (n * 16 + fr) * TM_ROW + m * 16 + fq * 4) = o;
    }
}
DI void readout_tm(const bf16_t* wl, bf16_t* gdst, size_t ld, int lane) {
#pragma unroll
  for (int it = 0; it < 4; ++it) {
    const int idx = lane + 64 * it; const int row = idx >> 3, ch = idx & 7;
    *(uint4*)(gdst + (size_t)row * ld + ch * 8) = *(const uint4*)(wl + row * TM_ROW + ch * 8);
  }
}
DI void stage_cm(const f32x4 (&a)[4][2], bf16_t* wl, int fr, int fq) {
#pragma unroll
  for (int m = 0; m < 4; ++m)
#pragma unroll
    for (int n = 0; n < 2; ++n)
#pragma unroll
      for (int j = 0; j < 4; ++j) wl[(m * 16 + fq * 4 + j) * CM_ROW + n * 16 + fr] = f2bf(a[m][n][j]);
}
DI void readout_cm(const bf16_t* wl, bf16_t* gdst, int lane) {
#pragma unroll
  for (int it = 0; it < 4; ++it) {
    const int idx = lane + 64 * it; const int row = idx >> 2, ch = idx & 3;
    *(uint4*)(gdst + (size_t)row * SEQ + ch * 8) = *(const uint4*)(wl + row * CM_ROW + ch * 8);
  }
}
constexpr int CMP_ROW = 72;
DI void stage_cm_pair(const f32x4 (&a)[4][2], bf16_t* wlp, int par, int fr, int fq) {
#pragma unroll
  for (int m = 0; m < 4; ++m)
#pragma unroll
    for (int n = 0; n < 2; ++n)
#pragma unroll
      for (int j = 0; j < 4; ++j) wlp[(m * 16 + fq * 4 + j) * CMP_ROW + par * 32 + n * 16 + fr] = f2bf(a[m][n][j]);
}
DI void readout_cm_pair(const bf16_t* wlp, bf16_t* gdst, int par, int lane) {
#pragma unroll
  for (int it = 0; it < 4; ++it) {
    const int idx = lane + 64 * it; const int row = par * 32 + (idx >> 3), ch = idx & 7;
    *(uint4*)(gdst + (size_t)row * SEQ + ch * 8) = *(const uint4*)(wlp + row * CMP_ROW + ch * 8);
  }
}
DI void stage_f32(const f32x4 (&a)[4][2], float* wl, int fr, int fq) {
#pragma unroll
  for (int m = 0; m < 4; ++m)
#pragma unroll
    for (int n = 0; n < 2; ++n) *(f32x4*)(wl + (n * 16 + fr) * F32_ROW + m * 16 + fq * 4) = a[m][n];
}
DI void readout_f32_resid(const float* wl, const float* __restrict__ resid, float* __restrict__ gdst, int lane) {
#pragma unroll 4
  for (int it = 0; it < 8; ++it) {
    const int idx = lane + 64 * it; const int row = idx >> 4, ch = idx & 15;
    const float4 v = *(const float4*)(wl + row * F32_ROW + ch * 4);
    const float4 r = *(const float4*)(resid + (size_t)row * DM + ch * 4);
    *(float4*)(gdst + (size_t)row * DM + ch * 4) = make_float4(v.x + r.x, v.y + r.y, v.z + r.z, v.w + r.w);
  }
}

DI void readout_f32_resid_ssq(const float* wl, const float* __restrict__ resid, float* __restrict__ gdst, bf16_t* __restrict__ hs, float* __restrict__ ssq, int lane) {
#pragma unroll 4
  for (int it = 0; it < 8; ++it) {
    const int idx = lane + 64 * it; const int row = idx >> 4, ch = idx & 15;
    const float4 v = *(const float4*)(wl + row * F32_ROW + ch * 4);
    const float4 r = *(const float4*)(resid + (size_t)row * DM + ch * 4);
    const float4 h = make_float4(v.x + r.x, v.y + r.y, v.z + r.z, v.w + r.w);
    *(float4*)(gdst + (size_t)row * DM + ch * 4) = h;
    uint2 o; o.x = pk2(h.x, h.y); o.y = pk2(h.z, h.w);
    *(uint2*)(hs + (size_t)row * DM + ch * 4) = o;
    float q = h.x * h.x + h.y * h.y + h.z * h.z + h.w * h.w;
    q += swz_xor<1>(q); q += swz_xor<2>(q); q += swz_xor<4>(q); q += swz_xor<8>(q);
    if (ch == 0) atomicAdd(ssq + row, q);
  }
}

DI void resid_preload(const float* __restrict__ resid, int lane, float4 (&rr)[8]) {
#pragma unroll
  for (int it = 0; it < 8; ++it) { const int idx = lane + 64 * it; rr[it] = *(const float4*)(resid + (size_t)(idx >> 4) * DM + (idx & 15) * 4); }
}
DI void readout_f32_pre(const float* wl, const float4 (&rr)[8], float* __restrict__ gdst, int lane) {
#pragma unroll
  for (int it = 0; it < 8; ++it) {
    const int idx = lane + 64 * it; const int row = idx >> 4, ch = idx & 15;
    const float4 v = *(const float4*)(wl + row * F32_ROW + ch * 4);
    *(float4*)(gdst + (size_t)row * DM + ch * 4) = make_float4(v.x + rr[it].x, v.y + rr[it].y, v.z + rr[it].z, v.w + rr[it].w);
  }
}
DI void readout_f32_pre_ssq(const float* wl, const float4 (&rr)[8], float* __restrict__ gdst, bf16_t* __restrict__ hs, float* __restrict__ ssq, int lane) {
#pragma unroll
  for (int it = 0; it < 8; ++it) {
    const int idx = lane + 64 * it; const int row = idx >> 4, ch = idx & 15;
    const float4 v = *(const float4*)(wl + row * F32_ROW + ch * 4);
    const float4 h = make_float4(v.x + rr[it].x, v.y + rr[it].y, v.z + rr[it].z, v.w + rr[it].w);
    *(float4*)(gdst + (size_t)row * DM + ch * 4) = h;
    uint2 o; o.x = pk2(h.x, h.y); o.y = pk2(h.z, h.w);
    *(uint2*)(hs + (size_t)row * DM + ch * 4) = o;
    float q = h.x * h.x + h.y * h.y + h.z * h.z + h.w * h.w;
    q += swz_xor<1>(q); q += swz_xor<2>(q); q += swz_xor<4>(q); q += swz_xor<8>(q);
    if (ch == 0) atomicAdd(ssq + row, q);
  }
}

DI void wave_lds_sync() { asm volatile("s_waitcnt lgkmcnt(0)" ::: "memory"); }

template <int EPI>
DI void epilogue_block(const Params& p, const f32x4 (&a)[4][2], int c0, int mt, bf16_t* wl, bf16_t* wlp, int par, int lane, int fr, int fq, const float (&sq)[2], const f32x4 (&csv)[2], const f32x4 (&snv)[2], const float4 (&rr)[8]) {
  unsigned char* ws = p.ws;
  const int b = mt >> 13, tok0 = mt & 8191;
  const int tok0p = tok0 - par * 32;
  if (EPI == EPI_SSM_IN) {
    if (c0 < 2048) {
      stage_tm<false>(a, wl, fr, fq); wave_lds_sync();
      readout_tm(wl, (bf16_t*)p.out + (size_t)mt * 2048 + c0, 2048, lane); wave_lds_sync();
    } else if (c0 < 4096) {
      stage_cm_pair(a, wlp, par, fr, fq); __syncthreads();
      readout_cm_pair(wlp, (bf16_t*)(ws + OFF_XT) + ((size_t)(b * 2048 + (c0 - 2048))) * SEQ + tok0p, par, lane); __syncthreads();
    } else if (c0 < 4608) {
      stage_tm<false>(a, wl, fr, fq); wave_lds_sync();
      readout_tm(wl, (bf16_t*)(ws + OFF_BR) + (size_t)mt * 512 + (c0 - 4096), 512, lane); __syncthreads();
      stage_cm_pair(a, wlp, par, fr, fq); __syncthreads();
      readout_cm_pair(wlp, (bf16_t*)(ws + OFF_BT) + ((size_t)(b * 512 + (c0 - 4096))) * SEQ + tok0p, par, lane); __syncthreads();
    } else if (c0 < 5120) {
      stage_tm<false>(a, wl, fr, fq); wave_lds_sync();
      readout_tm(wl, (bf16_t*)(ws + OFF_CR) + (size_t)mt * 512 + (c0 - 4608), 512, lane); wave_lds_sync();
    } else if (c0 == 5120) {
#pragma unroll
      for (int m = 0; m < 2; ++m)
#pragma unroll
        for (int n = 0; n < 2; ++n) {
          const int h = m * 16 + fq * 4;
          float4 o; float* op = (float*)&o;
#pragma unroll
          for (int j = 0; j < 4; ++j) { const float t = a[m][n][j] + p.dt_bias[h + j]; op[j] = (t > 20.f) ? t : log1pf(__expf(t)); }
          *(float4*)((float*)(ws + OFF_DT) + (size_t)(mt + n * 16 + fr) * 32 + h) = o;
        }
    }
  } else if (EPI == EPI_OUT1 || EPI == EPI_OUT2) {
    const float* resid = (EPI == EPI_OUT1) ? p.x : (const float*)(ws + OFF_XT);
    float* dst = (EPI == EPI_OUT1) ? (float*)(ws + OFF_XT) : p.out;
    stage_f32(a, (float*)wl, fr, fq); wave_lds_sync();
    if (EPI == EPI_OUT1) readout_f32_pre_ssq((const float*)wl, rr, dst + (size_t)mt * DM + c0, (bf16_t*)(ws + OFF_XN) + (size_t)mt * DM + c0, (float*)(ws + OFF_SSQ) + mt, lane);
    else readout_f32_pre((const float*)wl, rr, dst + (size_t)mt * DM + c0, lane);
    wave_lds_sync();
  } else if (EPI == EPI_MLA_IN) {
    const float* SSQ = (const float*)(ws + OFF_SSQ);
    f32x4 a2[4][2];
    float rs[2];
#pragma unroll
    for (int n = 0; n < 2; ++n) rs[n] = rsqrtf(sq[n] * (1.f / 1024.f) + 1e-6f);
#pragma unroll
    for (int m = 0; m < 4; ++m)
#pragma unroll
      for (int n = 0; n < 2; ++n) a2[m][n] = a[m][n] * rs[n];
    if (c0 < 640) {
      float* dstq = (float*)(ws + OFF_SSQ) + (c0 < 256 ? T : 2 * T);
#pragma unroll
      for (int n = 0; n < 2; ++n) {
        float q = 0.f;
#pragma unroll
        for (int m = 0; m < 4; ++m) q += a2[m][n][0] * a2[m][n][0] + a2[m][n][1] * a2[m][n][1] + a2[m][n][2] * a2[m][n][2] + a2[m][n][3] * a2[m][n][3];
        q += swz_xor<16>(q); q += __shfl_xor(q, 32);
        if (fq == 0) atomicAdd(dstq + mt + n * 16 + fr, q);
      }
    }
    const f32x4 (&a)[4][2] = a2;
    if (c0 < 640) stage_tm<false>(a, wl, fr, fq);
    else if (c0 < 1664) stage_tm<true>(a, wl, fr, fq);
    wave_lds_sync();
    if (c0 < 256) readout_tm(wl, (bf16_t*)(ws + OFF_ST + 32 * MiB) + (size_t)mt * 256 + c0, 256, lane);
    else if (c0 < 640) readout_tm(wl, (bf16_t*)(ws + OFF_ST + 40 * MiB) + (size_t)mt * 384 + (c0 - 256), 384, lane);
    else if (c0 < 1664) readout_tm(wl, (bf16_t*)(ws + OFF_ST) + (size_t)mt * 1024 + (c0 - 640), 1024, lane);
    else if (c0 == 1664) {
      const float* COS = (const float*)(ws + OFF_COS); const float* SIN = (const float*)(ws + OFF_SIN);
      bf16_t* KROPE = (bf16_t*)(ws + OFF_DEC);
#pragma unroll
      for (int n = 0; n < 2; ++n) {
        const int t = mt + n * 16 + fr;
        const f32x4 cs = *(const f32x4*)(COS + (size_t)t * 16 + fq * 4), sn = *(const f32x4*)(SIN + (size_t)t * 16 + fq * 4);
        const f32x4 x1 = a[0][n], x2 = a[1][n];
        const f32x4 r1 = x1 * cs - x2 * sn, r2 = x1 * sn + x2 * cs;
        uint2 o1, o2; o1.x = pk2(r1[0], r1[1]); o1.y = pk2(r1[2], r1[3]); o2.x = pk2(r2[0], r2[1]); o2.y = pk2(r2[2], r2[3]);
        *(uint2*)(KROPE + (size_t)t * 32 + fq * 4) = o1; *(uint2*)(KROPE + (size_t)t * 32 + 16 + fq * 4) = o2;
      }
    }
    wave_lds_sync();
  } else if (EPI == EPI_KVUP) {
    const int head = c0 >> 7; const bool isv = (c0 & 64) != 0;
    const float* SSQ = (const float*)(ws + OFF_SSQ) + T;
    f32x4 a2[4][2];
#pragma unroll
    for (int n = 0; n < 2; ++n) {
      const float rsn = rsqrtf(sq[n] * (1.f / 256.f) + 1e-6f);
#pragma unroll
      for (int m = 0; m < 4; ++m) a2[m][n] = a[m][n] * rsn;
    }
    const f32x4 (&a)[4][2] = a2;
    if (!isv) stage_tm<false>(a, wl, fr, fq); else stage_cm_pair(a, wlp, par, fr, fq);
    __syncthreads();
    if (!isv) readout_tm(wl, (bf16_t*)(ws + OFF_XN) + (size_t)mt * 1024 + head * 64, 1024, lane);
    else readout_cm_pair(wlp, (bf16_t*)(ws + OFF_BT) + ((size_t)((b * 16 + head) * 64)) * SEQ + tok0p, par, lane);
    __syncthreads();
  } else if (EPI == EPI_QUP) {
    const float SC = 0.10206207261596575f * 1.4426950408889634f;
    const float* SSQ = (const float*)(ws + OFF_SSQ) + 2 * T;
    f32x4 v[4][2];
#pragma unroll
    for (int n = 0; n < 2; ++n) {
      const float rsn = rsqrtf(sq[n] * (1.f / 384.f) + 1e-6f) * SC;
#pragma unroll
      for (int m = 0; m < 4; ++m) v[m][n] = a[m][n] * rsn;
    }
    const int ph = c0 % 96;
    if (ph != 0) {
      const float* COS = (const float*)(ws + OFF_COS); const float* SIN = (const float*)(ws + OFF_SIN);
#pragma unroll
      for (int n = 0; n < 2; ++n) {
        const f32x4 cs = csv[n], sn = snv[n];
        if (ph == 64) { const f32x4 x1 = v[0][n], x2 = v[1][n]; v[0][n] = x1 * cs - x2 * sn; v[1][n] = x1 * sn + x2 * cs; }
        else          { const f32x4 x1 = v[2][n], x2 = v[3][n]; v[2][n] = x1 * cs - x2 * sn; v[3][n] = x1 * sn + x2 * cs; }
      }
    }
    stage_tm<false>(v, wl, fr, fq); wave_lds_sync();
    readout_tm(wl, (bf16_t*)p.out + (size_t)mt * 1536 + c0, 1536, lane);
    wave_lds_sync();
  }
}

constexpr int G8_BK = 64, G8_HALF = 128, G8_HT = G8_HALF * G8_BK;
constexpr int LDS_BYTES = 143360;
DI int g8_lds_byte(int r, int c) { const int st = (r >> 4) * 2 + (c >> 5), rr = r & 15, cc = c & 31, ob = rr * 64 + cc * 2; return st * 1024 + (ob ^ (((ob >> 9) & 1) << 5)); }
DI void g8_stage_rc(int b, int& R, int& C) { const int st = b / 1024, sb = b % 1024, swz = sb ^ (((sb >> 9) & 1) << 5); R = (st >> 1) * 16 + swz / 64; C = (st & 1) * 32 + (swz % 64) / 2; }

template <int EPI, int K>
DI void gemm_tile(const Params& p, const bf16_t* __restrict__ A, const bf16_t* __restrict__ Bt, int brow, int bcol, unsigned char* smem) {
  bf16_t* shm = (bf16_t*)smem;
#define SA(b, h) (shm + ((b) * 2 + (h)) * G8_HT)
#define SB(b, h) (shm + (4 + (b) * 2 + (h)) * G8_HT)
#define STAGE(P, BASE, br, kt) do { const long _g = (long)(br) * K + (long)(kt) * G8_BK; \
    _Pragma("unroll") for (int _i = 0; _i < 2; ++_i) { const int _b = tid * 16 + _i * 8192; int _r, _c; g8_stage_rc(_b, _r, _c); \
      __builtin_amdgcn_global_load_lds((const unsigned*)(BASE + _g + (long)_r * K + _c), (unsigned*)((char*)(P) + _b), 16, 0, 0); } } while (0)
#define LDA(dst, b, h) _Pragma("unroll") for (int m = 0; m < 4; ++m) _Pragma("unroll") for (int k = 0; k < 2; ++k) \
    dst[m][k] = *reinterpret_cast<const bf16x8*>((const char*)SA(b, h) + g8_lds_byte(wr * 64 + m * 16 + fr, k * 32 + fq * 8))
#define LDB(dst, b, h) _Pragma("unroll") for (int n = 0; n < 2; ++n) _Pragma("unroll") for (int k = 0; k < 2; ++k) \
    dst[n][k] = *reinterpret_cast<const bf16x8*>((const char*)SB(b, h) + g8_lds_byte(wc * 32 + n * 16 + fr, k * 32 + fq * 8))
#define MMA(ai, bj, At_, Bt_) do { __builtin_amdgcn_s_setprio(1); \
    _Pragma("unroll") for (int m = 0; m < 4; ++m) _Pragma("unroll") for (int n = 0; n < 2; ++n) _Pragma("unroll") for (int k = 0; k < 2; ++k) \
      acc[ai][bj][m][n] = __builtin_amdgcn_mfma_f32_16x16x32_bf16(At_[m][k], Bt_[n][k], acc[ai][bj][m][n], 0, 0, 0); \
    __builtin_amdgcn_s_setprio(0); } while (0)
#define WAIT_V(n) asm volatile("s_waitcnt vmcnt(" #n ")" ::: "memory")
#define WAIT_L(n) asm volatile("s_waitcnt lgkmcnt(" #n ")" ::: "memory")
#define BAR __builtin_amdgcn_s_barrier()
#define SCHED __builtin_amdgcn_sched_barrier(0)
  const int tid = otid();
  const int wid = tid >> 6, lane = tid & 63, wr = wid >> 2, wc = wid & 3, fr = lane & 15, fq = lane >> 4;
  f32x4 acc[2][2][4][2];
#pragma unroll
  for (int a_ = 0; a_ < 2; ++a_)
#pragma unroll
    for (int b_ = 0; b_ < 2; ++b_)
#pragma unroll
      for (int m = 0; m < 4; ++m)
#pragma unroll
        for (int n = 0; n < 2; ++n) acc[a_][b_][m][n] = (f32x4){0.f, 0.f, 0.f, 0.f};
  bf16x8 At[4][2], B0[2][2], B1[2][2];
  constexpr int nt = K / G8_BK;
  STAGE(SB(0, 0), Bt, bcol, 0); STAGE(SA(0, 0), A, brow, 0);
  STAGE(SB(0, 1), Bt, bcol + G8_HALF, 0); STAGE(SA(0, 1), A, brow + G8_HALF, 0);
  if (wr == 1) BAR;
  WAIT_V(4); BAR;
  STAGE(SB(1, 0), Bt, bcol, 1); STAGE(SA(1, 0), A, brow, 1); STAGE(SB(1, 1), Bt, bcol + G8_HALF, 1);
  WAIT_V(6); BAR;
  for (int t = 0; t < nt - 2; t += 2) {
    LDB(B0, 0, 0); SCHED; LDA(At, 0, 0); STAGE(SA(1, 1), A, brow + G8_HALF, t + 1);
    WAIT_L(8); BAR; WAIT_L(0); MMA(0, 0, At, B0); BAR; SCHED;
    LDB(B1, 0, 1); STAGE(SB(0, 0), Bt, bcol, t + 2);
    BAR; WAIT_L(0); MMA(0, 1, At, B1); BAR;
    LDA(At, 0, 1); STAGE(SA(0, 0), A, brow, t + 2);
    BAR; WAIT_L(0); MMA(1, 0, At, B0); BAR; SCHED;
    STAGE(SB(0, 1), Bt, bcol + G8_HALF, t + 2);
    WAIT_V(6); BAR; MMA(1, 1, At, B1); BAR;
    LDB(B0, 1, 0); SCHED; LDA(At, 1, 0); STAGE(SA(0, 1), A, brow + G8_HALF, t + 2);
    WAIT_L(8); BAR; WAIT_L(0); MMA(0, 0, At, B0); BAR; SCHED;
    LDB(B1, 1, 1); STAGE(SB(1, 0), Bt, bcol, t + 3);
    BAR; WAIT_L(0); MMA(0, 1, At, B1); BAR;
    LDA(At, 1, 1); STAGE(SA(1, 0), A, brow, t + 3);
    BAR; WAIT_L(0); MMA(1, 0, At, B0); BAR; SCHED;
    STAGE(SB(1, 1), Bt, bcol + G8_HALF, t + 3);
    WAIT_V(6); BAR; MMA(1, 1, At, B1); BAR;
  }
  { LDB(B0, 0, 0); LDA(At, 0, 0); STAGE(SA(1, 1), A, brow + G8_HALF, nt - 1);
    BAR; WAIT_L(0); MMA(0, 0, At, B0); BAR;
    LDB(B1, 0, 1); BAR; WAIT_L(0); MMA(0, 1, At, B1); BAR;
    LDA(At, 0, 1); WAIT_V(4); BAR; WAIT_L(0); MMA(1, 0, At, B0); MMA(1, 1, At, B1); BAR; }
  { LDB(B0, 1, 0); LDA(At, 1, 0); WAIT_V(2); BAR; WAIT_L(0); MMA(0, 0, At, B0); BAR;
    LDB(B1, 1, 1); WAIT_V(0); BAR; WAIT_L(0); MMA(0, 1, At, B1); BAR;
    LDA(At, 1, 1); BAR; WAIT_L(0); MMA(1, 0, At, B0); MMA(1, 1, At, B1); BAR; }
  if (wr == 0) BAR;
  __syncthreads();
  int t2 = tid; asm volatile("" : "+v"(t2));
  const int wid2 = t2 >> 6, lane2 = t2 & 63, wr2 = wid2 >> 2, wc2 = wid2 & 3, fr2 = lane2 & 15, fq2 = lane2 >> 4;
  bf16_t* wl = (bf16_t*)(smem + wid2 * EPI_WAVE_BYTES);
  bf16_t* wlp = (bf16_t*)(smem + (wid2 & ~1) * EPI_WAVE_BYTES);
  float sqv[2][2] = {{0.f, 0.f}, {0.f, 0.f}};
  if (EPI == EPI_MLA_IN || EPI == EPI_KVUP || EPI == EPI_QUP) {
    const float* SQ = (const float*)(p.ws + OFF_SSQ) + (EPI == EPI_MLA_IN ? 0 : (EPI == EPI_KVUP ? T : 2 * T));
#pragma unroll
    for (int bj = 0; bj < 2; ++bj)
#pragma unroll
      for (int n = 0; n < 2; ++n) sqv[bj][n] = SQ[bcol + bj * 128 + wc2 * 32 + n * 16 + fr2];
  }
  f32x4 csv[2][2], snv[2][2];
#pragma unroll
  for (int bj = 0; bj < 2; ++bj)
#pragma unroll
    for (int n = 0; n < 2; ++n) { csv[bj][n] = (f32x4){0.f, 0.f, 0.f, 0.f}; snv[bj][n] = (f32x4){0.f, 0.f, 0.f, 0.f}; }
  if (EPI == EPI_QUP) {
    const float* COS = (const float*)(p.ws + OFF_COS); const float* SIN = (const float*)(p.ws + OFF_SIN);
#pragma unroll
    for (int bj = 0; bj < 2; ++bj)
#pragma unroll
      for (int n = 0; n < 2; ++n) {
        const size_t t = (size_t)(bcol + bj * 128 + wc2 * 32 + n * 16 + fr2);
        csv[bj][n] = *(const f32x4*)(COS + t * 16 + fq2 * 4); snv[bj][n] = *(const f32x4*)(SIN + t * 16 + fq2 * 4);
      }
  }
  float4 rrb[2][8];
  const float* residp = (EPI == EPI_OUT1) ? p.x : (const float*)(p.ws + OFF_XT);
  if (EPI == EPI_OUT1 || EPI == EPI_OUT2) resid_preload(residp + (size_t)(bcol + wc2 * 32) * DM + brow + wr2 * 64, lane2, rrb[0]);
#pragma unroll
  for (int ai = 0; ai < 2; ++ai)
#pragma unroll
    for (int bj = 0; bj < 2; ++bj) {
      const int k = ai * 2 + bj;
      if ((EPI == EPI_OUT1 || EPI == EPI_OUT2) && k < 3) {
        const int ai1 = (k + 1) >> 1, bj1 = (k + 1) & 1;
        resid_preload(residp + (size_t)(bcol + bj1 * 128 + wc2 * 32) * DM + brow + ai1 * 128 + wr2 * 64, lane2, rrb[(k + 1) & 1]);
      }
      epilogue_block<EPI>(p, acc[ai][bj], brow + ai * 128 + wr2 * 64, bcol + bj * 128 + wc2 * 32, wl, wlp, wc2 & 1, lane2, fr2, fq2, sqv[bj], csv[bj], snv[bj], rrb[k & 1]);
    }
  __syncthreads();
#undef SA
#undef SB
#undef STAGE
#undef LDA
#undef LDB
#undef MMA
#undef WAIT_V
#undef WAIT_L
#undef BAR
#undef SCHED
}

template <int EPI, int K>
DI void gemm_phase(const Params& p, const bf16_t* Wt, const bf16_t* X, int ntn, unsigned char* smem) {
  const bool xa = (gridDim.x == 256);
  const int xcd = blockIdx.x & 7, li = blockIdx.x >> 3;
  const int per_half = 4 * ntn;
  const int start = xa ? li : (int)blockIdx.x, step = xa ? 32 : (int)gridDim.x, total = ntn * (xa ? 8 : 64);
  for (int t = start; t < total; t += step) {
    int tm, tn;
    if (xa) { const int h = t / per_half, tp = t - h * per_half; tn = tp >> 2; tm = xcd * 8 + h * 4 + (tp & 3); }
    else { tm = t / ntn; tn = t % ntn; }
    gemm_tile<EPI, K>(p, Wt, X, tn * 256, tm * 256, smem);
  }
}

DI void conv8_load(const bf16_t* rp, bool has_prev, uint4& cur, uint2& prv) {
  cur = *(const uint4*)rp; prv = make_uint2(0u, 0u);
  if (has_prev) prv = *(const uint2*)(rp - 4);
}
DI float fast_silu(float v) { return v * __builtin_amdgcn_rcpf(1.f + __expf(-v)); }
DI void conv8_compute(const uint4 cur, const uint2 prv, float w0, float w1, float w2, float w3, float bias, float (&out)[8]) {
  float r[11];
  r[0] = hi16(prv.x); r[1] = lo16(prv.y); r[2] = hi16(prv.y);
  r[3] = lo16(cur.x); r[4] = hi16(cur.x); r[5] = lo16(cur.y); r[6] = hi16(cur.y); r[7] = lo16(cur.z); r[8] = hi16(cur.z); r[9] = lo16(cur.w); r[10] = hi16(cur.w);
#pragma unroll
  for (int j = 0; j < 8; ++j) out[j] = fast_silu(bias + w0 * r[j] + w1 * r[j + 1] + w2 * r[j + 2] + w3 * r[j + 3]);
}
DI void conv8(const bf16_t* rp, bool has_prev, float w0, float w1, float w2, float w3, float bias, float (&out)[8]) {
  uint4 cur; uint2 prv; conv8_load(rp, has_prev, cur, prv); conv8_compute(cur, prv, w0, w1, w2, w3, bias, out);
}
DI bf16x8 pack8(const float (&v)[8]) {
  uint4 u; u.x = pk2(v[0], v[1]); u.y = pk2(v[2], v[3]); u.z = pk2(v[4], v[5]); u.w = pk2(v[6], v[7]);
  return __builtin_bit_cast(bf16x8, u);
}
DI void chunk_cumsum(const float* __restrict__ DTp, size_t tk0, int hd, float A, int lane, float (&d4)[4], float (&c4)[4], float& last) {
#pragma unroll
  for (int i = 0; i < 4; ++i) d4[i] = DTp[(tk0 + 4 * lane + i) * 32 + hd];
  c4[0] = d4[0] * A; c4[1] = c4[0] + d4[1] * A; c4[2] = c4[1] + d4[2] * A; c4[3] = c4[2] + d4[3] * A;
  const float tot = c4[3];
  float sum = tot, ex = 0.f, t;
  t = swz_xor<1>(sum);  if (lane & 1) ex += t;  sum += t;
  t = swz_xor<2>(sum);  if (lane & 2) ex += t;  sum += t;
  t = swz_xor<4>(sum);  if (lane & 4) ex += t;  sum += t;
  t = swz_xor<8>(sum);  if (lane & 8) ex += t;  sum += t;
  t = swz_xor<16>(sum); if (lane & 16) ex += t; sum += t;
  t = __shfl_xor(sum, 32); if (lane & 32) ex += t; sum += t;
#pragma unroll
  for (int i = 0; i < 4; ++i) c4[i] += ex;
  last = sum;
}

constexpr int BT_ROW = 264;
constexpr int CN_ROW = 136;

DI void phase_ssd_state(const Params& p, unsigned char* smem) {
  const bf16_t* XT = (const bf16_t*)(p.ws + OFF_XT); const bf16_t* BT = (const bf16_t*)(p.ws + OFF_BT); const float* DTp = (const float*)(p.ws + OFF_DT);
  float* ST = (float*)(p.ws + OFF_ST); float* DEC = (float*)(p.ws + OFF_DEC);
  bf16_t* BTs = (bf16_t*)smem; float* wgt = (float*)(smem + 128 * BT_ROW * 2);
  const int tid = otid(), lane = tid & 63, w = tid >> 6, l31 = lane & 31, lh = lane >> 5;
  for (int u = blockIdx.x; u < 256; u += gridDim.x) {
    const int b = u >> 7, c = (u >> 2) & 31, g = u & 3; const int hd = 8 * g + w;
    bf16_t* XTC = (bf16_t*)(p.ws + (b ? OFF_ST + 32 * MiB : OFF_XN));
    {
      float d4[4], c4[4], last; chunk_cumsum(DTp, (size_t)b * SEQ + c * 256, hd, -__expf(p.A_log[hd]), lane, d4, c4, last);
      float4 o = {__expf(last - c4[0]) * d4[0], __expf(last - c4[1]) * d4[1], __expf(last - c4[2]) * d4[2], __expf(last - c4[3]) * d4[3]};
      *(float4*)(wgt + w * 256 + 4 * lane) = o;
      if (lane == 0) DEC[(b * 32 + c) * 32 + hd] = __expf(last);
    }
#pragma unroll 2
    for (int i = 0; i < 8; ++i) {
      const int chunk = tid + 512 * i; const int s8 = (chunk & 31) * 8, n = chunk >> 5; const int ch = 2048 + g * 128 + n;
      float v[8];
      conv8(BT + ((size_t)(b * 512 + g * 128 + n)) * SEQ + c * 256 + s8, !(c == 0 && s8 == 0),
            p.conv_w[ch], p.conv_w[3072 + ch], p.conv_w[2 * 3072 + ch], p.conv_w[3 * 3072 + ch], p.conv_b[ch], v);
      *(bf16x8*)(BTs + n * BT_ROW + s8) = pack8(v);
    }
    __syncthreads();
    f32x16 acc[2][4];
#pragma unroll
    for (int a = 0; a < 2; ++a)
#pragma unroll
      for (int q = 0; q < 4; ++q)
#pragma unroll
        for (int i = 0; i < 16; ++i) acc[a][q][i] = 0.f;
    float xw[2][4], xb[2];
#pragma unroll
    for (int pt = 0; pt < 2; ++pt) {
      const int ch = hd * 64 + pt * 32 + l31;
#pragma unroll
      for (int k = 0; k < 4; ++k) xw[pt][k] = p.conv_w[k * 3072 + ch];
      xb[pt] = p.conv_b[ch];
    }
    for (int kb = 0; kb < 16; kb += 2) {
      uint4 rc[2][2]; uint2 rp[2][2];
#pragma unroll
      for (int i = 0; i < 2; ++i)
#pragma unroll
        for (int pt = 0; pt < 2; ++pt) {
          const int s0 = (kb + i) * 16 + 8 * lh;
          conv8_load(XT + ((size_t)(b * 2048 + hd * 64 + pt * 32 + l31)) * SEQ + c * 256 + s0, !(c == 0 && s0 == 0), rc[i][pt], rp[i][pt]);
        }
#pragma unroll
      for (int i = 0; i < 2; ++i) {
        const int ks = kb + i; const int s0 = ks * 16 + 8 * lh;
        const float4 g0 = *(const float4*)(wgt + w * 256 + s0), g1 = *(const float4*)(wgt + w * 256 + s0 + 4);
        const float wg[8] = {g0.x, g0.y, g0.z, g0.w, g1.x, g1.y, g1.z, g1.w};
        bf16x8 afr[2];
#pragma unroll
        for (int pt = 0; pt < 2; ++pt) {
          float v[8];
          conv8_compute(rc[i][pt], rp[i][pt], xw[pt][0], xw[pt][1], xw[pt][2], xw[pt][3], xb[pt], v);
          *(bf16x8*)(XTC + ((size_t)(hd * 64 + pt * 32 + l31)) * SEQ + c * 256 + s0) = pack8(v);
#pragma unroll
          for (int j = 0; j < 8; ++j) v[j] *= wg[j];
          afr[pt] = pack8(v);
        }
#pragma unroll
        for (int nt = 0; nt < 4; ++nt) {
          const bf16x8 bfr = *(const bf16x8*)(BTs + (nt * 32 + l31) * BT_ROW + ks * 16 + 8 * lh);
#pragma unroll
          for (int pt = 0; pt < 2; ++pt) acc[pt][nt] = MFMA32(afr[pt], bfr, acc[pt][nt]);
        }
      }
    }
    bf16_t* Sp = (bf16_t*)ST + (((size_t)(b * 32 + c) * 32 + hd) * 64) * 128;
#pragma unroll
    for (int pt = 0; pt < 2; ++pt)
#pragma unroll
      for (int nt = 0; nt < 4; ++nt)
#pragma unroll
        for (int r = 0; r < 16; ++r) Sp[(pt * 32 + (r & 3) + 8 * (r >> 2) + 4 * lh) * 128 + nt * 32 + l31] = f2bf(acc[pt][nt][r]);
    __syncthreads();
  }
}

DI void phase_ssd_scan(const Params& p) {
  bf16_t* ST = (bf16_t*)(p.ws + OFF_ST); const float* DEC = (const float*)(p.ws + OFF_DEC);
  for (int idx = blockIdx.x * NTHREADS + otid(); idx < 131072; idx += gridDim.x * NTHREADS) {
    const int n4 = idx & 31, pp = (idx >> 5) & 63, h = (idx >> 11) & 31, b = idx >> 16;
    float run[4] = {0.f, 0.f, 0.f, 0.f};
    bf16_t* base = ST + (((size_t)(b * 32) * 32 + h) * 64 + pp) * 128 + n4 * 4;
    const float* dbase = DEC + (b * 32) * 32 + h;
    for (int c0 = 0; c0 < 32; c0 += 16) {
      uint2 loc[16]; float d[16];
#pragma unroll
      for (int i = 0; i < 16; ++i) { loc[i] = *(const uint2*)(base + (size_t)(c0 + i) * (32 * 64 * 128)); d[i] = dbase[(c0 + i) * 32]; }
#pragma unroll
      for (int i = 0; i < 16; ++i) {
        uint2 o; o.x = pk2(run[0], run[1]); o.y = pk2(run[2], run[3]);
        *(uint2*)(base + (size_t)(c0 + i) * (32 * 64 * 128)) = o;
        run[0] = run[0] * d[i] + lo16(loc[i].x); run[1] = run[1] * d[i] + hi16(loc[i].x);
        run[2] = run[2] * d[i] + lo16(loc[i].y); run[3] = run[3] * d[i] + hi16(loc[i].y);
      }
    }
  }
}

DI void stage_tokmajor(const Params& p, const bf16_t* __restrict__ RAW, int b, int tok0, int nrows, int g, int cbase, bf16_t* dst, int tid_) {
  const int tid = otid(); (void)tid_;
  const int n8 = (tid & 15) * 8; const int ch = cbase + g * 128 + n8;
  float cw[4][8], cb[8];
#pragma unroll
  for (int k = 0; k < 4; ++k) {
    const float4 a = *(const float4*)(p.conv_w + k * 3072 + ch), bq = *(const float4*)(p.conv_w + k * 3072 + ch + 4);
    cw[k][0] = a.x; cw[k][1] = a.y; cw[k][2] = a.z; cw[k][3] = a.w; cw[k][4] = bq.x; cw[k][5] = bq.y; cw[k][6] = bq.z; cw[k][7] = bq.w;
  }
  { const float4 a = *(const float4*)(p.conv_b + ch), bq = *(const float4*)(p.conv_b + ch + 4);
    cb[0] = a.x; cb[1] = a.y; cb[2] = a.z; cb[3] = a.w; cb[4] = bq.x; cb[5] = bq.y; cb[6] = bq.z; cb[7] = bq.w; }
  for (int t = tid >> 4; t < nrows; t += 64) {
    uint4 r[2][4];
#pragma unroll
    for (int u = 0; u < 2; ++u)
#pragma unroll
      for (int k = 0; k < 4; ++k) {
        const int tk = tok0 + t + 32 * u - 3 + k;
        r[u][k] = make_uint4(0u, 0u, 0u, 0u);
        if (tk >= 0) r[u][k] = *(const uint4*)(RAW + ((size_t)b * SEQ + tk) * 512 + g * 128 + n8);
      }
#pragma unroll
    for (int u = 0; u < 2; ++u) {
      float acc[8];
#pragma unroll
      for (int j = 0; j < 8; ++j) acc[j] = cb[j];
#pragma unroll
      for (int k = 0; k < 4; ++k) {
        const uint4 q = r[u][k];
        acc[0] += cw[k][0] * lo16(q.x); acc[1] += cw[k][1] * hi16(q.x); acc[2] += cw[k][2] * lo16(q.y); acc[3] += cw[k][3] * hi16(q.y);
        acc[4] += cw[k][4] * lo16(q.z); acc[5] += cw[k][5] * hi16(q.z); acc[6] += cw[k][6] * lo16(q.w); acc[7] += cw[k][7] * hi16(q.w);
      }
#pragma unroll
      for (int j = 0; j < 8; ++j) acc[j] = fast_silu(acc[j]);
      *(bf16x8*)(dst + (t + 32 * u) * CN_ROW + n8) = pack8(acc);
    }
  }
}

constexpr int S3_CS = 0, S3_BS = 64 * CN_ROW * 2, S3_CB = S3_BS + 256 * CN_ROW * 2, S3_CUM = S3_CB + 64 * BT_ROW * 2, S3_DTS = S3_CUM + 8192,
              S3_PART = S3_DTS + 8192, S3_RSTD = S3_PART + 2048, S3_END = S3_RSTD + 256;

DI void phase_ssd_out(const Params& p, unsigned char* smem) {
  const bf16_t* XT = (const bf16_t*)(p.ws + OFF_XT); const bf16_t* BR = (const bf16_t*)(p.ws + OFF_BR); const bf16_t* CR = (const bf16_t*)(p.ws + OFF_CR);
  const float* DTp = (const float*)(p.ws + OFF_DT); const float* ST = (const float*)(p.ws + OFF_ST); bf16_t* Z = (bf16_t*)p.out;
  bf16_t* Cs = (bf16_t*)(smem + S3_CS); bf16_t* Bs = (bf16_t*)(smem + S3_BS); bf16_t* CBs = (bf16_t*)(smem + S3_CB);
  float* cumA = (float*)(smem + S3_CUM); float* dts = (float*)(smem + S3_DTS); float* part = (float*)(smem + S3_PART); float* rstd = (float*)(smem + S3_RSTD);
  const int tid = otid(), lane = tid & 63, w = tid >> 6, l31 = lane & 31, lh = lane >> 5;
  const bool persist = (gridDim.x == 256);
  for (int u = blockIdx.x; u < 1024; u += gridDim.x) {
    const int tq = u >> 8, rest = u & 255; const int b = rest >> 7, c = (rest >> 2) & 31, g = rest & 3; const int hd = 8 * g + w;
    const int ns = (tq + 1) * 64;
    if (!persist || tq == 0) {
      float d4[4], c4[4], last; chunk_cumsum(DTp, (size_t)b * SEQ + c * 256, hd, -__expf(p.A_log[hd]), lane, d4, c4, last);
      *(float4*)(cumA + w * 256 + 4 * lane) = make_float4(c4[0], c4[1], c4[2], c4[3]);
      *(float4*)(dts + w * 256 + 4 * lane) = make_float4(d4[0], d4[1], d4[2], d4[3]);
    }
    stage_tokmajor(p, CR, b, c * 256 + tq * 64, 64, g, 2560, Cs, tid);
    { const int r0 = persist ? tq * 64 : 0; stage_tokmajor(p, BR, b, c * 256 + r0, ns - r0, g, 2048, Bs + r0 * CN_ROW, tid); }
    __syncthreads();
    if (32 * w < ns) {
      f32x16 a2[2];
#pragma unroll
      for (int a = 0; a < 2; ++a)
#pragma unroll
        for (int i = 0; i < 16; ++i) a2[a][i] = 0.f;
#pragma unroll
      for (int ks = 0; ks < 8; ++ks) {
        const bf16x8 af = *(const bf16x8*)(Bs + (32 * w + l31) * CN_ROW + ks * 16 + 8 * lh);
#pragma unroll
        for (int tt = 0; tt < 2; ++tt) {
          const bf16x8 bq = *(const bf16x8*)(Cs + (tt * 32 + l31) * CN_ROW + ks * 16 + 8 * lh);
          a2[tt] = MFMA32(af, bq, a2[tt]);
        }
      }
#pragma unroll
      for (int tt = 0; tt < 2; ++tt)
#pragma unroll
        for (int rg = 0; rg < 4; ++rg) {
          uint2 o; o.x = pk2(a2[tt][4 * rg], a2[tt][4 * rg + 1]); o.y = pk2(a2[tt][4 * rg + 2], a2[tt][4 * rg + 3]);
          *(uint2*)(CBs + (tt * 32 + l31) * BT_ROW + 32 * w + 8 * rg + 4 * lh) = o;
        }
    }
    __syncthreads();
    f32x16 acc[2][2];
#pragma unroll
    for (int a = 0; a < 2; ++a)
#pragma unroll
      for (int q = 0; q < 2; ++q)
#pragma unroll
        for (int i = 0; i < 16; ++i) acc[a][q][i] = 0.f;
    {
      const bf16_t* Sp = (const bf16_t*)ST + (((size_t)(b * 32 + c) * 32 + hd) * 64) * 128;
      for (int kb = 0; kb < 8; kb += 4) {
        bf16x8 bfr[4][2];
#pragma unroll
        for (int i = 0; i < 4; ++i)
#pragma unroll
          for (int pt = 0; pt < 2; ++pt) bfr[i][pt] = *(const bf16x8*)(Sp + (pt * 32 + l31) * 128 + (kb + i) * 16 + 8 * lh);
#pragma unroll
        for (int i = 0; i < 4; ++i) {
          const int ks = kb + i;
#pragma unroll
          for (int tt = 0; tt < 2; ++tt) {
            const bf16x8 af = *(const bf16x8*)(Cs + (tt * 32 + l31) * CN_ROW + ks * 16 + 8 * lh);
#pragma unroll
            for (int pt = 0; pt < 2; ++pt) acc[tt][pt] = MFMA32(af, bfr[i][pt], acc[tt][pt]);
          }
        }
      }
#pragma unroll
      for (int tt = 0; tt < 2; ++tt)
#pragma unroll
        for (int r = 0; r < 16; ++r) {
          const float e = __expf(cumA[w * 256 + tq * 64 + tt * 32 + (r & 3) + 8 * (r >> 2) + 4 * lh]);
          acc[tt][0][r] *= e; acc[tt][1][r] *= e;
        }
    }
    {
      const float Dh = p.Dskip[hd];
      const int tl0 = tq * 64 + l31, tl1 = tq * 64 + 32 + l31;
      const float ct0 = cumA[w * 256 + tl0], ct1 = cumA[w * 256 + tl1];
      const bf16_t* XTC = (const bf16_t*)(p.ws + (b ? OFF_ST + 32 * MiB : OFF_XN)) + ((size_t)(hd * 64 + l31)) * SEQ + c * 256 + 8 * lh;
      const int nks = ns >> 4;
      for (int kb = 0; kb < nks; kb += 4) {
        bf16x8 xq[4][2];
#pragma unroll
        for (int i = 0; i < 4; ++i)
#pragma unroll
          for (int pt = 0; pt < 2; ++pt) xq[i][pt] = *(const bf16x8*)(XTC + (size_t)pt * 32 * SEQ + (kb + i) * 16);
#pragma unroll
        for (int i = 0; i < 4; ++i) {
          const int ks = kb + i; const int s0 = ks * 16 + 8 * lh;
          const float4 c0 = *(const float4*)(cumA + w * 256 + s0), c1 = *(const float4*)(cumA + w * 256 + s0 + 4);
          const float4 d0 = *(const float4*)(dts + w * 256 + s0), d1 = *(const float4*)(dts + w * 256 + s0 + 4);
          const float cs[8] = {c0.x, c0.y, c0.z, c0.w, c1.x, c1.y, c1.z, c1.w};
          const float ds[8] = {d0.x, d0.y, d0.z, d0.w, d1.x, d1.y, d1.z, d1.w};
          const float cref = cumA[w * 256 + ks * 16];
          const bool steep = (cref - cumA[w * 256 + ks * 16 + 15]) > 60.f;
          float Fs[8];
#pragma unroll
          for (int j = 0; j < 8; ++j) Fs[j] = __expf(fminf(cref - cs[j], 64.f)) * ds[j];
#pragma unroll
          for (int tt = 0; tt < 2; ++tt) {
            if (ks * 16 <= tq * 64 + tt * 32 + 31) {
              const int tl = tt ? tl1 : tl0; const float ct = tt ? ct1 : ct0;
              const float Et = __expf(fminf(ct - cref, 0.f));
              const uint4 cbv = *(const uint4*)(CBs + (tt * 32 + l31) * BT_ROW + s0);
              const float cb[8] = {lo16(cbv.x), hi16(cbv.x), lo16(cbv.y), hi16(cbv.y), lo16(cbv.z), hi16(cbv.z), lo16(cbv.w), hi16(cbv.w)};
              float mv[8];
              if (steep) {
#pragma unroll
                for (int j = 0; j < 8; ++j) {
                  const int sidx = s0 + j;
                  float v = cb[j] * __expf(fminf(ct - cs[j], 0.f)) * ds[j];
                  v = (sidx <= tl) ? v : 0.f;
                  if (sidx == tl) v += Dh;
                  mv[j] = v;
                }
              } else if (ks * 16 + 15 > tq * 64 + tt * 32) {
#pragma unroll
                for (int j = 0; j < 8; ++j) {
                  const int sidx = s0 + j;
                  float v = cb[j] * (Et * Fs[j]);
                  v = (sidx <= tl) ? v : 0.f;
                  if (sidx == tl) v += Dh;
                  mv[j] = v;
                }
              } else {
#pragma unroll
                for (int j = 0; j < 8; ++j) mv[j] = cb[j] * (Et * Fs[j]);
              }
              const bf16x8 af = pack8(mv);
#pragma unroll
              for (int pt = 0; pt < 2; ++pt) acc[tt][pt] = MFMA32(af, xq[i][pt], acc[tt][pt]);
            }
          }
        }
      }
    }
    const size_t tokb = (size_t)b * SEQ + c * 256 + tq * 64;
#pragma unroll
    for (int tt = 0; tt < 2; ++tt)
#pragma unroll
      for (int r = 0; r < 16; ++r) {
        const int tloc = tt * 32 + (r & 3) + 8 * (r >> 2) + 4 * lh;
        const bf16_t* zp = Z + (tokb + tloc) * 2048 + hd * 64 + l31;
        const float y0 = acc[tt][0][r] * silu_f(bf2f(zp[0])), y1 = acc[tt][1][r] * silu_f(bf2f(zp[32]));
        acc[tt][0][r] = y0; acc[tt][1][r] = y1;
        float v = y0 * y0 + y1 * y1;
        v += swz_xor<1>(v); v += swz_xor<2>(v); v += swz_xor<4>(v); v += swz_xor<8>(v); v += swz_xor<16>(v);
        if (l31 == 0) part[w * 64 + tloc] = v;
      }
    __syncthreads();
    if (tid < 64) {
      float sres = 0.f;
#pragma unroll
      for (int ww = 0; ww < 8; ++ww) sres += part[ww * 64 + tid];
      rstd[tid] = rsqrtf(sres * (1.f / 512.f) + 1e-6f);
    }
    __syncthreads();
#pragma unroll
    for (int tt = 0; tt < 2; ++tt)
#pragma unroll
      for (int r = 0; r < 16; ++r) {
        const int tloc = tt * 32 + (r & 3) + 8 * (r >> 2) + 4 * lh;
        const float rs = rstd[tloc];
        bf16_t* zp = Z + (tokb + tloc) * 2048 + hd * 64 + l31;
        zp[0] = f2bf(acc[tt][0][r] * rs); zp[32] = f2bf(acc[tt][1][r] * rs);
      }
    __syncthreads();
  }
}

constexpr int KROW = 104;
constexpr int VROW = 68;
constexpr int ATT_K_BYTES = 64 * KROW * 2;
constexpr int ATT_V_BYTES = 64 * VROW * 2;
constexpr int ATT_STAGE = ATT_K_BYTES + ATT_V_BYTES;

DI void attn_kload(const bf16_t* sK, bf16x8 (&kf)[2][6], int l31, int lh) {
#pragma unroll
  for (int sub = 0; sub < 2; ++sub)
#pragma unroll
    for (int ks = 0; ks < 6; ++ks) kf[sub][ks] = *(const bf16x8*)(sK + (sub * 32 + l31) * KROW + ks * 16 + lh * 8);
}
DI void attn_qkmma(const bf16x8 (&kf)[2][6], const bf16x8 (&qf)[6], f32x16 (&sc)[2]) {
#pragma unroll
  for (int sub = 0; sub < 2; ++sub)
#pragma unroll
    for (int i = 0; i < 16; ++i) sc[sub][i] = 0.f;
#pragma unroll
  for (int ks = 0; ks < 6; ++ks)
#pragma unroll
    for (int sub = 0; sub < 2; ++sub) sc[sub] = MFMA32(kf[sub][ks], qf[ks], sc[sub]);
}
DI void attn_qk(const bf16_t* sK, const bf16x8 (&qf)[6], f32x16 (&sc)[2], int l31, int lh) {
  bf16x8 kf[2][6]; attn_kload(sK, kf, l31, lh); attn_qkmma(kf, qf, sc);
}

template <bool MASK>
DI void attn_softmax(f32x16 (&sc)[2], f32x16 (&o)[2], float& m, float& l, int kt, int myq, int lh) {
  float tmax = -1e30f;
#pragma unroll
  for (int sub = 0; sub < 2; ++sub)
#pragma unroll
    for (int r = 0; r < 16; ++r) {
      if (MASK) { const int key = kt * 64 + sub * 32 + (r & 3) + 8 * (r >> 2) + 4 * lh; if (key > myq) sc[sub][r] = -1e30f; }
      tmax = fmaxf(tmax, sc[sub][r]);
    }
  tmax = fmaxf(tmax, __shfl_xor(tmax, 32));
  if (__builtin_amdgcn_ballot_w64(tmax - m > 8.f) != 0) {
    const float mn = fmaxf(m, tmax); const float al = __builtin_amdgcn_exp2f(m - mn); m = mn;
    l *= al;
#pragma unroll
    for (int a = 0; a < 2; ++a)
#pragma unroll
      for (int i = 0; i < 16; ++i) o[a][i] *= al;
  }
  f32x2 ps2 = {0.f, 0.f}; const f32x2 mn2 = {m, m};
#pragma unroll
  for (int sub = 0; sub < 2; ++sub)
#pragma unroll
    for (int r = 0; r < 16; r += 2) {
      f32x2 d = {sc[sub][r], sc[sub][r + 1]}; d = d - mn2;
      f32x2 pe; pe.x = __builtin_amdgcn_exp2f(d.x); pe.y = __builtin_amdgcn_exp2f(d.y);
      sc[sub][r] = pe.x; sc[sub][r + 1] = pe.y; ps2 = ps2 + pe;
    }
  l += ps2.x + ps2.y;
}
DI void attn_pv(const f32x16 (&sc)[2], f32x16 (&o)[2], const bf16_t* sV, int l31, int lh) {
#pragma unroll
  for (int sub = 0; sub < 2; ++sub)
#pragma unroll
    for (int s2 = 0; s2 < 2; ++s2) {
      uint4 pu; pu.x = pk2(sc[sub][8 * s2], sc[sub][8 * s2 + 1]); pu.y = pk2(sc[sub][8 * s2 + 2], sc[sub][8 * s2 + 3]);
      pu.z = pk2(sc[sub][8 * s2 + 4], sc[sub][8 * s2 + 5]); pu.w = pk2(sc[sub][8 * s2 + 6], sc[sub][8 * s2 + 7]);
      const bf16x8 pb = __builtin_bit_cast(bf16x8, pu);
#pragma unroll
      for (int dvt = 0; dvt < 2; ++dvt) {
        const bf16_t* vp = sV + (dvt * 32 + l31) * VROW + sub * 32 + 16 * s2 + 4 * lh;
        const uint2 lo = *(const uint2*)vp, hi = *(const uint2*)(vp + 8);
        uint4 vu = {lo.x, lo.y, hi.x, hi.y};
        o[dvt] = MFMA32(__builtin_bit_cast(bf16x8, vu), pb, o[dvt]);
      }
    }
}

DI void attn_unit(const Params& p, int b, int h, int qb, unsigned char* smem) {
  const bf16_t* Q = (const bf16_t*)p.out; const bf16_t* KN = (const bf16_t*)(p.ws + OFF_XN); const bf16_t* VT = (const bf16_t*)(p.ws + OFF_BT);
  const bf16_t* KROPE = (const bf16_t*)(p.ws + OFF_DEC); const bf16_t* GATE = (const bf16_t*)(p.ws + OFF_ST); bf16_t* O = (bf16_t*)(p.ws + OFF_ST + 32 * MiB);
  const int tid = otid(), lane = tid & 63, w = tid >> 6, l31 = lane & 31, lh = lane >> 5;
  const int q0 = qb * 256, qw0 = q0 + 32 * w, myq = qw0 + l31;
  const size_t tq = (size_t)b * SEQ + myq;
  bf16x8 qf[6];
#pragma unroll
  for (int ks = 0; ks < 6; ++ks) qf[ks] = *(const bf16x8*)(Q + tq * 1536 + h * 96 + ks * 16 + lh * 8);
  f32x16 o[2];
#pragma unroll
  for (int a = 0; a < 2; ++a)
#pragma unroll
    for (int i = 0; i < 16; ++i) o[a][i] = 0.f;
  float m = -1e30f, l = 0.f;
  const int ntiles = 4 * qb + 4;
  const int nact = (qw0 + 31) / 64 + 1;
  const int kr = tid >> 3, kc = (tid & 7) * 8;
  const int rr = (tid & 255) >> 2, rc = (tid & 3) * 8;
  const bf16_t* gK = KN + ((size_t)b * SEQ + kr) * 1024 + h * 64 + kc;
  const bf16_t* gR = KROPE + ((size_t)b * SEQ + rr) * 32 + rc;
  const bf16_t* gV = VT + ((size_t)((b * 16 + h) * 64 + kr)) * SEQ + kc;
  uint4 rk, rr4, rv;
#define ATT_LOAD(T) do { rk = *(const uint4*)(gK + (size_t)(T) * 64 * 1024); rr4 = *(const uint4*)(gR + (size_t)(T) * 64 * 32); rv = *(const uint4*)(gV + (T) * 64); } while (0)
#define ATT_STORE(ST_) do { bf16_t* dK_ = (bf16_t*)(smem + (ST_) * ATT_STAGE); bf16_t* dV_ = (bf16_t*)(smem + (ST_) * ATT_STAGE + ATT_K_BYTES); \
    *(uint4*)(dK_ + kr * KROW + kc) = rk; *(uint4*)(dK_ + rr * KROW + 64 + rc) = rr4; \
    *(uint2*)(dV_ + kr * VROW + kc) = make_uint2(rv.x, rv.y); *(uint2*)(dV_ + kr * VROW + kc + 4) = make_uint2(rv.z, rv.w); } while (0)
  ATT_LOAD(0); ATT_STORE(0);
  ATT_LOAD(1); ATT_STORE(1);
  ATT_LOAD(2);
  __syncthreads();
  f32x16 sc[2], sn[2];
  attn_qk((const bf16_t*)smem, qf, sc, l31, lh);
  int st = 0;
  int kt = 0;
  for (; kt < nact - 1; ++kt) {
    const int st1 = (st == 2) ? 0 : st + 1, st2 = (st1 == 2) ? 0 : st1 + 1;
    ATT_STORE(st2);
    { const int tl = (kt + 3 < ntiles) ? kt + 3 : ntiles - 1; ATT_LOAD(tl); }
    attn_qk((const bf16_t*)(smem + st1 * ATT_STAGE), qf, sn, l31, lh);
    attn_softmax<false>(sc, o, m, l, kt, myq, lh);
    attn_pv(sc, o, (const bf16_t*)(smem + st * ATT_STAGE + ATT_K_BYTES), l31, lh);
    __syncthreads();
#pragma unroll
    for (int sub = 0; sub < 2; ++sub) sc[sub] = sn[sub];
    st = st1;
  }
  uint2 gpre[2][4];
#pragma unroll
  for (int dvt = 0; dvt < 2; ++dvt)
#pragma unroll
    for (int rg = 0; rg < 4; ++rg) gpre[dvt][rg] = *(const uint2*)(GATE + tq * 1024 + h * 64 + dvt * 32 + 8 * rg + 4 * lh);
  {
    const int st1 = (st == 2) ? 0 : st + 1, st2 = (st1 == 2) ? 0 : st1 + 1;
    ATT_STORE(st2);
    { const int tl = (kt + 3 < ntiles) ? kt + 3 : ntiles - 1; ATT_LOAD(tl); }
    attn_softmax<true>(sc, o, m, l, kt, myq, lh);
    attn_pv(sc, o, (const bf16_t*)(smem + st * ATT_STAGE + ATT_K_BYTES), l31, lh);
    __syncthreads();
    st = st1; ++kt;
  }
  for (; kt < ntiles; ++kt) {
    const int st1 = (st == 2) ? 0 : st + 1, st2 = (st1 == 2) ? 0 : st1 + 1;
    ATT_STORE(st2);
    { const int tl = (kt + 3 < ntiles) ? kt + 3 : ntiles - 1; ATT_LOAD(tl); }
    __syncthreads();
    st = st1;
  }
#undef ATT_LOAD
#undef ATT_STORE
  l += __shfl_xor(l, 32);
  const float il = 1.f / l;
#pragma unroll
  for (int dvt = 0; dvt < 2; ++dvt)
#pragma unroll
    for (int rg = 0; rg < 4; ++rg) {
      const int dv = dvt * 32 + 8 * rg + 4 * lh;
      const uint2 gv = gpre[dvt][rg];
      const float g0 = __uint_as_float(gv.x << 16), g1 = __uint_as_float(gv.x & 0xffff0000u), g2 = __uint_as_float(gv.y << 16), g3 = __uint_as_float(gv.y & 0xffff0000u);
      uint2 ov; ov.x = pk2(o[dvt][4 * rg] * il * g0, o[dvt][4 * rg + 1] * il * g1); ov.y = pk2(o[dvt][4 * rg + 2] * il * g2, o[dvt][4 * rg + 3] * il * g3);
      *(uint2*)(O + tq * 1024 + h * 64 + dv) = ov;
    }
}

DI void phase_attn(const Params& p, unsigned char* smem) {
  for (int u = blockIdx.x; u < 512; u += gridDim.x) {
    int pu = u;
    if (gridDim.x == 256) {
      const int xcd = blockIdx.x & 7, li = blockIdx.x >> 3, r = u >> 8;
      pu = (r * 16 + xcd * 2 + (li >> 4)) * 16 + (li & 15);
    }
    const int bh = pu >> 4, x = pu & 15;
    for (int half = 0; half < 2; ++half) attn_unit(p, bh >> 4, bh & 15, half ? x : 31 - x, smem);
  }
}

DI void phase_final_norm(const Params& p) {
  const int tid = otid(); const int lane = tid & 63, w = tid >> 6;
  float4 g[4];
#pragma unroll
  for (int i = 0; i < 4; ++i) g[i] = ((const float4*)p.g_final)[lane + 64 * i];
  for (int row = (blockIdx.x * 8 + w) * 4; row < T; row += gridDim.x * 32) {
    float4 v[4][4]; float ss[4] = {0.f, 0.f, 0.f, 0.f};
#pragma unroll
    for (int u = 0; u < 4; ++u)
#pragma unroll
      for (int i = 0; i < 4; ++i) v[u][i] = ((const float4*)(p.out + (size_t)(row + u) * DM))[lane + 64 * i];
#pragma unroll
    for (int u = 0; u < 4; ++u) {
#pragma unroll
      for (int i = 0; i < 4; ++i) ss[u] += v[u][i].x * v[u][i].x + v[u][i].y * v[u][i].y + v[u][i].z * v[u][i].z + v[u][i].w * v[u][i].w;
      ss[u] = wave_sum(ss[u]);
      const float r = rsqrtf(ss[u] * (1.f / 1024.f) + 1e-6f);
#pragma unroll
      for (int i = 0; i < 4; ++i)
        ((float4*)(p.out + (size_t)(row + u) * DM))[lane + 64 * i] = make_float4(v[u][i].x * r * g[i].x, v[u][i].y * r * g[i].y, v[u][i].z * r * g[i].z, v[u][i].w * r * g[i].w);
    }
  }
}

__global__ void __launch_bounds__(NTHREADS) mega(Params p) {
  cg::grid_group grid = cg::this_grid();
  extern __shared__ __attribute__((aligned(16))) unsigned char smem[];
  unsigned char* ws = p.ws;
  __shared__ unsigned bar_st[4];
  if (threadIdx.x < 4) bar_st[threadIdx.x] = 0u;
  __syncthreads();
  const XcdBarrier xb = xcd_barrier_post((unsigned*)(ws + OFF_BAR), bar_st);
  const bool tailfill = (gridDim.x == 256);
  phase_prep(p, smem, blockIdx.x, tailfill ? 1344 : 2832, gridDim.x);
  if (!tailfill) phase_rope_tables(p, blockIdx.x, gridDim.x);
  phase_rmsnorm_rows(p.x, (bf16_t*)(ws + OFF_XN));
  if (p.out == nullptr) grid.sync();
  xcd_barrier(xb);
  gemm_phase<EPI_SSM_IN, 1024>(p, (const bf16_t*)(ws + OFF_W1), (const bf16_t*)(ws + OFF_XN), 21, smem);
  if (tailfill && (blockIdx.x >> 3) >= 8) {
    const int tj = (blockIdx.x & 7) * 24 + ((blockIdx.x >> 3) - 8);
    phase_prep(p, smem, 1344 + tj, 2832, 192);
    phase_rope_tables(p, tj, 192);
  }
  xcd_barrier(xb);
  phase_ssd_state(p, smem);
  xcd_barrier(xb);
  phase_ssd_scan(p);
  xcd_barrier(xb);
  phase_ssd_out(p, smem);
  xcd_barrier(xb);
  gemm_phase<EPI_OUT1, 2048>(p, (const bf16_t*)(ws + OFF_W2), (const bf16_t*)p.out, 4, smem);
  xcd_barrier(xb);
  gemm_phase<EPI_MLA_IN, 1024>(p, (const bf16_t*)(ws + OFF_W3), (const bf16_t*)(ws + OFF_XN), 7, smem);
  xcd_barrier(xb);
  gemm_phase<EPI_KVUP, 256>(p, (const bf16_t*)(ws + OFF_W4), (const bf16_t*)(ws + OFF_ST + 32 * MiB), 8, smem);
  gemm_phase<EPI_QUP, 384>(p, (const bf16_t*)(ws + OFF_W5), (const bf16_t*)(ws + OFF_ST + 40 * MiB), 6, smem);
  xcd_barrier(xb);
  phase_attn(p, smem);
  xcd_barrier(xb);
  gemm_phase<EPI_OUT2, 1024>(p, (const bf16_t*)(ws + OFF_W6), (const bf16_t*)(ws + OFF_ST + 32 * MiB), 4, smem);
  xcd_barrier(xb);
  phase_final_norm(p);
}

extern "C" void kernel_launch(void* const* d_in, const int* in_sizes, int n_in, void* d_out, int out_size, void* d_ws, size_t ws_size, hipStream_t stream) {
  static int grid = 0;
  if (grid == 0) {
    if (n_in != 20 || ws_size < WS_NEED) { fprintf(stderr, "kernel_launch: unexpected n_in %d / ws_size %zu\n", n_in, ws_size); grid = -1; return; }
    int dev = 0, cus = 0, per_cu = 0;
    hipGetDevice(&dev);
    hipDeviceGetAttribute(&cus, hipDeviceAttributeMultiprocessorCount, dev);
    if (hipFuncSetAttribute((const void*)mega, hipFuncAttributeMaxDynamicSharedMemorySize, LDS_BYTES) != hipSuccess) { fprintf(stderr, "hipFuncSetAttribute failed\n"); grid = -1; return; }
    hipOccupancyMaxActiveBlocksPerMultiprocessor(&per_cu, (const void*)mega, NTHREADS, LDS_BYTES);
    if (per_cu < 1) per_cu = 1;
    (void)hipGetLastError();
    grid = cus;
  }
  if (grid < 0) return;
  Params p{};
  p.x = (const float*)d_in[0]; p.pos = (const int*)d_in[1]; p.g_pre = (const float*)d_in[2]; p.ssm_w_in = (const float*)d_in[3];
  p.conv_w = (const float*)d_in[4]; p.conv_b = (const float*)d_in[5]; p.dt_bias = (const float*)d_in[6]; p.A_log = (const float*)d_in[7];
  p.Dskip = (const float*)d_in[8]; p.g_out = (const float*)d_in[9]; p.ssm_w_out = (const float*)d_in[10]; p.kv_g_in = (const float*)d_in[11];
  p.kv_w_down = (const float*)d_in[12]; p.kv_g_lat = (const float*)d_in[13]; p.kv_w_up = (const float*)d_in[14]; p.mla_w_in = (const float*)d_in[15];
  p.mla_g_q = (const float*)d_in[16]; p.mla_w_uq = (const float*)d_in[17]; p.mla_w_out = (const float*)d_in[18]; p.g_final = (const float*)d_in[19];
  p.out = (float*)d_out; p.ws = (unsigned char*)d_ws;
  if (hipMemsetAsync((char*)d_ws + OFF_BAR, 0, XCD_BAR_WORDS * sizeof(unsigned), stream) != hipSuccess) { fprintf(stderr, "memset of barrier words failed\n"); return; }
  void* args[] = {&p};
  hipError_t e = hipLaunchCooperativeKernel((const void*)mega, dim3(grid), dim3(NTHREADS), args, LDS_BYTES, stream);
  if (e != hipSuccess) fprintf(stderr, "cooperative launch failed: %s (grid %d)\n", hipGetErrorString(e), grid);
}
```
